# Optimizing an MI355X kernel written in HIP

```python
import jax, jax.numpy as jnp
from jax import lax
import numpy as np

D_MODEL = 2048
BATCH = 1
SEQ = 16384
DEPTH = 1

MIX_WIDTH = D_MODEL
ATTN_HEAD_DIM = 128
ATTN_WIDTH = MIX_WIDTH // 2
ATTN_HEADS = ATTN_WIDTH // ATTN_HEAD_DIM
HGRN_HEAD_DIM = 128
HGRN_WIDTH = MIX_WIDTH - ATTN_WIDTH
HGRN_HEADS = HGRN_WIDTH // HGRN_HEAD_DIM
IN_SPLITS = [ATTN_WIDTH, ATTN_WIDTH, ATTN_WIDTH, HGRN_WIDTH, HGRN_WIDTH, HGRN_WIDTH, HGRN_WIDTH]
IN_WIDTH = sum(IN_SPLITS)

MOBA_BLOCK = 256
MOBA_TOPK = 3
MOBA_QCHUNK = 64
HGRN_CHUNK = 64
PEER_HEADS = 8
PEER_N_KEYS = 128
PEER_N_EXPERTS = PEER_N_KEYS * PEER_N_KEYS
PEER_QUERY_DIM = 256
PEER_SUB_DIM = PEER_QUERY_DIM // 2
PEER_TOPK = 16
PEER_TOKEN_CHUNK = 128
PLE_DIM = 256
EPS = 1e-6

kernel_name = "hybrid_moba_hgrn2_peer_block"


def rms_norm(x, gain):
    xf = x.astype(jnp.float32)
    y = xf * lax.rsqrt(jnp.mean(xf * xf, axis=-1, keepdims=True) + EPS)
    return (y * gain.astype(jnp.float32)).astype(x.dtype)


def moba_attention(q, k, v):
    B, S, H, Dh = q.shape
    L = MOBA_BLOCK
    nb = -(-S // L)
    S_pad = nb * L
    pad = ((0, 0), (0, S_pad - S), (0, 0), (0, 0))
    q = jnp.pad(q, pad)
    k = jnp.pad(k, pad)
    v = jnp.pad(v, pad)
    kb = k.reshape(B, nb, L, H, Dh).transpose(0, 3, 1, 2, 4)
    vb = v.reshape(B, nb, L, H, Dh).transpose(0, 3, 1, 2, 4)
    qh = q.transpose(0, 2, 1, 3)
    k_mean = jnp.mean(kb.astype(jnp.float32), axis=3)
    gate = jnp.einsum('bhtd,bhnd->bhtn', qh.astype(jnp.float32), k_mean)
    q_blk = jnp.arange(S_pad) // L
    fully_past = jnp.arange(nb)[None, :] < q_blk[:, None]
    gate = jnp.where(fully_past, gate, -jnp.inf)
    k_sel = min(MOBA_TOPK, nb)
    _, sel = lax.top_k(gate, k_sel)
    sel_valid = sel < q_blk[:, None]
    scale = Dh ** -0.5
    Q = MOBA_QCHUNK
    n_chunks = S_pad // Q
    b_idx = jnp.arange(B)[:, None, None, None]
    h_idx = jnp.arange(H)[None, :, None, None]

    def chunk(c):
        start = c * Q
        qc = lax.dynamic_slice_in_dim(qh, start, Q, axis=2)
        sc = lax.dynamic_slice_in_dim(sel, start, Q, axis=2)
        vc = lax.dynamic_slice_in_dim(sel_valid, start, Q, axis=2)
        kg = kb[b_idx, h_idx, sc]
        vg = vb[b_idx, h_idx, sc]
        own = start // L
        k_own = lax.dynamic_index_in_dim(kb, own, axis=2, keepdims=False)
        v_own = lax.dynamic_index_in_dim(vb, own, axis=2, keepdims=False)
        s_sel = jnp.einsum('bhqd,bhqnld->bhqnl', qc, kg).astype(jnp.float32) * scale
        s_sel = jnp.where(vc[..., None], s_sel, -jnp.inf).reshape(B, H, Q, k_sel * L)
        s_own = jnp.einsum('bhqd,bhld->bhql', qc, k_own).astype(jnp.float32) * scale
        q_pos = start + jnp.arange(Q)
        k_pos = own * L + jnp.arange(L)
        s_own = jnp.where(k_pos[None, :] <= q_pos[:, None], s_own, -jnp.inf)
        probs = jax.nn.softmax(jnp.concatenate([s_sel, s_own], axis=-1), axis=-1).astype(q.dtype)
        p_sel = probs[..., :k_sel * L].reshape(B, H, Q, k_sel, L)
        p_own = probs[..., k_sel * L:]
        return (jnp.einsum('bhqnl,bhqnld->bhqd', p_sel, vg)
                + jnp.einsum('bhql,bhld->bhqd', p_own, v_own))

    out = lax.map(chunk, jnp.arange(n_chunks))
    out = out.transpose(1, 0, 3, 2, 4).reshape(B, S_pad, H * Dh)
    return out[:, :S]


def hgrn2(q, f_logit, i_in, g, lb, out_gain):
    B, S, H, K = q.shape
    dtype = q.dtype
    lbh = lb.astype(jnp.float32).reshape(H, K)
    f = lbh + (1.0 - lbh) * jax.nn.sigmoid(f_logit.astype(jnp.float32))
    log_f = jnp.log(f)
    kk = 1.0 - f
    qq = jax.nn.silu(q.astype(jnp.float32))
    vv = i_in.astype(jnp.float32)
    C = HGRN_CHUNK
    n = S // C

    def to_chunks(a):
        return a.reshape(B, n, C, H, K).transpose(1, 0, 3, 2, 4)

    qs, ks, vs = to_chunks(qq), to_chunks(kk), to_chunks(vv)
    bs = jnp.cumsum(to_chunks(log_f), axis=3)
    causal = jnp.tril(jnp.ones((C, C), dtype=bool))

    def step(state, inp):
        qc, kc, vc, bc = inp
        o_inter = jnp.einsum('bhck,bhkv->bhcv', qc * jnp.exp(bc), state)
        diff = bc[:, :, :, None, :] - bc[:, :, None, :, :]
        decay = jnp.exp(jnp.where(causal[None, None, :, :, None], diff, -jnp.inf))
        attn = jnp.einsum('bhtk,bhsk,bhtsk->bhts', qc, kc, decay)
        o_intra = jnp.einsum('bhts,bhsv->bhtv', attn, vc)
        b_last = bc[:, :, -1, :]
        k_dec = kc * jnp.exp(b_last[:, :, None, :] - bc)
        new_state = (jnp.exp(b_last)[..., None] * state
                     + jnp.einsum('bhsk,bhsv->bhkv', k_dec, vc))
        return new_state, o_inter + o_intra

    state0 = jnp.zeros((B, H, K, K), jnp.float32)
    _, o = lax.scan(step, state0, (qs, ks, vs, bs))
    o = o.transpose(1, 0, 3, 2, 4).reshape(B, S, H, K)
    o = rms_norm(o, out_gain.reshape(H, K))
    o = o * jax.nn.silu(g.astype(jnp.float32))
    return o.reshape(B, S, H * K).astype(dtype)


def peer(h, w_query, sub_keys, expert_down, expert_up):
    B, S, D = h.shape
    kt = PEER_TOPK
    qry = (h @ w_query).reshape(B, S, PEER_HEADS, 2, PEER_SUB_DIM)
    scores = jnp.einsum('bshpd,hpnd->bshpn', qry, sub_keys).astype(jnp.float32)
    top_s, top_i = lax.top_k(scores, kt)
    cand_s = top_s[..., 0, :, None] + top_s[..., 1, None, :]
    cand_i = top_i[..., 0, :, None] * PEER_N_KEYS + top_i[..., 1, None, :]
    best_s, best_pos = lax.top_k(cand_s.reshape(B, S, PEER_HEADS, kt * kt), kt)
    expert_idx = jnp.take_along_axis(cand_i.reshape(B, S, PEER_HEADS, kt * kt), best_pos, axis=-1)
    gates = jax.nn.softmax(best_s, axis=-1).astype(h.dtype)
    T = B * S
    c = PEER_TOKEN_CHUNK
    hf = h.reshape(T // c, c, D)
    idx = expert_idx.reshape(T // c, c, PEER_HEADS * kt)
    gf = gates.reshape(T // c, c, PEER_HEADS * kt)

    def step(args):
        hc, ic, gc = args
        u = expert_down[ic]
        act = jax.nn.gelu(jnp.einsum('cd,ced->ce', hc, u), approximate=False)
        v = expert_up[ic]
        return jnp.einsum('ce,ced->cd', act * gc, v)

    out = lax.map(step, (hf, idx, gf))
    return out.reshape(B, S, D)


def setup_inputs(seed: int = 0) -> dict:
    key = jax.random.key(seed)
    ks = jax.random.split(key, 16)
    f32 = jnp.float32

    def nrm(k, shape, scale):
        return jax.random.normal(k, shape, f32) * scale

    def gain(k, shape):
        return 1.0 + 0.02 * jax.random.normal(k, shape, f32)

    return {
        "x": nrm(ks[0], (BATCH, SEQ, D_MODEL), 1.0),
        "p": nrm(ks[1], (DEPTH, BATCH, SEQ, PLE_DIM), 1.0),
        "norm_mix": gain(ks[2], (DEPTH, D_MODEL)),
        "w_in": nrm(ks[3], (DEPTH, D_MODEL, IN_WIDTH), D_MODEL ** -0.5),
        "lb_logits": nrm(ks[4], (DEPTH + 1, HGRN_WIDTH), 0.5),
        "hgrn_norm": gain(ks[5], (DEPTH, HGRN_WIDTH)),
        "w_out": nrm(ks[6], (DEPTH, MIX_WIDTH, D_MODEL), MIX_WIDTH ** -0.5),
        "norm_ffn": gain(ks[7], (DEPTH, D_MODEL)),
        "peer_query": nrm(ks[8], (DEPTH, D_MODEL, PEER_HEADS * PEER_QUERY_DIM), D_MODEL ** -0.5),
        "peer_sub_keys": nrm(ks[9], (DEPTH, PEER_HEADS, 2, PEER_N_KEYS, PEER_SUB_DIM), PEER_SUB_DIM ** -0.5),
        "peer_down": nrm(ks[10], (DEPTH, PEER_N_EXPERTS, D_MODEL), D_MODEL ** -0.5),
        "peer_up": nrm(ks[11], (DEPTH, PEER_N_EXPERTS, D_MODEL), PEER_HEADS ** -0.5),
        "norm_ple": gain(ks[12], (DEPTH, D_MODEL)),
        "w_ple": nrm(ks[13], (DEPTH, PLE_DIM, D_MODEL), PLE_DIM ** -0.5),
        "w_ple_gate": nrm(ks[14], (DEPTH, D_MODEL, D_MODEL), D_MODEL ** -0.5),
        "norm_final": gain(ks[15], (D_MODEL,)),
    }


def reference(x, p, norm_mix, w_in, lb_logits, hgrn_norm, w_out, norm_ffn, peer_query,
              peer_sub_keys, peer_down, peer_up, norm_ple, w_ple, w_ple_gate, norm_final):
    B, S, D = x.shape
    lb_all = jnp.cumsum(jax.nn.softmax(lb_logits.astype(jnp.float32), axis=0), axis=0)
    split_points = list(np.cumsum(IN_SPLITS)[:-1])
    h = x
    for layer in range(DEPTH):
        hn = rms_norm(h, norm_mix[layer])
        proj = hn @ w_in[layer]
        aq, ak, av, gq, gf, gi, gg = jnp.split(proj, split_points, axis=-1)
        a_shape = (B, S, ATTN_HEADS, ATTN_HEAD_DIM)
        g_shape = (B, S, HGRN_HEADS, HGRN_HEAD_DIM)
        attn_out = moba_attention(aq.reshape(a_shape), ak.reshape(a_shape), av.reshape(a_shape))
        rec_out = hgrn2(gq.reshape(g_shape), gf.reshape(g_shape), gi.reshape(g_shape),
                        gg.reshape(g_shape), lb_all[layer], hgrn_norm[layer])
        mixed = jnp.concatenate([attn_out, rec_out], axis=-1)
        h = h + mixed @ w_out[layer]
        h = h + peer(rms_norm(h, norm_ffn[layer]), peer_query[layer], peer_sub_keys[layer],
                     peer_down[layer], peer_up[layer])
        ple = p[layer] @ w_ple[layer]
        ple_gate = jax.nn.sigmoid(rms_norm(h, norm_ple[layer]) @ w_ple_gate[layer])
        h = h + ple_gate * ple
    return rms_norm(h, norm_final)
```

```cpp
#include <hip/hip_runtime.h>
#include <cstdio>
#include <cstdint>

#ifndef DBG_PLE_SCALE
#define DBG_PLE_SCALE 1.f
#endif
#ifndef MK_PER_PHASE
#define MK_PER_PHASE 0
#endif

namespace pg8 {
#define PG8_LAS __attribute__((address_space(3)))
typedef unsigned short bf16_t;
typedef short bf16x8 __attribute__((ext_vector_type(8)));
typedef float f32x4 __attribute__((ext_vector_type(4)));
typedef unsigned u32x4 __attribute__((ext_vector_type(4)));
constexpr int BM = 256, BK = 64, HALF = 128, HTB = HALF * BK * 2, STAGE_BYTES = 8 * HTB, NXCD = 8, WGM = 8;

__host__ __device__ __forceinline__ int lds_byte(int r, int c) { const int st = (r >> 4) * 2 + (c >> 5), rr = r & 15, cc = c & 31, ob = rr * 64 + cc * 2; return st * 1024 + (ob ^ (((ob >> 9) & 1) << 5)); }
__host__ __device__ __forceinline__ void stage_rc(int b, int& R, int& C) { const int st = b / 1024, sb = b % 1024, swz = sb ^ (((sb >> 9) & 1) << 5); R = (st >> 1) * 16 + swz / 64; C = (st & 1) * 32 + (swz % 64) / 2; }
__host__ __device__ __forceinline__ int perm32(int rho) { const int n = rho >> 4, i = rho & 15; return 8 * (i >> 2) + 4 * n + (i & 3); }

struct Unit { int pm, pn; };
struct Gemm { const bf16_t* A; const bf16_t* Bt; int M, N, K; };

struct StaticOrder {
    int nM, nN, nwg, G, c;
    __host__ __device__ void init(int M, int N, int G_, int c_) { nM = M / BM; nN = N / BM; nwg = nM * nN; G = G_; c = c_; }
    __host__ __device__ bool next(int i, Unit& u) const {
        const long L = (long)i * G + c; if (L >= nwg) return false;
        int wgid = (int)L; { const int q = nwg / NXCD, r = nwg % NXCD, xcd = wgid % NXCD, off = wgid / NXCD; wgid = (xcd < r ? xcd * (q + 1) : r * (q + 1) + (xcd - r) * q) + off; }
        const int nig = WGM * nN, gid = wgid / nig, fm = gid * WGM, gsz = (nM - fm) < WGM ? (nM - fm) : WGM;
        u.pm = fm + ((wgid % nig) % gsz); u.pn = (wgid % nig) / gsz; return true;
    }
    __device__ __forceinline__ void a_ready(const Unit&) const {}
    __device__ __forceinline__ void done(const Unit&) const {}
};

template <class Epi, class Sched, bool ALIGN_EPI = false, bool SP2 = false>
__device__ __forceinline__ void gemm_phase(PG8_LAS unsigned char* lds, const Gemm g, const Sched& S, const Epi& E) {
    const int tid = threadIdx.x, wid = __builtin_amdgcn_readfirstlane(tid >> 6), lane = tid & 63, wr = wid >> 2, wc = wid & 3, fr = lane & 15, fq = lane >> 4;
    int K_ = g.K; asm volatile("" : "+s"(K_));
    const int K = K_, nt = K / BK;
    unsigned voffA[2], voffB[2];
#pragma unroll
    for (int i = 0; i < 2; ++i) { int R, C; stage_rc(tid * 16 + i * 8192, R, C); const int Rb = Epi::PERM ? ((R & ~31) + perm32(R & 31)) : R;
        voffA[i] = (unsigned)(R * K + C) * 2u; voffB[i] = (unsigned)(Rb * K + C) * 2u; }
    const size_t kstep = (size_t)(BK * 2);
    const size_t hstep = (size_t)HALF * K * 2;
    const size_t tstep = 2 * hstep;
    const unsigned ldsw = (unsigned)wid * 1024u;
    const int aoff = lds_byte(wr * 64 + fr, fq * 8), boff = lds_byte(wc * 32 + fr, fq * 8);
#define PG8_SA(b, h) (((b) * 2 + (h)) * HTB)
#define PG8_SB(b, h) ((4 + (b) * 2 + (h)) * HTB)
#define PG8_STAGE(bufoff, gbase, voff) do { _Pragma("unroll") for (int _i = 0; _i < 2; ++_i) \
        __builtin_amdgcn_global_load_lds((const unsigned*)((const char*)(gbase) + (voff)[_i]), (PG8_LAS unsigned*)(lds + (bufoff) + ldsw + _i * 8192), 16, 0, 0); } while (0)
#define PG8_LDA(dst, b, h) do { _Pragma("unroll") for (int m = 0; m < 4; ++m) _Pragma("unroll") for (int k = 0; k < 2; ++k) dst[m][k] = *(const PG8_LAS bf16x8*)(lds + PG8_SA(b, h) + aoff + m * 2048 + k * 1024); } while (0)
#define PG8_LDB(dst, b, h) do { _Pragma("unroll") for (int n = 0; n < 2; ++n) _Pragma("unroll") for (int k = 0; k < 2; ++k) dst[n][k] = *(const PG8_LAS bf16x8*)(lds + PG8_SB(b, h) + boff + n * 2048 + k * 1024); } while (0)
#define PG8_MMA(ai, bj, At, Bt) do { __builtin_amdgcn_s_setprio(1); _Pragma("unroll") for (int m = 0; m < 4; ++m) _Pragma("unroll") for (int n = 0; n < 2; ++n) _Pragma("unroll") for (int k = 0; k < 2; ++k) \
        acc[ai][bj][m][n] = __builtin_amdgcn_mfma_f32_16x16x32_bf16(Bt[n][k], At[m][k], acc[ai][bj][m][n], 0, 0, 0); __builtin_amdgcn_s_setprio(0); } while (0)
#define PG8_WAIT_V(n) asm volatile("s_waitcnt vmcnt(" #n ")" ::: "memory")
#define PG8_WAIT_L(n) asm volatile("s_waitcnt lgkmcnt(" #n ")" ::: "memory")
#define PG8_BAR __builtin_amdgcn_s_barrier()
#define PG8_SCHED __builtin_amdgcn_sched_barrier(0)
    Unit cur, nxt; int ui = 0;
    if (!S.next(0, cur)) return;
    f32x4 acc[2][2][4][2];
#pragma unroll
    for (int a = 0; a < 2; ++a)
#pragma unroll
        for (int b = 0; b < 2; ++b)
#pragma unroll
            for (int m = 0; m < 4; ++m)
#pragma unroll
                for (int n = 0; n < 2; ++n) acc[a][b][m][n] = (f32x4){0.f, 0.f, 0.f, 0.f};
    bf16x8 At[4][2], B0[2][2], B1[2][2];
    const char* cA = (const char*)g.A + (size_t)cur.pm * tstep; const char* cB = (const char*)g.Bt + (size_t)cur.pn * tstep;
    S.a_ready(cur);
    if constexpr (SP2) {
        PG8_STAGE(PG8_SB(0, 0), cB, voffB); PG8_STAGE(PG8_SB(0, 1), cB + hstep, voffB); PG8_STAGE(PG8_SA(0, 0), cA, voffA); PG8_STAGE(PG8_SA(0, 1), cA + hstep, voffA);
        if (wr == 1) PG8_BAR;
        PG8_WAIT_V(2); PG8_BAR;
        PG8_STAGE(PG8_SB(1, 0), cB + kstep, voffB); PG8_STAGE(PG8_SA(1, 0), cA + kstep, voffA); PG8_STAGE(PG8_SB(1, 1), cB + hstep + kstep, voffB);
        PG8_WAIT_V(6); PG8_BAR;
    } else {
        PG8_STAGE(PG8_SB(0, 0), cB, voffB); PG8_STAGE(PG8_SA(0, 0), cA, voffA); PG8_STAGE(PG8_SB(0, 1), cB + hstep, voffB); PG8_STAGE(PG8_SA(0, 1), cA + hstep, voffA);
        if (wr == 1) PG8_BAR;
        PG8_WAIT_V(4); PG8_BAR;
        PG8_STAGE(PG8_SB(1, 0), cB + kstep, voffB); PG8_STAGE(PG8_SA(1, 0), cA + kstep, voffA); PG8_STAGE(PG8_SB(1, 1), cB + hstep + kstep, voffB);
        PG8_WAIT_V(6); PG8_BAR;
    }
    for (;;) {
        const bool has_next = S.next(ui + 1, nxt);
        const char* nA = has_next ? (const char*)g.A + (size_t)nxt.pm * tstep : cA; const char* nB = has_next ? (const char*)g.Bt + (size_t)nxt.pn * tstep : cB;
        for (int t = 0; t < nt; t += 2) {
            const bool last = (t == nt - 2);
            const char* a1 = cA + (size_t)(t + 1) * kstep;
            const char* a2 = last ? nA : cA + (size_t)(t + 2) * kstep; const char* b2 = last ? nB : cB + (size_t)(t + 2) * kstep;
            const char* a3 = a2 + kstep; const char* b3 = b2 + kstep;
            if (last && has_next) S.a_ready(nxt);
            if constexpr (SP2) {
            PG8_LDB(B0, 0, 0); PG8_LDB(B1, 0, 1); PG8_SCHED; PG8_LDA(At, 0, 0); PG8_STAGE(PG8_SA(1, 1), a1 + hstep, voffA);
            PG8_WAIT_V(8); PG8_WAIT_L(0); PG8_BAR; PG8_MMA(0, 0, At, B0); PG8_MMA(0, 1, At, B1); PG8_BAR; PG8_SCHED;
            PG8_LDA(At, 0, 1); PG8_STAGE(PG8_SB(0, 0), b2, voffB); PG8_STAGE(PG8_SB(0, 1), b2 + hstep, voffB); PG8_STAGE(PG8_SA(0, 0), a2, voffA);
            PG8_WAIT_V(8); PG8_WAIT_L(0); PG8_BAR; PG8_MMA(1, 0, At, B0); PG8_MMA(1, 1, At, B1); PG8_BAR; PG8_SCHED;
            PG8_LDB(B0, 1, 0); PG8_LDB(B1, 1, 1); PG8_SCHED; PG8_LDA(At, 1, 0); PG8_STAGE(PG8_SA(0, 1), a2 + hstep, voffA);
            PG8_WAIT_V(8); PG8_WAIT_L(0); PG8_BAR; PG8_MMA(0, 0, At, B0); PG8_MMA(0, 1, At, B1); PG8_BAR; PG8_SCHED;
            PG8_LDA(At, 1, 1); PG8_STAGE(PG8_SB(1, 0), b3, voffB); PG8_STAGE(PG8_SB(1, 1), b3 + hstep, voffB); PG8_STAGE(PG8_SA(1, 0), a3, voffA);
            PG8_WAIT_V(8); PG8_WAIT_L(0); PG8_BAR; PG8_MMA(1, 0, At, B0); PG8_MMA(1, 1, At, B1); PG8_BAR; PG8_SCHED;
            } else {
            PG8_LDB(B0, 0, 0); PG8_SCHED; PG8_LDA(At, 0, 0); PG8_STAGE(PG8_SA(1, 1), a1 + hstep, voffA);
            PG8_WAIT_L(8); PG8_BAR; PG8_WAIT_L(0); PG8_MMA(0, 0, At, B0); PG8_BAR; PG8_SCHED;
            PG8_LDB(B1, 0, 1); PG8_STAGE(PG8_SB(0, 0), b2, voffB);
            PG8_BAR; PG8_WAIT_L(0); PG8_MMA(0, 1, At, B1); PG8_BAR;
            PG8_LDA(At, 0, 1); PG8_STAGE(PG8_SA(0, 0), a2, voffA);
            PG8_BAR; PG8_WAIT_L(0); PG8_MMA(1, 0, At, B0); PG8_BAR; PG8_SCHED;
            PG8_STAGE(PG8_SB(0, 1), b2 + hstep, voffB);
            PG8_WAIT_V(6); PG8_BAR; PG8_MMA(1, 1, At, B1); PG8_BAR;
            PG8_LDB(B0, 1, 0); PG8_SCHED; PG8_LDA(At, 1, 0); PG8_STAGE(PG8_SA(0, 1), a2 + hstep, voffA);
            PG8_WAIT_L(8); PG8_BAR; PG8_WAIT_L(0); PG8_MMA(0, 0, At, B0); PG8_BAR; PG8_SCHED;
            PG8_LDB(B1, 1, 1); PG8_STAGE(PG8_SB(1, 0), b3, voffB);
            PG8_BAR; PG8_WAIT_L(0); PG8_MMA(0, 1, At, B1); PG8_BAR;
            PG8_LDA(At, 1, 1); PG8_STAGE(PG8_SA(1, 0), a3, voffA);
            PG8_BAR; PG8_WAIT_L(0); PG8_MMA(1, 0, At, B0); PG8_BAR; PG8_SCHED;
            PG8_STAGE(PG8_SB(1, 1), b3 + hstep, voffB);
            PG8_WAIT_V(6); PG8_BAR; PG8_MMA(1, 1, At, B1); PG8_BAR;
            }
        }
        if constexpr (ALIGN_EPI) { if (wr == 0) PG8_BAR; }
        E(acc, cur, wr, wc, fr, fq); S.done(cur);
        if (!has_next) break;
#pragma unroll
        for (int a = 0; a < 2; ++a)
#pragma unroll
            for (int b = 0; b < 2; ++b)
#pragma unroll
                for (int m = 0; m < 4; ++m)
#pragma unroll
                    for (int n = 0; n < 2; ++n) acc[a][b][m][n] = (f32x4){0.f, 0.f, 0.f, 0.f};
        cur = nxt; cA = nA; cB = nB; ++ui;
        if constexpr (ALIGN_EPI) { if (wr == 1) PG8_BAR; }
    }
    PG8_WAIT_V(0);
    if constexpr (!ALIGN_EPI) { if (wr == 0) PG8_BAR; }
    PG8_BAR;
#undef PG8_SA
#undef PG8_SB
#undef PG8_STAGE
#undef PG8_LDA
#undef PG8_LDB
#undef PG8_MMA
#undef PG8_WAIT_V
#undef PG8_WAIT_L
#undef PG8_BAR
#undef PG8_SCHED
}
}

#define PG8_SP2 true
#define PG8_ALIGN true

constexpr int NWAVES = 8, NTHREADS = 512;
constexpr int S_ = 16384, D_ = 2048, NIN = 7168, AW = 1024, NH = 8, HD = 128, NBLK = 64, LBLK = 256;
constexpr int PLE = 256, NEXP = 16384, PH = 8, NKEY = 128, PTOP = 16;
constexpr float EPS = 1e-6f;
constexpr float QSCALE = 0.08838834764831845f * 1.4426950408889634f;
constexpr int HSC = 64, HSCLEN = 256, HSUB = 32;
constexpr int LSTRIDE = 256 * (63 * 64 / 2);
__host__ __device__ __forceinline__ int list_off(int n) { return 256 * (63 * n - (n * (n - 1)) / 2); }

constexpr size_t MiB = 1u << 20;
constexpr size_t WS_CTL = 0, CTL_ZERO_BYTES = 1 * MiB;
constexpr size_t WS_W1T = 2 * MiB, WS_W2T = 30 * MiB, WS_WQT = 38 * MiB, WS_WGT = 46 * MiB, WS_WPT = 54 * MiB, WS_SKB = 55 * MiB;
constexpr size_t WS_STAT = 56 * MiB;
constexpr size_t WS_SSQ2 = 57 * MiB, WS_SSQ4 = 59 * MiB;
constexpr size_t WS_KPART = 61 * MiB, WS_HDEC = 62 * MiB;
constexpr size_t WS_PB = 63 * MiB;
constexpr size_t WS_DOWN = 71 * MiB, WS_UP = 135 * MiB;
constexpr size_t WS_R1 = 199 * MiB;
constexpr size_t WS_XB = WS_R1, WS_LIST = WS_R1, WS_PML = WS_R1 + 16 * MiB, WS_HST = WS_R1 + 20 * MiB, WS_H1B = WS_R1;
constexpr size_t WS_R2 = 263 * MiB;
constexpr size_t WS_Q = WS_R2, WS_K = WS_R2 + 32 * MiB, WS_VT = WS_R2 + 64 * MiB, WS_MIX = WS_R2, WS_QRY = WS_R2, WS_PIDX = WS_R2 + 64 * MiB, WS_PGATE = WS_R2 + 72 * MiB;
constexpr size_t WS_R3 = 359 * MiB;
constexpr size_t WS_HQ = WS_R3, WS_HLF = WS_R3 + 32 * MiB, WS_HV = WS_R3 + 64 * MiB, WS_HG = WS_R3 + 96 * MiB, WS_PLE = WS_R3;
constexpr size_t WS_END = 487 * MiB;
constexpr int CW_BAR = 4096;
constexpr int CW_GCNT = 16384;
constexpr int ST_RS1 = 0, ST_LB = S_, ST_RS2 = S_ + 1024, ST_RS3 = 2 * S_ + 1024;

constexpr int RING_BYTES = 131072;
constexpr int LDS_BYTES = 147456;
constexpr int MISC_OFF = LDS_BYTES - 256;

#define LAS __attribute__((address_space(3)))
typedef unsigned short bf16;
typedef unsigned u32x4 __attribute__((ext_vector_type(4)));
typedef unsigned u32x2 __attribute__((ext_vector_type(2)));
typedef float f32x4 __attribute__((ext_vector_type(4)));
typedef float f32x2 __attribute__((ext_vector_type(2)));
typedef float f32x16 __attribute__((ext_vector_type(16)));
typedef short bf16x8 __attribute__((ext_vector_type(8)));
typedef short s16x4 __attribute__((ext_vector_type(4)));
typedef __bf16 bf16x2n __attribute__((ext_vector_type(2)));
#define RLX_AGENT __ATOMIC_RELAXED, __HIP_MEMORY_SCOPE_AGENT
#define LDS_WAIT() asm volatile("s_waitcnt lgkmcnt(0)" ::: "memory")
#define DI __device__ __forceinline__

DI unsigned pk2(float lo, float hi) { f32x2 v = {lo, hi}; bf16x2n b = __builtin_convertvector(v, bf16x2n); return __builtin_bit_cast(unsigned, b); }
DI float bflo(unsigned u) { return __uint_as_float(u << 16); }
DI float bfhi(unsigned u) { return __uint_as_float(u & 0xffff0000u); }
DI float wave_sum(float v) {
#pragma unroll
    for (int o = 1; o < 64; o <<= 1) v += __shfl_xor(v, o);
    return v;
}
DI float sigmoidf_(float x) { return 1.f / (1.f + __expf(-x)); }
DI float siluf_(float x) { return x / (1.f + __expf(-x)); }
DI int crow(int reg, int h) { return (reg & 3) + 8 * (reg >> 2) + 4 * h; }

#define XB_TMO      128
#define XB_XCNT(j)  (256  + 64 * (j))
#define XB_XSUB(j)  (1280 + 64 * (j))
#define XB_XGEN(j)  (2304 + 64 * (j))
#define XB_TOP      3328
#define XB_TOPGEN   3392
#define XCD_BAR_WORDS 3456
#define XB_SPIN_CAP (1u << 22)
DI unsigned xb_ld(unsigned* p)              { return __hip_atomic_load(p, __ATOMIC_RELAXED, __HIP_MEMORY_SCOPE_AGENT); }
DI unsigned xb_add(unsigned* p, unsigned v) { return __hip_atomic_fetch_add(p, v, __ATOMIC_RELAXED, __HIP_MEMORY_SCOPE_AGENT); }
DI unsigned xb_xcc_id() { return (unsigned)__builtin_amdgcn_s_getreg((3 << 11) | 20) & 0xFu; }
#define XB_SPIN(cond, bar) do { unsigned _sp = 0; while (cond) { __builtin_amdgcn_s_sleep(1); \
    if ((++_sp & 255u) == 0u) { if (xb_ld(&(bar)[XB_TMO])) break; if (_sp > XB_SPIN_CAP) { atomicAdd(&(bar)[XB_TMO], 1u); break; } } } } while (0)
struct XcdBarrier { unsigned* bar; unsigned x; volatile LAS unsigned* st; };
DI XcdBarrier xcd_barrier_post(unsigned* bar, volatile LAS unsigned* st) {
    XcdBarrier b; b.bar = bar; b.x = xb_xcc_id(); b.st = st;
    if (threadIdx.x == 0) (void)xb_add(&bar[XB_XCNT(b.x)], 1u);
    return b;
}
DI void xcd_barrier_complete(unsigned* bar, unsigned x, unsigned& nloc, unsigned& nx) {
    const unsigned G = gridDim.x * gridDim.y * gridDim.z;
    unsigned sum, cnt, mine, sp = 0u;
    for (;;) {
        sum = 0u; cnt = 0u; mine = 0u;
#pragma unroll
        for (unsigned j = 0; j < 16; ++j) { const unsigned c = xb_ld(&bar[XB_XCNT(j)]); sum += c; cnt += (c > 0u) ? 1u : 0u; mine = (j == x) ? c : mine; }
        if (sum == G) break;
        __builtin_amdgcn_s_sleep(1);
        if ((++sp & 255u) == 0u) { if (xb_ld(&bar[XB_TMO])) break; if (sp > XB_SPIN_CAP) { atomicAdd(&bar[XB_TMO], 1u); break; } }
    }
    nloc = mine > 0u ? mine : 1u; nx = cnt > 0u ? cnt : 1u;
}
DI void xcd_barrier(const XcdBarrier& b) {
    asm volatile("s_waitcnt vmcnt(0)" ::: "memory");
    __syncthreads();
    if (threadIdx.x == 0) {
        unsigned* bar = b.bar;
        __builtin_amdgcn_s_waitcnt(0);
        unsigned nloc = b.st[0], nx = b.st[1];
        if (nloc == 0u) { xcd_barrier_complete(bar, b.x, nloc, nx); b.st[0] = nloc; b.st[1] = nx; }
        const unsigned old = xb_add(&bar[XB_XSUB(b.x)], 1u);
        const unsigned gen = old / nloc;
        if (old + 1u == (gen + 1u) * nloc) {
            __builtin_amdgcn_fence(__ATOMIC_RELEASE, "agent");
            asm volatile("s_waitcnt vmcnt(0)" ::: "memory");
            const unsigned og = xb_add(&bar[XB_TOP], 1u);
            const unsigned tg = og / nx;
            if (og + 1u == (tg + 1u) * nx) xb_add(&bar[XB_TOPGEN], 1u);
            else XB_SPIN(xb_ld(&bar[XB_TOPGEN]) == tg, bar);
            __builtin_amdgcn_fence(__ATOMIC_ACQUIRE, "agent");
            xb_add(&bar[XB_XGEN(b.x)], 1u);
            asm volatile("s_waitcnt vmcnt(0)" ::: "memory");
        } else {
            XB_SPIN(xb_ld(&bar[XB_XGEN(b.x)]) == gen, bar);
            __builtin_amdgcn_fence(__ATOMIC_ACQUIRE, "agent");
            asm volatile("s_waitcnt vmcnt(0)" ::: "memory");
        }
    }
    __syncthreads();
}

struct Frame {
    LAS unsigned char* lds;
    unsigned* ctl;
    int tid, lane, wave, G, bid;
    const float* in[16];
    float* out;
    unsigned char* ws;
};
template <class T> DI T* wsp(const Frame& F, size_t off) { return (T*)(F.ws + off); }

DI void p0_transpose_item(const float* W, const float* gain, int K, int N, bf16* WT, LAS float* scr, int item, int lane, int nscaled = 0, float nscale = 1.f) {
    const int nblk = N / 32, kb = item / nblk, nb = item % nblk, k0 = 64 * kb, n0 = 32 * nb; const float osc = (n0 < nscaled) ? nscale : 1.f;
#pragma unroll 8
    for (int i = 0; i < 32; ++i) { const int kk = 2 * i + (lane >> 5); const float g = (gain ? gain[k0 + kk] : 1.f) * osc; scr[kk * 33 + (lane & 31)] = W[(size_t)(k0 + kk) * N + n0 + (lane & 31)] * g; }
    LDS_WAIT(); asm volatile("" ::: "memory");
    const int c = lane & 7;
#pragma unroll
    for (int j = 0; j < 4; ++j) { const int n = (lane >> 3) + 8 * j; const LAS float* s = scr + (8 * c) * 33 + n;
        u32x4 o; o.x = pk2(s[0 * 33], s[1 * 33]); o.y = pk2(s[2 * 33], s[3 * 33]); o.z = pk2(s[4 * 33], s[5 * 33]); o.w = pk2(s[6 * 33], s[7 * 33]);
        *(u32x4*)(WT + (size_t)(n0 + n) * K + k0 + 8 * c) = o; }
    LDS_WAIT(); asm volatile("" ::: "memory");
}
DI void p0_convert(const float* src, bf16* dst, size_t n8, const float* colgain, size_t gtid, size_t gstride) {
    for (size_t i = gtid; i < n8; i += gstride) {
        f32x4 a = *(const f32x4*)(src + i * 8), b = *(const f32x4*)(src + i * 8 + 4);
        if (colgain) { const int c = (int)((i * 8) & 2047); a = a * *(const f32x4*)(colgain + c); b = b * *(const f32x4*)(colgain + c + 4); }
        u32x4 o; o.x = pk2(a.x, a.y); o.y = pk2(a.z, a.w); o.z = pk2(b.x, b.y); o.w = pk2(b.z, b.w);
        *(u32x4*)(dst + i * 8) = o;
    }
}
DI void p0_prologue(Frame& F) {
    LAS float* scr = (LAS float*)(F.lds + F.wave * 16384);
    const int gw = F.bid * NWAVES + F.wave, NGW = F.G * NWAVES;
    const float* x = F.in[0];
    constexpr int I1 = (D_ / 64) * (NIN / 32), I2 = (D_ / 64) * (D_ / 32), IP = (PLE / 64) * (D_ / 32);
    constexpr int NITEMS = I1 + 3 * I2 + IP;
    for (int it = gw; it < NITEMS; it += NGW) {
        int r = it;
        if (r < I1) { p0_transpose_item(F.in[3], F.in[2], D_, NIN, wsp<bf16>(F, WS_W1T), scr, r, F.lane, AW, QSCALE); continue; } r -= I1;
        if (r < I2) { p0_transpose_item(F.in[6], nullptr, D_, D_, wsp<bf16>(F, WS_W2T), scr, r, F.lane); continue; } r -= I2;
        if (r < I2) { p0_transpose_item(F.in[8], F.in[7], D_, D_, wsp<bf16>(F, WS_WQT), scr, r, F.lane); continue; } r -= I2;
        if (r < I2) { p0_transpose_item(F.in[14], F.in[12], D_, D_, wsp<bf16>(F, WS_WGT), scr, r, F.lane); continue; } r -= I2;
        p0_transpose_item(F.in[13], nullptr, PLE, D_, wsp<bf16>(F, WS_WPT), scr, r, F.lane);
    }
    float* stat = wsp<float>(F, WS_STAT);
    bf16* xb = wsp<bf16>(F, WS_XB);
    for (int m = gw; m < S_; m += NGW) {
        const f32x4* xr = (const f32x4*)(x + (size_t)m * D_) + F.lane;
        f32x4 v[8]; float s = 0.f;
#pragma unroll
        for (int j = 0; j < 8; ++j) { v[j] = xr[64 * j]; s += (v[j].x * v[j].x + v[j].y * v[j].y) + (v[j].z * v[j].z + v[j].w * v[j].w); }
        s = wave_sum(s);
        if (F.lane == 0) stat[ST_RS1 + m] = 1.f / sqrtf(s * (1.f / D_) + EPS);
        u32x2* o8 = (u32x2*)(xb + (size_t)m * D_) + F.lane;
#pragma unroll
        for (int j = 0; j < 8; ++j) { u32x2 w; w.x = pk2(v[j].x, v[j].y); w.y = pk2(v[j].z, v[j].w); o8[64 * j] = w; }
    }
    const size_t gtid = (size_t)F.bid * NTHREADS + F.tid, gstride = (size_t)F.G * NTHREADS;
    p0_convert(F.in[1], wsp<bf16>(F, WS_PB), (size_t)S_ * PLE / 8, nullptr, gtid, gstride);
    p0_convert(F.in[9], wsp<bf16>(F, WS_SKB), (size_t)PH * 2 * NKEY * 128 / 8, nullptr, gtid, gstride);
    p0_convert(F.in[10], wsp<bf16>(F, WS_DOWN), (size_t)NEXP * D_ / 8, F.in[7], gtid, gstride);
    p0_convert(F.in[11], wsp<bf16>(F, WS_UP), (size_t)NEXP * D_ / 8, nullptr, gtid, gstride);
    for (size_t i = gtid; i < 1024; i += gstride) { const float l0 = F.in[4][i], l1 = F.in[4][1024 + i]; stat[ST_LB + i] = 1.f / (1.f + __expf(l1 - l0)); }
}

struct Epi1 {
    static constexpr bool PERM = true, AFTER_DRAIN = false;
    bf16 *q, *k, *vt, *hq, *hlf, *hv, *hg; float* kpart; const float* rs1;
    template <int R> DI void run(const pg8::f32x4 (&acc)[2][2][4][2], const pg8::Unit& u, int wr, int wc, int fr, int fq, bf16* dst) const {
        const int cb = (u.pn & 3) * 256;
        const int row0 = u.pm * 256 + wr * 64 + fr;
        const int colw = cb + wc * 32 + 8 * fq;
        f32x4 cs[2][2];
        if (R == 1) { cs[0][0] = cs[0][1] = cs[1][0] = cs[1][1] = (f32x4){0.f, 0.f, 0.f, 0.f}; }
#pragma unroll
        for (int ai = 0; ai < 2; ++ai)
#pragma unroll
            for (int m = 0; m < 4; ++m) {
                const int row = row0 + ai * 128 + m * 16;
                const float rs = rs1[row];
#pragma unroll
                for (int bj = 0; bj < 2; ++bj) {
                    const f32x4 v0 = acc[ai][bj][m][0] * rs, v1 = acc[ai][bj][m][1] * rs;
                    const int col = colw + 128 * bj;
                    if (R == 1) { cs[bj][0] = cs[bj][0] + v0; cs[bj][1] = cs[bj][1] + v1; }
                    if (R == 2) {
                        bf16* p = dst + (size_t)col * S_ + row;
#pragma unroll
                        for (int i = 0; i < 4; ++i) { p[(size_t)i * S_] = (bf16)(pk2(v0[i], 0.f) & 0xffffu); p[(size_t)(i + 4) * S_] = (bf16)(pk2(v1[i], 0.f) & 0xffffu); }
                    } else {
                        u32x4 w; w.x = pk2(v0[0], v0[1]); w.y = pk2(v0[2], v0[3]); w.z = pk2(v1[0], v1[1]); w.w = pk2(v1[2], v1[3]);
                        *(u32x4*)(dst + (size_t)row * AW + col) = w;
                    }
                }
                asm volatile("" ::: "memory");
            }
        if (R == 1) {
#pragma unroll
            for (int bj = 0; bj < 2; ++bj)
#pragma unroll
                for (int n = 0; n < 2; ++n)
#pragma unroll
                    for (int i = 0; i < 4; ++i) {
                        float s = cs[bj][n][i];
                        s += __shfl_xor(s, 1); s += __shfl_xor(s, 2); s += __shfl_xor(s, 4); s += __shfl_xor(s, 8);
                        if (fr == 0) kpart[(size_t)(wr * NBLK + u.pm) * AW + colw + 128 * bj + 4 * n + i] = s;
                    }
        }
    }
    DI void operator()(const pg8::f32x4 (&acc)[2][2][4][2], const pg8::Unit& u, int wr, int wc, int fr, int fq) const {
        asm volatile("" : "+v"(fr), "+v"(fq));
        const int reg = u.pn >> 2;
        if (reg == 1) run<1>(acc, u, wr, wc, fr, fq, k);
        else if (reg == 2) run<2>(acc, u, wr, wc, fr, fq, vt);
        else { bf16* dst = reg == 0 ? q : reg == 3 ? hq : reg == 4 ? hlf : reg == 5 ? hv : hg; run<0>(acc, u, wr, wc, fr, fq, dst); }
    }
};

DI void ins3(float v, int i, float& v0, float& v1, float& v2, int& i0, int& i1, int& i2) {
    const bool c0 = v > v0, c1 = v > v1, c2 = v > v2;
    v2 = c1 ? v1 : (c2 ? v : v2); i2 = c1 ? i1 : (c2 ? i : i2);
    v1 = c0 ? v0 : (c1 ? v : v1); i1 = c0 ? i0 : (c1 ? i : i1);
    v0 = c0 ? v : v0; i0 = c0 ? i : i0;
}
DI void p2_gate(Frame& F) {
    LAS float* km = (LAS float*)F.lds;
    LAS int* lcnt = (LAS int*)(F.lds + 32768);
    LAS int* lbase = (LAS int*)(F.lds + 32768 + 256);
    const float* kpart = wsp<float>(F, WS_KPART);
    const bf16* q = wsp<bf16>(F, WS_Q);
    unsigned* gcnt = F.ctl + CW_GCNT;
    int* list = wsp<int>(F, WS_LIST);
    const int tid = F.tid;
    for (int it = F.bid; it < NH * 63; it += F.G) {
        const int h = it & 7, qb = 63 - (it >> 3);
        for (int i = tid; i < qb * 128; i += NTHREADS) { const int n = i >> 7, d = i & 127; km[i] = kpart[(size_t)n * AW + h * HD + d] + kpart[(size_t)(NBLK + n) * AW + h * HD + d]; }
        if (tid < 64) lcnt[tid] = 0;
        __syncthreads();
        const int tt = tid >> 1, half = tid & 1, t = qb * LBLK + tt;
        u32x4 qv[16];
        const u32x4* qp = (const u32x4*)(q + (size_t)t * AW + h * HD);
#pragma unroll
        for (int c = 0; c < 16; ++c) qv[c] = qp[c];
        float v0 = -INFINITY, v1 = -INFINITY, v2 = -INFINITY; int i0 = -1, i1 = -1, i2 = -1;
        for (int n = half; n < qb; n += 2) {
            const LAS f32x4* kr = (const LAS f32x4*)(km + n * 128);
            float a0 = 0.f, a1 = 0.f, a2 = 0.f, a3 = 0.f;
#pragma unroll
            for (int c = 0; c < 16; ++c) {
                const f32x4 ka = kr[2 * c], kb = kr[2 * c + 1]; const u32x4 w = qv[c];
                a0 += bflo(w.x) * ka.x + bfhi(w.x) * ka.y; a1 += bflo(w.y) * ka.z + bfhi(w.y) * ka.w;
                a2 += bflo(w.z) * kb.x + bfhi(w.z) * kb.y; a3 += bflo(w.w) * kb.z + bfhi(w.w) * kb.w;
            }
            ins3((a0 + a1) + (a2 + a3), n, v0, v1, v2, i0, i1, i2);
        }
        {
            const float p0 = __shfl_xor(v0, 1), p1 = __shfl_xor(v1, 1), p2 = __shfl_xor(v2, 1);
            const int j0 = __shfl_xor(i0, 1), j1 = __shfl_xor(i1, 1), j2 = __shfl_xor(i2, 1);
            ins3(p0, j0, v0, v1, v2, i0, i1, i2);
            ins3(p1, j1, v0, v1, v2, i0, i1, i2);
            ins3(p2, j2, v0, v1, v2, i0, i1, i2);
        }
        int r0 = 0, r1 = 0, r2 = 0;
        if (half == 0) {
            if (i0 >= 0) r0 = __hip_atomic_fetch_add(lcnt + i0, 1, __ATOMIC_RELAXED, __HIP_MEMORY_SCOPE_WORKGROUP);
            if (i1 >= 0) r1 = __hip_atomic_fetch_add(lcnt + i1, 1, __ATOMIC_RELAXED, __HIP_MEMORY_SCOPE_WORKGROUP);
            if (i2 >= 0) r2 = __hip_atomic_fetch_add(lcnt + i2, 1, __ATOMIC_RELAXED, __HIP_MEMORY_SCOPE_WORKGROUP);
        }
        __syncthreads();
        if (tid < 64) { const int c = lcnt[tid]; lbase[tid] = c ? (int)__hip_atomic_fetch_add(gcnt + h * NBLK + tid, (unsigned)c, RLX_AGENT) : 0; }
        __syncthreads();
        if (half == 0) {
            int* lh = list + (size_t)h * LSTRIDE;
            if (i0 >= 0) lh[list_off(i0) + lbase[i0] + r0] = (t << 2) | 0;
            if (i1 >= 0) lh[list_off(i1) + lbase[i1] + r1] = (t << 2) | 1;
            if (i2 >= 0) lh[list_off(i2) + lbase[i2] + r2] = (t << 2) | 2;
        }
        __syncthreads();
    }
}

template <bool READOUT> DI void hgrn_item(Frame& F, int h, int sc) {
    LAS float* fA = (LAS float*)F.lds;
    LAS float* kA = fA + HSUB * 128;
    LAS float* vA = kA + HSUB * 128;
    LAS float* qA = vA + HSUB * 128;
    LAS float* oP = qA + HSUB * 128;
    const bf16* hq = wsp<bf16>(F, WS_HQ); const bf16* hlf = wsp<bf16>(F, WS_HLF); const bf16* hv = wsp<bf16>(F, WS_HV); const bf16* hg = wsp<bf16>(F, WS_HG);
    float* hst = wsp<float>(F, WS_HST) + ((size_t)sc * NH + h) * (HD * HD);
    const int tid = F.tid, w = F.wave, lane = F.lane, g = w >> 1, v = (w & 1) * 64 + lane;
    float Sreg[32];
    if (READOUT) {
#pragma unroll
        for (int i = 0; i < 32; ++i) Sreg[i] = hst[(size_t)(g * 32 + i) * HD + v];
    } else {
#pragma unroll
        for (int i = 0; i < 32; ++i) Sreg[i] = 0.f;
    }
    float dec = 1.f;
    float lbr[8];
    { const float* lbp = wsp<float>(F, WS_STAT) + ST_LB + h * HD + (tid & 15) * 8;
#pragma unroll
      for (int j = 0; j < 8; ++j) lbr[j] = lbp[j]; }
    for (int sub = 0; sub < HSCLEN / HSUB; ++sub) {
        const int t0 = sc * HSCLEN + sub * HSUB;
        {
            const int tt = tid >> 4, c8 = (tid & 15) * 8; const size_t go = (size_t)(t0 + tt) * AW + h * HD + c8;
            const u32x4 lf = *(const u32x4*)(hlf + go), vv = *(const u32x4*)(hv + go);
            const unsigned lw[4] = {lf.x, lf.y, lf.z, lf.w}, vw[4] = {vv.x, vv.y, vv.z, vv.w};
#pragma unroll
            for (int j = 0; j < 4; ++j) {
                const float f0 = lbr[2 * j] + (1.f - lbr[2 * j]) * sigmoidf_(bflo(lw[j])), f1 = lbr[2 * j + 1] + (1.f - lbr[2 * j + 1]) * sigmoidf_(bfhi(lw[j]));
                fA[tt * 128 + c8 + 2 * j] = f0; fA[tt * 128 + c8 + 2 * j + 1] = f1;
                kA[tt * 128 + c8 + 2 * j] = 1.f - f0; kA[tt * 128 + c8 + 2 * j + 1] = 1.f - f1;
                vA[tt * 128 + c8 + 2 * j] = bflo(vw[j]); vA[tt * 128 + c8 + 2 * j + 1] = bfhi(vw[j]);
            }
            if (READOUT) {
                const u32x4 qq = *(const u32x4*)(hq + go); const unsigned qw[4] = {qq.x, qq.y, qq.z, qq.w};
#pragma unroll
                for (int j = 0; j < 4; ++j) { qA[tt * 128 + c8 + 2 * j] = siluf_(bflo(qw[j])); qA[tt * 128 + c8 + 2 * j + 1] = siluf_(bfhi(qw[j])); }
            }
        }
        __syncthreads();
        if (!READOUT && tid < 128) {
#pragma unroll 8
            for (int tt = 0; tt < HSUB; ++tt) dec *= fA[tt * 128 + tid];
        }
        for (int tt = 0; tt < HSUB; ++tt) {
            const LAS f32x4* fr4 = (const LAS f32x4*)(fA + tt * 128 + g * 32);
            const LAS f32x4* kr4 = (const LAS f32x4*)(kA + tt * 128 + g * 32);
            const float vv = vA[tt * 128 + v];
            float o0 = 0.f, o1 = 0.f;
#pragma unroll
            for (int i4 = 0; i4 < 8; ++i4) {
                const f32x4 f4 = fr4[i4], k4 = kr4[i4];
#pragma unroll
                for (int j = 0; j < 4; ++j) Sreg[i4 * 4 + j] = f4[j] * Sreg[i4 * 4 + j] + (k4[j] * vv);
                if (READOUT) {
                    const f32x4 q4 = ((const LAS f32x4*)(qA + tt * 128 + g * 32))[i4];
                    o0 += q4[0] * Sreg[i4 * 4 + 0] + q4[1] * Sreg[i4 * 4 + 1]; o1 += q4[2] * Sreg[i4 * 4 + 2] + q4[3] * Sreg[i4 * 4 + 3];
                }
            }
            if (READOUT) oP[(g * HSUB + tt) * 128 + v] = o0 + o1;
        }
        __syncthreads();
        if (READOUT) {
            const float* gain = F.in[5];
            bf16* mixed = wsp<bf16>(F, WS_MIX);
#pragma unroll
            for (int j = 0; j < 4; ++j) {
                const int tt = w * 4 + j;
                float oa = 0.f, ob = 0.f;
#pragma unroll
                for (int gg = 0; gg < 4; ++gg) { oa += oP[(gg * HSUB + tt) * 128 + lane]; ob += oP[(gg * HSUB + tt) * 128 + 64 + lane]; }
                const float ss = wave_sum(oa * oa + ob * ob);
                const float r = 1.f / sqrtf(ss * (1.f / HD) + EPS);
                const size_t go = (size_t)(t0 + tt) * AW + h * HD;
                const float ga = siluf_(__uint_as_float((unsigned)hg[go + lane] << 16)), gb = siluf_(__uint_as_float((unsigned)hg[go + 64 + lane] << 16));
                bf16* mo = mixed + (size_t)(t0 + tt) * D_ + AW + h * HD;
                #ifdef DBG_ZERO_REC
                mo[lane] = 0; mo[64 + lane] = 0; continue;
#endif
                mo[lane] = (bf16)(pk2(oa * r * gain[h * HD + lane] * ga, 0.f) & 0xffffu);
                mo[64 + lane] = (bf16)(pk2(ob * r * gain[h * HD + 64 + lane] * gb, 0.f) & 0xffffu);
            }
            __syncthreads();
        }
    }
    if (!READOUT) {
#pragma unroll
        for (int i = 0; i < 32; ++i) hst[(size_t)(g * 32 + i) * HD + v] = Sreg[i];
        if (tid < 128) wsp<float>(F, WS_HDEC)[((size_t)sc * NH + h) * HD + tid] = dec;
    }
}
DI void hgrn_scan(Frame& F) {
    float* hst = wsp<float>(F, WS_HST); const float* hdec = wsp<float>(F, WS_HDEC);
    for (int e = F.bid * NTHREADS + F.tid; e < NH * HD * HD; e += F.G * NTHREADS) {
        const int hk = e >> 7;
        float cur = 0.f;
        for (int sc = 0; sc < HSC; ++sc) {
            const size_t o = (size_t)sc * (NH * HD * HD) + e;
            const float tmp = hst[o]; hst[o] = cur;
            cur = hdec[(size_t)sc * (NH * HD) + hk] * cur + tmp;
        }
    }
}

constexpr int AT_KSTR = 272, AT_VSTR = 520;
constexpr int AT_K_OFF = 0, AT_V_OFF = 256 * AT_KSTR, AT_PRE_OFF = AT_V_OFF + 128 * AT_VSTR;
static_assert(AT_PRE_OFF + 516 * 4 <= MISC_OFF, "attention LDS map");
DI void p3_attn(Frame& F) {
    LAS unsigned char* Kl = F.lds + AT_K_OFF; LAS unsigned char* Vl = F.lds + AT_V_OFF; LAS int* pre = (LAS int*)(F.lds + AT_PRE_OFF);
    const bf16* q = wsp<bf16>(F, WS_Q); const bf16* kg = wsp<bf16>(F, WS_K); const bf16* vt = wsp<bf16>(F, WS_VT);
    const int* list = wsp<int>(F, WS_LIST);
    bf16* po = (bf16*)F.out;
    f32x2* pml = wsp<f32x2>(F, WS_PML);
    const unsigned* gcnt = F.ctl + CW_GCNT;
    const int tid = F.tid, lane = F.lane, w = F.wave, r = lane & 31, hh = lane >> 5;
    if (w == 0) {
        int c[8], s = 0;
#pragma unroll
        for (int k = 0; k < 8; ++k) { const unsigned cc = __hip_atomic_load(gcnt + lane * 8 + k, RLX_AGENT); c[k] = 1 + (int)((cc + 255u) >> 8); s += c[k]; }
        int incl = s;
#pragma unroll
        for (int o = 1; o < 64; o <<= 1) { const int t = __shfl_up(incl, o); if (lane >= o) incl += t; }
        int run = incl - s;
#pragma unroll
        for (int k = 0; k < 8; ++k) { pre[lane * 8 + k] = run; run += c[k]; }
        if (lane == 63) pre[512] = incl;
    }
    __syncthreads();
    const int total = pre[512];
    for (int ti = F.bid; ti < total; ti += F.G) {
        int lo = 0, hi = 511;
        while (lo < hi) { const int mid = (lo + hi + 1) >> 1; if (pre[mid] <= ti) lo = mid; else hi = mid - 1; }
        const int h = lo >> 6, n = lo & 63, seg = ti - pre[lo];
        const int cnt = (int)__hip_atomic_load(gcnt + lo, RLX_AGENT);
        const int nvalid = seg == 0 ? 256 : min(256, cnt - (seg - 1) * 256);
#pragma unroll
        for (int p = 0; p < 8; ++p) {
            const int idx = p * NTHREADS + tid;
            { const int row = idx >> 4, pc = idx & 15; const u32x4 v = *(const u32x4*)(kg + (size_t)(n * LBLK + row) * AW + h * HD + pc * 8); *(LAS u32x4*)(Kl + row * AT_KSTR + pc * 16) = v; }
            { const int d = idx >> 5, pc = idx & 31; const u32x4 v = *(const u32x4*)(vt + (size_t)(h * HD + d) * S_ + n * LBLK + pc * 8);
              LAS u32x2* dst = (LAS u32x2*)(Vl + d * AT_VSTR + pc * 16); dst[0] = (u32x2){v.x, v.y}; dst[1] = (u32x2){v.z, v.w}; }
        }
        __syncthreads();
        const int ei = w * 32 + r; const bool valid = ei < nvalid;
        int t, slot;
        if (seg == 0) { t = n * LBLK + ei; slot = 3; }
        else { const int e = valid ? list[(size_t)h * LSTRIDE + list_off(n) + (seg - 1) * 256 + ei] : 0; t = e >> 2; slot = e & 3; }
        bf16x8 Qf[8];
        { const bf16x8* qp = (const bf16x8*)(q + (size_t)t * AW + h * HD + 8 * hh);
#pragma unroll
          for (int s = 0; s < 8; ++s) Qf[s] = qp[2 * s]; }
        f32x16 X[8];
#pragma unroll
        for (int kb = 0; kb < 8; ++kb) {
            f32x16 x;
#pragma unroll
            for (int i = 0; i < 16; ++i) x[i] = 0.f;
#pragma unroll
            for (int s = 0; s < 8; ++s) { const bf16x8 a = *(const LAS bf16x8*)(Kl + (kb * 32 + r) * AT_KSTR + 32 * s + 16 * hh); x = __builtin_amdgcn_mfma_f32_32x32x16_bf16(a, Qf[s], x, 0, 0, 0); }
            X[kb] = x;
        }
        if (seg == 0) {
            const int ql = w * 32 + r;
#pragma unroll
            for (int kb = 0; kb < 8; ++kb)
#pragma unroll
                for (int i = 0; i < 16; ++i) if (kb * 32 + crow(i, hh) > ql) X[kb][i] = -INFINITY;
        }
        float mx = -INFINITY;
#pragma unroll
        for (int kb = 0; kb < 8; ++kb)
#pragma unroll
            for (int i = 0; i < 16; ++i) mx = fmaxf(mx, X[kb][i]);
        mx = fmaxf(mx, __shfl_xor(mx, 32));
        float l = 0.f;
#pragma unroll
        for (int kb = 0; kb < 8; ++kb)
#pragma unroll
            for (int i = 0; i < 16; ++i) { const float p = __builtin_amdgcn_exp2f(X[kb][i] - mx); X[kb][i] = p; l += p; }
        l += __shfl_xor(l, 32);
        f32x16 O[4];
#pragma unroll
        for (int db = 0; db < 4; ++db)
#pragma unroll
            for (int i = 0; i < 16; ++i) O[db][i] = 0.f;
#pragma unroll
        for (int kb = 0; kb < 8; ++kb)
#pragma unroll
            for (int s2 = 0; s2 < 2; ++s2) {
                u32x4 pb; pb.x = pk2(X[kb][8 * s2 + 0], X[kb][8 * s2 + 1]); pb.y = pk2(X[kb][8 * s2 + 2], X[kb][8 * s2 + 3]); pb.z = pk2(X[kb][8 * s2 + 4], X[kb][8 * s2 + 5]); pb.w = pk2(X[kb][8 * s2 + 6], X[kb][8 * s2 + 7]);
                const bf16x8 bfrag = __builtin_bit_cast(bf16x8, pb);
#pragma unroll
                for (int db = 0; db < 4; ++db) {
                    const LAS u32x2* vp = (const LAS u32x2*)(Vl + (db * 32 + r) * AT_VSTR + (kb * 32 + 16 * s2 + 4 * hh) * 2);
                    const u32x2 a0 = vp[0], a1 = vp[2];
                    const u32x4 av = {a0.x, a0.y, a1.x, a1.y};
                    O[db] = __builtin_amdgcn_mfma_f32_32x32x16_bf16(__builtin_bit_cast(bf16x8, av), bfrag, O[db], 0, 0, 0);
                }
            }
        if (valid) {
            const float inv = 1.f / l;
            bf16* orow = po + ((size_t)(t * NH + h) * 4 + slot) * HD;
#pragma unroll
            for (int db = 0; db < 4; ++db)
#pragma unroll
                for (int g4 = 0; g4 < 4; ++g4) {
                    u32x2 o; o.x = pk2(O[db][4 * g4 + 0] * inv, O[db][4 * g4 + 1] * inv); o.y = pk2(O[db][4 * g4 + 2] * inv, O[db][4 * g4 + 3] * inv);
                    *(u32x2*)(orow + db * 32 + 8 * g4 + 4 * hh) = o;
                }
            if (hh == 0) pml[(size_t)(t * NH + h) * 4 + slot] = (f32x2){mx, l};
        }
        __syncthreads();
    }
}

DI void p4_combine(Frame& F) {
    const bf16* po = (const bf16*)F.out; const f32x2* pml = wsp<f32x2>(F, WS_PML); bf16* mixed = wsp<bf16>(F, WS_MIX);
    const size_t total = (size_t)S_ * NH * 16;
    for (size_t wi = (size_t)F.bid * NTHREADS + F.tid; wi < total; wi += (size_t)F.G * NTHREADS) {
        const int c16 = (int)(wi & 15); const size_t th = wi >> 4; const int t = (int)(th >> 3), h = (int)(th & 7);
        const int nv = min(3, t >> 8);
        float m[4], l[4]; float M = -INFINITY;
#pragma unroll
        for (int j = 0; j < 4; ++j) { const bool on = (j == 3) || (j < nv); f32x2 ml = on ? pml[th * 4 + j] : (f32x2){-INFINITY, 0.f}; m[j] = ml.x; l[j] = ml.y; M = fmaxf(M, m[j]); }
        float wj[4], W = 0.f;
#pragma unroll
        for (int j = 0; j < 4; ++j) { wj[j] = ((j == 3) || (j < nv)) ? __builtin_amdgcn_exp2f(m[j] - M) * l[j] : 0.f; W += wj[j]; }
        const float iW = 1.f / W;
        float o[8];
#pragma unroll
        for (int i = 0; i < 8; ++i) o[i] = 0.f;
#pragma unroll
        for (int j = 0; j < 4; ++j) if ((j == 3) || (j < nv)) {
            const u32x4 v = *(const u32x4*)(po + (th * 4 + j) * HD + c16 * 8); const float ww = wj[j] * iW;
            o[0] += ww * bflo(v.x); o[1] += ww * bfhi(v.x); o[2] += ww * bflo(v.y); o[3] += ww * bfhi(v.y);
            o[4] += ww * bflo(v.z); o[5] += ww * bfhi(v.z); o[6] += ww * bflo(v.w); o[7] += ww * bfhi(v.w);
        }
        u32x4 ov; ov.x = pk2(o[0], o[1]); ov.y = pk2(o[2], o[3]); ov.z = pk2(o[4], o[5]); ov.w = pk2(o[6], o[7]);
        *(u32x4*)(mixed + (size_t)t * D_ + h * HD + c16 * 8) = ov;
    }
}

struct Epi2 {
    static constexpr bool PERM = false, AFTER_DRAIN = false;
    const float* x; float* out; bf16* hb; float* ssq;
    DI void operator()(const pg8::f32x4 (&acc)[2][2][4][2], const pg8::Unit& u, int wr, int wc, int fr, int fq) const {
        asm volatile("" : "+v"(fr), "+v"(fq));
        const int row0 = u.pm * 256 + wr * 64 + fr, col0 = u.pn * 256 + wc * 32 + 4 * fq;
#pragma unroll
        for (int ai = 0; ai < 2; ++ai)
#pragma unroll
            for (int m = 0; m < 4; ++m) {
                const int row = row0 + ai * 128 + m * 16; const size_t off = (size_t)row * D_ + col0; float s = 0.f;
#pragma unroll
                for (int bj = 0; bj < 2; ++bj)
#pragma unroll
                    for (int n = 0; n < 2; ++n) {
                        const f32x4 v = *(const f32x4*)(x + off + bj * 128 + n * 16) + acc[ai][bj][m][n];
                        *(f32x4*)(out + off + bj * 128 + n * 16) = v;
                        u32x2 b; b.x = pk2(v[0], v[1]); b.y = pk2(v[2], v[3]); *(u32x2*)(hb + off + bj * 128 + n * 16) = b;
                        s += (v[0] * v[0] + v[1] * v[1]) + (v[2] * v[2] + v[3] * v[3]);
                    }
                s += __shfl_xor(s, 16); s += __shfl_xor(s, 32);
                if (fq == 0) ssq[(size_t)row * 32 + u.pn * 4 + wc] = s;
                asm volatile("" ::: "memory");
            }
    }
};
struct EpiB {
    static constexpr bool PERM = true, AFTER_DRAIN = false;
    bf16* O; int ldc;
    DI void operator()(const pg8::f32x4 (&acc)[2][2][4][2], const pg8::Unit& u, int wr, int wc, int fr, int fq) const {
        asm volatile("" : "+v"(fr), "+v"(fq));
        const int row0 = u.pm * 256 + wr * 64 + fr, col0 = u.pn * 256 + wc * 32 + 8 * fq;
#pragma unroll
        for (int ai = 0; ai < 2; ++ai)
#pragma unroll
            for (int m = 0; m < 4; ++m) { bf16* rowp = O + (size_t)(row0 + ai * 128 + m * 16) * ldc + col0;
#pragma unroll
                for (int bj = 0; bj < 2; ++bj) { const f32x4 v0 = acc[ai][bj][m][0], v1 = acc[ai][bj][m][1];
                    u32x4 w; w.x = pk2(v0[0], v0[1]); w.y = pk2(v0[2], v0[3]); w.z = pk2(v1[0], v1[1]); w.w = pk2(v1[2], v1[3]);
                    *(u32x4*)(rowp + bj * 128) = w; } }
    }
};
struct EpiP {
    static constexpr bool PERM = false, AFTER_DRAIN = false;
    bf16* O;
    DI void operator()(const pg8::f32x4 (&acc)[2][2][4][2], const pg8::Unit& u, int wr, int wc, int fr, int fq) const {
        asm volatile("" : "+v"(fr), "+v"(fq));
        const int row0 = u.pm * 256 + wr * 64 + fr, col0 = u.pn * 256 + wc * 32 + 4 * fq;
#pragma unroll
        for (int ai = 0; ai < 2; ++ai)
#pragma unroll
            for (int m = 0; m < 4; ++m) { const size_t off = (size_t)(row0 + ai * 128 + m * 16) * D_ + col0;
#pragma unroll
                for (int bj = 0; bj < 2; ++bj)
#pragma unroll
                    for (int n = 0; n < 2; ++n) { const f32x4 v = acc[ai][bj][m][n]; u32x2 b; b.x = pk2(v[0], v[1]); b.y = pk2(v[2], v[3]); *(u32x2*)(O + off + bj * 128 + n * 16) = b; } }
    }
};
struct Epi4 {
    static constexpr bool PERM = false, AFTER_DRAIN = false;
    float* out; const bf16* ple; const float* rs3; float* ssq;
    DI void operator()(const pg8::f32x4 (&acc)[2][2][4][2], const pg8::Unit& u, int wr, int wc, int fr, int fq) const {
        asm volatile("" : "+v"(fr), "+v"(fq));
        const int row0 = u.pm * 256 + wr * 64 + fr, col0 = u.pn * 256 + wc * 32 + 4 * fq;
#pragma unroll
        for (int ai = 0; ai < 2; ++ai)
#pragma unroll
            for (int m = 0; m < 4; ++m) {
                const int row = row0 + ai * 128 + m * 16; const size_t off = (size_t)row * D_ + col0; float s = 0.f; const float rs = rs3[row];
#pragma unroll
                for (int bj = 0; bj < 2; ++bj)
#pragma unroll
                    for (int n = 0; n < 2; ++n) {
                        const u32x2 pw = *(const u32x2*)(ple + off + bj * 128 + n * 16);
                        const f32x4 pv = {bflo(pw.x), bfhi(pw.x), bflo(pw.y), bfhi(pw.y)};
                        f32x4 v = *(const f32x4*)(out + off + bj * 128 + n * 16);
#pragma unroll
                        for (int i = 0; i < 4; ++i) v[i] += DBG_PLE_SCALE * sigmoidf_(acc[ai][bj][m][n][i] * rs) * pv[i];
                        *(f32x4*)(out + off + bj * 128 + n * 16) = v;
                        s += (v[0] * v[0] + v[1] * v[1]) + (v[2] * v[2] + v[3] * v[3]);
                    }
                s += __shfl_xor(s, 16); s += __shfl_xor(s, 32);
                if (fq == 0) ssq[(size_t)row * 32 + u.pn * 4 + wc] = s;
                asm volatile("" ::: "memory");
            }
    }
};

DI unsigned fkey(float f, unsigned lowbits, unsigned mask) { unsigned u = __float_as_uint(f); u = (u & 0x80000000u) ? ~u : (u | 0x80000000u); return (u & ~mask) | lowbits; }
DI float fval(unsigned k, unsigned mask) { unsigned u = k & ~mask; u = (u & 0x80000000u) ? (u & 0x7fffffffu) : ~u; return __uint_as_float(u); }
DI void ins16(unsigned (&tk)[16], unsigned x) {
    if (x > tk[15]) {
        tk[15] = x;
#pragma unroll
        for (int k = 15; k >= 1; --k) { const unsigned a = tk[k - 1], b = tk[k]; tk[k - 1] = max(a, b); tk[k] = min(a, b); }
    }
}
DI void p7_route(Frame& F) {
    const bf16* qry = wsp<bf16>(F, WS_QRY); const bf16* skb = wsp<bf16>(F, WS_SKB);
    float* stat = wsp<float>(F, WS_STAT); const float* ssq2 = wsp<float>(F, WS_SSQ2);
    int* pidx = wsp<int>(F, WS_PIDX); float* pgate = wsp<float>(F, WS_PGATE);
    LAS unsigned* tops = (LAS unsigned*)F.lds;
    const int tid = F.tid, lane = F.lane, w = F.wave, r = lane & 31, hh = lane >> 5;
    const int tg = w & 3, p = w >> 2;
    for (int it = F.bid; it < (S_ / 128) * PH; it += F.G) {
        const int h = it & 7, tb = it >> 3;
        const int t = tb * 128 + tg * 32 + r;
        float ss = 0.f;
        { const f32x4* sp = (const f32x4*)(ssq2 + (size_t)t * 32);
#pragma unroll
          for (int j = 0; j < 8; ++j) { const f32x4 v = sp[j]; ss += (v.x + v.y) + (v.z + v.w); } }
        const float rs2 = 1.f / sqrtf(ss * (1.f / D_) + EPS);
        if (h == 0 && p == 0 && hh == 0) stat[ST_RS2 + t] = rs2;
        bf16x8 Bq[8];
        { const bf16x8* qp = (const bf16x8*)(qry + (size_t)t * D_ + h * 256 + p * 128 + 8 * hh);
#pragma unroll
          for (int s = 0; s < 8; ++s) Bq[s] = qp[2 * s]; }
        unsigned tk[16];
#pragma unroll
        for (int i = 0; i < 16; ++i) tk[i] = 0u;
        const bf16* kbase = skb + (size_t)((h * 2 + p) * NKEY) * 128;
#pragma unroll
        for (int kt = 0; kt < 4; ++kt) {
            f32x16 x;
#pragma unroll
            for (int i = 0; i < 16; ++i) x[i] = 0.f;
            const bf16x8* ap = (const bf16x8*)(kbase + (size_t)(kt * 32 + r) * 128 + 8 * hh);
#pragma unroll
            for (int s = 0; s < 8; ++s) x = __builtin_amdgcn_mfma_f32_32x32x16_bf16(ap[2 * s], Bq[s], x, 0, 0, 0);
#pragma unroll
            for (int i = 0; i < 16; ++i) { const int key = kt * 32 + crow(i, hh); ins16(tk, fkey(x[i] * rs2, (unsigned)(127 - key), 127u)); }
        }
        {
            unsigned ok[16];
#pragma unroll
            for (int i = 0; i < 16; ++i) ok[i] = (unsigned)__shfl_xor((int)tk[i], 32);
#pragma unroll
            for (int i = 0; i < 16; ++i) ins16(tk, ok[i]);
        }
        if (hh == 0) {
            LAS u32x4* dst = (LAS u32x4*)(tops + ((tg * 32 + r) * 2 + p) * 16);
            dst[0] = (u32x4){tk[0], tk[1], tk[2], tk[3]}; dst[1] = (u32x4){tk[4], tk[5], tk[6], tk[7]}; dst[2] = (u32x4){tk[8], tk[9], tk[10], tk[11]}; dst[3] = (u32x4){tk[12], tk[13], tk[14], tk[15]};
        }
        __syncthreads();
        if (tid < 128) {
            const int tt = tb * 128 + tid;
            unsigned ka[16], kb[16];
            { const LAS u32x4* s = (const LAS u32x4*)(tops + (tid * 2) * 16);
#pragma unroll
              for (int j = 0; j < 4; ++j) { const u32x4 a = s[j], b = s[4 + j]; ka[4 * j] = a.x; ka[4 * j + 1] = a.y; ka[4 * j + 2] = a.z; ka[4 * j + 3] = a.w; kb[4 * j] = b.x; kb[4 * j + 1] = b.y; kb[4 * j + 2] = b.z; kb[4 * j + 3] = b.w; } }
            float va[16], vb[16];
#pragma unroll
            for (int i = 0; i < 16; ++i) { va[i] = fval(ka[i], 127u); vb[i] = fval(kb[i], 127u); }
            unsigned ck[16];
#pragma unroll
            for (int i = 0; i < 16; ++i) ck[i] = 0u;
#pragma unroll
            for (int i = 0; i < 16; ++i)
#pragma unroll
                for (int j = 0; j < 16; ++j) if ((i + 1) * (j + 1) <= 16) ins16(ck, fkey(va[i] + vb[j], (unsigned)(255 - (i * 16 + j)), 255u));
            float sv[16]; float mxv = -INFINITY;
#pragma unroll
            for (int i = 0; i < 16; ++i) { sv[i] = fval(ck[i], 255u); mxv = fmaxf(mxv, sv[i]); }
            float den = 0.f;
#pragma unroll
            for (int i = 0; i < 16; ++i) { sv[i] = __expf(sv[i] - mxv); den += sv[i]; }
            const float iden = 1.f / den;
            int* io = pidx + (size_t)tt * 128 + h * 16; float* go = pgate + (size_t)tt * 128 + h * 16;
#pragma unroll
            for (int i = 0; i < 16; ++i) {
                const int pos = 255 - (int)(ck[i] & 255u), ci = pos >> 4, cj = pos & 15;
                unsigned ea = 0u, eb = 0u;
#pragma unroll
                for (int k = 0; k < 16; ++k) { ea = (ci == k) ? ka[k] : ea; eb = (cj == k) ? kb[k] : eb; }
                io[i] = (int)((127u - (ea & 127u)) * 128u + (127u - (eb & 127u)));
                go[i] = sv[i] * iden;
            }
        }
        __syncthreads();
    }
}

typedef __bf16 bf16x8n __attribute__((ext_vector_type(8)));
DI float dot8(const u32x4 a, const u32x4 b, float acc) {
    const bf16x8n A = __builtin_bit_cast(bf16x8n, a), B = __builtin_bit_cast(bf16x8n, b);
    acc = __builtin_amdgcn_fdot2_f32_bf16(__builtin_shufflevector(A, A, 0, 1), __builtin_shufflevector(B, B, 0, 1), acc, false);
    acc = __builtin_amdgcn_fdot2_f32_bf16(__builtin_shufflevector(A, A, 2, 3), __builtin_shufflevector(B, B, 2, 3), acc, false);
    acc = __builtin_amdgcn_fdot2_f32_bf16(__builtin_shufflevector(A, A, 4, 5), __builtin_shufflevector(B, B, 4, 5), acc, false);
    acc = __builtin_amdgcn_fdot2_f32_bf16(__builtin_shufflevector(A, A, 6, 7), __builtin_shufflevector(B, B, 6, 7), acc, false);
    return acc;
}
DI void p8_peer(Frame& F) {
    const bf16* down = wsp<bf16>(F, WS_DOWN); const bf16* up = wsp<bf16>(F, WS_UP);
    bf16* hb = wsp<bf16>(F, WS_H1B); float* stat = wsp<float>(F, WS_STAT);
    const int* pidx = wsp<int>(F, WS_PIDX); const float* pgate = wsp<float>(F, WS_PGATE);
    const int lane = F.lane;
    for (int t = F.bid * NWAVES + F.wave; t < S_; t += F.G * NWAVES) {
        u32x4 hr[4];
        { const u32x4* hp = (const u32x4*)(hb + (size_t)t * D_) + lane;
#pragma unroll
          for (int j = 0; j < 4; ++j) hr[j] = hp[64 * j]; }
        const float rs2 = stat[ST_RS2 + t];
        const int e0 = pidx[(size_t)t * 128 + lane], e1 = pidx[(size_t)t * 128 + 64 + lane];
        const float g0 = pgate[(size_t)t * 128 + lane], g1 = pgate[(size_t)t * 128 + 64 + lane];
        float a0 = 0.f, a1 = 0.f;
        for (int eb = 0; eb < 128; eb += 4) {
            u32x4 dv[4][4];
#pragma unroll
            for (int k = 0; k < 4; ++k) {
                const int e = eb + k; const int ex = __builtin_amdgcn_readlane(e < 64 ? e0 : e1, e & 63);
                const u32x4* dp = (const u32x4*)(down + (size_t)ex * D_) + lane;
#pragma unroll
                for (int j = 0; j < 4; ++j) dv[k][j] = dp[64 * j];
            }
#pragma unroll
            for (int k = 0; k < 4; ++k) {
                float s = 0.f;
#pragma unroll
                for (int j = 0; j < 4; ++j) s = dot8(hr[j], dv[k][j], s);
                s = wave_sum(s);
                const int e = eb + k;
                if (e < 64) { a0 = (lane == e) ? s : a0; } else { a1 = (lane == e - 64) ? s : a1; }
            }
        }
        {
            const float z0 = a0 * rs2, z1 = a1 * rs2;
            a0 = 0.5f * z0 * (1.f + erff(z0 * 0.70710678118654752f)) * g0;
            a1 = 0.5f * z1 * (1.f + erff(z1 * 0.70710678118654752f)) * g1;
        }
        float acc[4][8];
#pragma unroll
        for (int j = 0; j < 4; ++j)
#pragma unroll
            for (int i = 0; i < 8; ++i) acc[j][i] = 0.f;
        for (int eb = 0; eb < 128; eb += 4) {
            u32x4 uv[4][4]; float av[4];
#pragma unroll
            for (int k = 0; k < 4; ++k) {
                const int e = eb + k; const int ex = __builtin_amdgcn_readlane(e < 64 ? e0 : e1, e & 63);
                av[k] = __builtin_bit_cast(float, __builtin_amdgcn_readlane(__builtin_bit_cast(int, e < 64 ? a0 : a1), e & 63));
                const u32x4* upp = (const u32x4*)(up + (size_t)ex * D_) + lane;
#pragma unroll
                for (int j = 0; j < 4; ++j) uv[k][j] = upp[64 * j];
            }
#pragma unroll
            for (int k = 0; k < 4; ++k)
#pragma unroll
                for (int j = 0; j < 4; ++j) {
                    const u32x4 v = uv[k][j]; const float a = av[k];
                    acc[j][0] += a * bflo(v.x); acc[j][1] += a * bfhi(v.x); acc[j][2] += a * bflo(v.y); acc[j][3] += a * bfhi(v.y);
                    acc[j][4] += a * bflo(v.z); acc[j][5] += a * bfhi(v.z); acc[j][6] += a * bflo(v.w); acc[j][7] += a * bfhi(v.w);
                }
        }
        float ss = 0.f;
#pragma unroll
        for (int j = 0; j < 4; ++j) {
            float* op = F.out + (size_t)t * D_ + (size_t)(lane + 64 * j) * 8;
            f32x4 x0 = *(const f32x4*)op, x1 = *(const f32x4*)(op + 4);
#ifdef DBG_ZERO_PEER
#pragma unroll
            for (int i = 0; i < 8; ++i) acc[j][i] = 0.f;
#endif
            x0[0] += acc[j][0]; x0[1] += acc[j][1]; x0[2] += acc[j][2]; x0[3] += acc[j][3];
            x1[0] += acc[j][4]; x1[1] += acc[j][5]; x1[2] += acc[j][6]; x1[3] += acc[j][7];
            *(f32x4*)op = x0; *(f32x4*)(op + 4) = x1;
            u32x4 o; o.x = pk2(x0[0], x0[1]); o.y = pk2(x0[2], x0[3]); o.z = pk2(x1[0], x1[1]); o.w = pk2(x1[2], x1[3]);
            ((u32x4*)(hb + (size_t)t * D_))[lane + 64 * j] = o;
            ss += (x0[0] * x0[0] + x0[1] * x0[1]) + (x0[2] * x0[2] + x0[3] * x0[3]) + (x1[0] * x1[0] + x1[1] * x1[1]) + (x1[2] * x1[2] + x1[3] * x1[3]);
        }
        ss = wave_sum(ss);
        if (lane == 0) stat[ST_RS3 + t] = 1.f / sqrtf(ss * (1.f / D_) + EPS);
    }
}

DI void p10_final(Frame& F) {
    const float* ssq4 = wsp<float>(F, WS_SSQ4); const float* gain = F.in[15];
    for (int m = F.bid * NWAVES + F.wave; m < S_; m += F.G * NWAVES) {
        float s = (F.lane < 32) ? ssq4[(size_t)m * 32 + F.lane] : 0.f;
        s = wave_sum(s);
        const float rs = 1.f / sqrtf(s * (1.f / D_) + EPS);
        f32x4* xr = (f32x4*)(F.out + (size_t)m * D_) + F.lane; const f32x4* gr = (const f32x4*)gain + F.lane;
#pragma unroll
        for (int j = 0; j < 8; ++j) xr[64 * j] = xr[64 * j] * rs * gr[64 * j];
    }
}

constexpr int NPHASES = 11;
struct Args { const float* in[16]; float* out; unsigned char* ws; int ph_lo, ph_hi; };
__global__ void __launch_bounds__(NTHREADS, 2) mega_fwd(Args args) {
    extern __shared__ __attribute__((aligned(16))) unsigned char lds[];
    Frame F;
    F.lds = (LAS unsigned char*)lds;
    F.tid = threadIdx.x; F.lane = F.tid & 63; F.wave = __builtin_amdgcn_readfirstlane(F.tid >> 6);
    F.G = gridDim.x; F.bid = blockIdx.x;
#pragma unroll
    for (int i = 0; i < 16; ++i) F.in[i] = args.in[i];
    F.out = args.out; F.ws = args.ws; F.ctl = (unsigned*)(args.ws + WS_CTL);
    volatile LAS unsigned* MISC = (volatile LAS unsigned*)(F.lds + MISC_OFF);
    if (F.tid < 64) MISC[F.tid] = 0u;
    __syncthreads();
    const int lo = args.ph_lo, hi = args.ph_hi;
    XcdBarrier bar; bar.bar = F.ctl + CW_BAR; bar.x = 0; bar.st = nullptr;
    if (hi - lo > 1) bar = xcd_barrier_post(F.ctl + CW_BAR, MISC + 8);
#ifdef ONLY_PHASE
#define IN(k) ((k) == ONLY_PHASE && lo <= (k) && (k) < hi)
#else
#define IN(k) (lo <= (k) && (k) < hi)
#endif
#define SEAM(k) do { if (IN(k) && IN((k) + 1)) xcd_barrier(bar); } while (0)

    if (IN(0)) { p0_prologue(F); }
    SEAM(0);
    if (IN(1)) {
        pg8::Gemm g{wsp<bf16>(F, WS_XB), wsp<bf16>(F, WS_W1T), S_, NIN, D_}; pg8::StaticOrder S; S.init(S_, NIN, F.G, F.bid);
        const float* stat = wsp<float>(F, WS_STAT);
        Epi1 E{wsp<bf16>(F, WS_Q), wsp<bf16>(F, WS_K), wsp<bf16>(F, WS_VT), wsp<bf16>(F, WS_HQ), wsp<bf16>(F, WS_HLF), wsp<bf16>(F, WS_HV), wsp<bf16>(F, WS_HG), wsp<float>(F, WS_KPART), stat + ST_RS1};
        pg8::gemm_phase<Epi1, pg8::StaticOrder, PG8_ALIGN, PG8_SP2>(F.lds, g, S, E);
    }
    SEAM(1);
    if (IN(2)) {
        p2_gate(F);
        for (int it = F.bid; it < NH * HSC; it += F.G) hgrn_item<false>(F, it & 7, it >> 3);
    }
    SEAM(2);
    if (IN(3)) { p3_attn(F); hgrn_scan(F); }
    SEAM(3);
    if (IN(4)) {
        p4_combine(F);
        for (int it = F.bid; it < NH * HSC; it += F.G) hgrn_item<true>(F, it & 7, it >> 3);
    }
    SEAM(4);
    if (IN(5)) {
        pg8::Gemm g{wsp<bf16>(F, WS_MIX), wsp<bf16>(F, WS_W2T), S_, D_, D_}; pg8::StaticOrder S; S.init(S_, D_, F.G, F.bid);
        Epi2 E{F.in[0], F.out, wsp<bf16>(F, WS_H1B), wsp<float>(F, WS_SSQ2)};
        pg8::gemm_phase<Epi2, pg8::StaticOrder, PG8_ALIGN, PG8_SP2>(F.lds, g, S, E);
    }
    SEAM(5);
    if (IN(6)) {
        pg8::Gemm g{wsp<bf16>(F, WS_H1B), wsp<bf16>(F, WS_WQT), S_, D_, D_}; pg8::StaticOrder S; S.init(S_, D_, F.G, F.bid);
        EpiB E{wsp<bf16>(F, WS_QRY), D_};
        pg8::gemm_phase<EpiB, pg8::StaticOrder, PG8_ALIGN, PG8_SP2>(F.lds, g, S, E);
    }
    SEAM(6);
    if (IN(7)) { p7_route(F); }
    SEAM(7);
    if (IN(8)) { p8_peer(F); }
    SEAM(8);
    if (IN(9)) {
        pg8::StaticOrder S; S.init(S_, D_, F.G, F.bid);
        { pg8::Gemm g{wsp<bf16>(F, WS_PB), wsp<bf16>(F, WS_WPT), S_, D_, PLE}; EpiP E{wsp<bf16>(F, WS_PLE)};
          pg8::gemm_phase<EpiP, pg8::StaticOrder, PG8_ALIGN, PG8_SP2>(F.lds, g, S, E); }
        { pg8::Gemm g{wsp<bf16>(F, WS_H1B), wsp<bf16>(F, WS_WGT), S_, D_, D_}; Epi4 E{F.out, wsp<bf16>(F, WS_PLE), wsp<float>(F, WS_STAT) + ST_RS3, wsp<float>(F, WS_SSQ4)};
          pg8::gemm_phase<Epi4, pg8::StaticOrder, PG8_ALIGN, PG8_SP2>(F.lds, g, S, E); }
    }
    SEAM(9);
    if (IN(10)) { p10_final(F); }
#undef IN
#undef SEAM
}

extern "C" void kernel_launch(void* const* d_in, const int* in_sizes, int n_in, void* d_out, int out_size, void* d_ws, size_t ws_size, hipStream_t stream) {
    static int grid = 0;
    if (grid == 0) {
        if (n_in != 16 || out_size != S_ * D_ || ws_size < WS_END) { fprintf(stderr, "kernel_launch: unexpected problem (n_in %d, out %d, ws %zu < %zu)\n", n_in, out_size, ws_size, (size_t)WS_END); grid = -1; return; }
        int dev = 0, cus = 0, per_cu = 0;
        if (hipGetDevice(&dev) != hipSuccess || hipDeviceGetAttribute(&cus, hipDeviceAttributeMultiprocessorCount, dev) != hipSuccess) { grid = -1; return; }
        if (hipFuncSetAttribute((const void*)mega_fwd, hipFuncAttributeMaxDynamicSharedMemorySize, LDS_BYTES) != hipSuccess) { fprintf(stderr, "kernel_launch: hipFuncSetAttribute failed\n"); grid = -1; return; }
        if (hipOccupancyMaxActiveBlocksPerMultiprocessor(&per_cu, (const void*)mega_fwd, NTHREADS, LDS_BYTES) != hipSuccess || per_cu < 1) { fprintf(stderr, "kernel_launch: occupancy query says %d\n", per_cu); (void)hipGetLastError(); }
        grid = cus;
    }
    if (grid < 0) return;
    (void)hipMemsetAsync((char*)d_ws + WS_CTL, 0, CTL_ZERO_BYTES, stream);
    Args a{};
    for (int i = 0; i < 16; ++i) a.in[i] = (const float*)d_in[i];
    a.out = (float*)d_out; a.ws = (unsigned char*)d_ws;
#if MK_PER_PHASE
    for (int ph = 0; ph < NPHASES; ++ph) {
        a.ph_lo = ph; a.ph_hi = ph + 1;
        hipLaunchKernelGGL(mega_fwd, dim3(grid), dim3(NTHREADS), LDS_BYTES, stream, a);
    }
#else
    a.ph_lo = 0; a.ph_hi = NPHASES;
    void* kargs[] = {&a};
    hipError_t e = hipLaunchCooperativeKernel((const void*)mega_fwd, dim3(grid), dim3(NTHREADS), kargs, LDS_BYTES, stream);
    if (e != hipSuccess) fprintf(stderr, "kernel_launch: cooperative launch failed: %s\n", hipGetErrorString(e));
#endif
}
```

```cpp
#include <hip/hip_runtime.h>
#include <cstdio>
#include <cstdint>

#ifndef DBG_PLE_SCALE
#define DBG_PLE_SCALE 1.f
#endif
#ifndef MK_PER_PHASE
#define MK_PER_PHASE 0
#endif

namespace pg8 {
#define PG8_LAS __attribute__((address_space(3)))
typedef unsigned short bf16_t;
typedef short bf16x8 __attribute__((ext_vector_type(8)));
typedef float f32x4 __attribute__((ext_vector_type(4)));
typedef unsigned u32x4 __attribute__((ext_vector_type(4)));
constexpr int BM = 256, BK = 64, HALF = 128, HTB = HALF * BK * 2, STAGE_BYTES = 8 * HTB, NXCD = 8, WGM = 8;

__host__ __device__ __forceinline__ int lds_byte(int r, int c) { const int st = (r >> 4) * 2 + (c >> 5), rr = r & 15, cc = c & 31, ob = rr * 64 + cc * 2; return st * 1024 + (ob ^ (((ob >> 9) & 1) << 5)); }
__host__ __device__ __forceinline__ void stage_rc(int b, int& R, int& C) { const int st = b / 1024, sb = b % 1024, swz = sb ^ (((sb >> 9) & 1) << 5); R = (st >> 1) * 16 + swz / 64; C = (st & 1) * 32 + (swz % 64) / 2; }
__host__ __device__ __forceinline__ int perm32(int rho) { const int n = rho >> 4, i = rho & 15; return 8 * (i >> 2) + 4 * n + (i & 3); }

struct Unit { int pm, pn; };
struct Gemm { const bf16_t* A; const bf16_t* Bt; int M, N, K; };

struct StaticOrder {
    int nM, nN, nwg, G, c;
    __host__ __device__ void init(int M, int N, int G_, int c_) { nM = M / BM; nN = N / BM; nwg = nM * nN; G = G_; c = c_; }
    __host__ __device__ bool next(int i, Unit& u) const {
        const long L = (long)i * G + c; if (L >= nwg) return false;
        int wgid = (int)L; { const int q = nwg / NXCD, r = nwg % NXCD, xcd = wgid % NXCD, off = wgid / NXCD; wgid = (xcd < r ? xcd * (q + 1) : r * (q + 1) + (xcd - r) * q) + off; }
        const int nig = WGM * nN, gid = wgid / nig, fm = gid * WGM, gsz = (nM - fm) < WGM ? (nM - fm) : WGM;
        u.pm = fm + ((wgid % nig) % gsz); u.pn = (wgid % nig) / gsz; return true;
    }
    __device__ __forceinline__ void a_ready(const Unit&) const {}
    __device__ __forceinline__ void done(const Unit&) const {}
};

template <class Epi, class Sched, bool ALIGN_EPI = false, bool SP2 = false>
__device__ __forceinline__ void gemm_phase(PG8_LAS unsigned char* lds, const Gemm g, const Sched& S, const Epi& E) {
    const int tid = threadIdx.x, wid = __builtin_amdgcn_readfirstlane(tid >> 6), lane = tid & 63, wr = wid >> 2, wc = wid & 3, fr = lane & 15, fq = lane >> 4;
    int K_ = g.K; asm volatile("" : "+s"(K_));
    const int K = K_, nt = K / BK;
    unsigned voffA[2], voffB[2];
#pragma unroll
    for (int i = 0; i < 2; ++i) { int R, C; stage_rc(tid * 16 + i * 8192, R, C); const int Rb = Epi::PERM ? ((R & ~31) + perm32(R & 31)) : R;
        voffA[i] = (unsigned)(R * K + C) * 2u; voffB[i] = (unsigned)(Rb * K + C) * 2u; }
    const size_t kstep = (size_t)(BK * 2);
    const size_t hstep = (size_t)HALF * K * 2;
    const size_t tstep = 2 * hstep;
    const unsigned ldsw = (unsigned)wid * 1024u;
    const int aoff = lds_byte(wr * 64 + fr, fq * 8), boff = lds_byte(wc * 32 + fr, fq * 8);
#define PG8_SA(b, h) (((b) * 2 + (h)) * HTB)
#define PG8_SB(b, h) ((4 + (b) * 2 + (h)) * HTB)
#define PG8_STAGE(bufoff, gbase, voff) do { _Pragma("unroll") for (int _i = 0; _i < 2; ++_i) \
        __builtin_amdgcn_global_load_lds((const unsigned*)((const char*)(gbase) + (voff)[_i]), (PG8_LAS unsigned*)(lds + (bufoff) + ldsw + _i * 8192), 16, 0, 0); } while (0)
#define PG8_LDA(dst, b, h) do { _Pragma("unroll") for (int m = 0; m < 4; ++m) _Pragma("unroll") for (int k = 0; k < 2; ++k) dst[m][k] = *(const PG8_LAS bf16x8*)(lds + PG8_SA(b, h) + aoff + m * 2048 + k * 1024); } while (0)
#define PG8_LDB(dst, b, h) do { _Pragma("unroll") for (int n = 0; n < 2; ++n) _Pragma("unroll") for (int k = 0; k < 2; ++k) dst[n][k] = *(const PG8_LAS bf16x8*)(lds + PG8_SB(b, h) + boff + n * 2048 + k * 1024); } while (0)
#define PG8_MMA(ai, bj, At, Bt) do { __builtin_amdgcn_s_setprio(1); _Pragma("unroll") for (int m = 0; m < 4; ++m) _Pragma("unroll") for (int n = 0; n < 2; ++n) _Pragma("unroll") for (int k = 0; k < 2; ++k) \
        acc[ai][bj][m][n] = __builtin_amdgcn_mfma_f32_16x16x32_bf16(Bt[n][k], At[m][k], acc[ai][bj][m][n], 0, 0, 0); __builtin_amdgcn_s_setprio(0); } while (0)
#define PG8_WAIT_V(n) asm volatile("s_waitcnt vmcnt(" #n ")" ::: "memory")
#define PG8_WAIT_L(n) asm volatile("s_waitcnt lgkmcnt(" #n ")" ::: "memory")
#define PG8_BAR __builtin_amdgcn_s_barrier()
#define PG8_SCHED __builtin_amdgcn_sched_barrier(0)
    Unit cur, nxt; int ui = 0;
    if (!S.next(0, cur)) return;
    f32x4 acc[2][2][4][2];
#pragma unroll
    for (int a = 0; a < 2; ++a)
#pragma unroll
        for (int b = 0; b < 2; ++b)
#pragma unroll
            for (int m = 0; m < 4; ++m)
#pragma unroll
                for (int n = 0; n < 2; ++n) acc[a][b][m][n] = (f32x4){0.f, 0.f, 0.f, 0.f};
    bf16x8 At[4][2], B0[2][2], B1[2][2];
    const char* cA = (const char*)g.A + (size_t)cur.pm * tstep; const char* cB = (const char*)g.Bt + (size_t)cur.pn * tstep;
    S.a_ready(cur);
    if constexpr (SP2) {
        PG8_STAGE(PG8_SB(0, 0), cB, voffB); PG8_STAGE(PG8_SB(0, 1), cB + hstep, voffB); PG8_STAGE(PG8_SA(0, 0), cA, voffA); PG8_STAGE(PG8_SA(0, 1), cA + hstep, voffA);
        if (wr == 1) PG8_BAR;
        PG8_WAIT_V(2); PG8_BAR;
        PG8_STAGE(PG8_SB(1, 0), cB + kstep, voffB); PG8_STAGE(PG8_SA(1, 0), cA + kstep, voffA); PG8_STAGE(PG8_SB(1, 1), cB + hstep + kstep, voffB);
        PG8_WAIT_V(6); PG8_BAR;
    } else {
        PG8_STAGE(PG8_SB(0, 0), cB, voffB); PG8_STAGE(PG8_SA(0, 0), cA, voffA); PG8_STAGE(PG8_SB(0, 1), cB + hstep, voffB); PG8_STAGE(PG8_SA(0, 1), cA + hstep, voffA);
        if (wr == 1) PG8_BAR;
        PG8_WAIT_V(4); PG8_BAR;
        PG8_STAGE(PG8_SB(1, 0), cB + kstep, voffB); PG8_STAGE(PG8_SA(1, 0), cA + kstep, voffA); PG8_STAGE(PG8_SB(1, 1), cB + hstep + kstep, voffB);
        PG8_WAIT_V(6); PG8_BAR;
    }
    for (;;) {
        const bool has_next = S.next(ui + 1, nxt);
        const char* nA = has_next ? (const char*)g.A + (size_t)nxt.pm * tstep : cA; const char* nB = has_next ? (const char*)g.Bt + (size_t)nxt.pn * tstep : cB;
        for (int t = 0; t < nt; t += 2) {
            const bool last = (t == nt - 2);
            const char* a1 = cA + (size_t)(t + 1) * kstep;
            const char* a2 = last ? nA : cA + (size_t)(t + 2) * kstep; const char* b2 = last ? nB : cB + (size_t)(t + 2) * kstep;
            const char* a3 = a2 + kstep; const char* b3 = b2 + kstep;
            if (last && has_next) S.a_ready(nxt);
            if constexpr (SP2) {
            PG8_LDB(B0, 0, 0); PG8_LDB(B1, 0, 1); PG8_SCHED; PG8_LDA(At, 0, 0); PG8_STAGE(PG8_SA(1, 1), a1 + hstep, voffA);
            PG8_WAIT_V(8); PG8_WAIT_L(0); PG8_BAR; PG8_MMA(0, 0, At, B0); PG8_MMA(0, 1, At, B1); PG8_BAR; PG8_SCHED;
            PG8_LDA(At, 0, 1); PG8_STAGE(PG8_SB(0, 0), b2, voffB); PG8_STAGE(PG8_SB(0, 1), b2 + hstep, voffB); PG8_STAGE(PG8_SA(0, 0), a2, voffA);
            PG8_WAIT_V(8); PG8_WAIT_L(0); PG8_BAR; PG8_MMA(1, 0, At, B0); PG8_MMA(1, 1, At, B1); PG8_BAR; PG8_SCHED;
            PG8_LDB(B0, 1, 0); PG8_LDB(B1, 1, 1); PG8_SCHED; PG8_LDA(At, 1, 0); PG8_STAGE(PG8_SA(0, 1), a2 + hstep, voffA);
            PG8_WAIT_V(8); PG8_WAIT_L(0); PG8_BAR; PG8_MMA(0, 0, At, B0); PG8_MMA(0, 1, At, B1); PG8_BAR; PG8_SCHED;
            PG8_LDA(At, 1, 1); PG8_STAGE(PG8_SB(1, 0), b3, voffB); PG8_STAGE(PG8_SB(1, 1), b3 + hstep, voffB); PG8_STAGE(PG8_SA(1, 0), a3, voffA);
            PG8_WAIT_V(8); PG8_WAIT_L(0); PG8_BAR; PG8_MMA(1, 0, At, B0); PG8_MMA(1, 1, At, B1); PG8_BAR; PG8_SCHED;
            } else {
            PG8_LDB(B0, 0, 0); PG8_SCHED; PG8_LDA(At, 0, 0); PG8_STAGE(PG8_SA(1, 1), a1 + hstep, voffA);
            PG8_WAIT_L(8); PG8_BAR; PG8_WAIT_L(0); PG8_MMA(0, 0, At, B0); PG8_BAR; PG8_SCHED;
            PG8_LDB(B1, 0, 1); PG8_STAGE(PG8_SB(0, 0), b2, voffB);
            PG8_BAR; PG8_WAIT_L(0); PG8_MMA(0, 1, At, B1); PG8_BAR;
            PG8_LDA(At, 0, 1); PG8_STAGE(PG8_SA(0, 0), a2, voffA);
            PG8_BAR; PG8_WAIT_L(0); PG8_MMA(1, 0, At, B0); PG8_BAR; PG8_SCHED;
            PG8_STAGE(PG8_SB(0, 1), b2 + hstep, voffB);
            PG8_WAIT_V(6); PG8_BAR; PG8_MMA(1, 1, At, B1); PG8_BAR;
            PG8_LDB(B0, 1, 0); PG8_SCHED; PG8_LDA(At, 1, 0); PG8_STAGE(PG8_SA(0, 1), a2 + hstep, voffA);
            PG8_WAIT_L(8); PG8_BAR; PG8_WAIT_L(0); PG8_MMA(0, 0, At, B0); PG8_BAR; PG8_SCHED;
            PG8_LDB(B1, 1, 1); PG8_STAGE(PG8_SB(1, 0), b3, voffB);
            PG8_BAR; PG8_WAIT_L(0); PG8_MMA(0, 1, At, B1); PG8_BAR;
            PG8_LDA(At, 1, 1); PG8_STAGE(PG8_SA(1, 0), a3, voffA);
            PG8_BAR; PG8_WAIT_L(0); PG8_MMA(1, 0, At, B0); PG8_BAR; PG8_SCHED;
            PG8_STAGE(PG8_SB(1, 1), b3 + hstep, voffB);
            PG8_WAIT_V(6); PG8_BAR; PG8_MMA(1, 1, At, B1); PG8_BAR;
            }
        }
        if constexpr (ALIGN_EPI) { if (wr == 0) PG8_BAR; }
        E(acc, cur, wr, wc, fr, fq); S.done(cur);
        if (!has_next) break;
#pragma unroll
        for (int a = 0; a < 2; ++a)
#pragma unroll
            for (int b = 0; b < 2; ++b)
#pragma unroll
                for (int m = 0; m < 4; ++m)
#pragma unroll
                    for (int n = 0; n < 2; ++n) acc[a][b][m][n] = (f32x4){0.f, 0.f, 0.f, 0.f};
        cur = nxt; cA = nA; cB = nB; ++ui;
        if constexpr (ALIGN_EPI) { if (wr == 1) PG8_BAR; }
    }
    PG8_WAIT_V(0);
    if constexpr (!ALIGN_EPI) { if (wr == 0) PG8_BAR; }
    PG8_BAR;
#undef PG8_SA
#undef PG8_SB
#undef PG8_STAGE
#undef PG8_LDA
#undef PG8_LDB
#undef PG8_MMA
#undef PG8_WAIT_V
#undef PG8_WAIT_L
#undef PG8_BAR
#undef PG8_SCHED
}
}

#define PG8_SP2 true
#define PG8_ALIGN true

constexpr int NWAVES = 8, NTHREADS = 512;
constexpr int S_ = 16384, D_ = 2048, NIN = 7168, AW = 1024, NH = 8, HD = 128, NBLK = 64, LBLK = 256;
constexpr int PLE = 256, NEXP = 16384, PH = 8, NKEY = 128, PTOP = 16;
constexpr float EPS = 1e-6f;
constexpr float QSCALE = 0.08838834764831845f * 1.4426950408889634f;
constexpr float DSCALE = 512.f, USCALE = 32.f;
constexpr int HSC = 64, HSCLEN = 256, HSUB = 32;
constexpr int LSTRIDE = 256 * (63 * 64 / 2);
__host__ __device__ __forceinline__ int list_off(int n) { return 256 * (63 * n - (n * (n - 1)) / 2); }

constexpr size_t MiB = 1u << 20;
constexpr size_t WS_CTL = 0, CTL_ZERO_BYTES = 1 * MiB;
constexpr size_t WS_W1T = 2 * MiB, WS_W2T = 30 * MiB, WS_WQT = 38 * MiB, WS_WGT = 46 * MiB, WS_WPT = 54 * MiB, WS_SKB = 55 * MiB;
constexpr size_t WS_STAT = 56 * MiB;
constexpr size_t WS_SSQ2 = 57 * MiB, WS_SSQ4 = 59 * MiB;
constexpr size_t WS_KPART = 61 * MiB, WS_HDEC = 62 * MiB;
constexpr size_t WS_PB = 63 * MiB;
constexpr size_t WS_DOWN = 71 * MiB, WS_UP = 135 * MiB;
constexpr size_t WS_R1 = 199 * MiB;
constexpr size_t WS_XB = WS_R1, WS_LIST = WS_R1, WS_PML = WS_R1 + 16 * MiB, WS_HST = WS_R1 + 20 * MiB, WS_H1B = WS_R1;
constexpr size_t WS_R2 = 263 * MiB;
constexpr size_t WS_Q = WS_R2, WS_K = WS_R2 + 32 * MiB, WS_VT = WS_R2 + 64 * MiB, WS_MIX = WS_R2, WS_QRY = WS_R2, WS_PIDX = WS_R2 + 64 * MiB, WS_PGATE = WS_R2 + 72 * MiB;
constexpr size_t WS_R3 = 359 * MiB;
constexpr size_t WS_HQ = WS_R3, WS_HLF = WS_R3 + 32 * MiB, WS_HV = WS_R3 + 64 * MiB, WS_HG = WS_R3 + 96 * MiB, WS_PLE = WS_R3;
constexpr size_t WS_END = 487 * MiB;
constexpr int CW_BAR = 4096;
constexpr int CW_GCNT = 16384;
constexpr int ST_RS1 = 0, ST_LB = S_, ST_RS2 = S_ + 1024, ST_RS3 = 2 * S_ + 1024;

constexpr int RING_BYTES = 131072;
constexpr int LDS_BYTES = 147456;
constexpr int MISC_OFF = LDS_BYTES - 256;

#define LAS __attribute__((address_space(3)))
typedef unsigned short bf16;
typedef unsigned u32x4 __attribute__((ext_vector_type(4)));
typedef unsigned u32x2 __attribute__((ext_vector_type(2)));
typedef float f32x4 __attribute__((ext_vector_type(4)));
typedef float f32x2 __attribute__((ext_vector_type(2)));
typedef float f32x16 __attribute__((ext_vector_type(16)));
typedef short bf16x8 __attribute__((ext_vector_type(8)));
typedef short s16x4 __attribute__((ext_vector_type(4)));
typedef __bf16 bf16x2n __attribute__((ext_vector_type(2)));
#define RLX_AGENT __ATOMIC_RELAXED, __HIP_MEMORY_SCOPE_AGENT
#define LDS_WAIT() asm volatile("s_waitcnt lgkmcnt(0)" ::: "memory")
#define DI __device__ __forceinline__

DI unsigned pk2(float lo, float hi) { f32x2 v = {lo, hi}; bf16x2n b = __builtin_convertvector(v, bf16x2n); return __builtin_bit_cast(unsigned, b); }
DI float bflo(unsigned u) { return __uint_as_float(u << 16); }
DI float bfhi(unsigned u) { return __uint_as_float(u & 0xffff0000u); }
DI float wave_sum(float v) {
#pragma unroll
    for (int o = 1; o < 64; o <<= 1) v += __shfl_xor(v, o);
    return v;
}
DI float sigmoidf_(float x) { return 1.f / (1.f + __expf(-x)); }
DI float siluf_(float x) { return x / (1.f + __expf(-x)); }
DI int crow(int reg, int h) { return (reg & 3) + 8 * (reg >> 2) + 4 * h; }

#define XB_TMO      128
#define XB_XCNT(j)  (256  + 64 * (j))
#define XB_XSUB(j)  (1280 + 64 * (j))
#define XB_XGEN(j)  (2304 + 64 * (j))
#define XB_TOP      3328
#define XB_TOPGEN   3392
#define XCD_BAR_WORDS 3456
#define XB_SPIN_CAP (1u << 22)
DI unsigned xb_ld(unsigned* p)              { return __hip_atomic_load(p, __ATOMIC_RELAXED, __HIP_MEMORY_SCOPE_AGENT); }
DI unsigned xb_add(unsigned* p, unsigned v) { return __hip_atomic_fetch_add(p, v, __ATOMIC_RELAXED, __HIP_MEMORY_SCOPE_AGENT); }
DI unsigned xb_xcc_id() { return (unsigned)__builtin_amdgcn_s_getreg((3 << 11) | 20) & 0xFu; }
#define XB_SPIN(cond, bar) do { unsigned _sp = 0; while (cond) { __builtin_amdgcn_s_sleep(1); \
    if ((++_sp & 255u) == 0u) { if (xb_ld(&(bar)[XB_TMO])) break; if (_sp > XB_SPIN_CAP) { atomicAdd(&(bar)[XB_TMO], 1u); break; } } } } while (0)
struct XcdBarrier { unsigned* bar; unsigned x; volatile LAS unsigned* st; };
DI XcdBarrier xcd_barrier_post(unsigned* bar, volatile LAS unsigned* st) {
    XcdBarrier b; b.bar = bar; b.x = xb_xcc_id(); b.st = st;
    if (threadIdx.x == 0) (void)xb_add(&bar[XB_XCNT(b.x)], 1u);
    return b;
}
DI void xcd_barrier_complete(unsigned* bar, unsigned x, unsigned& nloc, unsigned& nx) {
    const unsigned G = gridDim.x * gridDim.y * gridDim.z;
    unsigned sum, cnt, mine, sp = 0u;
    for (;;) {
        sum = 0u; cnt = 0u; mine = 0u;
#pragma unroll
        for (unsigned j = 0; j < 16; ++j) { const unsigned c = xb_ld(&bar[XB_XCNT(j)]); sum += c; cnt += (c > 0u) ? 1u : 0u; mine = (j == x) ? c : mine; }
        if (sum == G) break;
        __builtin_amdgcn_s_sleep(1);
        if ((++sp & 255u) == 0u) { if (xb_ld(&bar[XB_TMO])) break; if (sp > XB_SPIN_CAP) { atomicAdd(&bar[XB_TMO], 1u); break; } }
    }
    nloc = mine > 0u ? mine : 1u; nx = cnt > 0u ? cnt : 1u;
}
DI void xcd_barrier(const XcdBarrier& b) {
    asm volatile("s_waitcnt vmcnt(0)" ::: "memory");
    __syncthreads();
    if (threadIdx.x == 0) {
        unsigned* bar = b.bar;
        __builtin_amdgcn_s_waitcnt(0);
        unsigned nloc = b.st[0], nx = b.st[1];
        if (nloc == 0u) { xcd_barrier_complete(bar, b.x, nloc, nx); b.st[0] = nloc; b.st[1] = nx; }
        const unsigned old = xb_add(&bar[XB_XSUB(b.x)], 1u);
        const unsigned gen = old / nloc;
        if (old + 1u == (gen + 1u) * nloc) {
            __builtin_amdgcn_fence(__ATOMIC_RELEASE, "agent");
            asm volatile("s_waitcnt vmcnt(0)" ::: "memory");
            const unsigned og = xb_add(&bar[XB_TOP], 1u);
            const unsigned tg = og / nx;
            if (og + 1u == (tg + 1u) * nx) xb_add(&bar[XB_TOPGEN], 1u);
            else XB_SPIN(xb_ld(&bar[XB_TOPGEN]) == tg, bar);
            __builtin_amdgcn_fence(__ATOMIC_ACQUIRE, "agent");
            xb_add(&bar[XB_XGEN(b.x)], 1u);
            asm volatile("s_waitcnt vmcnt(0)" ::: "memory");
        } else {
            XB_SPIN(xb_ld(&bar[XB_XGEN(b.x)]) == gen, bar);
            __builtin_amdgcn_fence(__ATOMIC_ACQUIRE, "agent");
            asm volatile("s_waitcnt vmcnt(0)" ::: "memory");
        }
    }
    __syncthreads();
}

struct Frame {
    LAS unsigned char* lds;
    unsigned* ctl;
    int tid, lane, wave, G, bid;
    const float* in[16];
    float* out;
    unsigned char* ws;
};
template <class T> DI T* wsp(const Frame& F, size_t off) { return (T*)(F.ws + off); }

DI void p0_transpose_item(const float* W, const float* gain, int K, int N, bf16* WT, LAS float* scr, int item, int lane, int nscaled = 0, float nscale = 1.f) {
    const int nblk = N / 32, kb = item / nblk, nb = item % nblk, k0 = 64 * kb, n0 = 32 * nb; const float osc = (n0 < nscaled) ? nscale : 1.f;
#pragma unroll 8
    for (int i = 0; i < 32; ++i) { const int kk = 2 * i + (lane >> 5); const float g = (gain ? gain[k0 + kk] : 1.f) * osc; scr[kk * 33 + (lane & 31)] = W[(size_t)(k0 + kk) * N + n0 + (lane & 31)] * g; }
    LDS_WAIT(); asm volatile("" ::: "memory");
    const int c = lane & 7;
#pragma unroll
    for (int j = 0; j < 4; ++j) { const int n = (lane >> 3) + 8 * j; const LAS float* s = scr + (8 * c) * 33 + n;
        u32x4 o; o.x = pk2(s[0 * 33], s[1 * 33]); o.y = pk2(s[2 * 33], s[3 * 33]); o.z = pk2(s[4 * 33], s[5 * 33]); o.w = pk2(s[6 * 33], s[7 * 33]);
        *(u32x4*)(WT + (size_t)(n0 + n) * K + k0 + 8 * c) = o; }
    LDS_WAIT(); asm volatile("" ::: "memory");
}
DI void p0_convert(const float* src, bf16* dst, size_t n8, const float* colgain, size_t gtid, size_t gstride) {
    for (size_t i = gtid; i < n8; i += gstride) {
        f32x4 a = *(const f32x4*)(src + i * 8), b = *(const f32x4*)(src + i * 8 + 4);
        if (colgain) { const int c = (int)((i * 8) & 2047); a = a * *(const f32x4*)(colgain + c); b = b * *(const f32x4*)(colgain + c + 4); }
        u32x4 o; o.x = pk2(a.x, a.y); o.y = pk2(a.z, a.w); o.z = pk2(b.x, b.y); o.w = pk2(b.z, b.w);
        *(u32x4*)(dst + i * 8) = o;
    }
}
DI void p0_convert_fp8(const float* src, unsigned char* dst, size_t n16, const float* colgain, float scale, size_t gtid, size_t gstride) {
    for (size_t i = gtid; i < n16; i += gstride) {
        u32x4 o;
#pragma unroll
        for (int q = 0; q < 4; ++q) {
            f32x4 a = *(const f32x4*)(src + i * 16 + q * 4);
            if (colgain) { const int c = (int)((i * 16 + q * 4) & 2047); a = a * *(const f32x4*)(colgain + c); }
            a = a * scale;
            int w = __builtin_amdgcn_cvt_pk_fp8_f32(a.x, a.y, 0, false);
            w = __builtin_amdgcn_cvt_pk_fp8_f32(a.z, a.w, w, true);
            o[q] = (unsigned)w;
        }
        *(u32x4*)(dst + i * 16) = o;
    }
}
DI void p0_prologue(Frame& F) {
    LAS float* scr = (LAS float*)(F.lds + F.wave * 16384);
    const int gw = F.bid * NWAVES + F.wave, NGW = F.G * NWAVES;
    const float* x = F.in[0];
    constexpr int I1 = (D_ / 64) * (NIN / 32), I2 = (D_ / 64) * (D_ / 32), IP = (PLE / 64) * (D_ / 32);
    constexpr int NITEMS = I1 + 3 * I2 + IP;
    for (int it = gw; it < NITEMS; it += NGW) {
        int r = it;
        if (r < I1) { p0_transpose_item(F.in[3], F.in[2], D_, NIN, wsp<bf16>(F, WS_W1T), scr, r, F.lane, AW, QSCALE); continue; } r -= I1;
        if (r < I2) { p0_transpose_item(F.in[6], nullptr, D_, D_, wsp<bf16>(F, WS_W2T), scr, r, F.lane); continue; } r -= I2;
        if (r < I2) { p0_transpose_item(F.in[8], F.in[7], D_, D_, wsp<bf16>(F, WS_WQT), scr, r, F.lane); continue; } r -= I2;
        if (r < I2) { p0_transpose_item(F.in[14], F.in[12], D_, D_, wsp<bf16>(F, WS_WGT), scr, r, F.lane); continue; } r -= I2;
        p0_transpose_item(F.in[13], nullptr, PLE, D_, wsp<bf16>(F, WS_WPT), scr, r, F.lane);
    }
    float* stat = wsp<float>(F, WS_STAT);
    bf16* xb = wsp<bf16>(F, WS_XB);
    for (int m = gw; m < S_; m += NGW) {
        const f32x4* xr = (const f32x4*)(x + (size_t)m * D_) + F.lane;
        f32x4 v[8]; float s = 0.f;
#pragma unroll
        for (int j = 0; j < 8; ++j) { v[j] = xr[64 * j]; s += (v[j].x * v[j].x + v[j].y * v[j].y) + (v[j].z * v[j].z + v[j].w * v[j].w); }
        s = wave_sum(s);
        if (F.lane == 0) stat[ST_RS1 + m] = 1.f / sqrtf(s * (1.f / D_) + EPS);
        u32x2* o8 = (u32x2*)(xb + (size_t)m * D_) + F.lane;
#pragma unroll
        for (int j = 0; j < 8; ++j) { u32x2 w; w.x = pk2(v[j].x, v[j].y); w.y = pk2(v[j].z, v[j].w); o8[64 * j] = w; }
    }
    const size_t gtid = (size_t)F.bid * NTHREADS + F.tid, gstride = (size_t)F.G * NTHREADS;
    p0_convert(F.in[1], wsp<bf16>(F, WS_PB), (size_t)S_ * PLE / 8, nullptr, gtid, gstride);
    p0_convert(F.in[9], wsp<bf16>(F, WS_SKB), (size_t)PH * 2 * NKEY * 128 / 8, nullptr, gtid, gstride);
    p0_convert_fp8(F.in[10], wsp<unsigned char>(F, WS_DOWN), (size_t)NEXP * D_ / 16, F.in[7], DSCALE, gtid, gstride);
    p0_convert_fp8(F.in[11], wsp<unsigned char>(F, WS_UP), (size_t)NEXP * D_ / 16, nullptr, USCALE, gtid, gstride);
    for (size_t i = gtid; i < 1024; i += gstride) { const float l0 = F.in[4][i], l1 = F.in[4][1024 + i]; stat[ST_LB + i] = 1.f / (1.f + __expf(l1 - l0)); }
}

struct Epi1 {
    static constexpr bool PERM = true, AFTER_DRAIN = false;
    bf16 *q, *k, *vt, *hq, *hlf, *hv, *hg; float* kpart; const float* rs1;
    template <int R> DI void run(const pg8::f32x4 (&acc)[2][2][4][2], const pg8::Unit& u, int wr, int wc, int fr, int fq, bf16* dst) const {
        const int cb = (u.pn & 3) * 256;
        const int row0 = u.pm * 256 + wr * 64 + fr;
        const int colw = cb + wc * 32 + 8 * fq;
        f32x4 cs[2][2];
        if (R == 1) { cs[0][0] = cs[0][1] = cs[1][0] = cs[1][1] = (f32x4){0.f, 0.f, 0.f, 0.f}; }
#pragma unroll
        for (int ai = 0; ai < 2; ++ai)
#pragma unroll
            for (int m = 0; m < 4; ++m) {
                const int row = row0 + ai * 128 + m * 16;
                const float rs = rs1[row];
#pragma unroll
                for (int bj = 0; bj < 2; ++bj) {
                    const f32x4 v0 = acc[ai][bj][m][0] * rs, v1 = acc[ai][bj][m][1] * rs;
                    const int col = colw + 128 * bj;
                    if (R == 1) { cs[bj][0] = cs[bj][0] + v0; cs[bj][1] = cs[bj][1] + v1; }
                    if (R == 2) {
                        bf16* p = dst + (size_t)col * S_ + row;
#pragma unroll
                        for (int i = 0; i < 4; ++i) { p[(size_t)i * S_] = (bf16)(pk2(v0[i], 0.f) & 0xffffu); p[(size_t)(i + 4) * S_] = (bf16)(pk2(v1[i], 0.f) & 0xffffu); }
                    } else {
                        u32x4 w; w.x = pk2(v0[0], v0[1]); w.y = pk2(v0[2], v0[3]); w.z = pk2(v1[0], v1[1]); w.w = pk2(v1[2], v1[3]);
                        *(u32x4*)(dst + (size_t)row * AW + col) = w;
                    }
                }
                asm volatile("" ::: "memory");
            }
        if (R == 1) {
#pragma unroll
            for (int bj = 0; bj < 2; ++bj)
#pragma unroll
                for (int n = 0; n < 2; ++n)
#pragma unroll
                    for (int i = 0; i < 4; ++i) {
                        float s = cs[bj][n][i];
                        s += __shfl_xor(s, 1); s += __shfl_xor(s, 2); s += __shfl_xor(s, 4); s += __shfl_xor(s, 8);
                        if (fr == 0) kpart[(size_t)(wr * NBLK + u.pm) * AW + colw + 128 * bj + 4 * n + i] = s;
                    }
        }
    }
    DI void operator()(const pg8::f32x4 (&acc)[2][2][4][2], const pg8::Unit& u, int wr, int wc, int fr, int fq) const {
        asm volatile("" : "+v"(fr), "+v"(fq));
        const int reg = u.pn >> 2;
        if (reg == 1) run<1>(acc, u, wr, wc, fr, fq, k);
        else if (reg == 2) run<2>(acc, u, wr, wc, fr, fq, vt);
        else { bf16* dst = reg == 0 ? q : reg == 3 ? hq : reg == 4 ? hlf : reg == 5 ? hv : hg; run<0>(acc, u, wr, wc, fr, fq, dst); }
    }
};

DI void ins3(float v, int i, float& v0, float& v1, float& v2, int& i0, int& i1, int& i2) {
    const bool c0 = v > v0, c1 = v > v1, c2 = v > v2;
    v2 = c1 ? v1 : (c2 ? v : v2); i2 = c1 ? i1 : (c2 ? i : i2);
    v1 = c0 ? v0 : (c1 ? v : v1); i1 = c0 ? i0 : (c1 ? i : i1);
    v0 = c0 ? v : v0; i0 = c0 ? i : i0;
}
DI void p2_gate(Frame& F) {
    LAS float* km = (LAS float*)F.lds;
    LAS int* lcnt = (LAS int*)(F.lds + 32768);
    LAS int* lbase = (LAS int*)(F.lds + 32768 + 256);
    const float* kpart = wsp<float>(F, WS_KPART);
    const bf16* q = wsp<bf16>(F, WS_Q);
    unsigned* gcnt = F.ctl + CW_GCNT;
    int* list = wsp<int>(F, WS_LIST);
    const int tid = F.tid;
    for (int it = F.bid; it < NH * 63; it += F.G) {
        const int h = it & 7, qb = 63 - (it >> 3);
        for (int i = tid; i < qb * 128; i += NTHREADS) { const int n = i >> 7, d = i & 127; km[i] = kpart[(size_t)n * AW + h * HD + d] + kpart[(size_t)(NBLK + n) * AW + h * HD + d]; }
        if (tid < 64) lcnt[tid] = 0;
        __syncthreads();
        const int tt = tid >> 1, half = tid & 1, t = qb * LBLK + tt;
        u32x4 qv[16];
        const u32x4* qp = (const u32x4*)(q + (size_t)t * AW + h * HD);
#pragma unroll
        for (int c = 0; c < 16; ++c) qv[c] = qp[c];
        float v0 = -INFINITY, v1 = -INFINITY, v2 = -INFINITY; int i0 = -1, i1 = -1, i2 = -1;
        for (int n = half; n < qb; n += 2) {
            const LAS f32x4* kr = (const LAS f32x4*)(km + n * 128);
            float a0 = 0.f, a1 = 0.f, a2 = 0.f, a3 = 0.f;
#pragma unroll
            for (int c = 0; c < 16; ++c) {
                const f32x4 ka = kr[2 * c], kb = kr[2 * c + 1]; const u32x4 w = qv[c];
                a0 += bflo(w.x) * ka.x + bfhi(w.x) * ka.y; a1 += bflo(w.y) * ka.z + bfhi(w.y) * ka.w;
                a2 += bflo(w.z) * kb.x + bfhi(w.z) * kb.y; a3 += bflo(w.w) * kb.z + bfhi(w.w) * kb.w;
            }
            ins3((a0 + a1) + (a2 + a3), n, v0, v1, v2, i0, i1, i2);
        }
        {
            const float p0 = __shfl_xor(v0, 1), p1 = __shfl_xor(v1, 1), p2 = __shfl_xor(v2, 1);
            const int j0 = __shfl_xor(i0, 1), j1 = __shfl_xor(i1, 1), j2 = __shfl_xor(i2, 1);
            ins3(p0, j0, v0, v1, v2, i0, i1, i2);
            ins3(p1, j1, v0, v1, v2, i0, i1, i2);
            ins3(p2, j2, v0, v1, v2, i0, i1, i2);
        }
        int r0 = 0, r1 = 0, r2 = 0;
        if (half == 0) {
            if (i0 >= 0) r0 = __hip_atomic_fetch_add(lcnt + i0, 1, __ATOMIC_RELAXED, __HIP_MEMORY_SCOPE_WORKGROUP);
            if (i1 >= 0) r1 = __hip_atomic_fetch_add(lcnt + i1, 1, __ATOMIC_RELAXED, __HIP_MEMORY_SCOPE_WORKGROUP);
            if (i2 >= 0) r2 = __hip_atomic_fetch_add(lcnt + i2, 1, __ATOMIC_RELAXED, __HIP_MEMORY_SCOPE_WORKGROUP);
        }
        __syncthreads();
        if (tid < 64) { const int c = lcnt[tid]; lbase[tid] = c ? (int)__hip_atomic_fetch_add(gcnt + h * NBLK + tid, (unsigned)c, RLX_AGENT) : 0; }
        __syncthreads();
        if (half == 0) {
            int* lh = list + (size_t)h * LSTRIDE;
            if (i0 >= 0) lh[list_off(i0) + lbase[i0] + r0] = (t << 2) | 0;
            if (i1 >= 0) lh[list_off(i1) + lbase[i1] + r1] = (t << 2) | 1;
            if (i2 >= 0) lh[list_off(i2) + lbase[i2] + r2] = (t << 2) | 2;
        }
        __syncthreads();
    }
}

template <bool READOUT> DI void hgrn_item(Frame& F, int h, int sc) {
    LAS float* fA = (LAS float*)F.lds;
    LAS float* kA = fA + HSUB * 128;
    LAS float* vA = kA + HSUB * 128;
    LAS float* qA = vA + HSUB * 128;
    LAS float* oP = qA + HSUB * 128;
    const bf16* hq = wsp<bf16>(F, WS_HQ); const bf16* hlf = wsp<bf16>(F, WS_HLF); const bf16* hv = wsp<bf16>(F, WS_HV); const bf16* hg = wsp<bf16>(F, WS_HG);
    float* hst = wsp<float>(F, WS_HST) + ((size_t)sc * NH + h) * (HD * HD);
    const int tid = F.tid, w = F.wave, lane = F.lane, g = w >> 1, v = (w & 1) * 64 + lane;
    float Sreg[32];
    if (READOUT) {
#pragma unroll
        for (int i = 0; i < 32; ++i) Sreg[i] = hst[(size_t)(g * 32 + i) * HD + v];
    } else {
#pragma unroll
        for (int i = 0; i < 32; ++i) Sreg[i] = 0.f;
    }
    float dec = 1.f;
    float lbr[8];
    { const float* lbp = wsp<float>(F, WS_STAT) + ST_LB + h * HD + (tid & 15) * 8;
#pragma unroll
      for (int j = 0; j < 8; ++j) lbr[j] = lbp[j]; }
    for (int sub = 0; sub < HSCLEN / HSUB; ++sub) {
        const int t0 = sc * HSCLEN + sub * HSUB;
        {
            const int tt = tid >> 4, c8 = (tid & 15) * 8; const size_t go = (size_t)(t0 + tt) * AW + h * HD + c8;
            const u32x4 lf = *(const u32x4*)(hlf + go), vv = *(const u32x4*)(hv + go);
            const unsigned lw[4] = {lf.x, lf.y, lf.z, lf.w}, vw[4] = {vv.x, vv.y, vv.z, vv.w};
#pragma unroll
            for (int j = 0; j < 4; ++j) {
                const float f0 = lbr[2 * j] + (1.f - lbr[2 * j]) * sigmoidf_(bflo(lw[j])), f1 = lbr[2 * j + 1] + (1.f - lbr[2 * j + 1]) * sigmoidf_(bfhi(lw[j]));
                fA[tt * 128 + c8 + 2 * j] = f0; fA[tt * 128 + c8 + 2 * j + 1] = f1;
                kA[tt * 128 + c8 + 2 * j] = 1.f - f0; kA[tt * 128 + c8 + 2 * j + 1] = 1.f - f1;
                vA[tt * 128 + c8 + 2 * j] = bflo(vw[j]); vA[tt * 128 + c8 + 2 * j + 1] = bfhi(vw[j]);
            }
            if (READOUT) {
                const u32x4 qq = *(const u32x4*)(hq + go); const unsigned qw[4] = {qq.x, qq.y, qq.z, qq.w};
#pragma unroll
                for (int j = 0; j < 4; ++j) { qA[tt * 128 + c8 + 2 * j] = siluf_(bflo(qw[j])); qA[tt * 128 + c8 + 2 * j + 1] = siluf_(bfhi(qw[j])); }
            }
        }
        __syncthreads();
        if (!READOUT && tid < 128) {
#pragma unroll 8
            for (int tt = 0; tt < HSUB; ++tt) dec *= fA[tt * 128 + tid];
        }
        for (int tt = 0; tt < HSUB; ++tt) {
            const LAS f32x4* fr4 = (const LAS f32x4*)(fA + tt * 128 + g * 32);
            const LAS f32x4* kr4 = (const LAS f32x4*)(kA + tt * 128 + g * 32);
            const float vv = vA[tt * 128 + v];
            float o0 = 0.f, o1 = 0.f;
#pragma unroll
            for (int i4 = 0; i4 < 8; ++i4) {
                const f32x4 f4 = fr4[i4], k4 = kr4[i4];
#pragma unroll
                for (int j = 0; j < 4; ++j) Sreg[i4 * 4 + j] = f4[j] * Sreg[i4 * 4 + j] + (k4[j] * vv);
                if (READOUT) {
                    const f32x4 q4 = ((const LAS f32x4*)(qA + tt * 128 + g * 32))[i4];
                    o0 += q4[0] * Sreg[i4 * 4 + 0] + q4[1] * Sreg[i4 * 4 + 1]; o1 += q4[2] * Sreg[i4 * 4 + 2] + q4[3] * Sreg[i4 * 4 + 3];
                }
            }
            if (READOUT) oP[(g * HSUB + tt) * 128 + v] = o0 + o1;
        }
        __syncthreads();
        if (READOUT) {
            const float* gain = F.in[5];
            bf16* mixed = wsp<bf16>(F, WS_MIX);
#pragma unroll
            for (int j = 0; j < 4; ++j) {
                const int tt = w * 4 + j;
                float oa = 0.f, ob = 0.f;
#pragma unroll
                for (int gg = 0; gg < 4; ++gg) { oa += oP[(gg * HSUB + tt) * 128 + lane]; ob += oP[(gg * HSUB + tt) * 128 + 64 + lane]; }
                const float ss = wave_sum(oa * oa + ob * ob);
                const float r = 1.f / sqrtf(ss * (1.f / HD) + EPS);
                const size_t go = (size_t)(t0 + tt) * AW + h * HD;
                const float ga = siluf_(__uint_as_float((unsigned)hg[go + lane] << 16)), gb = siluf_(__uint_as_float((unsigned)hg[go + 64 + lane] << 16));
                bf16* mo = mixed + (size_t)(t0 + tt) * D_ + AW + h * HD;
                #ifdef DBG_ZERO_REC
                mo[lane] = 0; mo[64 + lane] = 0; continue;
#endif
                mo[lane] = (bf16)(pk2(oa * r * gain[h * HD + lane] * ga, 0.f) & 0xffffu);
                mo[64 + lane] = (bf16)(pk2(ob * r * gain[h * HD + 64 + lane] * gb, 0.f) & 0xffffu);
            }
            __syncthreads();
        }
    }
    if (!READOUT) {
#pragma unroll
        for (int i = 0; i < 32; ++i) hst[(size_t)(g * 32 + i) * HD + v] = Sreg[i];
        if (tid < 128) wsp<float>(F, WS_HDEC)[((size_t)sc * NH + h) * HD + tid] = dec;
    }
}
DI void hgrn_scan(Frame& F) {
    float* hst = wsp<float>(F, WS_HST); const float* hdec = wsp<float>(F, WS_HDEC);
    for (int e = F.bid * NTHREADS + F.tid; e < NH * HD * HD; e += F.G * NTHREADS) {
        const int hk = e >> 7;
        float cur = 0.f;
        for (int sc = 0; sc < HSC; ++sc) {
            const size_t o = (size_t)sc * (NH * HD * HD) + e;
            const float tmp = hst[o]; hst[o] = cur;
            cur = hdec[(size_t)sc * (NH * HD) + hk] * cur + tmp;
        }
    }
}

constexpr int AT_KSTR = 272, AT_VSTR = 520;
constexpr int AT_K_OFF = 0, AT_V_OFF = 256 * AT_KSTR, AT_PRE_OFF = AT_V_OFF + 128 * AT_VSTR;
static_assert(AT_PRE_OFF + 516 * 4 <= MISC_OFF, "attention LDS map");
DI void p3_attn(Frame& F) {
    LAS unsigned char* Kl = F.lds + AT_K_OFF; LAS unsigned char* Vl = F.lds + AT_V_OFF; LAS int* pre = (LAS int*)(F.lds + AT_PRE_OFF);
    const bf16* q = wsp<bf16>(F, WS_Q); const bf16* kg = wsp<bf16>(F, WS_K); const bf16* vt = wsp<bf16>(F, WS_VT);
    const int* list = wsp<int>(F, WS_LIST);
    bf16* po = (bf16*)F.out;
    f32x2* pml = wsp<f32x2>(F, WS_PML);
    const unsigned* gcnt = F.ctl + CW_GCNT;
    const int tid = F.tid, lane = F.lane, w = F.wave, r = lane & 31, hh = lane >> 5;
    if (w == 0) {
        int c[8], s = 0;
#pragma unroll
        for (int k = 0; k < 8; ++k) { const unsigned cc = __hip_atomic_load(gcnt + lane * 8 + k, RLX_AGENT); c[k] = 1 + (int)((cc + 255u) >> 8); s += c[k]; }
        int incl = s;
#pragma unroll
        for (int o = 1; o < 64; o <<= 1) { const int t = __shfl_up(incl, o); if (lane >= o) incl += t; }
        int run = incl - s;
#pragma unroll
        for (int k = 0; k < 8; ++k) { pre[lane * 8 + k] = run; run += c[k]; }
        if (lane == 63) pre[512] = incl;
    }
    __syncthreads();
    const int total = pre[512];
    for (int ti = F.bid; ti < total; ti += F.G) {
        int lo = 0, hi = 511;
        while (lo < hi) { const int mid = (lo + hi + 1) >> 1; if (pre[mid] <= ti) lo = mid; else hi = mid - 1; }
        const int h = lo >> 6, n = lo & 63, seg = ti - pre[lo];
        const int cnt = (int)__hip_atomic_load(gcnt + lo, RLX_AGENT);
        const int nvalid = seg == 0 ? 256 : min(256, cnt - (seg - 1) * 256);
#pragma unroll
        for (int p = 0; p < 8; ++p) {
            const int idx = p * NTHREADS + tid;
            { const int row = idx >> 4, pc = idx & 15; const u32x4 v = *(const u32x4*)(kg + (size_t)(n * LBLK + row) * AW + h * HD + pc * 8); *(LAS u32x4*)(Kl + row * AT_KSTR + pc * 16) = v; }
            { const int d = idx >> 5, pc = idx & 31; const u32x4 v = *(const u32x4*)(vt + (size_t)(h * HD + d) * S_ + n * LBLK + pc * 8);
              LAS u32x2* dst = (LAS u32x2*)(Vl + d * AT_VSTR + pc * 16); dst[0] = (u32x2){v.x, v.y}; dst[1] = (u32x2){v.z, v.w}; }
        }
        __syncthreads();
        const int ei = w * 32 + r; const bool valid = ei < nvalid;
        int t, slot;
        if (seg == 0) { t = n * LBLK + ei; slot = 3; }
        else { const int e = valid ? list[(size_t)h * LSTRIDE + list_off(n) + (seg - 1) * 256 + ei] : 0; t = e >> 2; slot = e & 3; }
        bf16x8 Qf[8];
        { const bf16x8* qp = (const bf16x8*)(q + (size_t)t * AW + h * HD + 8 * hh);
#pragma unroll
          for (int s = 0; s < 8; ++s) Qf[s] = qp[2 * s]; }
        f32x16 X[8];
#pragma unroll
        for (int kb = 0; kb < 8; ++kb) {
            f32x16 x;
            if (seg == 0 && kb > w) {
#pragma unroll
                for (int i = 0; i < 16; ++i) x[i] = -INFINITY;
            } else {
#pragma unroll
                for (int i = 0; i < 16; ++i) x[i] = 0.f;
#pragma unroll
                for (int s = 0; s < 8; ++s) { const bf16x8 a = *(const LAS bf16x8*)(Kl + (kb * 32 + r) * AT_KSTR + 32 * s + 16 * hh); x = __builtin_amdgcn_mfma_f32_32x32x16_bf16(a, Qf[s], x, 0, 0, 0); }
                if (seg == 0 && kb == w) {
#pragma unroll
                    for (int i = 0; i < 16; ++i) if (crow(i, hh) > r) x[i] = -INFINITY;
                }
            }
            X[kb] = x;
        }
        float mx = -INFINITY;
#pragma unroll
        for (int kb = 0; kb < 8; ++kb)
#pragma unroll
            for (int i = 0; i < 16; ++i) mx = fmaxf(mx, X[kb][i]);
        mx = fmaxf(mx, __shfl_xor(mx, 32));
        float l = 0.f;
#pragma unroll
        for (int kb = 0; kb < 8; ++kb)
#pragma unroll
            for (int i = 0; i < 16; ++i) { const float p = __builtin_amdgcn_exp2f(X[kb][i] - mx); X[kb][i] = p; l += p; }
        l += __shfl_xor(l, 32);
        f32x16 O[4];
#pragma unroll
        for (int db = 0; db < 4; ++db)
#pragma unroll
            for (int i = 0; i < 16; ++i) O[db][i] = 0.f;
#pragma unroll
        for (int kb = 0; kb < 8; ++kb)
#pragma unroll
            for (int s2 = 0; s2 < 2; ++s2) {
                u32x4 pb; pb.x = pk2(X[kb][8 * s2 + 0], X[kb][8 * s2 + 1]); pb.y = pk2(X[kb][8 * s2 + 2], X[kb][8 * s2 + 3]); pb.z = pk2(X[kb][8 * s2 + 4], X[kb][8 * s2 + 5]); pb.w = pk2(X[kb][8 * s2 + 6], X[kb][8 * s2 + 7]);
                const bf16x8 bfrag = __builtin_bit_cast(bf16x8, pb);
#pragma unroll
                for (int db = 0; db < 4; ++db) {
                    const LAS u32x2* vp = (const LAS u32x2*)(Vl + (db * 32 + r) * AT_VSTR + (kb * 32 + 16 * s2 + 4 * hh) * 2);
                    const u32x2 a0 = vp[0], a1 = vp[2];
                    const u32x4 av = {a0.x, a0.y, a1.x, a1.y};
                    O[db] = __builtin_amdgcn_mfma_f32_32x32x16_bf16(__builtin_bit_cast(bf16x8, av), bfrag, O[db], 0, 0, 0);
                }
            }
        if (valid) {
            const float inv = 1.f / l;
            bf16* orow = po + ((size_t)(t * NH + h) * 4 + slot) * HD;
#pragma unroll
            for (int db = 0; db < 4; ++db)
#pragma unroll
                for (int g4 = 0; g4 < 4; ++g4) {
                    u32x2 o; o.x = pk2(O[db][4 * g4 + 0] * inv, O[db][4 * g4 + 1] * inv); o.y = pk2(O[db][4 * g4 + 2] * inv, O[db][4 * g4 + 3] * inv);
                    *(u32x2*)(orow + db * 32 + 8 * g4 + 4 * hh) = o;
                }
            if (hh == 0) pml[(size_t)(t * NH + h) * 4 + slot] = (f32x2){mx, l};
        }
        __syncthreads();
    }
}

DI void p4_combine(Frame& F) {
    const bf16* po = (const bf16*)F.out; const f32x2* pml = wsp<f32x2>(F, WS_PML); bf16* mixed = wsp<bf16>(F, WS_MIX);
    const size_t total = (size_t)S_ * NH * 16;
    for (size_t wi = (size_t)F.bid * NTHREADS + F.tid; wi < total; wi += (size_t)F.G * NTHREADS) {
        const int c16 = (int)(wi & 15); const size_t th = wi >> 4; const int t = (int)(th >> 3), h = (int)(th & 7);
        const int nv = min(3, t >> 8);
        float m[4], l[4]; float M = -INFINITY;
#pragma unroll
        for (int j = 0; j < 4; ++j) { const bool on = (j == 3) || (j < nv); f32x2 ml = on ? pml[th * 4 + j] : (f32x2){-INFINITY, 0.f}; m[j] = ml.x; l[j] = ml.y; M = fmaxf(M, m[j]); }
        float wj[4], W = 0.f;
#pragma unroll
        for (int j = 0; j < 4; ++j) { wj[j] = ((j == 3) || (j < nv)) ? __builtin_amdgcn_exp2f(m[j] - M) * l[j] : 0.f; W += wj[j]; }
        const float iW = 1.f / W;
        float o[8];
#pragma unroll
        for (int i = 0; i < 8; ++i) o[i] = 0.f;
#pragma unroll
        for (int j = 0; j < 4; ++j) if ((j == 3) || (j < nv)) {
            const u32x4 v = *(const u32x4*)(po + (th * 4 + j) * HD + c16 * 8); const float ww = wj[j] * iW;
            o[0] += ww * bflo(v.x); o[1] += ww * bfhi(v.x); o[2] += ww * bflo(v.y); o[3] += ww * bfhi(v.y);
            o[4] += ww * bflo(v.z); o[5] += ww * bfhi(v.z); o[6] += ww * bflo(v.w); o[7] += ww * bfhi(v.w);
        }
        u32x4 ov; ov.x = pk2(o[0], o[1]); ov.y = pk2(o[2], o[3]); ov.z = pk2(o[4], o[5]); ov.w = pk2(o[6], o[7]);
        *(u32x4*)(mixed + (size_t)t * D_ + h * HD + c16 * 8) = ov;
    }
}

struct Epi2 {
    static constexpr bool PERM = false, AFTER_DRAIN = false;
    const float* x; float* out; bf16* hb; float* ssq;
    DI void operator()(const pg8::f32x4 (&acc)[2][2][4][2], const pg8::Unit& u, int wr, int wc, int fr, int fq) const {
        asm volatile("" : "+v"(fr), "+v"(fq));
        const int row0 = u.pm * 256 + wr * 64 + fr, col0 = u.pn * 256 + wc * 32 + 4 * fq;
#pragma unroll
        for (int ai = 0; ai < 2; ++ai)
#pragma unroll
            for (int m = 0; m < 4; ++m) {
                const int row = row0 + ai * 128 + m * 16; const size_t off = (size_t)row * D_ + col0; float s = 0.f;
#pragma unroll
                for (int bj = 0; bj < 2; ++bj)
#pragma unroll
                    for (int n = 0; n < 2; ++n) {
                        const f32x4 v = *(const f32x4*)(x + off + bj * 128 + n * 16) + acc[ai][bj][m][n];
                        *(f32x4*)(out + off + bj * 128 + n * 16) = v;
                        u32x2 b; b.x = pk2(v[0], v[1]); b.y = pk2(v[2], v[3]); *(u32x2*)(hb + off + bj * 128 + n * 16) = b;
                        s += (v[0] * v[0] + v[1] * v[1]) + (v[2] * v[2] + v[3] * v[3]);
                    }
                s += __shfl_xor(s, 16); s += __shfl_xor(s, 32);
                if (fq == 0) ssq[(size_t)row * 32 + u.pn * 4 + wc] = s;
                asm volatile("" ::: "memory");
            }
    }
};
struct EpiB {
    static constexpr bool PERM = true, AFTER_DRAIN = false;
    bf16* O; int ldc;
    DI void operator()(const pg8::f32x4 (&acc)[2][2][4][2], const pg8::Unit& u, int wr, int wc, int fr, int fq) const {
        asm volatile("" : "+v"(fr), "+v"(fq));
        const int row0 = u.pm * 256 + wr * 64 + fr, col0 = u.pn * 256 + wc * 32 + 8 * fq;
#pragma unroll
        for (int ai = 0; ai < 2; ++ai)
#pragma unroll
            for (int m = 0; m < 4; ++m) { bf16* rowp = O + (size_t)(row0 + ai * 128 + m * 16) * ldc + col0;
#pragma unroll
                for (int bj = 0; bj < 2; ++bj) { const f32x4 v0 = acc[ai][bj][m][0], v1 = acc[ai][bj][m][1];
                    u32x4 w; w.x = pk2(v0[0], v0[1]); w.y = pk2(v0[2], v0[3]); w.z = pk2(v1[0], v1[1]); w.w = pk2(v1[2], v1[3]);
                    *(u32x4*)(rowp + bj * 128) = w; } }
    }
};
struct EpiP {
    static constexpr bool PERM = false, AFTER_DRAIN = false;
    bf16* O;
    DI void operator()(const pg8::f32x4 (&acc)[2][2][4][2], const pg8::Unit& u, int wr, int wc, int fr, int fq) const {
        asm volatile("" : "+v"(fr), "+v"(fq));
        const int row0 = u.pm * 256 + wr * 64 + fr, col0 = u.pn * 256 + wc * 32 + 4 * fq;
#pragma unroll
        for (int ai = 0; ai < 2; ++ai)
#pragma unroll
            for (int m = 0; m < 4; ++m) { const size_t off = (size_t)(row0 + ai * 128 + m * 16) * D_ + col0;
#pragma unroll
                for (int bj = 0; bj < 2; ++bj)
#pragma unroll
                    for (int n = 0; n < 2; ++n) { const f32x4 v = acc[ai][bj][m][n]; u32x2 b; b.x = pk2(v[0], v[1]); b.y = pk2(v[2], v[3]); *(u32x2*)(O + off + bj * 128 + n * 16) = b; } }
    }
};
struct Epi4 {
    static constexpr bool PERM = false, AFTER_DRAIN = false;
    float* out; const bf16* ple; const float* rs3; float* ssq;
    DI void operator()(const pg8::f32x4 (&acc)[2][2][4][2], const pg8::Unit& u, int wr, int wc, int fr, int fq) const {
        asm volatile("" : "+v"(fr), "+v"(fq));
        const int row0 = u.pm * 256 + wr * 64 + fr, col0 = u.pn * 256 + wc * 32 + 4 * fq;
#pragma unroll
        for (int ai = 0; ai < 2; ++ai)
#pragma unroll
            for (int m = 0; m < 4; ++m) {
                const int row = row0 + ai * 128 + m * 16; const size_t off = (size_t)row * D_ + col0; float s = 0.f; const float rs = rs3[row];
#pragma unroll
                for (int bj = 0; bj < 2; ++bj)
#pragma unroll
                    for (int n = 0; n < 2; ++n) {
                        const u32x2 pw = *(const u32x2*)(ple + off + bj * 128 + n * 16);
                        const f32x4 pv = {bflo(pw.x), bfhi(pw.x), bflo(pw.y), bfhi(pw.y)};
                        f32x4 v = *(const f32x4*)(out + off + bj * 128 + n * 16);
#pragma unroll
                        for (int i = 0; i < 4; ++i) v[i] += DBG_PLE_SCALE * sigmoidf_(acc[ai][bj][m][n][i] * rs) * pv[i];
                        *(f32x4*)(out + off + bj * 128 + n * 16) = v;
                        s += (v[0] * v[0] + v[1] * v[1]) + (v[2] * v[2] + v[3] * v[3]);
                    }
                s += __shfl_xor(s, 16); s += __shfl_xor(s, 32);
                if (fq == 0) ssq[(size_t)row * 32 + u.pn * 4 + wc] = s;
                asm volatile("" ::: "memory");
            }
    }
};

DI unsigned fkey(float f, unsigned lowbits, unsigned mask) { unsigned u = __float_as_uint(f); u = (u & 0x80000000u) ? ~u : (u | 0x80000000u); return (u & ~mask) | lowbits; }
DI float fval(unsigned k, unsigned mask) { unsigned u = k & ~mask; u = (u & 0x80000000u) ? (u & 0x7fffffffu) : ~u; return __uint_as_float(u); }
DI void ins16(unsigned (&tk)[16], unsigned x) {
    if (x > tk[15]) {
        tk[15] = x;
#pragma unroll
        for (int k = 15; k >= 1; --k) { const unsigned a = tk[k - 1], b = tk[k]; tk[k - 1] = max(a, b); tk[k] = min(a, b); }
    }
}
DI void p7_route(Frame& F) {
    const bf16* qry = wsp<bf16>(F, WS_QRY); const bf16* skb = wsp<bf16>(F, WS_SKB);
    float* stat = wsp<float>(F, WS_STAT); const float* ssq2 = wsp<float>(F, WS_SSQ2);
    int* pidx = wsp<int>(F, WS_PIDX); float* pgate = wsp<float>(F, WS_PGATE);
    LAS unsigned* tops = (LAS unsigned*)F.lds;
    const int tid = F.tid, lane = F.lane, w = F.wave, r = lane & 31, hh = lane >> 5;
    const int tg = w & 3, p = w >> 2;
    for (int it = F.bid; it < (S_ / 128) * PH; it += F.G) {
        const int h = it & 7, tb = it >> 3;
        const int t = tb * 128 + tg * 32 + r;
        float ss = 0.f;
        { const f32x4* sp = (const f32x4*)(ssq2 + (size_t)t * 32);
#pragma unroll
          for (int j = 0; j < 8; ++j) { const f32x4 v = sp[j]; ss += (v.x + v.y) + (v.z + v.w); } }
        const float rs2 = 1.f / sqrtf(ss * (1.f / D_) + EPS);
        if (h == 0 && p == 0 && hh == 0) stat[ST_RS2 + t] = rs2;
        bf16x8 Bq[8];
        { const bf16x8* qp = (const bf16x8*)(qry + (size_t)t * D_ + h * 256 + p * 128 + 8 * hh);
#pragma unroll
          for (int s = 0; s < 8; ++s) Bq[s] = qp[2 * s]; }
        unsigned tk[16];
#pragma unroll
        for (int i = 0; i < 16; ++i) tk[i] = 0u;
        const bf16* kbase = skb + (size_t)((h * 2 + p) * NKEY) * 128;
#pragma unroll
        for (int kt = 0; kt < 4; ++kt) {
            f32x16 x;
#pragma unroll
            for (int i = 0; i < 16; ++i) x[i] = 0.f;
            const bf16x8* ap = (const bf16x8*)(kbase + (size_t)(kt * 32 + r) * 128 + 8 * hh);
#pragma unroll
            for (int s = 0; s < 8; ++s) x = __builtin_amdgcn_mfma_f32_32x32x16_bf16(ap[2 * s], Bq[s], x, 0, 0, 0);
#pragma unroll
            for (int i = 0; i < 16; ++i) { const int key = kt * 32 + crow(i, hh); ins16(tk, fkey(x[i] * rs2, (unsigned)(127 - key), 127u)); }
        }
        {
            unsigned ok[16];
#pragma unroll
            for (int i = 0; i < 16; ++i) ok[i] = (unsigned)__shfl_xor((int)tk[i], 32);
#pragma unroll
            for (int i = 0; i < 16; ++i) ins16(tk, ok[i]);
        }
        if (hh == 0) {
            LAS u32x4* dst = (LAS u32x4*)(tops + ((tg * 32 + r) * 2 + p) * 16);
            dst[0] = (u32x4){tk[0], tk[1], tk[2], tk[3]}; dst[1] = (u32x4){tk[4], tk[5], tk[6], tk[7]}; dst[2] = (u32x4){tk[8], tk[9], tk[10], tk[11]}; dst[3] = (u32x4){tk[12], tk[13], tk[14], tk[15]};
        }
        __syncthreads();
        if (tid < 128) {
            const int tt = tb * 128 + tid;
            unsigned ka[16], kb[16];
            { const LAS u32x4* s = (const LAS u32x4*)(tops + (tid * 2) * 16);
#pragma unroll
              for (int j = 0; j < 4; ++j) { const u32x4 a = s[j], b = s[4 + j]; ka[4 * j] = a.x; ka[4 * j + 1] = a.y; ka[4 * j + 2] = a.z; ka[4 * j + 3] = a.w; kb[4 * j] = b.x; kb[4 * j + 1] = b.y; kb[4 * j + 2] = b.z; kb[4 * j + 3] = b.w; } }
            float va[16], vb[16];
#pragma unroll
            for (int i = 0; i < 16; ++i) { va[i] = fval(ka[i], 127u); vb[i] = fval(kb[i], 127u); }
            unsigned ck[16];
#pragma unroll
            for (int i = 0; i < 16; ++i) ck[i] = 0u;
#pragma unroll
            for (int i = 0; i < 16; ++i)
#pragma unroll
                for (int j = 0; j < 16; ++j) if ((i + 1) * (j + 1) <= 16) ins16(ck, fkey(va[i] + vb[j], (unsigned)(255 - (i * 16 + j)), 255u));
            float sv[16]; float mxv = -INFINITY;
#pragma unroll
            for (int i = 0; i < 16; ++i) { sv[i] = fval(ck[i], 255u); mxv = fmaxf(mxv, sv[i]); }
            float den = 0.f;
#pragma unroll
            for (int i = 0; i < 16; ++i) { sv[i] = __expf(sv[i] - mxv); den += sv[i]; }
            const float iden = 1.f / den;
            int* io = pidx + (size_t)tt * 128 + h * 16; float* go = pgate + (size_t)tt * 128 + h * 16;
#pragma unroll
            for (int i = 0; i < 16; ++i) {
                const int pos = 255 - (int)(ck[i] & 255u), ci = pos >> 4, cj = pos & 15;
                unsigned ea = 0u, eb = 0u;
#pragma unroll
                for (int k = 0; k < 16; ++k) { ea = (ci == k) ? ka[k] : ea; eb = (cj == k) ? kb[k] : eb; }
                io[i] = (int)((127u - (ea & 127u)) * 128u + (127u - (eb & 127u)));
                go[i] = sv[i] * iden;
            }
        }
        __syncthreads();
    }
}

DI void fp8x16_to_f32(const u32x4 w, float (&f)[16]) {
#pragma unroll
    for (int q = 0; q < 4; ++q) { const f32x2 lo = __builtin_amdgcn_cvt_pk_f32_fp8((int)w[q], false), hi = __builtin_amdgcn_cvt_pk_f32_fp8((int)w[q], true); f[4 * q] = lo.x; f[4 * q + 1] = lo.y; f[4 * q + 2] = hi.x; f[4 * q + 3] = hi.y; }
}
template <bool DRY> DI void p8_peer(Frame& F) {
    const unsigned char* down = wsp<unsigned char>(F, WS_DOWN); const unsigned char* up = wsp<unsigned char>(F, WS_UP);
    bf16* hb = wsp<bf16>(F, WS_H1B); float* stat = wsp<float>(F, WS_STAT);
    const int* pidx = wsp<int>(F, WS_PIDX); const float* pgate = wsp<float>(F, WS_PGATE);
    const int lane = F.lane;
    constexpr int EB = 4;
    for (int t = F.bid * NWAVES + F.wave; t < S_; t += F.G * NWAVES) {
        float hf[2][16];
#pragma unroll
        for (int j = 0; j < 2; ++j) {
            const u32x4* hp = (const u32x4*)(hb + (size_t)t * D_ + 1024 * j + 16 * lane); const u32x4 a = hp[0], b = hp[1];
            hf[j][0] = bflo(a.x); hf[j][1] = bfhi(a.x); hf[j][2] = bflo(a.y); hf[j][3] = bfhi(a.y); hf[j][4] = bflo(a.z); hf[j][5] = bfhi(a.z); hf[j][6] = bflo(a.w); hf[j][7] = bfhi(a.w);
            hf[j][8] = bflo(b.x); hf[j][9] = bfhi(b.x); hf[j][10] = bflo(b.y); hf[j][11] = bfhi(b.y); hf[j][12] = bflo(b.z); hf[j][13] = bfhi(b.z); hf[j][14] = bflo(b.w); hf[j][15] = bfhi(b.w);
        }
        const float rs2 = stat[ST_RS2 + t] * (1.f / DSCALE);
        const int e0 = pidx[(size_t)t * 128 + lane], e1 = pidx[(size_t)t * 128 + 64 + lane];
        const float g0 = pgate[(size_t)t * 128 + lane], g1 = pgate[(size_t)t * 128 + 64 + lane];
        float a0 = 0.f, a1 = 0.f;
        for (int eb = 0; eb < 128; eb += EB) {
            u32x4 dv[EB][2];
#pragma unroll
            for (int k = 0; k < EB; ++k) {
                const int e = eb + k; const int ex = __builtin_amdgcn_readlane(e < 64 ? e0 : e1, e & 63);
                const u32x4* dp = (const u32x4*)(down + (size_t)ex * D_) + lane;
                dv[k][0] = dp[0]; dv[k][1] = dp[64];
            }
#pragma unroll
            for (int k = 0; k < EB; ++k) {
                float s0 = 0.f, s1 = 0.f;
#pragma unroll
                for (int j = 0; j < 2; ++j) { float f[16]; fp8x16_to_f32(dv[k][j], f);
#pragma unroll
                    for (int i = 0; i < 16; i += 2) { s0 += hf[j][i] * f[i]; s1 += hf[j][i + 1] * f[i + 1]; } }
                const float s = wave_sum(s0 + s1);
                const int e = eb + k;
                if (e < 64) { a0 = (lane == e) ? s : a0; } else { a1 = (lane == e - 64) ? s : a1; }
            }
        }
        {
            const float z0 = a0 * rs2, z1 = a1 * rs2;
            a0 = 0.5f * z0 * (1.f + erff(z0 * 0.70710678118654752f)) * g0 * (1.f / USCALE);
            a1 = 0.5f * z1 * (1.f + erff(z1 * 0.70710678118654752f)) * g1 * (1.f / USCALE);
        }
        float acc[2][16];
#pragma unroll
        for (int j = 0; j < 2; ++j)
#pragma unroll
            for (int i = 0; i < 16; ++i) acc[j][i] = 0.f;
        for (int eb = 0; eb < 128; eb += EB) {
            u32x4 uv[EB][2]; float av[EB];
#pragma unroll
            for (int k = 0; k < EB; ++k) {
                const int e = eb + k; const int ex = __builtin_amdgcn_readlane(e < 64 ? e0 : e1, e & 63);
                av[k] = __builtin_bit_cast(float, __builtin_amdgcn_readlane(__builtin_bit_cast(int, e < 64 ? a0 : a1), e & 63));
                const u32x4* upp = (const u32x4*)(up + (size_t)ex * D_) + lane;
                uv[k][0] = upp[0]; uv[k][1] = upp[64];
            }
#pragma unroll
            for (int k = 0; k < EB; ++k)
#pragma unroll
                for (int j = 0; j < 2; ++j) { float f[16]; fp8x16_to_f32(uv[k][j], f);
#pragma unroll
                    for (int i = 0; i < 16; ++i) acc[j][i] += av[k] * f[i]; }
        }
        float ss = 0.f;
#pragma unroll
        for (int j = 0; j < 2; ++j) {
            float* op = F.out + (size_t)t * D_ + 1024 * j + 16 * lane;
            u32x4 ob[2];
#pragma unroll
            for (int q = 0; q < 4; ++q) {
                f32x4 x = *(const f32x4*)(op + 4 * q);
                x[0] += acc[j][4 * q]; x[1] += acc[j][4 * q + 1]; x[2] += acc[j][4 * q + 2]; x[3] += acc[j][4 * q + 3];
                if (!DRY) *(f32x4*)(op + 4 * q) = x;
                ob[q >> 1][(q & 1) * 2] = pk2(x[0], x[1]); ob[q >> 1][(q & 1) * 2 + 1] = pk2(x[2], x[3]);
                ss += (x[0] * x[0] + x[1] * x[1]) + (x[2] * x[2] + x[3] * x[3]);
            }
            u32x4* hw = (u32x4*)((DRY ? wsp<bf16>(F, WS_PLE) : hb) + (size_t)t * D_ + 1024 * j + 16 * lane);
            hw[0] = ob[0]; hw[1] = ob[1];
        }
        ss = wave_sum(ss);
        if (lane == 0 && !DRY) stat[ST_RS3 + t] = 1.f / sqrtf(ss * (1.f / D_) + EPS);
    }
}

DI void p10_final(Frame& F) {
    const float* ssq4 = wsp<float>(F, WS_SSQ4); const float* gain = F.in[15];
    for (int m = F.bid * NWAVES + F.wave; m < S_; m += F.G * NWAVES) {
        float s = (F.lane < 32) ? ssq4[(size_t)m * 32 + F.lane] : 0.f;
        s = wave_sum(s);
        const float rs = 1.f / sqrtf(s * (1.f / D_) + EPS);
        f32x4* xr = (f32x4*)(F.out + (size_t)m * D_) + F.lane; const f32x4* gr = (const f32x4*)gain + F.lane;
#pragma unroll
        for (int j = 0; j < 8; ++j) xr[64 * j] = xr[64 * j] * rs * gr[64 * j];
    }
}

constexpr int NPHASES = 11;
struct Args { const float* in[16]; float* out; unsigned char* ws; int ph_lo, ph_hi; };
DI Frame make_frame(LAS unsigned char* lds) {
    typedef const Args __attribute__((address_space(4))) * cargs_t;
    cargs_t ap = (cargs_t)__builtin_amdgcn_kernarg_segment_ptr();
    asm volatile("" : "+s"(ap));
    Frame F;
    F.lds = lds;
    F.tid = threadIdx.x; F.lane = F.tid & 63; F.wave = __builtin_amdgcn_readfirstlane(F.tid >> 6);
    F.G = gridDim.x; F.bid = blockIdx.x;
#pragma unroll
    for (int i = 0; i < 16; ++i) F.in[i] = ap->in[i];
    F.out = ap->out; F.ws = ap->ws; F.ctl = (unsigned*)(ap->ws + WS_CTL);
    return F;
}
__global__ void __launch_bounds__(NTHREADS, 2) mega_fwd(Args args) {
    extern __shared__ __attribute__((aligned(16))) unsigned char lds_[];
    LAS unsigned char* lds = (LAS unsigned char*)lds_;
    volatile LAS unsigned* MISC = (volatile LAS unsigned*)(lds + MISC_OFF);
    if (threadIdx.x < 64) MISC[threadIdx.x] = 0u;
    __syncthreads();
    const int lo = args.ph_lo, hi = args.ph_hi;
    XcdBarrier bar; bar.bar = (unsigned*)(args.ws + WS_CTL) + CW_BAR; bar.x = 0; bar.st = nullptr;
    if (hi - lo > 1) bar = xcd_barrier_post((unsigned*)(args.ws + WS_CTL) + CW_BAR, MISC + 8);
#ifdef ONLY_PHASE
#define IN(k) ((k) == ONLY_PHASE && lo <= (k) && (k) < hi)
#else
#define IN(k) (lo <= (k) && (k) < hi)
#endif
#define SEAM(k) do { if (IN(k) && IN((k) + 1)) xcd_barrier(bar); } while (0)

    if (IN(0)) { Frame F = make_frame(lds); p0_prologue(F); }
    SEAM(0);
    if (IN(1)) {
        Frame F = make_frame(lds);
        pg8::Gemm g{wsp<bf16>(F, WS_XB), wsp<bf16>(F, WS_W1T), S_, NIN, D_}; pg8::StaticOrder S; S.init(S_, NIN, F.G, F.bid);
        const float* stat = wsp<float>(F, WS_STAT);
        Epi1 E{wsp<bf16>(F, WS_Q), wsp<bf16>(F, WS_K), wsp<bf16>(F, WS_VT), wsp<bf16>(F, WS_HQ), wsp<bf16>(F, WS_HLF), wsp<bf16>(F, WS_HV), wsp<bf16>(F, WS_HG), wsp<float>(F, WS_KPART), stat + ST_RS1};
        pg8::gemm_phase<Epi1, pg8::StaticOrder, PG8_ALIGN, PG8_SP2>(F.lds, g, S, E);
    }
    SEAM(1);
    if (IN(2)) {
        Frame F = make_frame(lds);
        p2_gate(F);
        for (int it = F.bid; it < NH * HSC; it += F.G) hgrn_item<false>(F, it & 7, it >> 3);
    }
    SEAM(2);
    if (IN(3)) { Frame F = make_frame(lds); p3_attn(F); hgrn_scan(F); }
    SEAM(3);
    if (IN(4)) {
        Frame F = make_frame(lds);
        p4_combine(F);
        for (int it = F.bid; it < NH * HSC; it += F.G) hgrn_item<true>(F, it & 7, it >> 3);
    }
    SEAM(4);
    if (IN(5)) {
        Frame F = make_frame(lds);
        pg8::Gemm g{wsp<bf16>(F, WS_MIX), wsp<bf16>(F, WS_W2T), S_, D_, D_}; pg8::StaticOrder S; S.init(S_, D_, F.G, F.bid);
        Epi2 E{F.in[0], F.out, wsp<bf16>(F, WS_H1B), wsp<float>(F, WS_SSQ2)};
        pg8::gemm_phase<Epi2, pg8::StaticOrder, PG8_ALIGN, PG8_SP2>(F.lds, g, S, E);
    }
    SEAM(5);
    if (IN(6)) {
        Frame F = make_frame(lds);
        pg8::Gemm g{wsp<bf16>(F, WS_H1B), wsp<bf16>(F, WS_WQT), S_, D_, D_}; pg8::StaticOrder S; S.init(S_, D_, F.G, F.bid);
        EpiB E{wsp<bf16>(F, WS_QRY), D_};
        pg8::gemm_phase<EpiB, pg8::StaticOrder, PG8_ALIGN, PG8_SP2>(F.lds, g, S, E);
    }
    SEAM(6);
    if (IN(7)) { Frame F = make_frame(lds); p7_route(F); }
    SEAM(7);
#ifdef TIME_P8
    if (IN(8)) { Frame F = make_frame(lds); p8_peer<true>(F); }
#endif
    if (IN(8)) { Frame F = make_frame(lds); p8_peer<false>(F); }
    SEAM(8);
    if (IN(9)) {
        { Frame F = make_frame(lds); pg8::StaticOrder S; S.init(S_, D_, F.G, F.bid);
          pg8::Gemm g{wsp<bf16>(F, WS_PB), wsp<bf16>(F, WS_WPT), S_, D_, PLE}; EpiP E{wsp<bf16>(F, WS_PLE)};
          pg8::gemm_phase<EpiP, pg8::StaticOrder, PG8_ALIGN, PG8_SP2>(F.lds, g, S, E); }
        { Frame F = make_frame(lds); pg8::StaticOrder S; S.init(S_, D_, F.G, F.bid);
          pg8::Gemm g{wsp<bf16>(F, WS_H1B), wsp<bf16>(F, WS_WGT), S_, D_, D_}; Epi4 E{F.out, wsp<bf16>(F, WS_PLE), wsp<float>(F, WS_STAT) + ST_RS3, wsp<float>(F, WS_SSQ4)};
          pg8::gemm_phase<Epi4, pg8::StaticOrder, PG8_ALIGN, PG8_SP2>(F.lds, g, S, E); }
    }
    SEAM(9);
    if (IN(10)) { Frame F = make_frame(lds); p10_final(F); }
#undef IN
#undef SEAM
}

extern "C" void kernel_launch(void* const* d_in, const int* in_sizes, int n_in, void* d_out, int out_size, void* d_ws, size_t ws_size, hipStream_t stream) {
    static int grid = 0;
    if (grid == 0) {
        if (n_in != 16 || out_size != S_ * D_ || ws_size < WS_END) { fprintf(stderr, "kernel_launch: unexpected problem (n_in %d, out %d, ws %zu < %zu)\n", n_in, out_size, ws_size, (size_t)WS_END); grid = -1; return; }
        int dev = 0, cus = 0, per_cu = 0;
        if (hipGetDevice(&dev) != hipSuccess || hipDeviceGetAttribute(&cus, hipDeviceAttributeMultiprocessorCount, dev) != hipSuccess) { grid = -1; return; }
        if (hipFuncSetAttribute((const void*)mega_fwd, hipFuncAttributeMaxDynamicSharedMemorySize, LDS_BYTES) != hipSuccess) { fprintf(stderr, "kernel_launch: hipFuncSetAttribute failed\n"); grid = -1; return; }
        if (hipOccupancyMaxActiveBlocksPerMultiprocessor(&per_cu, (const void*)mega_fwd, NTHREADS, LDS_BYTES) != hipSuccess || per_cu < 1) { fprintf(stderr, "kernel_launch: occupancy query says %d\n", per_cu); (void)hipGetLastError(); }
        grid = cus;
    }
    if (grid < 0) return;
    (void)hipMemsetAsync((char*)d_ws + WS_CTL, 0, CTL_ZERO_BYTES, stream);
    Args a{};
    for (int i = 0; i < 16; ++i) a.in[i] = (const float*)d_in[i];
    a.out = (float*)d_out; a.ws = (unsigned char*)d_ws;
#if MK_PER_PHASE
    for (int ph = 0; ph < NPHASES; ++ph) {
        a.ph_lo = ph; a.ph_hi = ph + 1;
        hipLaunchKernelGGL(mega_fwd, dim3(grid), dim3(NTHREADS), LDS_BYTES, stream, a);
    }
#else
    a.ph_lo = 0; a.ph_hi = NPHASES;
    void* kargs[] = {&a};
    hipError_t e = hipLaunchCooperativeKernel((const void*)mega_fwd, dim3(grid), dim3(NTHREADS), kargs, LDS_BYTES, stream);
    if (e != hipSuccess) fprintf(stderr, "kernel_launch: cooperative launch failed: %s\n", hipGetErrorString(e));
#endif
}
```

```cpp
#include <hip/hip_runtime.h>
#include <cstdio>
#include <cstdint>

#ifndef DBG_PLE_SCALE
#define DBG_PLE_SCALE 1.f
#endif
#ifndef MK_PER_PHASE
#define MK_PER_PHASE 0
#endif

namespace pg8 {
#define PG8_LAS __attribute__((address_space(3)))
typedef unsigned short bf16_t;
typedef short bf16x8 __attribute__((ext_vector_type(8)));
typedef float f32x4 __attribute__((ext_vector_type(4)));
typedef unsigned u32x4 __attribute__((ext_vector_type(4)));
constexpr int BM = 256, BK = 64, HALF = 128, HTB = HALF * BK * 2, STAGE_BYTES = 8 * HTB, NXCD = 8, WGM = 8;

__host__ __device__ __forceinline__ int lds_byte(int r, int c) { const int st = (r >> 4) * 2 + (c >> 5), rr = r & 15, cc = c & 31, ob = rr * 64 + cc * 2; return st * 1024 + (ob ^ (((ob >> 9) & 1) << 5)); }
__host__ __device__ __forceinline__ void stage_rc(int b, int& R, int& C) { const int st = b / 1024, sb = b % 1024, swz = sb ^ (((sb >> 9) & 1) << 5); R = (st >> 1) * 16 + swz / 64; C = (st & 1) * 32 + (swz % 64) / 2; }
__host__ __device__ __forceinline__ int perm32(int rho) { const int n = rho >> 4, i = rho & 15; return 8 * (i >> 2) + 4 * n + (i & 3); }

struct Unit { int pm, pn; };
struct Gemm { const bf16_t* A; const bf16_t* Bt; int M, N, K; };

struct StaticOrder {
    int nM, nN, nwg, G, c;
    __host__ __device__ void init(int M, int N, int G_, int c_) { nM = M / BM; nN = N / BM; nwg = nM * nN; G = G_; c = c_; }
    __host__ __device__ bool next(int i, Unit& u) const {
        const long L = (long)i * G + c; if (L >= nwg) return false;
        int wgid = (int)L; { const int q = nwg / NXCD, r = nwg % NXCD, xcd = wgid % NXCD, off = wgid / NXCD; wgid = (xcd < r ? xcd * (q + 1) : r * (q + 1) + (xcd - r) * q) + off; }
        const int nig = WGM * nN, gid = wgid / nig, fm = gid * WGM, gsz = (nM - fm) < WGM ? (nM - fm) : WGM;
        u.pm = fm + ((wgid % nig) % gsz); u.pn = (wgid % nig) / gsz; return true;
    }
    __device__ __forceinline__ void a_ready(const Unit&) const {}
    __device__ __forceinline__ void done(const Unit&) const {}
};

template <class Epi, class Sched, bool ALIGN_EPI = false, bool SP2 = false>
__device__ __forceinline__ void gemm_phase(PG8_LAS unsigned char* lds, const Gemm g, const Sched& S, const Epi& E) {
    const int tid = threadIdx.x, wid = __builtin_amdgcn_readfirstlane(tid >> 6), lane = tid & 63, wr = wid >> 2, wc = wid & 3, fr = lane & 15, fq = lane >> 4;
    int K_ = g.K; asm volatile("" : "+s"(K_));
    const int K = K_, nt = K / BK;
    unsigned voffA[2], voffB[2];
#pragma unroll
    for (int i = 0; i < 2; ++i) { int R, C; stage_rc(tid * 16 + i * 8192, R, C); const int Rb = Epi::PERM ? ((R & ~31) + perm32(R & 31)) : R;
        voffA[i] = (unsigned)(R * K + C) * 2u; voffB[i] = (unsigned)(Rb * K + C) * 2u; }
    const size_t kstep = (size_t)(BK * 2);
    const size_t hstep = (size_t)HALF * K * 2;
    const size_t tstep = 2 * hstep;
    const unsigned ldsw = (unsigned)wid * 1024u;
    const int aoff = lds_byte(wr * 64 + fr, fq * 8), boff = lds_byte(wc * 32 + fr, fq * 8);
#define PG8_SA(b, h) (((b) * 2 + (h)) * HTB)
#define PG8_SB(b, h) ((4 + (b) * 2 + (h)) * HTB)
#define PG8_STAGE(bufoff, gbase, voff) do { _Pragma("unroll") for (int _i = 0; _i < 2; ++_i) \
        __builtin_amdgcn_global_load_lds((const unsigned*)((const char*)(gbase) + (voff)[_i]), (PG8_LAS unsigned*)(lds + (bufoff) + ldsw + _i * 8192), 16, 0, 0); } while (0)
#define PG8_LDA(dst, b, h) do { _Pragma("unroll") for (int m = 0; m < 4; ++m) _Pragma("unroll") for (int k = 0; k < 2; ++k) dst[m][k] = *(const PG8_LAS bf16x8*)(lds + PG8_SA(b, h) + aoff + m * 2048 + k * 1024); } while (0)
#define PG8_LDB(dst, b, h) do { _Pragma("unroll") for (int n = 0; n < 2; ++n) _Pragma("unroll") for (int k = 0; k < 2; ++k) dst[n][k] = *(const PG8_LAS bf16x8*)(lds + PG8_SB(b, h) + boff + n * 2048 + k * 1024); } while (0)
#define PG8_MMA(ai, bj, At, Bt) do { __builtin_amdgcn_s_setprio(1); _Pragma("unroll") for (int m = 0; m < 4; ++m) _Pragma("unroll") for (int n = 0; n < 2; ++n) _Pragma("unroll") for (int k = 0; k < 2; ++k) \
        acc[ai][bj][m][n] = __builtin_amdgcn_mfma_f32_16x16x32_bf16(Bt[n][k], At[m][k], acc[ai][bj][m][n], 0, 0, 0); __builtin_amdgcn_s_setprio(0); } while (0)
#define PG8_WAIT_V(n) asm volatile("s_waitcnt vmcnt(" #n ")" ::: "memory")
#define PG8_WAIT_L(n) asm volatile("s_waitcnt lgkmcnt(" #n ")" ::: "memory")
#define PG8_BAR __builtin_amdgcn_s_barrier()
#define PG8_SCHED __builtin_amdgcn_sched_barrier(0)
    Unit cur, nxt; int ui = 0;
    if (!S.next(0, cur)) return;
    f32x4 acc[2][2][4][2];
#pragma unroll
    for (int a = 0; a < 2; ++a)
#pragma unroll
        for (int b = 0; b < 2; ++b)
#pragma unroll
            for (int m = 0; m < 4; ++m)
#pragma unroll
                for (int n = 0; n < 2; ++n) acc[a][b][m][n] = (f32x4){0.f, 0.f, 0.f, 0.f};
    bf16x8 At[4][2], B0[2][2], B1[2][2];
    const char* cA = (const char*)g.A + (size_t)cur.pm * tstep; const char* cB = (const char*)g.Bt + (size_t)cur.pn * tstep;
    S.a_ready(cur);
    if constexpr (SP2) {
        PG8_STAGE(PG8_SB(0, 0), cB, voffB); PG8_STAGE(PG8_SB(0, 1), cB + hstep, voffB); PG8_STAGE(PG8_SA(0, 0), cA, voffA); PG8_STAGE(PG8_SA(0, 1), cA + hstep, voffA);
        if (wr == 1) PG8_BAR;
        PG8_WAIT_V(2); PG8_BAR;
        PG8_STAGE(PG8_SB(1, 0), cB + kstep, voffB); PG8_STAGE(PG8_SA(1, 0), cA + kstep, voffA); PG8_STAGE(PG8_SB(1, 1), cB + hstep + kstep, voffB);
        PG8_WAIT_V(6); PG8_BAR;
    } else {
        PG8_STAGE(PG8_SB(0, 0), cB, voffB); PG8_STAGE(PG8_SA(0, 0), cA, voffA); PG8_STAGE(PG8_SB(0, 1), cB + hstep, voffB); PG8_STAGE(PG8_SA(0, 1), cA + hstep, voffA);
        if (wr == 1) PG8_BAR;
        PG8_WAIT_V(4); PG8_BAR;
        PG8_STAGE(PG8_SB(1, 0), cB + kstep, voffB); PG8_STAGE(PG8_SA(1, 0), cA + kstep, voffA); PG8_STAGE(PG8_SB(1, 1), cB + hstep + kstep, voffB);
        PG8_WAIT_V(6); PG8_BAR;
    }
    for (;;) {
        const bool has_next = S.next(ui + 1, nxt);
        const char* nA = has_next ? (const char*)g.A + (size_t)nxt.pm * tstep : cA; const char* nB = has_next ? (const char*)g.Bt + (size_t)nxt.pn * tstep : cB;
        for (int t = 0; t < nt; t += 2) {
            const bool last = (t == nt - 2);
            const char* a1 = cA + (size_t)(t + 1) * kstep;
            const char* a2 = last ? nA : cA + (size_t)(t + 2) * kstep; const char* b2 = last ? nB : cB + (size_t)(t + 2) * kstep;
            const char* a3 = a2 + kstep; const char* b3 = b2 + kstep;
            if (last && has_next) S.a_ready(nxt);
            if constexpr (SP2) {
            PG8_LDB(B0, 0, 0); PG8_LDB(B1, 0, 1); PG8_SCHED; PG8_LDA(At, 0, 0); PG8_STAGE(PG8_SA(1, 1), a1 + hstep, voffA);
            PG8_WAIT_V(8); PG8_WAIT_L(0); PG8_BAR; PG8_MMA(0, 0, At, B0); PG8_MMA(0, 1, At, B1); PG8_BAR; PG8_SCHED;
            PG8_LDA(At, 0, 1); PG8_STAGE(PG8_SB(0, 0), b2, voffB); PG8_STAGE(PG8_SB(0, 1), b2 + hstep, voffB); PG8_STAGE(PG8_SA(0, 0), a2, voffA);
            PG8_WAIT_V(8); PG8_WAIT_L(0); PG8_BAR; PG8_MMA(1, 0, At, B0); PG8_MMA(1, 1, At, B1); PG8_BAR; PG8_SCHED;
            PG8_LDB(B0, 1, 0); PG8_LDB(B1, 1, 1); PG8_SCHED; PG8_LDA(At, 1, 0); PG8_STAGE(PG8_SA(0, 1), a2 + hstep, voffA);
            PG8_WAIT_V(8); PG8_WAIT_L(0); PG8_BAR; PG8_MMA(0, 0, At, B0); PG8_MMA(0, 1, At, B1); PG8_BAR; PG8_SCHED;
            PG8_LDA(At, 1, 1); PG8_STAGE(PG8_SB(1, 0), b3, voffB); PG8_STAGE(PG8_SB(1, 1), b3 + hstep, voffB); PG8_STAGE(PG8_SA(1, 0), a3, voffA);
            PG8_WAIT_V(8); PG8_WAIT_L(0); PG8_BAR; PG8_MMA(1, 0, At, B0); PG8_MMA(1, 1, At, B1); PG8_BAR; PG8_SCHED;
            } else {
            PG8_LDB(B0, 0, 0); PG8_SCHED; PG8_LDA(At, 0, 0); PG8_STAGE(PG8_SA(1, 1), a1 + hstep, voffA);
            PG8_WAIT_L(8); PG8_BAR; PG8_WAIT_L(0); PG8_MMA(0, 0, At, B0); PG8_BAR; PG8_SCHED;
            PG8_LDB(B1, 0, 1); PG8_STAGE(PG8_SB(0, 0), b2, voffB);
            PG8_BAR; PG8_WAIT_L(0); PG8_MMA(0, 1, At, B1); PG8_BAR;
            PG8_LDA(At, 0, 1); PG8_STAGE(PG8_SA(0, 0), a2, voffA);
            PG8_BAR; PG8_WAIT_L(0); PG8_MMA(1, 0, At, B0); PG8_BAR; PG8_SCHED;
            PG8_STAGE(PG8_SB(0, 1), b2 + hstep, voffB);
            PG8_WAIT_V(6); PG8_BAR; PG8_MMA(1, 1, At, B1); PG8_BAR;
            PG8_LDB(B0, 1, 0); PG8_SCHED; PG8_LDA(At, 1, 0); PG8_STAGE(PG8_SA(0, 1), a2 + hstep, voffA);
            PG8_WAIT_L(8); PG8_BAR; PG8_WAIT_L(0); PG8_MMA(0, 0, At, B0); PG8_BAR; PG8_SCHED;
            PG8_LDB(B1, 1, 1); PG8_STAGE(PG8_SB(1, 0), b3, voffB);
            PG8_BAR; PG8_WAIT_L(0); PG8_MMA(0, 1, At, B1); PG8_BAR;
            PG8_LDA(At, 1, 1); PG8_STAGE(PG8_SA(1, 0), a3, voffA);
            PG8_BAR; PG8_WAIT_L(0); PG8_MMA(1, 0, At, B0); PG8_BAR; PG8_SCHED;
            PG8_STAGE(PG8_SB(1, 1), b3 + hstep, voffB);
            PG8_WAIT_V(6); PG8_BAR; PG8_MMA(1, 1, At, B1); PG8_BAR;
            }
        }
        if constexpr (ALIGN_EPI) { if (wr == 0) PG8_BAR; }
        E(acc, cur, wr, wc, fr, fq); S.done(cur);
        if (!has_next) break;
#pragma unroll
        for (int a = 0; a < 2; ++a)
#pragma unroll
            for (int b = 0; b < 2; ++b)
#pragma unroll
                for (int m = 0; m < 4; ++m)
#pragma unroll
                    for (int n = 0; n < 2; ++n) acc[a][b][m][n] = (f32x4){0.f, 0.f, 0.f, 0.f};
        cur = nxt; cA = nA; cB = nB; ++ui;
        if constexpr (ALIGN_EPI) { if (wr == 1) PG8_BAR; }
    }
    PG8_WAIT_V(0);
    if constexpr (!ALIGN_EPI) { if (wr == 0) PG8_BAR; }
    PG8_BAR;
#undef PG8_SA
#undef PG8_SB
#undef PG8_STAGE
#undef PG8_LDA
#undef PG8_LDB
#undef PG8_MMA
#undef PG8_WAIT_V
#undef PG8_WAIT_L
#undef PG8_BAR
#undef PG8_SCHED
}
}

#define PG8_SP2 true
#define PG8_ALIGN true

constexpr int NWAVES = 8, NTHREADS = 512;
constexpr int S_ = 16384, D_ = 2048, NIN = 7168, AW = 1024, NH = 8, HD = 128, NBLK = 64, LBLK = 256;
constexpr int PLE = 256, NEXP = 16384, PH = 8, NKEY = 128, PTOP = 16;
constexpr float EPS = 1e-6f;
constexpr float QSCALE = 0.08838834764831845f * 1.4426950408889634f;
constexpr float DSCALE = 512.f, USCALE = 32.f;
constexpr int HSC = 64, HSCLEN = 256, HSUB = 32;
constexpr int LSTRIDE = 256 * (63 * 64 / 2);
__host__ __device__ __forceinline__ int list_off(int n) { return 256 * (63 * n - (n * (n - 1)) / 2); }

constexpr size_t MiB = 1u << 20;
constexpr size_t WS_CTL = 0, CTL_ZERO_BYTES = 1 * MiB;
constexpr size_t WS_W1T = 2 * MiB, WS_W2T = 30 * MiB, WS_WQT = 38 * MiB, WS_WGT = 46 * MiB, WS_WPT = 54 * MiB, WS_SKB = 55 * MiB;
constexpr size_t WS_STAT = 56 * MiB;
constexpr size_t WS_SSQ2 = 57 * MiB, WS_SSQ4 = 59 * MiB;
constexpr size_t WS_KPART = 61 * MiB, WS_HDEC = 62 * MiB;
constexpr size_t WS_PB = 63 * MiB;
constexpr size_t WS_DOWN = 71 * MiB, WS_UP = 135 * MiB;
constexpr size_t WS_R1 = 199 * MiB;
constexpr size_t WS_XB = WS_R1, WS_LIST = WS_R1, WS_PML = WS_R1 + 16 * MiB, WS_HST = WS_R1 + 20 * MiB, WS_H1B = WS_R1;
constexpr size_t WS_R2 = 263 * MiB;
constexpr size_t WS_Q = WS_R2, WS_K = WS_R2 + 32 * MiB, WS_VT = WS_R2 + 64 * MiB, WS_MIX = WS_R2, WS_QRY = WS_R2, WS_PIDX = WS_R2 + 64 * MiB, WS_PGATE = WS_R2 + 72 * MiB;
constexpr size_t WS_R3 = 359 * MiB;
constexpr size_t WS_HQ = WS_R3, WS_HLF = WS_R3 + 32 * MiB, WS_HV = WS_R3 + 64 * MiB, WS_HG = WS_R3 + 96 * MiB, WS_PLE = WS_R3;
constexpr size_t WS_END = 487 * MiB;
constexpr int CW_BAR = 4096;
constexpr int CW_GCNT = 16384;
constexpr int ST_RS1 = 0, ST_LB = S_, ST_RS2 = S_ + 1024, ST_RS3 = 2 * S_ + 1024;

constexpr int RING_BYTES = 131072;
constexpr int LDS_BYTES = 147456;
constexpr int MISC_OFF = LDS_BYTES - 256;

#define LAS __attribute__((address_space(3)))
typedef unsigned short bf16;
typedef unsigned u32x4 __attribute__((ext_vector_type(4)));
typedef unsigned u32x2 __attribute__((ext_vector_type(2)));
typedef float f32x4 __attribute__((ext_vector_type(4)));
typedef float f32x2 __attribute__((ext_vector_type(2)));
typedef float f32x16 __attribute__((ext_vector_type(16)));
typedef short bf16x8 __attribute__((ext_vector_type(8)));
typedef short s16x4 __attribute__((ext_vector_type(4)));
typedef __bf16 bf16x2n __attribute__((ext_vector_type(2)));
#define RLX_AGENT __ATOMIC_RELAXED, __HIP_MEMORY_SCOPE_AGENT
#define LDS_WAIT() asm volatile("s_waitcnt lgkmcnt(0)" ::: "memory")
#define DI __device__ __forceinline__

DI unsigned pk2(float lo, float hi) { f32x2 v = {lo, hi}; bf16x2n b = __builtin_convertvector(v, bf16x2n); return __builtin_bit_cast(unsigned, b); }
DI float bflo(unsigned u) { return __uint_as_float(u << 16); }
DI float bfhi(unsigned u) { return __uint_as_float(u & 0xffff0000u); }
DI float wave_sum(float v) {
#pragma unroll
    for (int o = 1; o < 64; o <<= 1) v += __shfl_xor(v, o);
    return v;
}
DI float sigmoidf_(float x) { return 1.f / (1.f + __expf(-x)); }
DI float siluf_(float x) { return x / (1.f + __expf(-x)); }
DI int crow(int reg, int h) { return (reg & 3) + 8 * (reg >> 2) + 4 * h; }

#define XB_TMO      128
#define XB_XCNT(j)  (256  + 64 * (j))
#define XB_XSUB(j)  (1280 + 64 * (j))
#define XB_XGEN(j)  (2304 + 64 * (j))
#define XB_TOP      3328
#define XB_TOPGEN   3392
#define XCD_BAR_WORDS 3456
#define XB_SPIN_CAP (1u << 22)
DI unsigned xb_ld(unsigned* p)              { return __hip_atomic_load(p, __ATOMIC_RELAXED, __HIP_MEMORY_SCOPE_AGENT); }
DI unsigned xb_add(unsigned* p, unsigned v) { return __hip_atomic_fetch_add(p, v, __ATOMIC_RELAXED, __HIP_MEMORY_SCOPE_AGENT); }
DI unsigned xb_xcc_id() { return (unsigned)__builtin_amdgcn_s_getreg((3 << 11) | 20) & 0xFu; }
#define XB_SPIN(cond, bar) do { unsigned _sp = 0; while (cond) { __builtin_amdgcn_s_sleep(1); \
    if ((++_sp & 255u) == 0u) { if (xb_ld(&(bar)[XB_TMO])) break; if (_sp > XB_SPIN_CAP) { atomicAdd(&(bar)[XB_TMO], 1u); break; } } } } while (0)
struct XcdBarrier { unsigned* bar; unsigned x; volatile LAS unsigned* st; };
DI XcdBarrier xcd_barrier_post(unsigned* bar, volatile LAS unsigned* st) {
    XcdBarrier b; b.bar = bar; b.x = xb_xcc_id(); b.st = st;
    if (threadIdx.x == 0) (void)xb_add(&bar[XB_XCNT(b.x)], 1u);
    return b;
}
DI void xcd_barrier_complete(unsigned* bar, unsigned x, unsigned& nloc, unsigned& nx) {
    const unsigned G = gridDim.x * gridDim.y * gridDim.z;
    unsigned sum, cnt, mine, sp = 0u;
    for (;;) {
        sum = 0u; cnt = 0u; mine = 0u;
#pragma unroll
        for (unsigned j = 0; j < 16; ++j) { const unsigned c = xb_ld(&bar[XB_XCNT(j)]); sum += c; cnt += (c > 0u) ? 1u : 0u; mine = (j == x) ? c : mine; }
        if (sum == G) break;
        __builtin_amdgcn_s_sleep(1);
        if ((++sp & 255u) == 0u) { if (xb_ld(&bar[XB_TMO])) break; if (sp > XB_SPIN_CAP) { atomicAdd(&bar[XB_TMO], 1u); break; } }
    }
    nloc = mine > 0u ? mine : 1u; nx = cnt > 0u ? cnt : 1u;
}
DI void xcd_barrier(const XcdBarrier& b) {
    asm volatile("s_waitcnt vmcnt(0)" ::: "memory");
    __syncthreads();
    if (threadIdx.x == 0) {
        unsigned* bar = b.bar;
        __builtin_amdgcn_s_waitcnt(0);
        unsigned nloc = b.st[0], nx = b.st[1];
        if (nloc == 0u) { xcd_barrier_complete(bar, b.x, nloc, nx); b.st[0] = nloc; b.st[1] = nx; }
        const unsigned old = xb_add(&bar[XB_XSUB(b.x)], 1u);
        const unsigned gen = old / nloc;
        if (old + 1u == (gen + 1u) * nloc) {
            __builtin_amdgcn_fence(__ATOMIC_RELEASE, "agent");
            asm volatile("s_waitcnt vmcnt(0)" ::: "memory");
            const unsigned og = xb_add(&bar[XB_TOP], 1u);
            const unsigned tg = og / nx;
            if (og + 1u == (tg + 1u) * nx) xb_add(&bar[XB_TOPGEN], 1u);
            else XB_SPIN(xb_ld(&bar[XB_TOPGEN]) == tg, bar);
            __builtin_amdgcn_fence(__ATOMIC_ACQUIRE, "agent");
            xb_add(&bar[XB_XGEN(b.x)], 1u);
            asm volatile("s_waitcnt vmcnt(0)" ::: "memory");
        } else {
            XB_SPIN(xb_ld(&bar[XB_XGEN(b.x)]) == gen, bar);
            __builtin_amdgcn_fence(__ATOMIC_ACQUIRE, "agent");
            asm volatile("s_waitcnt vmcnt(0)" ::: "memory");
        }
    }
    __syncthreads();
}

struct Frame {
    LAS unsigned char* lds;
    unsigned* ctl;
    int tid, lane, wave, G, bid;
    const float* in[16];
    float* out;
    unsigned char* ws;
};
template <class T> DI T* wsp(const Frame& F, size_t off) { return (T*)(F.ws + off); }

DI void p0_transpose_item(const float* W, const float* gain, int K, int N, bf16* WT, LAS float* scr, int item, int lane, int nscaled = 0, float nscale = 1.f) {
    const int nblk = N / 32, kb = item / nblk, nb = item % nblk, k0 = 64 * kb, n0 = 32 * nb; const float osc = (n0 < nscaled) ? nscale : 1.f;
#pragma unroll 8
    for (int i = 0; i < 32; ++i) { const int kk = 2 * i + (lane >> 5); const float g = (gain ? gain[k0 + kk] : 1.f) * osc; scr[kk * 33 + (lane & 31)] = W[(size_t)(k0 + kk) * N + n0 + (lane & 31)] * g; }
    LDS_WAIT(); asm volatile("" ::: "memory");
    const int c = lane & 7;
#pragma unroll
    for (int j = 0; j < 4; ++j) { const int n = (lane >> 3) + 8 * j; const LAS float* s = scr + (8 * c) * 33 + n;
        u32x4 o; o.x = pk2(s[0 * 33], s[1 * 33]); o.y = pk2(s[2 * 33], s[3 * 33]); o.z = pk2(s[4 * 33], s[5 * 33]); o.w = pk2(s[6 * 33], s[7 * 33]);
        *(u32x4*)(WT + (size_t)(n0 + n) * K + k0 + 8 * c) = o; }
    LDS_WAIT(); asm volatile("" ::: "memory");
}
DI void p0_convert(const float* src, bf16* dst, size_t n8, const float* colgain, size_t gtid, size_t gstride) {
    for (size_t i = gtid; i < n8; i += gstride) {
        f32x4 a = *(const f32x4*)(src + i * 8), b = *(const f32x4*)(src + i * 8 + 4);
        if (colgain) { const int c = (int)((i * 8) & 2047); a = a * *(const f32x4*)(colgain + c); b = b * *(const f32x4*)(colgain + c + 4); }
        u32x4 o; o.x = pk2(a.x, a.y); o.y = pk2(a.z, a.w); o.z = pk2(b.x, b.y); o.w = pk2(b.z, b.w);
        *(u32x4*)(dst + i * 8) = o;
    }
}
DI void p0_convert_fp8(const float* src, unsigned char* dst, size_t n16, const float* colgain, float scale, size_t gtid, size_t gstride) {
    for (size_t i = gtid; i < n16; i += gstride) {
        u32x4 o;
#pragma unroll
        for (int q = 0; q < 4; ++q) {
            f32x4 a = *(const f32x4*)(src + i * 16 + q * 4);
            if (colgain) { const int c = (int)((i * 16 + q * 4) & 2047); a = a * *(const f32x4*)(colgain + c); }
            a = a * scale;
            int w = __builtin_amdgcn_cvt_pk_fp8_f32(a.x, a.y, 0, false);
            w = __builtin_amdgcn_cvt_pk_fp8_f32(a.z, a.w, w, true);
            o[q] = (unsigned)w;
        }
        *(u32x4*)(dst + i * 16) = o;
    }
}
DI void p0_prologue(Frame& F) {
    LAS float* scr = (LAS float*)(F.lds + F.wave * 16384);
    const int gw = F.bid * NWAVES + F.wave, NGW = F.G * NWAVES;
    const float* x = F.in[0];
    constexpr int I1 = (D_ / 64) * (NIN / 32), I2 = (D_ / 64) * (D_ / 32), IP = (PLE / 64) * (D_ / 32);
    constexpr int NITEMS = I1 + 3 * I2 + IP;
    for (int it = gw; it < NITEMS; it += NGW) {
        int r = it;
        if (r < I1) { p0_transpose_item(F.in[3], F.in[2], D_, NIN, wsp<bf16>(F, WS_W1T), scr, r, F.lane, AW, QSCALE); continue; } r -= I1;
        if (r < I2) { p0_transpose_item(F.in[6], nullptr, D_, D_, wsp<bf16>(F, WS_W2T), scr, r, F.lane); continue; } r -= I2;
        if (r < I2) { p0_transpose_item(F.in[8], F.in[7], D_, D_, wsp<bf16>(F, WS_WQT), scr, r, F.lane); continue; } r -= I2;
        if (r < I2) { p0_transpose_item(F.in[14], F.in[12], D_, D_, wsp<bf16>(F, WS_WGT), scr, r, F.lane); continue; } r -= I2;
        p0_transpose_item(F.in[13], nullptr, PLE, D_, wsp<bf16>(F, WS_WPT), scr, r, F.lane);
    }
    float* stat = wsp<float>(F, WS_STAT);
    bf16* xb = wsp<bf16>(F, WS_XB);
    for (int m = gw; m < S_; m += NGW) {
        const f32x4* xr = (const f32x4*)(x + (size_t)m * D_) + F.lane;
        f32x4 v[8]; float s = 0.f;
#pragma unroll
        for (int j = 0; j < 8; ++j) { v[j] = xr[64 * j]; s += (v[j].x * v[j].x + v[j].y * v[j].y) + (v[j].z * v[j].z + v[j].w * v[j].w); }
        s = wave_sum(s);
        if (F.lane == 0) stat[ST_RS1 + m] = 1.f / sqrtf(s * (1.f / D_) + EPS);
        u32x2* o8 = (u32x2*)(xb + (size_t)m * D_) + F.lane;
#pragma unroll
        for (int j = 0; j < 8; ++j) { u32x2 w; w.x = pk2(v[j].x, v[j].y); w.y = pk2(v[j].z, v[j].w); o8[64 * j] = w; }
    }
    const size_t gtid = (size_t)F.bid * NTHREADS + F.tid, gstride = (size_t)F.G * NTHREADS;
    p0_convert(F.in[1], wsp<bf16>(F, WS_PB), (size_t)S_ * PLE / 8, nullptr, gtid, gstride);
    p0_convert(F.in[9], wsp<bf16>(F, WS_SKB), (size_t)PH * 2 * NKEY * 128 / 8, nullptr, gtid, gstride);
    p0_convert_fp8(F.in[10], wsp<unsigned char>(F, WS_DOWN), (size_t)NEXP * D_ / 16, F.in[7], DSCALE, gtid, gstride);
    p0_convert_fp8(F.in[11], wsp<unsigned char>(F, WS_UP), (size_t)NEXP * D_ / 16, nullptr, USCALE, gtid, gstride);
    for (size_t i = gtid; i < 1024; i += gstride) { const float l0 = F.in[4][i], l1 = F.in[4][1024 + i]; stat[ST_LB + i] = 1.f / (1.f + __expf(l1 - l0)); }
}

struct Epi1 {
    static constexpr bool PERM = true, AFTER_DRAIN = false;
    bf16 *q, *k, *vt, *hq, *hlf, *hv, *hg; float* kpart; const float* rs1;
    template <int R> DI void run(const pg8::f32x4 (&acc)[2][2][4][2], const pg8::Unit& u, int wr, int wc, int fr, int fq, bf16* dst) const {
        const int cb = (u.pn & 3) * 256;
        const int row0 = u.pm * 256 + wr * 64 + fr;
        const int colw = cb + wc * 32 + 8 * fq;
        f32x4 cs[2][2];
        if (R == 1) { cs[0][0] = cs[0][1] = cs[1][0] = cs[1][1] = (f32x4){0.f, 0.f, 0.f, 0.f}; }
#pragma unroll
        for (int ai = 0; ai < 2; ++ai)
#pragma unroll
            for (int m = 0; m < 4; ++m) {
                const int row = row0 + ai * 128 + m * 16;
                const float rs = rs1[row];
#pragma unroll
                for (int bj = 0; bj < 2; ++bj) {
                    const f32x4 v0 = acc[ai][bj][m][0] * rs, v1 = acc[ai][bj][m][1] * rs;
                    const int col = colw + 128 * bj;
                    if (R == 1) { cs[bj][0] = cs[bj][0] + v0; cs[bj][1] = cs[bj][1] + v1; }
                    if (R == 2) {
                        bf16* p = dst + (size_t)col * S_ + row;
#pragma unroll
                        for (int i = 0; i < 4; ++i) { p[(size_t)i * S_] = (bf16)(pk2(v0[i], 0.f) & 0xffffu); p[(size_t)(i + 4) * S_] = (bf16)(pk2(v1[i], 0.f) & 0xffffu); }
                    } else {
                        u32x4 w; w.x = pk2(v0[0], v0[1]); w.y = pk2(v0[2], v0[3]); w.z = pk2(v1[0], v1[1]); w.w = pk2(v1[2], v1[3]);
                        *(u32x4*)(dst + (size_t)row * AW + col) = w;
                    }
                }
                asm volatile("" ::: "memory");
            }
        if (R == 1) {
#pragma unroll
            for (int bj = 0; bj < 2; ++bj)
#pragma unroll
                for (int n = 0; n < 2; ++n)
#pragma unroll
                    for (int i = 0; i < 4; ++i) {
                        float s = cs[bj][n][i];
                        s += __shfl_xor(s, 1); s += __shfl_xor(s, 2); s += __shfl_xor(s, 4); s += __shfl_xor(s, 8);
                        if (fr == 0) kpart[(size_t)(wr * NBLK + u.pm) * AW + colw + 128 * bj + 4 * n + i] = s;
                    }
        }
    }
    DI void operator()(const pg8::f32x4 (&acc)[2][2][4][2], const pg8::Unit& u, int wr, int wc, int fr, int fq) const {
        asm volatile("" : "+v"(fr), "+v"(fq));
        const int reg = u.pn >> 2;
        if (reg == 1) run<1>(acc, u, wr, wc, fr, fq, k);
        else if (reg == 2) run<2>(acc, u, wr, wc, fr, fq, vt);
        else { bf16* dst = reg == 0 ? q : reg == 3 ? hq : reg == 4 ? hlf : reg == 5 ? hv : hg; run<0>(acc, u, wr, wc, fr, fq, dst); }
    }
};

DI void ins3(float v, int i, float& v0, float& v1, float& v2, int& i0, int& i1, int& i2) {
    const bool c0 = v > v0, c1 = v > v1, c2 = v > v2;
    v2 = c1 ? v1 : (c2 ? v : v2); i2 = c1 ? i1 : (c2 ? i : i2);
    v1 = c0 ? v0 : (c1 ? v : v1); i1 = c0 ? i0 : (c1 ? i : i1);
    v0 = c0 ? v : v0; i0 = c0 ? i : i0;
}
DI void p2_gate(Frame& F) {
    LAS float* km = (LAS float*)F.lds;
    LAS int* lcnt = (LAS int*)(F.lds + 32768);
    LAS int* lbase = (LAS int*)(F.lds + 32768 + 256);
    const float* kpart = wsp<float>(F, WS_KPART);
    const bf16* q = wsp<bf16>(F, WS_Q);
    unsigned* gcnt = F.ctl + CW_GCNT;
    int* list = wsp<int>(F, WS_LIST);
    const int tid = F.tid;
    for (int it = F.bid; it < NH * 63; it += F.G) {
        const int h = it & 7, qb = 63 - (it >> 3);
        for (int i = tid; i < qb * 128; i += NTHREADS) { const int n = i >> 7, d = i & 127; km[i] = kpart[(size_t)n * AW + h * HD + d] + kpart[(size_t)(NBLK + n) * AW + h * HD + d]; }
        if (tid < 64) lcnt[tid] = 0;
        __syncthreads();
        const int tt = tid >> 1, half = tid & 1, t = qb * LBLK + tt;
        u32x4 qv[16];
        const u32x4* qp = (const u32x4*)(q + (size_t)t * AW + h * HD);
#pragma unroll
        for (int c = 0; c < 16; ++c) qv[c] = qp[c];
        float v0 = -INFINITY, v1 = -INFINITY, v2 = -INFINITY; int i0 = -1, i1 = -1, i2 = -1;
        for (int n = half; n < qb; n += 2) {
            const LAS f32x4* kr = (const LAS f32x4*)(km + n * 128);
            float a0 = 0.f, a1 = 0.f, a2 = 0.f, a3 = 0.f;
#pragma unroll
            for (int c = 0; c < 16; ++c) {
                const f32x4 ka = kr[2 * c], kb = kr[2 * c + 1]; const u32x4 w = qv[c];
                a0 += bflo(w.x) * ka.x + bfhi(w.x) * ka.y; a1 += bflo(w.y) * ka.z + bfhi(w.y) * ka.w;
                a2 += bflo(w.z) * kb.x + bfhi(w.z) * kb.y; a3 += bflo(w.w) * kb.z + bfhi(w.w) * kb.w;
            }
            ins3((a0 + a1) + (a2 + a3), n, v0, v1, v2, i0, i1, i2);
        }
        {
            const float p0 = __shfl_xor(v0, 1), p1 = __shfl_xor(v1, 1), p2 = __shfl_xor(v2, 1);
            const int j0 = __shfl_xor(i0, 1), j1 = __shfl_xor(i1, 1), j2 = __shfl_xor(i2, 1);
            ins3(p0, j0, v0, v1, v2, i0, i1, i2);
            ins3(p1, j1, v0, v1, v2, i0, i1, i2);
            ins3(p2, j2, v0, v1, v2, i0, i1, i2);
        }
        int r0 = 0, r1 = 0, r2 = 0;
        if (half == 0) {
            if (i0 >= 0) r0 = __hip_atomic_fetch_add(lcnt + i0, 1, __ATOMIC_RELAXED, __HIP_MEMORY_SCOPE_WORKGROUP);
            if (i1 >= 0) r1 = __hip_atomic_fetch_add(lcnt + i1, 1, __ATOMIC_RELAXED, __HIP_MEMORY_SCOPE_WORKGROUP);
            if (i2 >= 0) r2 = __hip_atomic_fetch_add(lcnt + i2, 1, __ATOMIC_RELAXED, __HIP_MEMORY_SCOPE_WORKGROUP);
        }
        __syncthreads();
        if (tid < 64) { const int c = lcnt[tid]; lbase[tid] = c ? (int)__hip_atomic_fetch_add(gcnt + h * NBLK + tid, (unsigned)c, RLX_AGENT) : 0; }
        __syncthreads();
        if (half == 0) {
            int* lh = list + (size_t)h * LSTRIDE;
            if (i0 >= 0) lh[list_off(i0) + lbase[i0] + r0] = (t << 2) | 0;
            if (i1 >= 0) lh[list_off(i1) + lbase[i1] + r1] = (t << 2) | 1;
            if (i2 >= 0) lh[list_off(i2) + lbase[i2] + r2] = (t << 2) | 2;
        }
        __syncthreads();
    }
}

template <bool READOUT> DI void hgrn_item(Frame& F, int h, int sc) {
    LAS float* fA = (LAS float*)F.lds;
    LAS float* kA = fA + HSUB * 128;
    LAS float* vA = kA + HSUB * 128;
    LAS float* qA = vA + HSUB * 128;
    LAS float* oP = qA + HSUB * 128;
    const bf16* hq = wsp<bf16>(F, WS_HQ); const bf16* hlf = wsp<bf16>(F, WS_HLF); const bf16* hv = wsp<bf16>(F, WS_HV); const bf16* hg = wsp<bf16>(F, WS_HG);
    float* hst = wsp<float>(F, WS_HST) + ((size_t)sc * NH + h) * (HD * HD);
    const int tid = F.tid, w = F.wave, lane = F.lane, g = w >> 1, v = (w & 1) * 64 + lane;
    float Sreg[32];
    if (READOUT) {
#pragma unroll
        for (int i = 0; i < 32; ++i) Sreg[i] = hst[(size_t)(g * 32 + i) * HD + v];
    } else {
#pragma unroll
        for (int i = 0; i < 32; ++i) Sreg[i] = 0.f;
    }
    float dec = 1.f;
    float lbr[8];
    { const float* lbp = wsp<float>(F, WS_STAT) + ST_LB + h * HD + (tid & 15) * 8;
#pragma unroll
      for (int j = 0; j < 8; ++j) lbr[j] = lbp[j]; }
    for (int sub = 0; sub < HSCLEN / HSUB; ++sub) {
        const int t0 = sc * HSCLEN + sub * HSUB;
        {
            const int tt = tid >> 4, c8 = (tid & 15) * 8; const size_t go = (size_t)(t0 + tt) * AW + h * HD + c8;
            const u32x4 lf = *(const u32x4*)(hlf + go), vv = *(const u32x4*)(hv + go);
            const unsigned lw[4] = {lf.x, lf.y, lf.z, lf.w}, vw[4] = {vv.x, vv.y, vv.z, vv.w};
#pragma unroll
            for (int j = 0; j < 4; ++j) {
                const float f0 = lbr[2 * j] + (1.f - lbr[2 * j]) * sigmoidf_(bflo(lw[j])), f1 = lbr[2 * j + 1] + (1.f - lbr[2 * j + 1]) * sigmoidf_(bfhi(lw[j]));
                fA[tt * 128 + c8 + 2 * j] = f0; fA[tt * 128 + c8 + 2 * j + 1] = f1;
                kA[tt * 128 + c8 + 2 * j] = 1.f - f0; kA[tt * 128 + c8 + 2 * j + 1] = 1.f - f1;
                vA[tt * 128 + c8 + 2 * j] = bflo(vw[j]); vA[tt * 128 + c8 + 2 * j + 1] = bfhi(vw[j]);
            }
            if (READOUT) {
                const u32x4 qq = *(const u32x4*)(hq + go); const unsigned qw[4] = {qq.x, qq.y, qq.z, qq.w};
#pragma unroll
                for (int j = 0; j < 4; ++j) { qA[tt * 128 + c8 + 2 * j] = siluf_(bflo(qw[j])); qA[tt * 128 + c8 + 2 * j + 1] = siluf_(bfhi(qw[j])); }
            }
        }
        __syncthreads();
        if (!READOUT && tid < 128) {
#pragma unroll 8
            for (int tt = 0; tt < HSUB; ++tt) dec *= fA[tt * 128 + tid];
        }
        for (int tt = 0; tt < HSUB; ++tt) {
            const LAS f32x4* fr4 = (const LAS f32x4*)(fA + tt * 128 + g * 32);
            const LAS f32x4* kr4 = (const LAS f32x4*)(kA + tt * 128 + g * 32);
            const float vv = vA[tt * 128 + v];
            float o0 = 0.f, o1 = 0.f;
#pragma unroll
            for (int i4 = 0; i4 < 8; ++i4) {
                const f32x4 f4 = fr4[i4], k4 = kr4[i4];
#pragma unroll
                for (int j = 0; j < 4; ++j) Sreg[i4 * 4 + j] = f4[j] * Sreg[i4 * 4 + j] + (k4[j] * vv);
                if (READOUT) {
                    const f32x4 q4 = ((const LAS f32x4*)(qA + tt * 128 + g * 32))[i4];
                    o0 += q4[0] * Sreg[i4 * 4 + 0] + q4[1] * Sreg[i4 * 4 + 1]; o1 += q4[2] * Sreg[i4 * 4 + 2] + q4[3] * Sreg[i4 * 4 + 3];
                }
            }
            if (READOUT) oP[(g * HSUB + tt) * 128 + v] = o0 + o1;
        }
        __syncthreads();
        if (READOUT) {
            const float* gain = F.in[5];
            bf16* mixed = wsp<bf16>(F, WS_MIX);
#pragma unroll
            for (int j = 0; j < 4; ++j) {
                const int tt = w * 4 + j;
                float oa = 0.f, ob = 0.f;
#pragma unroll
                for (int gg = 0; gg < 4; ++gg) { oa += oP[(gg * HSUB + tt) * 128 + lane]; ob += oP[(gg * HSUB + tt) * 128 + 64 + lane]; }
                const float ss = wave_sum(oa * oa + ob * ob);
                const float r = 1.f / sqrtf(ss * (1.f / HD) + EPS);
                const size_t go = (size_t)(t0 + tt) * AW + h * HD;
                const float ga = siluf_(__uint_as_float((unsigned)hg[go + lane] << 16)), gb = siluf_(__uint_as_float((unsigned)hg[go + 64 + lane] << 16));
                bf16* mo = mixed + (size_t)(t0 + tt) * D_ + AW + h * HD;
                #ifdef DBG_ZERO_REC
                mo[lane] = 0; mo[64 + lane] = 0; continue;
#endif
                mo[lane] = (bf16)(pk2(oa * r * gain[h * HD + lane] * ga, 0.f) & 0xffffu);
                mo[64 + lane] = (bf16)(pk2(ob * r * gain[h * HD + 64 + lane] * gb, 0.f) & 0xffffu);
            }
            __syncthreads();
        }
    }
    if (!READOUT) {
#pragma unroll
        for (int i = 0; i < 32; ++i) hst[(size_t)(g * 32 + i) * HD + v] = Sreg[i];
        if (tid < 128) wsp<float>(F, WS_HDEC)[((size_t)sc * NH + h) * HD + tid] = dec;
    }
}
constexpr int HG_QM = 0, HG_KM = 8704, HG_QD = 17408, HG_KDT = 25856, HG_VT = 36096, HG_O = 46336, HG_TOT = 62720, HG_DL = 64768, HG_BYTES = 65280;
constexpr int HG_RS = 272, HG_RD = 264, HG_RT = 80;
static_assert(2 * HG_BYTES <= MISC_OFF, "hgrn LDS map");
DI bf16x8 pack8(const f32x16& x, int s) {
    u32x4 p; p.x = pk2(x[8 * s + 0], x[8 * s + 1]); p.y = pk2(x[8 * s + 2], x[8 * s + 3]); p.z = pk2(x[8 * s + 4], x[8 * s + 5]); p.w = pk2(x[8 * s + 6], x[8 * s + 7]);
    return __builtin_bit_cast(bf16x8, p);
}
template <bool READOUT> DI void hgrn_mfma(Frame& F) {
    const int w = F.wave, grp = w >> 2, wq = w & 3, lane = F.lane, r = lane & 31, hh = lane >> 5, p = lane;
    LAS unsigned char* L = F.lds + grp * HG_BYTES;
    const bf16* hq = wsp<bf16>(F, WS_HQ); const bf16* hlf = wsp<bf16>(F, WS_HLF); const bf16* hv = wsp<bf16>(F, WS_HV); const bf16* hg = wsp<bf16>(F, WS_HG);
    const float* lbp = wsp<float>(F, WS_STAT) + ST_LB;
    bf16* mixed = wsp<bf16>(F, WS_MIX);
    for (int base = F.bid * 2; base < NH * HSC; base += 2 * F.G) {
        const int it = base + grp, h = it & 7, sc = it >> 3;
        float* hst = wsp<float>(F, WS_HST) + ((size_t)sc * NH + h) * (HD * HD);
        f32x16 S[4];
#pragma unroll
        for (int kb = 0; kb < 4; ++kb)
#pragma unroll
            for (int i = 0; i < 16; ++i) S[kb][i] = READOUT ? hst[(size_t)(kb * 32 + crow(i, hh)) * HD + wq * 32 + r] : 0.f;
        const float lb0 = lbp[h * HD + 2 * p], lb1 = lbp[h * HD + 2 * p + 1];
        const int lt = wq * 64 + lane, nt = lt >> 3, nvg = lt & 7;
        f32x4 gn[4];
        if (READOUT) {
#pragma unroll
            for (int j = 0; j < 4; ++j) gn[j] = *(const f32x4*)(F.in[5] + h * HD + nvg * 16 + 4 * j);
        }
        float sumbl0 = 0.f, sumbl1 = 0.f;
        unsigned xf[8], xq[8], xv[8];
        const size_t gcol = (size_t)h * HD + 2 * p;
        {   const size_t t0 = (size_t)sc * HSCLEN + 8 * wq;
#pragma unroll
            for (int i = 0; i < 8; ++i) { xf[i] = *(const unsigned*)(hlf + (t0 + i) * AW + gcol); xv[i] = *(const unsigned*)(hv + (t0 + i) * AW + gcol); if (READOUT) xq[i] = *(const unsigned*)(hq + (t0 + i) * AW + gcol); } }
        for (int c = 0; c < HSCLEN / 32; ++c) {
            const int tc = sc * HSCLEN + c * 32;
            float bl0[8], bl1[8], f0[8], f1[8];
            {   float run0 = 0.f, run1 = 0.f;
#pragma unroll
                for (int i = 0; i < 8; ++i) {
                    const float fa = lb0 + (1.f - lb0) * sigmoidf_(bflo(xf[i])), fb = lb1 + (1.f - lb1) * sigmoidf_(bfhi(xf[i]));
                    run0 += __logf(fa); run1 += __logf(fb); bl0[i] = run0; bl1[i] = run1; f0[i] = fa; f1[i] = fb;
                }
                *(LAS f32x2*)(L + HG_TOT + (wq * 128 + 2 * p) * 4) = (f32x2){run0, run1};
            }
            __syncthreads();
            {
                float off0 = 0.f, off1 = 0.f, bm0, bm1, be0, be1;
                {   f32x2 tq[4];
#pragma unroll
                    for (int q = 0; q < 4; ++q) tq[q] = *(const LAS f32x2*)(L + HG_TOT + (q * 128 + 2 * p) * 4);
#pragma unroll
                    for (int q = 0; q < 4; ++q) if (q < wq) { off0 += tq[q].x; off1 += tq[q].y; }
                    bm0 = tq[0].x + tq[1].x; bm1 = tq[0].y + tq[1].y; be0 = bm0 + tq[2].x + tq[3].x; be1 = bm1 + tq[2].y + tq[3].y; }
                if (wq == 0) { *(LAS f32x2*)(L + HG_DL + 2 * p * 4) = (f32x2){__expf(be0), __expf(be1)}; sumbl0 += be0; sumbl1 += be1; }
                unsigned kd0[4], kd1[4], vt0[4], vt1[4];
#pragma unroll
                for (int i = 0; i < 8; ++i) {
                    const int t = 8 * wq + i;
                    const float b0 = bl0[i] + off0, b1 = bl1[i] + off1;
                    const float k0 = 1.f - f0[i], k1 = 1.f - f1[i];
                    const float kdv0 = k0 * __expf(be0 - b0), kdv1 = k1 * __expf(be1 - b1);
                    if (READOUT) {
                        const float q0 = siluf_(bflo(xq[i])), q1 = siluf_(bfhi(xq[i]));
                        *(LAS unsigned*)(L + HG_QD + t * HG_RD + 4 * p) = pk2(q0 * __expf(b0), q1 * __expf(b1));
                        *(LAS unsigned*)(L + HG_QM + t * HG_RS + 4 * p) = pk2(q0 * __expf(b0 - bm0), q1 * __expf(b1 - bm1));
                        *(LAS unsigned*)(L + HG_KM + t * HG_RS + 4 * p) = pk2(k0 * __expf(bm0 - b0), k1 * __expf(bm1 - b1));
                    }
                    if (i & 1) { kd0[i >> 1] |= pk2(0.f, kdv0) ; kd1[i >> 1] |= pk2(0.f, kdv1); vt0[i >> 1] |= xv[i] << 16; vt1[i >> 1] |= xv[i] & 0xffff0000u; }
                    else { kd0[i >> 1] = pk2(kdv0, 0.f); kd1[i >> 1] = pk2(kdv1, 0.f); vt0[i >> 1] = xv[i] & 0xffffu; vt1[i >> 1] = xv[i] >> 16; }
                }
                *(LAS u32x4*)(L + HG_KDT + (2 * p) * HG_RT + 16 * wq) = (u32x4){kd0[0], kd0[1], kd0[2], kd0[3]};
                *(LAS u32x4*)(L + HG_KDT + (2 * p + 1) * HG_RT + 16 * wq) = (u32x4){kd1[0], kd1[1], kd1[2], kd1[3]};
                *(LAS u32x4*)(L + HG_VT + (2 * p) * HG_RT + 16 * wq) = (u32x4){vt0[0], vt0[1], vt0[2], vt0[3]};
                *(LAS u32x4*)(L + HG_VT + (2 * p + 1) * HG_RT + 16 * wq) = (u32x4){vt1[0], vt1[1], vt1[2], vt1[3]};
            }
            __syncthreads();
            if (c + 1 < HSCLEN / 32) { const size_t t0 = (size_t)tc + 32 + 8 * wq;
#pragma unroll
                for (int i = 0; i < 8; ++i) { xf[i] = *(const unsigned*)(hlf + (t0 + i) * AW + gcol); xv[i] = *(const unsigned*)(hv + (t0 + i) * AW + gcol); if (READOUT) xq[i] = *(const unsigned*)(hq + (t0 + i) * AW + gcol); } }
            u32x4 gg0, gg1;
            if (READOUT) { const u32x4* gp = (const u32x4*)(hg + (size_t)(tc + nt) * AW + h * HD + nvg * 16); gg0 = gp[0]; gg1 = gp[1]; }
            if (READOUT) {
                f32x16 X, Y;
#pragma unroll
                for (int i = 0; i < 16; ++i) { X[i] = 0.f; Y[i] = 0.f; }
#pragma unroll
                for (int st = 0; st < 8; ++st) {
                    const bf16x8 a = *(const LAS bf16x8*)(L + HG_KM + r * HG_RS + 32 * st + 16 * hh), b = *(const LAS bf16x8*)(L + HG_QM + r * HG_RS + 32 * st + 16 * hh);
                    X = __builtin_amdgcn_mfma_f32_32x32x16_bf16(a, b, X, 0, 0, 0);
                }
#pragma unroll
                for (int i = 0; i < 16; ++i) if (crow(i, hh) > r) X[i] = 0.f;
#pragma unroll
                for (int kb = 0; kb < 4; ++kb)
#pragma unroll
                    for (int st = 0; st < 2; ++st) {
                        const LAS u32x2* qp = (const LAS u32x2*)(L + HG_QD + r * HG_RD + (kb * 32 + 16 * st + 4 * hh) * 2);
                        const u32x2 a0 = qp[0], a1 = qp[2]; const u32x4 av = {a0.x, a0.y, a1.x, a1.y};
                        Y = __builtin_amdgcn_mfma_f32_32x32x16_bf16(__builtin_bit_cast(bf16x8, av), pack8(S[kb], st), Y, 0, 0, 0);
                    }
#pragma unroll
                for (int st = 0; st < 2; ++st) {
                    const LAS u32x2* vp = (const LAS u32x2*)(L + HG_VT + (wq * 32 + r) * HG_RT + (16 * st + 4 * hh) * 2);
                    const u32x2 b0 = vp[0], b1 = vp[2]; const u32x4 bv = {b0.x, b0.y, b1.x, b1.y};
                    Y = __builtin_amdgcn_mfma_f32_32x32x16_bf16(pack8(X, st), __builtin_bit_cast(bf16x8, bv), Y, 0, 0, 0);
                }
#pragma unroll
                for (int i = 0; i < 16; ++i) *(LAS float*)(L + HG_O + crow(i, hh) * 512 + (wq * 32 + r) * 4) = Y[i];
            }
#pragma unroll
            for (int kb = 0; kb < 4; ++kb) {
#pragma unroll
                for (int g4 = 0; g4 < 4; ++g4) { const f32x4 d = *(const LAS f32x4*)(L + HG_DL + (kb * 32 + 8 * g4 + 4 * hh) * 4);
#pragma unroll
                    for (int j = 0; j < 4; ++j) S[kb][4 * g4 + j] *= d[j]; }
#pragma unroll
                for (int st = 0; st < 2; ++st) {
                    const bf16x8 a = *(const LAS bf16x8*)(L + HG_KDT + (kb * 32 + r) * HG_RT + 32 * st + 16 * hh), b = *(const LAS bf16x8*)(L + HG_VT + (wq * 32 + r) * HG_RT + 32 * st + 16 * hh);
                    S[kb] = __builtin_amdgcn_mfma_f32_32x32x16_bf16(a, b, S[kb], 0, 0, 0);
                }
            }
            __syncthreads();
            if (READOUT) {
                f32x4 o[4]; float ss = 0.f;
#pragma unroll
                for (int j = 0; j < 4; ++j) { o[j] = *(const LAS f32x4*)(L + HG_O + nt * 512 + (nvg * 16 + 4 * j) * 4); ss += (o[j].x * o[j].x + o[j].y * o[j].y) + (o[j].z * o[j].z + o[j].w * o[j].w); }
                ss += __shfl_xor(ss, 1); ss += __shfl_xor(ss, 2); ss += __shfl_xor(ss, 4);
                const float rr = 1.f / sqrtf(ss * (1.f / HD) + EPS);
                const unsigned gw[8] = {gg0.x, gg0.y, gg0.z, gg0.w, gg1.x, gg1.y, gg1.z, gg1.w};
                u32x4 o0, o1;
#pragma unroll
                for (int j = 0; j < 4; ++j) {
                    const float g0 = siluf_(bflo(gw[2 * j])), g1 = siluf_(bfhi(gw[2 * j])), g2 = siluf_(bflo(gw[2 * j + 1])), g3 = siluf_(bfhi(gw[2 * j + 1]));
                    const unsigned wa = pk2(o[j].x * rr * gn[j].x * g0, o[j].y * rr * gn[j].y * g1), wb = pk2(o[j].z * rr * gn[j].z * g2, o[j].w * rr * gn[j].w * g3);
                    if (j < 2) { o0[2 * j] = wa; o0[2 * j + 1] = wb; } else { o1[2 * (j - 2)] = wa; o1[2 * (j - 2) + 1] = wb; }
                }
                u32x4* mo = (u32x4*)(mixed + (size_t)(tc + nt) * D_ + AW + h * HD + nvg * 16);
                mo[0] = o0; mo[1] = o1;
            }
        }
        if (!READOUT) {
#pragma unroll
            for (int kb = 0; kb < 4; ++kb)
#pragma unroll
                for (int i = 0; i < 16; ++i) hst[(size_t)(kb * 32 + crow(i, hh)) * HD + wq * 32 + r] = S[kb][i];
            if (wq == 0) *(f32x2*)(wsp<float>(F, WS_HDEC) + ((size_t)sc * NH + h) * HD + 2 * p) = (f32x2){__expf(sumbl0), __expf(sumbl1)};
        }
        __syncthreads();
    }
}
DI void hgrn_scan(Frame& F) {
    float* hst = wsp<float>(F, WS_HST); const float* hdec = wsp<float>(F, WS_HDEC);
    for (int e = F.bid * NTHREADS + F.tid; e < NH * HD * HD; e += F.G * NTHREADS) {
        const int hk = e >> 7;
        float cur = 0.f;
        for (int sc = 0; sc < HSC; ++sc) {
            const size_t o = (size_t)sc * (NH * HD * HD) + e;
            const float tmp = hst[o]; hst[o] = cur;
            cur = hdec[(size_t)sc * (NH * HD) + hk] * cur + tmp;
        }
    }
}

constexpr int AT_KSTR = 272, AT_VSTR = 520;
constexpr int AT_K_OFF = 0, AT_V_OFF = 256 * AT_KSTR, AT_PRE_OFF = AT_V_OFF + 128 * AT_VSTR;
static_assert(AT_PRE_OFF + 516 * 4 <= MISC_OFF, "attention LDS map");
DI void p3_attn(Frame& F) {
    LAS unsigned char* Kl = F.lds + AT_K_OFF; LAS unsigned char* Vl = F.lds + AT_V_OFF; LAS int* pre = (LAS int*)(F.lds + AT_PRE_OFF);
    const bf16* q = wsp<bf16>(F, WS_Q); const bf16* kg = wsp<bf16>(F, WS_K); const bf16* vt = wsp<bf16>(F, WS_VT);
    const int* list = wsp<int>(F, WS_LIST);
    bf16* po = (bf16*)F.out;
    f32x2* pml = wsp<f32x2>(F, WS_PML);
    const unsigned* gcnt = F.ctl + CW_GCNT;
    const int tid = F.tid, lane = F.lane, w = F.wave, r = lane & 31, hh = lane >> 5;
    if (w == 0) {
        int c[8], s = 0;
#pragma unroll
        for (int k = 0; k < 8; ++k) { const unsigned cc = __hip_atomic_load(gcnt + lane * 8 + k, RLX_AGENT); c[k] = 1 + (int)((cc + 255u) >> 8); s += c[k]; }
        int incl = s;
#pragma unroll
        for (int o = 1; o < 64; o <<= 1) { const int t = __shfl_up(incl, o); if (lane >= o) incl += t; }
        int run = incl - s;
#pragma unroll
        for (int k = 0; k < 8; ++k) { pre[lane * 8 + k] = run; run += c[k]; }
        if (lane == 63) pre[512] = incl;
    }
    __syncthreads();
    const int total = pre[512];
    for (int ti = F.bid; ti < total; ti += F.G) {
        int lo = 0, hi = 511;
        while (lo < hi) { const int mid = (lo + hi + 1) >> 1; if (pre[mid] <= ti) lo = mid; else hi = mid - 1; }
        const int h = lo >> 6, n = lo & 63, seg = ti - pre[lo];
        const int cnt = (int)__hip_atomic_load(gcnt + lo, RLX_AGENT);
        const int nvalid = seg == 0 ? 256 : min(256, cnt - (seg - 1) * 256);
#pragma unroll
        for (int p = 0; p < 8; ++p) {
            const int idx = p * NTHREADS + tid;
            { const int row = idx >> 4, pc = idx & 15; const u32x4 v = *(const u32x4*)(kg + (size_t)(n * LBLK + row) * AW + h * HD + pc * 8); *(LAS u32x4*)(Kl + row * AT_KSTR + pc * 16) = v; }
            { const int d = idx >> 5, pc = idx & 31; const u32x4 v = *(const u32x4*)(vt + (size_t)(h * HD + d) * S_ + n * LBLK + pc * 8);
              LAS u32x2* dst = (LAS u32x2*)(Vl + d * AT_VSTR + pc * 16); dst[0] = (u32x2){v.x, v.y}; dst[1] = (u32x2){v.z, v.w}; }
        }
        __syncthreads();
        const int ei = w * 32 + r; const bool valid = ei < nvalid;
        int t, slot;
        if (seg == 0) { t = n * LBLK + ei; slot = 3; }
        else { const int e = valid ? list[(size_t)h * LSTRIDE + list_off(n) + (seg - 1) * 256 + ei] : 0; t = e >> 2; slot = e & 3; }
        bf16x8 Qf[8];
        { const bf16x8* qp = (const bf16x8*)(q + (size_t)t * AW + h * HD + 8 * hh);
#pragma unroll
          for (int s = 0; s < 8; ++s) Qf[s] = qp[2 * s]; }
        f32x16 X[8];
#pragma unroll
        for (int kb = 0; kb < 8; ++kb) {
            f32x16 x;
            if (seg == 0 && kb > w) {
#pragma unroll
                for (int i = 0; i < 16; ++i) x[i] = -INFINITY;
            } else {
#pragma unroll
                for (int i = 0; i < 16; ++i) x[i] = 0.f;
#pragma unroll
                for (int s = 0; s < 8; ++s) { const bf16x8 a = *(const LAS bf16x8*)(Kl + (kb * 32 + r) * AT_KSTR + 32 * s + 16 * hh); x = __builtin_amdgcn_mfma_f32_32x32x16_bf16(a, Qf[s], x, 0, 0, 0); }
                if (seg == 0 && kb == w) {
#pragma unroll
                    for (int i = 0; i < 16; ++i) if (crow(i, hh) > r) x[i] = -INFINITY;
                }
            }
            X[kb] = x;
        }
        float mx = -INFINITY;
#pragma unroll
        for (int kb = 0; kb < 8; ++kb)
#pragma unroll
            for (int i = 0; i < 16; ++i) mx = fmaxf(mx, X[kb][i]);
        mx = fmaxf(mx, __shfl_xor(mx, 32));
        float l = 0.f;
#pragma unroll
        for (int kb = 0; kb < 8; ++kb)
#pragma unroll
            for (int i = 0; i < 16; ++i) { const float p = __builtin_amdgcn_exp2f(X[kb][i] - mx); X[kb][i] = p; l += p; }
        l += __shfl_xor(l, 32);
        f32x16 O[4];
#pragma unroll
        for (int db = 0; db < 4; ++db)
#pragma unroll
            for (int i = 0; i < 16; ++i) O[db][i] = 0.f;
#pragma unroll
        for (int kb = 0; kb < 8; ++kb)
#pragma unroll
            for (int s2 = 0; s2 < 2; ++s2) {
                u32x4 pb; pb.x = pk2(X[kb][8 * s2 + 0], X[kb][8 * s2 + 1]); pb.y = pk2(X[kb][8 * s2 + 2], X[kb][8 * s2 + 3]); pb.z = pk2(X[kb][8 * s2 + 4], X[kb][8 * s2 + 5]); pb.w = pk2(X[kb][8 * s2 + 6], X[kb][8 * s2 + 7]);
                const bf16x8 bfrag = __builtin_bit_cast(bf16x8, pb);
#pragma unroll
                for (int db = 0; db < 4; ++db) {
                    const LAS u32x2* vp = (const LAS u32x2*)(Vl + (db * 32 + r) * AT_VSTR + (kb * 32 + 16 * s2 + 4 * hh) * 2);
                    const u32x2 a0 = vp[0], a1 = vp[2];
                    const u32x4 av = {a0.x, a0.y, a1.x, a1.y};
                    O[db] = __builtin_amdgcn_mfma_f32_32x32x16_bf16(__builtin_bit_cast(bf16x8, av), bfrag, O[db], 0, 0, 0);
                }
            }
        if (valid) {
            const float inv = 1.f / l;
            bf16* orow = po + ((size_t)(t * NH + h) * 4 + slot) * HD;
#pragma unroll
            for (int db = 0; db < 4; ++db)
#pragma unroll
                for (int g4 = 0; g4 < 4; ++g4) {
                    u32x2 o; o.x = pk2(O[db][4 * g4 + 0] * inv, O[db][4 * g4 + 1] * inv); o.y = pk2(O[db][4 * g4 + 2] * inv, O[db][4 * g4 + 3] * inv);
                    *(u32x2*)(orow + db * 32 + 8 * g4 + 4 * hh) = o;
                }
            if (hh == 0) pml[(size_t)(t * NH + h) * 4 + slot] = (f32x2){mx, l};
        }
        __syncthreads();
    }
}

DI void p4_combine(Frame& F) {
    const bf16* po = (const bf16*)F.out; const f32x2* pml = wsp<f32x2>(F, WS_PML); bf16* mixed = wsp<bf16>(F, WS_MIX);
    const size_t total = (size_t)S_ * NH * 16;
    for (size_t wi = (size_t)F.bid * NTHREADS + F.tid; wi < total; wi += (size_t)F.G * NTHREADS) {
        const int c16 = (int)(wi & 15); const size_t th = wi >> 4; const int t = (int)(th >> 3), h = (int)(th & 7);
        const int nv = min(3, t >> 8);
        float m[4], l[4]; float M = -INFINITY;
#pragma unroll
        for (int j = 0; j < 4; ++j) { const bool on = (j == 3) || (j < nv); f32x2 ml = on ? pml[th * 4 + j] : (f32x2){-INFINITY, 0.f}; m[j] = ml.x; l[j] = ml.y; M = fmaxf(M, m[j]); }
        float wj[4], W = 0.f;
#pragma unroll
        for (int j = 0; j < 4; ++j) { wj[j] = ((j == 3) || (j < nv)) ? __builtin_amdgcn_exp2f(m[j] - M) * l[j] : 0.f; W += wj[j]; }
        const float iW = 1.f / W;
        float o[8];
#pragma unroll
        for (int i = 0; i < 8; ++i) o[i] = 0.f;
#pragma unroll
        for (int j = 0; j < 4; ++j) if ((j == 3) || (j < nv)) {
            const u32x4 v = *(const u32x4*)(po + (th * 4 + j) * HD + c16 * 8); const float ww = wj[j] * iW;
            o[0] += ww * bflo(v.x); o[1] += ww * bfhi(v.x); o[2] += ww * bflo(v.y); o[3] += ww * bfhi(v.y);
            o[4] += ww * bflo(v.z); o[5] += ww * bfhi(v.z); o[6] += ww * bflo(v.w); o[7] += ww * bfhi(v.w);
        }
        u32x4 ov; ov.x = pk2(o[0], o[1]); ov.y = pk2(o[2], o[3]); ov.z = pk2(o[4], o[5]); ov.w = pk2(o[6], o[7]);
        *(u32x4*)(mixed + (size_t)t * D_ + h * HD + c16 * 8) = ov;
    }
}

struct Epi2 {
    static constexpr bool PERM = false, AFTER_DRAIN = false;
    const float* x; float* out; bf16* hb; float* ssq;
    DI void operator()(const pg8::f32x4 (&acc)[2][2][4][2], const pg8::Unit& u, int wr, int wc, int fr, int fq) const {
        asm volatile("" : "+v"(fr), "+v"(fq));
        const int row0 = u.pm * 256 + wr * 64 + fr, col0 = u.pn * 256 + wc * 32 + 4 * fq;
#pragma unroll
        for (int ai = 0; ai < 2; ++ai)
#pragma unroll
            for (int m = 0; m < 4; ++m) {
                const int row = row0 + ai * 128 + m * 16; const size_t off = (size_t)row * D_ + col0; float s = 0.f;
#pragma unroll
                for (int bj = 0; bj < 2; ++bj)
#pragma unroll
                    for (int n = 0; n < 2; ++n) {
                        const f32x4 v = *(const f32x4*)(x + off + bj * 128 + n * 16) + acc[ai][bj][m][n];
                        *(f32x4*)(out + off + bj * 128 + n * 16) = v;
                        u32x2 b; b.x = pk2(v[0], v[1]); b.y = pk2(v[2], v[3]); *(u32x2*)(hb + off + bj * 128 + n * 16) = b;
                        s += (v[0] * v[0] + v[1] * v[1]) + (v[2] * v[2] + v[3] * v[3]);
                    }
                s += __shfl_xor(s, 16); s += __shfl_xor(s, 32);
                if (fq == 0) ssq[(size_t)row * 32 + u.pn * 4 + wc] = s;
                asm volatile("" ::: "memory");
            }
    }
};
struct EpiB {
    static constexpr bool PERM = true, AFTER_DRAIN = false;
    bf16* O; int ldc;
    DI void operator()(const pg8::f32x4 (&acc)[2][2][4][2], const pg8::Unit& u, int wr, int wc, int fr, int fq) const {
        asm volatile("" : "+v"(fr), "+v"(fq));
        const int row0 = u.pm * 256 + wr * 64 + fr, col0 = u.pn * 256 + wc * 32 + 8 * fq;
#pragma unroll
        for (int ai = 0; ai < 2; ++ai)
#pragma unroll
            for (int m = 0; m < 4; ++m) { bf16* rowp = O + (size_t)(row0 + ai * 128 + m * 16) * ldc + col0;
#pragma unroll
                for (int bj = 0; bj < 2; ++bj) { const f32x4 v0 = acc[ai][bj][m][0], v1 = acc[ai][bj][m][1];
                    u32x4 w; w.x = pk2(v0[0], v0[1]); w.y = pk2(v0[2], v0[3]); w.z = pk2(v1[0], v1[1]); w.w = pk2(v1[2], v1[3]);
                    *(u32x4*)(rowp + bj * 128) = w; } }
    }
};
struct EpiP {
    static constexpr bool PERM = false, AFTER_DRAIN = false;
    bf16* O;
    DI void operator()(const pg8::f32x4 (&acc)[2][2][4][2], const pg8::Unit& u, int wr, int wc, int fr, int fq) const {
        asm volatile("" : "+v"(fr), "+v"(fq));
        const int row0 = u.pm * 256 + wr * 64 + fr, col0 = u.pn * 256 + wc * 32 + 4 * fq;
#pragma unroll
        for (int ai = 0; ai < 2; ++ai)
#pragma unroll
            for (int m = 0; m < 4; ++m) { const size_t off = (size_t)(row0 + ai * 128 + m * 16) * D_ + col0;
#pragma unroll
                for (int bj = 0; bj < 2; ++bj)
#pragma unroll
                    for (int n = 0; n < 2; ++n) { const f32x4 v = acc[ai][bj][m][n]; u32x2 b; b.x = pk2(v[0], v[1]); b.y = pk2(v[2], v[3]); *(u32x2*)(O + off + bj * 128 + n * 16) = b; } }
    }
};
struct Epi4 {
    static constexpr bool PERM = false, AFTER_DRAIN = false;
    float* out; const bf16* ple; const float* rs3; float* ssq;
    DI void operator()(const pg8::f32x4 (&acc)[2][2][4][2], const pg8::Unit& u, int wr, int wc, int fr, int fq) const {
        asm volatile("" : "+v"(fr), "+v"(fq));
        const int row0 = u.pm * 256 + wr * 64 + fr, col0 = u.pn * 256 + wc * 32 + 4 * fq;
#pragma unroll
        for (int ai = 0; ai < 2; ++ai)
#pragma unroll
            for (int m = 0; m < 4; ++m) {
                const int row = row0 + ai * 128 + m * 16; const size_t off = (size_t)row * D_ + col0; float s = 0.f; const float rs = rs3[row];
#pragma unroll
                for (int bj = 0; bj < 2; ++bj)
#pragma unroll
                    for (int n = 0; n < 2; ++n) {
                        const u32x2 pw = *(const u32x2*)(ple + off + bj * 128 + n * 16);
                        const f32x4 pv = {bflo(pw.x), bfhi(pw.x), bflo(pw.y), bfhi(pw.y)};
                        f32x4 v = *(const f32x4*)(out + off + bj * 128 + n * 16);
#pragma unroll
                        for (int i = 0; i < 4; ++i) v[i] += DBG_PLE_SCALE * sigmoidf_(acc[ai][bj][m][n][i] * rs) * pv[i];
                        *(f32x4*)(out + off + bj * 128 + n * 16) = v;
                        s += (v[0] * v[0] + v[1] * v[1]) + (v[2] * v[2] + v[3] * v[3]);
                    }
                s += __shfl_xor(s, 16); s += __shfl_xor(s, 32);
                if (fq == 0) ssq[(size_t)row * 32 + u.pn * 4 + wc] = s;
                asm volatile("" ::: "memory");
            }
    }
};

DI unsigned fkey(float f, unsigned lowbits, unsigned mask) { unsigned u = __float_as_uint(f); u = (u & 0x80000000u) ? ~u : (u | 0x80000000u); return (u & ~mask) | lowbits; }
DI float fval(unsigned k, unsigned mask) { unsigned u = k & ~mask; u = (u & 0x80000000u) ? (u & 0x7fffffffu) : ~u; return __uint_as_float(u); }
DI void ins16(unsigned (&tk)[16], unsigned x) {
    if (x > tk[15]) {
        tk[15] = x;
#pragma unroll
        for (int k = 15; k >= 1; --k) { const unsigned a = tk[k - 1], b = tk[k]; tk[k - 1] = max(a, b); tk[k] = min(a, b); }
    }
}
DI void p7_route(Frame& F) {
    const bf16* qry = wsp<bf16>(F, WS_QRY); const bf16* skb = wsp<bf16>(F, WS_SKB);
    float* stat = wsp<float>(F, WS_STAT); const float* ssq2 = wsp<float>(F, WS_SSQ2);
    int* pidx = wsp<int>(F, WS_PIDX); float* pgate = wsp<float>(F, WS_PGATE);
    LAS unsigned* tops = (LAS unsigned*)F.lds;
    const int tid = F.tid, lane = F.lane, w = F.wave, r = lane & 31, hh = lane >> 5;
    const int tg = w & 3, p = w >> 2;
    for (int it = F.bid; it < (S_ / 128) * PH; it += F.G) {
        const int h = it & 7, tb = it >> 3;
        const int t = tb * 128 + tg * 32 + r;
        float ss = 0.f;
        { const f32x4* sp = (const f32x4*)(ssq2 + (size_t)t * 32);
#pragma unroll
          for (int j = 0; j < 8; ++j) { const f32x4 v = sp[j]; ss += (v.x + v.y) + (v.z + v.w); } }
        const float rs2 = 1.f / sqrtf(ss * (1.f / D_) + EPS);
        if (h == 0 && p == 0 && hh == 0) stat[ST_RS2 + t] = rs2;
        bf16x8 Bq[8];
        { const bf16x8* qp = (const bf16x8*)(qry + (size_t)t * D_ + h * 256 + p * 128 + 8 * hh);
#pragma unroll
          for (int s = 0; s < 8; ++s) Bq[s] = qp[2 * s]; }
        unsigned tk[16];
#pragma unroll
        for (int i = 0; i < 16; ++i) tk[i] = 0u;
        const bf16* kbase = skb + (size_t)((h * 2 + p) * NKEY) * 128;
#pragma unroll
        for (int kt = 0; kt < 4; ++kt) {
            f32x16 x;
#pragma unroll
            for (int i = 0; i < 16; ++i) x[i] = 0.f;
            const bf16x8* ap = (const bf16x8*)(kbase + (size_t)(kt * 32 + r) * 128 + 8 * hh);
#pragma unroll
            for (int s = 0; s < 8; ++s) x = __builtin_amdgcn_mfma_f32_32x32x16_bf16(ap[2 * s], Bq[s], x, 0, 0, 0);
#pragma unroll
            for (int i = 0; i < 16; ++i) { const int key = kt * 32 + crow(i, hh); ins16(tk, fkey(x[i] * rs2, (unsigned)(127 - key), 127u)); }
        }
        {
            unsigned ok[16];
#pragma unroll
            for (int i = 0; i < 16; ++i) ok[i] = (unsigned)__shfl_xor((int)tk[i], 32);
#pragma unroll
            for (int i = 0; i < 16; ++i) ins16(tk, ok[i]);
        }
        if (hh == 0) {
            LAS u32x4* dst = (LAS u32x4*)(tops + ((tg * 32 + r) * 2 + p) * 16);
            dst[0] = (u32x4){tk[0], tk[1], tk[2], tk[3]}; dst[1] = (u32x4){tk[4], tk[5], tk[6], tk[7]}; dst[2] = (u32x4){tk[8], tk[9], tk[10], tk[11]}; dst[3] = (u32x4){tk[12], tk[13], tk[14], tk[15]};
        }
        __syncthreads();
        if (tid < 128) {
            const int tt = tb * 128 + tid;
            unsigned ka[16], kb[16];
            { const LAS u32x4* s = (const LAS u32x4*)(tops + (tid * 2) * 16);
#pragma unroll
              for (int j = 0; j < 4; ++j) { const u32x4 a = s[j], b = s[4 + j]; ka[4 * j] = a.x; ka[4 * j + 1] = a.y; ka[4 * j + 2] = a.z; ka[4 * j + 3] = a.w; kb[4 * j] = b.x; kb[4 * j + 1] = b.y; kb[4 * j + 2] = b.z; kb[4 * j + 3] = b.w; } }
            float va[16], vb[16];
#pragma unroll
            for (int i = 0; i < 16; ++i) { va[i] = fval(ka[i], 127u); vb[i] = fval(kb[i], 127u); }
            unsigned ck[16];
#pragma unroll
            for (int i = 0; i < 16; ++i) ck[i] = 0u;
#pragma unroll
            for (int i = 0; i < 16; ++i)
#pragma unroll
                for (int j = 0; j < 16; ++j) if ((i + 1) * (j + 1) <= 16) ins16(ck, fkey(va[i] + vb[j], (unsigned)(255 - (i * 16 + j)), 255u));
            float sv[16]; float mxv = -INFINITY;
#pragma unroll
            for (int i = 0; i < 16; ++i) { sv[i] = fval(ck[i], 255u); mxv = fmaxf(mxv, sv[i]); }
            float den = 0.f;
#pragma unroll
            for (int i = 0; i < 16; ++i) { sv[i] = __expf(sv[i] - mxv); den += sv[i]; }
            const float iden = 1.f / den;
            int* io = pidx + (size_t)tt * 128 + h * 16; float* go = pgate + (size_t)tt * 128 + h * 16;
#pragma unroll
            for (int i = 0; i < 16; ++i) {
                const int pos = 255 - (int)(ck[i] & 255u), ci = pos >> 4, cj = pos & 15;
                unsigned ea = 0u, eb = 0u;
#pragma unroll
                for (int k = 0; k < 16; ++k) { ea = (ci == k) ? ka[k] : ea; eb = (cj == k) ? kb[k] : eb; }
                io[i] = (int)((127u - (ea & 127u)) * 128u + (127u - (eb & 127u)));
                go[i] = sv[i] * iden;
            }
        }
        __syncthreads();
    }
}

DI void fp8x16_to_f32(const u32x4 w, float (&f)[16]) {
#pragma unroll
    for (int q = 0; q < 4; ++q) { const f32x2 lo = __builtin_amdgcn_cvt_pk_f32_fp8((int)w[q], false), hi = __builtin_amdgcn_cvt_pk_f32_fp8((int)w[q], true); f[4 * q] = lo.x; f[4 * q + 1] = lo.y; f[4 * q + 2] = hi.x; f[4 * q + 3] = hi.y; }
}
template <bool DRY> DI void p8_peer(Frame& F) {
    const unsigned char* down = wsp<unsigned char>(F, WS_DOWN); const unsigned char* up = wsp<unsigned char>(F, WS_UP);
    bf16* hb = wsp<bf16>(F, WS_H1B); float* stat = wsp<float>(F, WS_STAT);
    const int* pidx = wsp<int>(F, WS_PIDX); const float* pgate = wsp<float>(F, WS_PGATE);
    const int lane = F.lane;
    constexpr int EB = 4;
    for (int t = F.bid * NWAVES + F.wave; t < S_; t += F.G * NWAVES) {
        float hf[2][16];
#pragma unroll
        for (int j = 0; j < 2; ++j) {
            const u32x4* hp = (const u32x4*)(hb + (size_t)t * D_ + 1024 * j + 16 * lane); const u32x4 a = hp[0], b = hp[1];
            hf[j][0] = bflo(a.x); hf[j][1] = bfhi(a.x); hf[j][2] = bflo(a.y); hf[j][3] = bfhi(a.y); hf[j][4] = bflo(a.z); hf[j][5] = bfhi(a.z); hf[j][6] = bflo(a.w); hf[j][7] = bfhi(a.w);
            hf[j][8] = bflo(b.x); hf[j][9] = bfhi(b.x); hf[j][10] = bflo(b.y); hf[j][11] = bfhi(b.y); hf[j][12] = bflo(b.z); hf[j][13] = bfhi(b.z); hf[j][14] = bflo(b.w); hf[j][15] = bfhi(b.w);
        }
        const float rs2 = stat[ST_RS2 + t] * (1.f / DSCALE);
        const int e0 = pidx[(size_t)t * 128 + lane], e1 = pidx[(size_t)t * 128 + 64 + lane];
        const float g0 = pgate[(size_t)t * 128 + lane], g1 = pgate[(size_t)t * 128 + 64 + lane];
        float a0 = 0.f, a1 = 0.f;
        for (int eb = 0; eb < 128; eb += EB) {
            u32x4 dv[EB][2];
#pragma unroll
            for (int k = 0; k < EB; ++k) {
                const int e = eb + k; const int ex = __builtin_amdgcn_readlane(e < 64 ? e0 : e1, e & 63);
                const u32x4* dp = (const u32x4*)(down + (size_t)ex * D_) + lane;
                dv[k][0] = dp[0]; dv[k][1] = dp[64];
            }
#pragma unroll
            for (int k = 0; k < EB; ++k) {
                float s0 = 0.f, s1 = 0.f;
#pragma unroll
                for (int j = 0; j < 2; ++j) { float f[16]; fp8x16_to_f32(dv[k][j], f);
#pragma unroll
                    for (int i = 0; i < 16; i += 2) { s0 += hf[j][i] * f[i]; s1 += hf[j][i + 1] * f[i + 1]; } }
                const float s = wave_sum(s0 + s1);
                const int e = eb + k;
                if (e < 64) { a0 = (lane == e) ? s : a0; } else { a1 = (lane == e - 64) ? s : a1; }
            }
        }
        {
            const float z0 = a0 * rs2, z1 = a1 * rs2;
            a0 = 0.5f * z0 * (1.f + erff(z0 * 0.70710678118654752f)) * g0 * (1.f / USCALE);
            a1 = 0.5f * z1 * (1.f + erff(z1 * 0.70710678118654752f)) * g1 * (1.f / USCALE);
        }
        float acc[2][16];
#pragma unroll
        for (int j = 0; j < 2; ++j)
#pragma unroll
            for (int i = 0; i < 16; ++i) acc[j][i] = 0.f;
        for (int eb = 0; eb < 128; eb += EB) {
            u32x4 uv[EB][2]; float av[EB];
#pragma unroll
            for (int k = 0; k < EB; ++k) {
                const int e = eb + k; const int ex = __builtin_amdgcn_readlane(e < 64 ? e0 : e1, e & 63);
                av[k] = __builtin_bit_cast(float, __builtin_amdgcn_readlane(__builtin_bit_cast(int, e < 64 ? a0 : a1), e & 63));
                const u32x4* upp = (const u32x4*)(up + (size_t)ex * D_) + lane;
                uv[k][0] = upp[0]; uv[k][1] = upp[64];
            }
#pragma unroll
            for (int k = 0; k < EB; ++k)
#pragma unroll
                for (int j = 0; j < 2; ++j) { float f[16]; fp8x16_to_f32(uv[k][j], f);
#pragma unroll
                    for (int i = 0; i < 16; ++i) acc[j][i] += av[k] * f[i]; }
        }
        float ss = 0.f;
#pragma unroll
        for (int j = 0; j < 2; ++j) {
            float* op = F.out + (size_t)t * D_ + 1024 * j + 16 * lane;
            u32x4 ob[2];
#pragma unroll
            for (int q = 0; q < 4; ++q) {
                f32x4 x = *(const f32x4*)(op + 4 * q);
                x[0] += acc[j][4 * q]; x[1] += acc[j][4 * q + 1]; x[2] += acc[j][4 * q + 2]; x[3] += acc[j][4 * q + 3];
                if (!DRY) *(f32x4*)(op + 4 * q) = x;
                ob[q >> 1][(q & 1) * 2] = pk2(x[0], x[1]); ob[q >> 1][(q & 1) * 2 + 1] = pk2(x[2], x[3]);
                ss += (x[0] * x[0] + x[1] * x[1]) + (x[2] * x[2] + x[3] * x[3]);
            }
            u32x4* hw = (u32x4*)((DRY ? wsp<bf16>(F, WS_PLE) : hb) + (size_t)t * D_ + 1024 * j + 16 * lane);
            hw[0] = ob[0]; hw[1] = ob[1];
        }
        ss = wave_sum(ss);
        if (lane == 0 && !DRY) stat[ST_RS3 + t] = 1.f / sqrtf(ss * (1.f / D_) + EPS);
    }
}

DI void p10_final(Frame& F) {
    const float* ssq4 = wsp<float>(F, WS_SSQ4); const float* gain = F.in[15];
    for (int m = F.bid * NWAVES + F.wave; m < S_; m += F.G * NWAVES) {
        float s = (F.lane < 32) ? ssq4[(size_t)m * 32 + F.lane] : 0.f;
        s = wave_sum(s);
        const float rs = 1.f / sqrtf(s * (1.f / D_) + EPS);
        f32x4* xr = (f32x4*)(F.out + (size_t)m * D_) + F.lane; const f32x4* gr = (const f32x4*)gain + F.lane;
#pragma unroll
        for (int j = 0; j < 8; ++j) xr[64 * j] = xr[64 * j] * rs * gr[64 * j];
    }
}

constexpr int NPHASES = 11;
struct Args { const float* in[16]; float* out; unsigned char* ws; int ph_lo, ph_hi; };
DI Frame make_frame(LAS unsigned char* lds) {
    typedef const Args __attribute__((address_space(4))) * cargs_t;
    cargs_t ap = (cargs_t)__builtin_amdgcn_kernarg_segment_ptr();
    asm volatile("" : "+s"(ap));
    Frame F;
    F.lds = lds;
    F.tid = threadIdx.x; F.lane = F.tid & 63; F.wave = __builtin_amdgcn_readfirstlane(F.tid >> 6);
    F.G = gridDim.x; F.bid = blockIdx.x;
#pragma unroll
    for (int i = 0; i < 16; ++i) F.in[i] = ap->in[i];
    F.out = ap->out; F.ws = ap->ws; F.ctl = (unsigned*)(ap->ws + WS_CTL);
    return F;
}
__global__ void __launch_bounds__(NTHREADS, 2) mega_fwd(Args args) {
    extern __shared__ __attribute__((aligned(16))) unsigned char lds_[];
    LAS unsigned char* lds = (LAS unsigned char*)lds_;
    volatile LAS unsigned* MISC = (volatile LAS unsigned*)(lds + MISC_OFF);
    if (threadIdx.x < 64) MISC[threadIdx.x] = 0u;
    __syncthreads();
    const int lo = args.ph_lo, hi = args.ph_hi;
    XcdBarrier bar; bar.bar = (unsigned*)(args.ws + WS_CTL) + CW_BAR; bar.x = 0; bar.st = nullptr;
    if (hi - lo > 1) bar = xcd_barrier_post((unsigned*)(args.ws + WS_CTL) + CW_BAR, MISC + 8);
#ifdef ONLY_PHASE
#define IN(k) ((k) == ONLY_PHASE && lo <= (k) && (k) < hi)
#else
#define IN(k) (lo <= (k) && (k) < hi)
#endif
#define SEAM(k) do { if (IN(k) && IN((k) + 1)) xcd_barrier(bar); } while (0)

    if (IN(0)) { Frame F = make_frame(lds); p0_prologue(F); }
    SEAM(0);
    if (IN(1)) {
        Frame F = make_frame(lds);
        pg8::Gemm g{wsp<bf16>(F, WS_XB), wsp<bf16>(F, WS_W1T), S_, NIN, D_}; pg8::StaticOrder S; S.init(S_, NIN, F.G, F.bid);
        const float* stat = wsp<float>(F, WS_STAT);
        Epi1 E{wsp<bf16>(F, WS_Q), wsp<bf16>(F, WS_K), wsp<bf16>(F, WS_VT), wsp<bf16>(F, WS_HQ), wsp<bf16>(F, WS_HLF), wsp<bf16>(F, WS_HV), wsp<bf16>(F, WS_HG), wsp<float>(F, WS_KPART), stat + ST_RS1};
        pg8::gemm_phase<Epi1, pg8::StaticOrder, PG8_ALIGN, PG8_SP2>(F.lds, g, S, E);
#ifdef TIME_P1
        pg8::gemm_phase<Epi1, pg8::StaticOrder, PG8_ALIGN, PG8_SP2>(F.lds, g, S, E);
#endif
    }
    SEAM(1);
    if (IN(2)) {
        Frame F = make_frame(lds);
        p2_gate(F);
        hgrn_mfma<false>(F);
    }
    SEAM(2);
    if (IN(3)) { Frame F = make_frame(lds); p3_attn(F);
#ifdef TIME_ATTN
        p3_attn(F);
#endif
        hgrn_scan(F); }
    SEAM(3);
    if (IN(4)) {
        Frame F = make_frame(lds);
        p4_combine(F);
        hgrn_mfma<true>(F);
    }
    SEAM(4);
    if (IN(5)) {
        Frame F = make_frame(lds);
        pg8::Gemm g{wsp<bf16>(F, WS_MIX), wsp<bf16>(F, WS_W2T), S_, D_, D_}; pg8::StaticOrder S; S.init(S_, D_, F.G, F.bid);
        Epi2 E{F.in[0], F.out, wsp<bf16>(F, WS_H1B), wsp<float>(F, WS_SSQ2)};
        pg8::gemm_phase<Epi2, pg8::StaticOrder, PG8_ALIGN, PG8_SP2>(F.lds, g, S, E);
    }
    SEAM(5);
    if (IN(6)) {
        Frame F = make_frame(lds);
        pg8::Gemm g{wsp<bf16>(F, WS_H1B), wsp<bf16>(F, WS_WQT), S_, D_, D_}; pg8::StaticOrder S; S.init(S_, D_, F.G, F.bid);
        EpiB E{wsp<bf16>(F, WS_QRY), D_};
        pg8::gemm_phase<EpiB, pg8::StaticOrder, PG8_ALIGN, PG8_SP2>(F.lds, g, S, E);
    }
    SEAM(6);
    if (IN(7)) { Frame F = make_frame(lds); p7_route(F); }
    SEAM(7);
#ifdef TIME_P8
    if (IN(8)) { Frame F = make_frame(lds); p8_peer<true>(F); }
#endif
    if (IN(8)) { Frame F = make_frame(lds); p8_peer<false>(F); }
    SEAM(8);
    if (IN(9)) {
        { Frame F = make_frame(lds); pg8::StaticOrder S; S.init(S_, D_, F.G, F.bid);
          pg8::Gemm g{wsp<bf16>(F, WS_PB), wsp<bf16>(F, WS_WPT), S_, D_, PLE}; EpiP E{wsp<bf16>(F, WS_PLE)};
          pg8::gemm_phase<EpiP, pg8::StaticOrder, PG8_ALIGN, PG8_SP2>(F.lds, g, S, E); }
        { Frame F = make_frame(lds); pg8::StaticOrder S; S.init(S_, D_, F.G, F.bid);
          pg8::Gemm g{wsp<bf16>(F, WS_H1B), wsp<bf16>(F, WS_WGT), S_, D_, D_}; Epi4 E{F.out, wsp<bf16>(F, WS_PLE), wsp<float>(F, WS_STAT) + ST_RS3, wsp<float>(F, WS_SSQ4)};
          pg8::gemm_phase<Epi4, pg8::StaticOrder, PG8_ALIGN, PG8_SP2>(F.lds, g, S, E); }
    }
    SEAM(9);
    if (IN(10)) { Frame F = make_frame(lds); p10_final(F); }
#undef IN
#undef SEAM
}

extern "C" void kernel_launch(void* const* d_in, const int* in_sizes, int n_in, void* d_out, int out_size, void* d_ws, size_t ws_size, hipStream_t stream) {
    static int grid = 0;
    if (grid == 0) {
        if (n_in != 16 || out_size != S_ * D_ || ws_size < WS_END) { fprintf(stderr, "kernel_launch: unexpected problem (n_in %d, out %d, ws %zu < %zu)\n", n_in, out_size, ws_size, (size_t)WS_END); grid = -1; return; }
        int dev = 0, cus = 0, per_cu = 0;
        if (hipGetDevice(&dev) != hipSuccess || hipDeviceGetAttribute(&cus, hipDeviceAttributeMultiprocessorCount, dev) != hipSuccess) { grid = -1; return; }
        if (hipFuncSetAttribute((const void*)mega_fwd, hipFuncAttributeMaxDynamicSharedMemorySize, LDS_BYTES) != hipSuccess) { fprintf(stderr, "kernel_launch: hipFuncSetAttribute failed\n"); grid = -1; return; }
        if (hipOccupancyMaxActiveBlocksPerMultiprocessor(&per_cu, (const void*)mega_fwd, NTHREADS, LDS_BYTES) != hipSuccess || per_cu < 1) { fprintf(stderr, "kernel_launch: occupancy query says %d\n", per_cu); (void)hipGetLastError(); }
        grid = cus;
    }
    if (grid < 0) return;
    (void)hipMemsetAsync((char*)d_ws + WS_CTL, 0, CTL_ZERO_BYTES, stream);
    Args a{};
    for (int i = 0; i < 16; ++i) a.in[i] = (const float*)d_in[i];
    a.out = (float*)d_out; a.ws = (unsigned char*)d_ws;
#if MK_PER_PHASE
    for (int ph = 0; ph < NPHASES; ++ph) {
        a.ph_lo = ph; a.ph_hi = ph + 1;
        hipLaunchKernelGGL(mega_fwd, dim3(grid), dim3(NTHREADS), LDS_BYTES, stream, a);
    }
#else
    a.ph_lo = 0; a.ph_hi = NPHASES;
    void* kargs[] = {&a};
    hipError_t e = hipLaunchCooperativeKernel((const void*)mega_fwd, dim3(grid), dim3(NTHREADS), kargs, LDS_BYTES, stream);
    if (e != hipSuccess) fprintf(stderr, "kernel_launch: cooperative launch failed: %s\n", hipGetErrorString(e));
#endif
}
```

```cpp
#include <hip/hip_runtime.h>
#include <cstdio>
#include <cstdint>

#ifndef MK_PER_PHASE
#define MK_PER_PHASE 0
#endif

namespace pg8 {
#define PG8_LAS __attribute__((address_space(3)))
typedef unsigned short bf16_t;
typedef short bf16x8 __attribute__((ext_vector_type(8)));
typedef float f32x4 __attribute__((ext_vector_type(4)));
typedef unsigned u32x4 __attribute__((ext_vector_type(4)));
constexpr int BM = 256, BK = 64, HALF = 128, HTB = HALF * BK * 2, STAGE_BYTES = 8 * HTB, NXCD = 8, WGM = 8;

__host__ __device__ __forceinline__ int lds_byte(int r, int c) { const int st = (r >> 4) * 2 + (c >> 5), rr = r & 15, cc = c & 31, ob = rr * 64 + cc * 2; return st * 1024 + (ob ^ (((ob >> 9) & 1) << 5)); }
__host__ __device__ __forceinline__ void stage_rc(int b, int& R, int& C) { const int st = b / 1024, sb = b % 1024, swz = sb ^ (((sb >> 9) & 1) << 5); R = (st >> 1) * 16 + swz / 64; C = (st & 1) * 32 + (swz % 64) / 2; }
__host__ __device__ __forceinline__ int perm32(int rho) { const int n = rho >> 4, i = rho & 15; return 8 * (i >> 2) + 4 * n + (i & 3); }

struct Unit { int pm, pn; };
struct Gemm { const bf16_t* A; const bf16_t* Bt; int M, N, K; };

struct StaticOrder {
    int nM, nN, nwg, G, c;
    __host__ __device__ void init(int M, int N, int G_, int c_) { nM = M / BM; nN = N / BM; nwg = nM * nN; G = G_; c = c_; }
    __host__ __device__ bool next(int i, Unit& u) const {
        const long L = (long)i * G + c; if (L >= nwg) return false;
        int wgid = (int)L; { const int q = nwg / NXCD, r = nwg % NXCD, xcd = wgid % NXCD, off = wgid / NXCD; wgid = (xcd < r ? xcd * (q + 1) : r * (q + 1) + (xcd - r) * q) + off; }
        const int nig = WGM * nN, gid = wgid / nig, fm = gid * WGM, gsz = (nM - fm) < WGM ? (nM - fm) : WGM;
        u.pm = fm + ((wgid % nig) % gsz); u.pn = (wgid % nig) / gsz; return true;
    }
    __device__ __forceinline__ void a_ready(const Unit&) const {}
    __device__ __forceinline__ void done(const Unit&) const {}
};

typedef int i32x8 __attribute__((ext_vector_type(8)));
template <bool FP8> struct FragSel { typedef bf16x8 A_t[4][2]; typedef bf16x8 B_t[2][2]; };
template <> struct FragSel<true> { typedef i32x8 A_t[4]; typedef i32x8 B_t[2]; };
template <class Epi, class Sched, bool ALIGN_EPI = false, bool SP2 = false, bool FP8 = false>
__device__ __forceinline__ void gemm_phase(PG8_LAS unsigned char* lds, const Gemm g, const Sched& S, const Epi& E, const int tid) {
    const int wid = __builtin_amdgcn_readfirstlane(tid >> 6), lane = tid & 63, wr = wid >> 2, wc = wid & 3, fr = lane & 15, fq = lane >> 4;
    int K_ = g.K; asm volatile("" : "+s"(K_));
    const int K = K_, nt = K / BK;
    unsigned voffA[2], voffB[2];
#pragma unroll
    for (int i = 0; i < 2; ++i) { int R, C; stage_rc(tid * 16 + i * 8192, R, C); const int Rb = Epi::PERM ? ((R & ~31) + perm32(R & 31)) : R;
        voffA[i] = (unsigned)(R * K + C) * 2u; voffB[i] = (unsigned)(Rb * K + C) * 2u; }
    const size_t kstep = (size_t)(BK * 2);
    const size_t hstep = (size_t)HALF * K * 2;
    const size_t tstep = 2 * hstep;
    const unsigned ldsw = (unsigned)wid * 1024u;
    const int fcol = FP8 ? (16 * (fq & 1) + 32 * (fq >> 1)) : fq * 8;
    const int aoff = lds_byte(wr * 64 + fr, fcol), boff = lds_byte(wc * 32 + fr, fcol);

#define PG8_SA(b, h) (((b) * 2 + (h)) * HTB)
#define PG8_SB(b, h) ((4 + (b) * 2 + (h)) * HTB)
#define PG8_STAGE(bufoff, gbase, voff) do { _Pragma("unroll") for (int _i = 0; _i < 2; ++_i) \
        __builtin_amdgcn_global_load_lds((const unsigned*)((const char*)(gbase) + (voff)[_i]), (PG8_LAS unsigned*)(lds + (bufoff) + ldsw + _i * 8192), 16, 0, 0); } while (0)
#define PG8_LDA(dst, b, h) do { if constexpr (FP8) { _Pragma("unroll") for (int m = 0; m < 4; ++m) dst[m] = *(const PG8_LAS i32x8*)(lds + PG8_SA(b, h) + aoff + m * 2048); } \
        else { _Pragma("unroll") for (int m = 0; m < 4; ++m) _Pragma("unroll") for (int k = 0; k < 2; ++k) dst[m][k] = *(const PG8_LAS bf16x8*)(lds + PG8_SA(b, h) + aoff + m * 2048 + k * 1024); } } while (0)
#define PG8_LDB(dst, b, h) do { if constexpr (FP8) { _Pragma("unroll") for (int n = 0; n < 2; ++n) dst[n] = *(const PG8_LAS i32x8*)(lds + PG8_SB(b, h) + boff + n * 2048); } \
        else { _Pragma("unroll") for (int n = 0; n < 2; ++n) _Pragma("unroll") for (int k = 0; k < 2; ++k) dst[n][k] = *(const PG8_LAS bf16x8*)(lds + PG8_SB(b, h) + boff + n * 2048 + k * 1024); } } while (0)
#define PG8_MMA(ai, bj, At, Bt) do { __builtin_amdgcn_s_setprio(1); \
        if constexpr (FP8) { _Pragma("unroll") for (int m = 0; m < 4; ++m) _Pragma("unroll") for (int n = 0; n < 2; ++n) \
            asm volatile("v_mfma_scale_f32_16x16x128_f8f6f4 %0, %1, %2, %0, %3, %3 op_sel_hi:[0,0,0]" : "+v"(acc[ai][bj][m][n]) : "v"(Bt[n]), "v"(At[m]), "v"(one_scale)); } \
        else { _Pragma("unroll") for (int m = 0; m < 4; ++m) _Pragma("unroll") for (int n = 0; n < 2; ++n) _Pragma("unroll") for (int k = 0; k < 2; ++k) \
            acc[ai][bj][m][n] = __builtin_amdgcn_mfma_f32_16x16x32_bf16(Bt[n][k], At[m][k], acc[ai][bj][m][n], 0, 0, 0); } \
        __builtin_amdgcn_s_setprio(0); } while (0)
#define PG8_WAIT_V(n) asm volatile("s_waitcnt vmcnt(" #n ")" ::: "memory")
#define PG8_WAIT_L(n) asm volatile("s_waitcnt lgkmcnt(" #n ")" ::: "memory")
#define PG8_BAR __builtin_amdgcn_s_barrier()
#define PG8_SCHED __builtin_amdgcn_sched_barrier(0)
    int one_scale = 0x7f7f7f7f;
    asm volatile("" : "+v"(one_scale));
    Unit cur, nxt; int ui = 0;
    if (!S.next(0, cur)) return;
    f32x4 acc[2][2][4][2];
#pragma unroll
    for (int a = 0; a < 2; ++a)
#pragma unroll
        for (int b = 0; b < 2; ++b)
#pragma unroll
            for (int m = 0; m < 4; ++m)
#pragma unroll
                for (int n = 0; n < 2; ++n) acc[a][b][m][n] = (f32x4){0.f, 0.f, 0.f, 0.f};
    typename FragSel<FP8>::A_t At; typename FragSel<FP8>::B_t B0, B1;
    const char* cA = (const char*)g.A + (size_t)cur.pm * tstep; const char* cB = (const char*)g.Bt + (size_t)cur.pn * tstep;
    S.a_ready(cur);
    if constexpr (SP2) {
        PG8_STAGE(PG8_SB(0, 0), cB, voffB); PG8_STAGE(PG8_SB(0, 1), cB + hstep, voffB); PG8_STAGE(PG8_SA(0, 0), cA, voffA); PG8_STAGE(PG8_SA(0, 1), cA + hstep, voffA);
        if (wr == 1) PG8_BAR;
        PG8_WAIT_V(2); PG8_BAR;
        PG8_STAGE(PG8_SB(1, 0), cB + kstep, voffB); PG8_STAGE(PG8_SA(1, 0), cA + kstep, voffA); PG8_STAGE(PG8_SB(1, 1), cB + hstep + kstep, voffB);
        PG8_WAIT_V(6); PG8_BAR;
    } else {
        PG8_STAGE(PG8_SB(0, 0), cB, voffB); PG8_STAGE(PG8_SA(0, 0), cA, voffA); PG8_STAGE(PG8_SB(0, 1), cB + hstep, voffB); PG8_STAGE(PG8_SA(0, 1), cA + hstep, voffA);
        if (wr == 1) PG8_BAR;
        PG8_WAIT_V(4); PG8_BAR;
        PG8_STAGE(PG8_SB(1, 0), cB + kstep, voffB); PG8_STAGE(PG8_SA(1, 0), cA + kstep, voffA); PG8_STAGE(PG8_SB(1, 1), cB + hstep + kstep, voffB);
        PG8_WAIT_V(6); PG8_BAR;
    }
    for (;;) {
        const bool has_next = S.next(ui + 1, nxt);
        const char* nA = has_next ? (const char*)g.A + (size_t)nxt.pm * tstep : cA; const char* nB = has_next ? (const char*)g.Bt + (size_t)nxt.pn * tstep : cB;
        for (int t = 0; t < nt; t += 2) {
            const bool last = (t == nt - 2);
            const char* a1 = cA + (size_t)(t + 1) * kstep;
            const char* a2 = last ? nA : cA + (size_t)(t + 2) * kstep; const char* b2 = last ? nB : cB + (size_t)(t + 2) * kstep;
            const char* a3 = a2 + kstep; const char* b3 = b2 + kstep;
            if (last && has_next) S.a_ready(nxt);
            if constexpr (SP2) {
            PG8_LDB(B0, 0, 0); PG8_LDB(B1, 0, 1); PG8_SCHED; PG8_LDA(At, 0, 0); PG8_STAGE(PG8_SA(1, 1), a1 + hstep, voffA);
            PG8_WAIT_V(8); PG8_WAIT_L(0); PG8_BAR; PG8_MMA(0, 0, At, B0); PG8_MMA(0, 1, At, B1); PG8_BAR; PG8_SCHED;
            PG8_LDA(At, 0, 1); PG8_STAGE(PG8_SB(0, 0), b2, voffB); PG8_STAGE(PG8_SB(0, 1), b2 + hstep, voffB); PG8_STAGE(PG8_SA(0, 0), a2, voffA);
            PG8_WAIT_V(8); PG8_WAIT_L(0); PG8_BAR; PG8_MMA(1, 0, At, B0); PG8_MMA(1, 1, At, B1); PG8_BAR; PG8_SCHED;
            PG8_LDB(B0, 1, 0); PG8_LDB(B1, 1, 1); PG8_SCHED; PG8_LDA(At, 1, 0); PG8_STAGE(PG8_SA(0, 1), a2 + hstep, voffA);
            PG8_WAIT_V(8); PG8_WAIT_L(0); PG8_BAR; PG8_MMA(0, 0, At, B0); PG8_MMA(0, 1, At, B1); PG8_BAR; PG8_SCHED;
            PG8_LDA(At, 1, 1); PG8_STAGE(PG8_SB(1, 0), b3, voffB); PG8_STAGE(PG8_SB(1, 1), b3 + hstep, voffB); PG8_STAGE(PG8_SA(1, 0), a3, voffA);
            PG8_WAIT_V(8); PG8_WAIT_L(0); PG8_BAR; PG8_MMA(1, 0, At, B0); PG8_MMA(1, 1, At, B1); PG8_BAR; PG8_SCHED;
            } else {
            PG8_LDB(B0, 0, 0); PG8_SCHED; PG8_LDA(At, 0, 0); PG8_STAGE(PG8_SA(1, 1), a1 + hstep, voffA);
            PG8_WAIT_L(8); PG8_BAR; PG8_WAIT_L(0); PG8_MMA(0, 0, At, B0); PG8_BAR; PG8_SCHED;
            PG8_LDB(B1, 0, 1); PG8_STAGE(PG8_SB(0, 0), b2, voffB);
            PG8_BAR; PG8_WAIT_L(0); PG8_MMA(0, 1, At, B1); PG8_BAR;
            PG8_LDA(At, 0, 1); PG8_STAGE(PG8_SA(0, 0), a2, voffA);
            PG8_BAR; PG8_WAIT_L(0); PG8_MMA(1, 0, At, B0); PG8_BAR; PG8_SCHED;
            PG8_STAGE(PG8_SB(0, 1), b2 + hstep, voffB);
            PG8_WAIT_V(6); PG8_BAR; PG8_MMA(1, 1, At, B1); PG8_BAR;
            PG8_LDB(B0, 1, 0); PG8_SCHED; PG8_LDA(At, 1, 0); PG8_STAGE(PG8_SA(0, 1), a2 + hstep, voffA);
            PG8_WAIT_L(8); PG8_BAR; PG8_WAIT_L(0); PG8_MMA(0, 0, At, B0); PG8_BAR; PG8_SCHED;
            PG8_LDB(B1, 1, 1); PG8_STAGE(PG8_SB(1, 0), b3, voffB);
            PG8_BAR; PG8_WAIT_L(0); PG8_MMA(0, 1, At, B1); PG8_BAR;
            PG8_LDA(At, 1, 1); PG8_STAGE(PG8_SA(1, 0), a3, voffA);
            PG8_BAR; PG8_WAIT_L(0); PG8_MMA(1, 0, At, B0); PG8_BAR; PG8_SCHED;
            PG8_STAGE(PG8_SB(1, 1), b3 + hstep, voffB);
            PG8_WAIT_V(6); PG8_BAR; PG8_MMA(1, 1, At, B1); PG8_BAR;
            }
        }
        if constexpr (ALIGN_EPI) { if (wr == 0) PG8_BAR; }
        if constexpr (FP8) asm volatile("s_nop 15\n\ts_nop 15" ::: "memory");
        E(acc, cur, wr, wc, fr, fq); S.done(cur);
        if (!has_next) break;
#pragma unroll
        for (int a = 0; a < 2; ++a)
#pragma unroll
            for (int b = 0; b < 2; ++b)
#pragma unroll
                for (int m = 0; m < 4; ++m)
#pragma unroll
                    for (int n = 0; n < 2; ++n) acc[a][b][m][n] = (f32x4){0.f, 0.f, 0.f, 0.f};
        cur = nxt; cA = nA; cB = nB; ++ui;
        if constexpr (ALIGN_EPI) { if (wr == 1) PG8_BAR; }
    }
    PG8_WAIT_V(0);
    if constexpr (!ALIGN_EPI) { if (wr == 0) PG8_BAR; }
    PG8_BAR;
#undef PG8_SA
#undef PG8_SB
#undef PG8_STAGE
#undef PG8_LDA
#undef PG8_LDB
#undef PG8_MMA
#undef PG8_WAIT_V
#undef PG8_WAIT_L
#undef PG8_BAR
#undef PG8_SCHED
}
}

#define PG8_SP2 true
#define PG8_ALIGN true

constexpr int NWAVES = 8, NTHREADS = 512;
constexpr int S_ = 16384, D_ = 2048, NIN = 7168, AW = 1024, NH = 8, HD = 128, NBLK = 64, LBLK = 256;
constexpr int PLE = 256, NEXP = 16384, PH = 8, NKEY = 128, PTOP = 16;
constexpr float EPS = 1e-6f;
constexpr float QSCALE = 0.08838834764831845f * 1.4426950408889634f;
constexpr float XSCALE = 16.f, W1SCALE = 512.f;
constexpr float MSCALE = 8.f;
constexpr float DSCALE = 512.f, USCALE = 32.f;
constexpr int HSC = 64, HSCLEN = 256, HSUB = 32;
constexpr int LSTRIDE = 256 * (63 * 64 / 2);
__host__ __device__ __forceinline__ int list_off(int n) { return 256 * (63 * n - (n * (n - 1)) / 2); }

constexpr size_t MiB = 1u << 20;
constexpr size_t WS_CTL = 0, CTL_ZERO_BYTES = 1 * MiB;
constexpr size_t WS_W1T = 2 * MiB  , WS_W1TB = 10 * MiB  , WS_W2T = 30 * MiB, WS_WQT = 38 * MiB, WS_WGT = 46 * MiB, WS_WPT = 54 * MiB, WS_SKB = 55 * MiB;
constexpr size_t WS_STAT = 56 * MiB;
constexpr size_t WS_SSQ2 = 57 * MiB, WS_SSQ4 = 59 * MiB;
constexpr size_t WS_KPART = 61 * MiB, WS_HDEC = 62 * MiB;
constexpr size_t WS_PB = 63 * MiB;
constexpr size_t WS_DOWN = 71 * MiB, WS_UP = 135 * MiB;
constexpr size_t WS_R1 = 199 * MiB;
constexpr size_t WS_XB = WS_R1, WS_LIST = WS_R1, WS_PML = WS_R1 + 16 * MiB, WS_HST = WS_R1 + 20 * MiB, WS_H1B = WS_R1;
constexpr size_t WS_R2 = 263 * MiB;
constexpr size_t WS_Q = WS_R2, WS_K = WS_R2 + 32 * MiB, WS_VT = WS_R2 + 64 * MiB, WS_MIX = WS_R2, WS_QRY = WS_R2, WS_PIDX = WS_R2 + 64 * MiB, WS_PGATE = WS_R2 + 72 * MiB;
constexpr size_t WS_R3 = 359 * MiB;
constexpr size_t WS_HQ = WS_R3, WS_HLF = WS_R3 + 32 * MiB, WS_HV = WS_R3 + 64 * MiB, WS_HG = WS_R3 + 96 * MiB, WS_PLE = WS_R3;
constexpr size_t WS_END = 487 * MiB;
constexpr int CW_BAR = 4096;
constexpr int CW_GCNT = 16384;
constexpr int ST_RS1 = 0, ST_LB = S_, ST_RS2 = S_ + 1024, ST_RS3 = 2 * S_ + 1024, ST_RS1Q = 3 * S_ + 1024;

constexpr int RING_BYTES = 131072;
constexpr int LDS_BYTES = 147456;
constexpr int MISC_OFF = LDS_BYTES - 256;

#define LAS __attribute__((address_space(3)))
typedef unsigned short bf16;
typedef unsigned u32x4 __attribute__((ext_vector_type(4)));
typedef unsigned u32x2 __attribute__((ext_vector_type(2)));
typedef float f32x4 __attribute__((ext_vector_type(4)));
typedef float f32x2 __attribute__((ext_vector_type(2)));
typedef float f32x16 __attribute__((ext_vector_type(16)));
typedef short bf16x8 __attribute__((ext_vector_type(8)));
typedef short s16x4 __attribute__((ext_vector_type(4)));
typedef __bf16 bf16x2n __attribute__((ext_vector_type(2)));
#define RLX_AGENT __ATOMIC_RELAXED, __HIP_MEMORY_SCOPE_AGENT
#define LDS_WAIT() asm volatile("s_waitcnt lgkmcnt(0)" ::: "memory")
#define DI __device__ __forceinline__

DI unsigned pk2(float lo, float hi) { f32x2 v = {lo, hi}; bf16x2n b = __builtin_convertvector(v, bf16x2n); return __builtin_bit_cast(unsigned, b); }
DI float sat8(float v) { return __builtin_amdgcn_fmed3f(v, -440.f, 440.f); }
DI float bflo(unsigned u) { return __uint_as_float(u << 16); }
DI float bfhi(unsigned u) { return __uint_as_float(u & 0xffff0000u); }
DI float wave_sum(float v) {
#pragma unroll
    for (int o = 1; o < 64; o <<= 1) v += __shfl_xor(v, o);
    return v;
}
DI float sigmoidf_(float x) { return 1.f / (1.f + __expf(-x)); }
DI float siluf_(float x) { return x / (1.f + __expf(-x)); }
DI int crow(int reg, int h) { return (reg & 3) + 8 * (reg >> 2) + 4 * h; }

#define XB_TMO      128
#define XB_XCNT(j)  (256  + 64 * (j))
#define XB_XSUB(j)  (1280 + 64 * (j))
#define XB_XGEN(j)  (2304 + 64 * (j))
#define XB_TOP      3328
#define XB_TOPGEN   3392
#define XCD_BAR_WORDS 3456
#define XB_SPIN_CAP (1u << 22)
DI unsigned xb_ld(unsigned* p)              { return __hip_atomic_load(p, __ATOMIC_RELAXED, __HIP_MEMORY_SCOPE_AGENT); }
DI unsigned xb_add(unsigned* p, unsigned v) { return __hip_atomic_fetch_add(p, v, __ATOMIC_RELAXED, __HIP_MEMORY_SCOPE_AGENT); }
DI unsigned xb_xcc_id() { return (unsigned)__builtin_amdgcn_s_getreg((3 << 11) | 20) & 0xFu; }
#define XB_SPIN(cond, bar) do { unsigned _sp = 0; while (cond) { __builtin_amdgcn_s_sleep(1); \
    if ((++_sp & 255u) == 0u) { if (xb_ld(&(bar)[XB_TMO])) break; if (_sp > XB_SPIN_CAP) { atomicAdd(&(bar)[XB_TMO], 1u); break; } } } } while (0)
struct XcdBarrier { unsigned* bar; unsigned x; volatile LAS unsigned* st; };
DI XcdBarrier xcd_barrier_post(unsigned* bar, volatile LAS unsigned* st, int tid) {
    XcdBarrier b; b.bar = bar; b.x = xb_xcc_id(); b.st = st;
    if (tid == 0) (void)xb_add(&bar[XB_XCNT(b.x)], 1u);
    return b;
}
DI void xcd_barrier_complete(unsigned* bar, unsigned x, unsigned& nloc, unsigned& nx) {
    const unsigned G = gridDim.x * gridDim.y * gridDim.z;
    unsigned sum, cnt, mine, sp = 0u;
    for (;;) {
        sum = 0u; cnt = 0u; mine = 0u;
#pragma unroll
        for (unsigned j = 0; j < 16; ++j) { const unsigned c = xb_ld(&bar[XB_XCNT(j)]); sum += c; cnt += (c > 0u) ? 1u : 0u; mine = (j == x) ? c : mine; }
        if (sum == G) break;
        __builtin_amdgcn_s_sleep(1);
        if ((++sp & 255u) == 0u) { if (xb_ld(&bar[XB_TMO])) break; if (sp > XB_SPIN_CAP) { atomicAdd(&bar[XB_TMO], 1u); break; } }
    }
    nloc = mine > 0u ? mine : 1u; nx = cnt > 0u ? cnt : 1u;
}
DI void xcd_barrier(const XcdBarrier& b, int tid) {
    asm volatile("s_waitcnt vmcnt(0)" ::: "memory");
    __syncthreads();
    if (tid == 0) {
        unsigned* bar = b.bar;
        __builtin_amdgcn_s_waitcnt(0);
        unsigned nloc = b.st[0], nx = b.st[1];
        if (nloc == 0u) { xcd_barrier_complete(bar, b.x, nloc, nx); b.st[0] = nloc; b.st[1] = nx; }
        const unsigned old = xb_add(&bar[XB_XSUB(b.x)], 1u);
        const unsigned gen = old / nloc;
        if (old + 1u == (gen + 1u) * nloc) {
            __builtin_amdgcn_fence(__ATOMIC_RELEASE, "agent");
            asm volatile("s_waitcnt vmcnt(0)" ::: "memory");
            const unsigned og = xb_add(&bar[XB_TOP], 1u);
            const unsigned tg = og / nx;
            if (og + 1u == (tg + 1u) * nx) xb_add(&bar[XB_TOPGEN], 1u);
            else XB_SPIN(xb_ld(&bar[XB_TOPGEN]) == tg, bar);
            __builtin_amdgcn_fence(__ATOMIC_ACQUIRE, "agent");
            xb_add(&bar[XB_XGEN(b.x)], 1u);
            asm volatile("s_waitcnt vmcnt(0)" ::: "memory");
        } else {
            XB_SPIN(xb_ld(&bar[XB_XGEN(b.x)]) == gen, bar);
            __builtin_amdgcn_fence(__ATOMIC_ACQUIRE, "agent");
            asm volatile("s_waitcnt vmcnt(0)" ::: "memory");
        }
    }
    __syncthreads();
}

struct Frame {
    LAS unsigned char* lds;
    unsigned* ctl;
    int tid, lane, wave, G, bid;
    const float* in[16];
    float* out;
    unsigned char* ws;
};
template <class T> DI T* wsp(const Frame& F, size_t off) { return (T*)(F.ws + off); }

constexpr int TP_PITCH = 65, TP_WAVE_BYTES = 64 * TP_PITCH * 4 + 64;
template <bool FP8 = false> DI void p0_transpose_item(const float* W, const float* gain, int K, int N, bf16* WT, LAS float* scr, int item, int lane, int nscaled = 0, float nscale = 1.f, float allscale = 1.f) {
    const int nblk = N / 64, kb = item / nblk, nb = item % nblk, k0 = 64 * kb, n0 = 64 * nb; const float osc = ((n0 < nscaled) ? nscale : 1.f) * allscale;
    const int kr = lane >> 4, n4 = (lane & 15) * 4;
    f32x4 v[16];
#pragma unroll
    for (int i = 0; i < 16; ++i) v[i] = *(const f32x4*)(W + (size_t)(k0 + 4 * i + kr) * N + n0 + n4);
#pragma unroll
    for (int i = 0; i < 16; ++i) { const int kk = 4 * i + kr; const float g = (gain ? gain[k0 + kk] : 1.f) * osc;
        scr[(n4 + 0) * TP_PITCH + kk] = v[i].x * g; scr[(n4 + 1) * TP_PITCH + kk] = v[i].y * g; scr[(n4 + 2) * TP_PITCH + kk] = v[i].z * g; scr[(n4 + 3) * TP_PITCH + kk] = v[i].w * g; }
    LDS_WAIT(); asm volatile("" ::: "memory");
    const int c = lane & 7, nn = lane >> 3;
#pragma unroll
    for (int j = 0; j < 8; ++j) { const int n = nn + 8 * j; const LAS float* sp = scr + n * TP_PITCH + 8 * c;
        if constexpr (FP8) {
            int w0 = __builtin_amdgcn_cvt_pk_fp8_f32(sp[0], sp[1], 0, false); w0 = __builtin_amdgcn_cvt_pk_fp8_f32(sp[2], sp[3], w0, true);
            int w1 = __builtin_amdgcn_cvt_pk_fp8_f32(sp[4], sp[5], 0, false); w1 = __builtin_amdgcn_cvt_pk_fp8_f32(sp[6], sp[7], w1, true);
            *(u32x2*)((unsigned char*)WT + (size_t)(n0 + n) * K + k0 + 8 * c) = (u32x2){(unsigned)w0, (unsigned)w1};
        } else {
            u32x4 o; o.x = pk2(sp[0], sp[1]); o.y = pk2(sp[2], sp[3]); o.z = pk2(sp[4], sp[5]); o.w = pk2(sp[6], sp[7]);
            *(u32x4*)(WT + (size_t)(n0 + n) * K + k0 + 8 * c) = o; } }
    LDS_WAIT(); asm volatile("" ::: "memory");
}
DI void p0_convert(const float* src, bf16* dst, size_t n8, const float* colgain, size_t gtid, size_t gstride) {
    for (size_t i = gtid; i < n8; i += gstride) {
        f32x4 a = *(const f32x4*)(src + i * 8), b = *(const f32x4*)(src + i * 8 + 4);
        if (colgain) { const int c = (int)((i * 8) & 2047); a = a * *(const f32x4*)(colgain + c); b = b * *(const f32x4*)(colgain + c + 4); }
        u32x4 o; o.x = pk2(a.x, a.y); o.y = pk2(a.z, a.w); o.z = pk2(b.x, b.y); o.w = pk2(b.z, b.w);
        *(u32x4*)(dst + i * 8) = o;
    }
}
DI void p0_convert_fp8(const float* src, unsigned char* dst, size_t nelem, const float* colgain, float scale, size_t gwave, size_t nwaves, int lane) {
    const size_t nunit = nelem / 2048;
    for (size_t u = gwave; u < nunit; u += nwaves) {
        const float* sp = src + u * 2048 + lane * 4; unsigned char* dp = dst + u * 2048 + lane * 4;
        f32x4 a[8];
#pragma unroll
        for (int q = 0; q < 8; ++q) a[q] = __builtin_nontemporal_load((const f32x4*)(sp + q * 256));
#pragma unroll
        for (int q = 0; q < 8; ++q) {
            f32x4 v = a[q];
            if (colgain) v = v * *(const f32x4*)(colgain + q * 256 + lane * 4);
            v = v * scale;
            int w = __builtin_amdgcn_cvt_pk_fp8_f32(v.x, v.y, 0, false);
            w = __builtin_amdgcn_cvt_pk_fp8_f32(v.z, v.w, w, true);
            __builtin_nontemporal_store((unsigned)w, (unsigned*)(dp + q * 256));
        }
    }
}
DI void p0_prologue(Frame& F) {
    LAS float* scr = (LAS float*)(F.lds + F.wave * TP_WAVE_BYTES);
    const int gw = F.bid * NWAVES + F.wave, NGW = F.G * NWAVES;
    const float* x = F.in[0];
    constexpr int I1 = (D_ / 64) * (NIN / 64), I2 = (D_ / 64) * (D_ / 64), IP = (PLE / 64) * (D_ / 64);
    constexpr int NITEMS = I1 + 3 * I2 + IP;
    for (int it = gw; it < NITEMS; it += NGW) {
        int r = it;
        if (r < I1) {
            const int nb = r % (NIN / 64);
            if (nb < 3 * AW / 64) p0_transpose_item<true>(F.in[3], F.in[2], D_, NIN, wsp<bf16>(F, WS_W1T), scr, r, F.lane, AW, QSCALE, W1SCALE);
            else p0_transpose_item<false>(F.in[3], F.in[2], D_, NIN, wsp<bf16>(F, WS_W1TB) - (size_t)3 * AW * D_, scr, r, F.lane);
            continue; } r -= I1;
        if (r < I2) { p0_transpose_item<true>(F.in[6], nullptr, D_, D_, wsp<bf16>(F, WS_W2T), scr, r, F.lane, 0, 1.f, W1SCALE); continue; } r -= I2;
        if (r < I2) { p0_transpose_item(F.in[8], F.in[7], D_, D_, wsp<bf16>(F, WS_WQT), scr, r, F.lane); continue; } r -= I2;
        if (r < I2) { p0_transpose_item(F.in[14], F.in[12], D_, D_, wsp<bf16>(F, WS_WGT), scr, r, F.lane); continue; } r -= I2;
        p0_transpose_item(F.in[13], nullptr, PLE, D_, wsp<bf16>(F, WS_WPT), scr, r, F.lane);
    }
    float* stat = wsp<float>(F, WS_STAT);
    bf16* xb = wsp<bf16>(F, WS_XB);
    for (int m = gw; m < S_; m += NGW) {
        const f32x4* xr = (const f32x4*)(x + (size_t)m * D_) + F.lane;
        f32x4 v[8]; float s = 0.f;
#pragma unroll
        for (int j = 0; j < 8; ++j) { v[j] = xr[64 * j]; s += (v[j].x * v[j].x + v[j].y * v[j].y) + (v[j].z * v[j].z + v[j].w * v[j].w); }
        s = wave_sum(s);
        if (F.lane == 0) { const float rs = 1.f / sqrtf(s * (1.f / D_) + EPS); stat[ST_RS1 + m] = rs; stat[ST_RS1Q + m] = rs * (1.f / (XSCALE * W1SCALE)); }
        u32x2* o8 = (u32x2*)(xb + (size_t)m * D_) + F.lane;
#pragma unroll
        for (int j = 0; j < 8; ++j) { u32x2 w; w.x = pk2(v[j].x, v[j].y); w.y = pk2(v[j].z, v[j].w); o8[64 * j] = w; }
        unsigned* o4 = (unsigned*)((unsigned char*)F.out + (size_t)m * D_) + F.lane;
#pragma unroll
        for (int j = 0; j < 8; ++j) { int w = __builtin_amdgcn_cvt_pk_fp8_f32(sat8(v[j].x * XSCALE), sat8(v[j].y * XSCALE), 0, false); w = __builtin_amdgcn_cvt_pk_fp8_f32(sat8(v[j].z * XSCALE), sat8(v[j].w * XSCALE), w, true); o4[64 * j] = (unsigned)w; }
    }
    const size_t gtid = (size_t)F.bid * NTHREADS + F.tid, gstride = (size_t)F.G * NTHREADS;
    p0_convert(F.in[1], wsp<bf16>(F, WS_PB), (size_t)S_ * PLE / 8, nullptr, gtid, gstride);
    p0_convert(F.in[9], wsp<bf16>(F, WS_SKB), (size_t)PH * 2 * NKEY * 128 / 8, nullptr, gtid, gstride);
    {
    p0_convert_fp8(F.in[10], wsp<unsigned char>(F, WS_DOWN), (size_t)NEXP * D_, F.in[7], DSCALE, (size_t)gw, (size_t)NGW, F.lane);
    p0_convert_fp8(F.in[11], wsp<unsigned char>(F, WS_UP), (size_t)NEXP * D_, nullptr, USCALE, (size_t)gw, (size_t)NGW, F.lane); }
    for (size_t i = gtid; i < 1024; i += gstride) { const float l0 = F.in[4][i], l1 = F.in[4][1024 + i]; stat[ST_LB + i] = 1.f / (1.f + __expf(l1 - l0)); }
}

template <int RBASE> struct Epi1 {
    static constexpr bool PERM = true, AFTER_DRAIN = false;
    bf16 *q, *k, *vt, *hq, *hlf, *hv, *hg; float* kpart; const float* rs1;
    template <int R> DI void run(const pg8::f32x4 (&acc)[2][2][4][2], const pg8::Unit& u, int wr, int wc, int fr, int fq, bf16* dst) const {
        const int cb = (u.pn & 3) * 256;
        const int row0 = u.pm * 256 + wr * 64 + fr;
        const int colw = cb + wc * 32 + 8 * fq;
        f32x4 cs[2][2];
        if (R == 1) { cs[0][0] = cs[0][1] = cs[1][0] = cs[1][1] = (f32x4){0.f, 0.f, 0.f, 0.f}; }
#pragma unroll
        for (int ai = 0; ai < 2; ++ai)
#pragma unroll
            for (int m = 0; m < 4; ++m) {
                const int row = row0 + ai * 128 + m * 16;
                const float rs = rs1[row];
#pragma unroll
                for (int bj = 0; bj < 2; ++bj) {
                    const f32x4 v0 = acc[ai][bj][m][0] * rs, v1 = acc[ai][bj][m][1] * rs;
                    const int col = colw + 128 * bj;
                    if (R == 1) { cs[bj][0] = cs[bj][0] + v0; cs[bj][1] = cs[bj][1] + v1; }
                    if (R == 2) {
                        bf16* p = dst + (size_t)col * S_ + row;
#pragma unroll
                        for (int i = 0; i < 4; ++i) { p[(size_t)i * S_] = (bf16)(pk2(v0[i], 0.f) & 0xffffu); p[(size_t)(i + 4) * S_] = (bf16)(pk2(v1[i], 0.f) & 0xffffu); }
                    } else {
                        u32x4 w; w.x = pk2(v0[0], v0[1]); w.y = pk2(v0[2], v0[3]); w.z = pk2(v1[0], v1[1]); w.w = pk2(v1[2], v1[3]);
                        *(u32x4*)(dst + (size_t)row * AW + col) = w;
                    }
                }
                asm volatile("" ::: "memory");
            }
        if (R == 1) {
#pragma unroll
            for (int bj = 0; bj < 2; ++bj)
#pragma unroll
                for (int n = 0; n < 2; ++n)
#pragma unroll
                    for (int i = 0; i < 4; ++i) {
                        float s = cs[bj][n][i];
                        s += __shfl_xor(s, 1); s += __shfl_xor(s, 2); s += __shfl_xor(s, 4); s += __shfl_xor(s, 8);
                        if (fr == 0) kpart[(size_t)(wr * NBLK + u.pm) * AW + colw + 128 * bj + 4 * n + i] = s;
                    }
        }
    }
    DI void operator()(const pg8::f32x4 (&acc)[2][2][4][2], const pg8::Unit& u, int wr, int wc, int fr, int fq) const {
        asm volatile("" : "+v"(fr), "+v"(fq));
        const int reg = RBASE + (u.pn >> 2);
        if constexpr (RBASE == 0) {
            if (reg == 1) run<1>(acc, u, wr, wc, fr, fq, k);
            else if (reg == 2) run<2>(acc, u, wr, wc, fr, fq, vt);
            else run<0>(acc, u, wr, wc, fr, fq, q);
        } else { bf16* dst = hq + (size_t)(reg - 3) * ((WS_HLF - WS_HQ) / 2); run<0>(acc, u, wr, wc, fr, fq, dst); }
    }
};

DI void ins3(float v, int i, float& v0, float& v1, float& v2, int& i0, int& i1, int& i2) {
    const bool c0 = v > v0, c1 = v > v1, c2 = v > v2;
    v2 = c1 ? v1 : (c2 ? v : v2); i2 = c1 ? i1 : (c2 ? i : i2);
    v1 = c0 ? v0 : (c1 ? v : v1); i1 = c0 ? i0 : (c1 ? i : i1);
    v0 = c0 ? v : v0; i0 = c0 ? i : i0;
}
DI void p2_gate(Frame& F) {
    LAS unsigned char* kmh = F.lds;
    LAS unsigned char* kml = F.lds + 64 * 272;
    LAS int* lcnt = (LAS int*)(F.lds + 2 * 64 * 272);
    LAS int* lbase = lcnt + 64;
    const float* kpart = wsp<float>(F, WS_KPART);
    const bf16* q = wsp<bf16>(F, WS_Q);
    unsigned* gcnt = F.ctl + CW_GCNT;
    int* list = wsp<int>(F, WS_LIST);
    const int tid = F.tid, lane = F.lane, w = F.wave, r = lane & 31, hh = lane >> 5;
    for (int it = F.bid; it < NH * 63; it += F.G) {
        const int h = it & 7, qb = 63 - (it >> 3);
        for (int i = tid; i < 64 * 64; i += NTHREADS) {
            const int n = i >> 6, d = 2 * (i & 63);
            f32x2 a = {0.f, 0.f};
            if (n < qb) { const f32x2 p0 = *(const f32x2*)(kpart + (size_t)n * AW + h * HD + d), p1 = *(const f32x2*)(kpart + (size_t)(NBLK + n) * AW + h * HD + d); a = p0 + p1; }
            const unsigned hi = pk2(a.x, a.y);
            const unsigned lo = pk2(a.x - bflo(hi), a.y - bfhi(hi));
            *(LAS unsigned*)(kmh + n * 272 + d * 2) = hi; *(LAS unsigned*)(kml + n * 272 + d * 2) = lo;
        }
        if (tid < 64) lcnt[tid] = 0;
        __syncthreads();
        const int t = qb * LBLK + w * 32 + r;
        bf16x8 Qf[8];
        { const bf16x8* qp = (const bf16x8*)(q + (size_t)t * AW + h * HD + 8 * hh);
#pragma unroll
          for (int s = 0; s < 8; ++s) Qf[s] = qp[2 * s]; }
        float v0 = -INFINITY, v1 = -INFINITY, v2 = -INFINITY; int i0 = -1, i1 = -1, i2 = -1;
#pragma unroll
        for (int nt = 0; nt < 2; ++nt) {
            if (nt * 32 < qb) {
                f32x16 x;
#pragma unroll
                for (int i = 0; i < 16; ++i) x[i] = 0.f;
#pragma unroll
                for (int s = 0; s < 8; ++s) {
                    const bf16x8 ah = *(const LAS bf16x8*)(kmh + (nt * 32 + r) * 272 + 32 * s + 16 * hh), al = *(const LAS bf16x8*)(kml + (nt * 32 + r) * 272 + 32 * s + 16 * hh);
                    x = __builtin_amdgcn_mfma_f32_32x32x16_bf16(ah, Qf[s], x, 0, 0, 0);
                    x = __builtin_amdgcn_mfma_f32_32x32x16_bf16(al, Qf[s], x, 0, 0, 0);
                }
#pragma unroll
                for (int i = 0; i < 16; ++i) { const int n = nt * 32 + crow(i, hh); ins3(n < qb ? x[i] : -INFINITY, n < qb ? n : -1, v0, v1, v2, i0, i1, i2); }
            }
        }
        {
            const float p0 = __shfl_xor(v0, 32), p1 = __shfl_xor(v1, 32), p2 = __shfl_xor(v2, 32);
            const int j0 = __shfl_xor(i0, 32), j1 = __shfl_xor(i1, 32), j2 = __shfl_xor(i2, 32);
            ins3(p0, j0, v0, v1, v2, i0, i1, i2);
            ins3(p1, j1, v0, v1, v2, i0, i1, i2);
            ins3(p2, j2, v0, v1, v2, i0, i1, i2);
        }
        int r0 = 0, r1 = 0, r2 = 0;
        if (hh == 0) {
            if (i0 >= 0) r0 = __hip_atomic_fetch_add(lcnt + i0, 1, __ATOMIC_RELAXED, __HIP_MEMORY_SCOPE_WORKGROUP);
            if (i1 >= 0) r1 = __hip_atomic_fetch_add(lcnt + i1, 1, __ATOMIC_RELAXED, __HIP_MEMORY_SCOPE_WORKGROUP);
            if (i2 >= 0) r2 = __hip_atomic_fetch_add(lcnt + i2, 1, __ATOMIC_RELAXED, __HIP_MEMORY_SCOPE_WORKGROUP);
        }
        __syncthreads();
        if (tid < 64) { const int c = lcnt[tid]; lbase[tid] = c ? (int)__hip_atomic_fetch_add(gcnt + h * NBLK + tid, (unsigned)c, RLX_AGENT) : 0; }
        __syncthreads();
        if (hh == 0) {
            int* lh = list + (size_t)h * LSTRIDE;
            if (i0 >= 0) lh[list_off(i0) + lbase[i0] + r0] = (t << 2) | 0;
            if (i1 >= 0) lh[list_off(i1) + lbase[i1] + r1] = (t << 2) | 1;
            if (i2 >= 0) lh[list_off(i2) + lbase[i2] + r2] = (t << 2) | 2;
        }
        __syncthreads();
    }
}

constexpr int HG_QM = 0, HG_KM = 8704, HG_QD = 17408, HG_KDT = 25856, HG_VT = 36096, HG_O = 46336, HG_TOT = 62720, HG_DL = 64768, HG_BYTES = 65280;
constexpr int HG_RS = 272, HG_RD = 264, HG_RT = 80;
static_assert(2 * HG_BYTES <= MISC_OFF, "hgrn LDS map");
DI bf16x8 pack8(const f32x16& x, int s) {
    u32x4 p; p.x = pk2(x[8 * s + 0], x[8 * s + 1]); p.y = pk2(x[8 * s + 2], x[8 * s + 3]); p.z = pk2(x[8 * s + 4], x[8 * s + 5]); p.w = pk2(x[8 * s + 6], x[8 * s + 7]);
    return __builtin_bit_cast(bf16x8, p);
}
template <bool READOUT> DI void hgrn_mfma(Frame& F) {
    const int w = F.wave, grp = w >> 2, wq = w & 3, lane = F.lane, r = lane & 31, hh = lane >> 5, p = lane;
    LAS unsigned char* L = F.lds + grp * HG_BYTES;
    const bf16* hq = wsp<bf16>(F, WS_HQ); const bf16* hlf = wsp<bf16>(F, WS_HLF); const bf16* hv = wsp<bf16>(F, WS_HV); const bf16* hg = wsp<bf16>(F, WS_HG);
    const float* lbp = wsp<float>(F, WS_STAT) + ST_LB;
    bf16* mixed = wsp<bf16>(F, WS_MIX);
    for (int base = F.bid * 2; base < NH * HSC; base += 2 * F.G) {
        const int it = base + grp, h = it & 7, sc = it >> 3;
        float* hst = wsp<float>(F, WS_HST) + ((size_t)sc * NH + h) * (HD * HD);
        f32x16 S[4];
#pragma unroll
        for (int kb = 0; kb < 4; ++kb)
#pragma unroll
            for (int i = 0; i < 16; ++i) S[kb][i] = READOUT ? hst[(size_t)(kb * 32 + crow(i, hh)) * HD + wq * 32 + r] : 0.f;
        const float lb0 = lbp[h * HD + 2 * p], lb1 = lbp[h * HD + 2 * p + 1];
        const int lt = wq * 64 + lane, nt = lt >> 3, nvg = lt & 7;
        f32x4 gn[4];
        if (READOUT) {
#pragma unroll
            for (int j = 0; j < 4; ++j) gn[j] = *(const f32x4*)(F.in[5] + h * HD + nvg * 16 + 4 * j);
        }
        float sumbl0 = 0.f, sumbl1 = 0.f;
        unsigned xf[8], xq[8], xv[8];
        const size_t gcol = (size_t)h * HD + 2 * p;
        {   const size_t t0 = (size_t)sc * HSCLEN + 8 * wq;
#pragma unroll
            for (int i = 0; i < 8; ++i) { xf[i] = *(const unsigned*)(hlf + (t0 + i) * AW + gcol); xv[i] = *(const unsigned*)(hv + (t0 + i) * AW + gcol); if (READOUT) xq[i] = *(const unsigned*)(hq + (t0 + i) * AW + gcol); } }
        for (int c = 0; c < HSCLEN / 32; ++c) {
            const int tc = sc * HSCLEN + c * 32;
            float bl0[8], bl1[8], f0[8], f1[8];
            {   float run0 = 0.f, run1 = 0.f;
#pragma unroll
                for (int i = 0; i < 8; ++i) {
                    const float fa = lb0 + (1.f - lb0) * sigmoidf_(bflo(xf[i])), fb = lb1 + (1.f - lb1) * sigmoidf_(bfhi(xf[i]));
                    run0 += __logf(fa); run1 += __logf(fb); bl0[i] = run0; bl1[i] = run1; f0[i] = fa; f1[i] = fb;
                }
                *(LAS f32x2*)(L + HG_TOT + (wq * 128 + 2 * p) * 4) = (f32x2){run0, run1};
            }
            __syncthreads();
            {
                float off0 = 0.f, off1 = 0.f, bm0, bm1, be0, be1;
                {   f32x2 tq[4];
#pragma unroll
                    for (int q = 0; q < 4; ++q) tq[q] = *(const LAS f32x2*)(L + HG_TOT + (q * 128 + 2 * p) * 4);
#pragma unroll
                    for (int q = 0; q < 4; ++q) if (q < wq) { off0 += tq[q].x; off1 += tq[q].y; }
                    bm0 = tq[0].x + tq[1].x; bm1 = tq[0].y + tq[1].y; be0 = bm0 + tq[2].x + tq[3].x; be1 = bm1 + tq[2].y + tq[3].y; }
                if (wq == 0) { *(LAS f32x2*)(L + HG_DL + 2 * p * 4) = (f32x2){__expf(be0), __expf(be1)}; sumbl0 += be0; sumbl1 += be1; }
                const float em0 = __expf(-bm0), em1 = __expf(-bm1), ek0 = __expf(bm0 - be0), ek1 = __expf(bm1 - be1);
                unsigned kd0[4], kd1[4], vt0[4], vt1[4];
#pragma unroll
                for (int i = 0; i < 8; ++i) {
                    const int t = 8 * wq + i;
                    const float b0 = bl0[i] + off0, b1 = bl1[i] + off1;
                    const float k0 = 1.f - f0[i], k1 = 1.f - f1[i];
                    const float kdv0 = k0 * __expf(be0 - b0), kdv1 = k1 * __expf(be1 - b1);
                    if (READOUT) {
                        const float q0 = siluf_(bflo(xq[i])), q1 = siluf_(bfhi(xq[i]));
                        const float qd0 = q0 * __expf(b0), qd1 = q1 * __expf(b1);
                        *(LAS unsigned*)(L + HG_QD + t * HG_RD + 4 * p) = pk2(qd0, qd1);
                        *(LAS unsigned*)(L + HG_QM + t * HG_RS + 4 * p) = pk2(qd0 * em0, qd1 * em1);
                        *(LAS unsigned*)(L + HG_KM + t * HG_RS + 4 * p) = pk2(kdv0 * ek0, kdv1 * ek1);
                    }
                    if (i & 1) { kd0[i >> 1] |= pk2(0.f, kdv0) ; kd1[i >> 1] |= pk2(0.f, kdv1); vt0[i >> 1] |= xv[i] << 16; vt1[i >> 1] |= xv[i] & 0xffff0000u; }
                    else { kd0[i >> 1] = pk2(kdv0, 0.f); kd1[i >> 1] = pk2(kdv1, 0.f); vt0[i >> 1] = xv[i] & 0xffffu; vt1[i >> 1] = xv[i] >> 16; }
                }
                *(LAS u32x4*)(L + HG_KDT + (2 * p) * HG_RT + 16 * wq) = (u32x4){kd0[0], kd0[1], kd0[2], kd0[3]};
                *(LAS u32x4*)(L + HG_KDT + (2 * p + 1) * HG_RT + 16 * wq) = (u32x4){kd1[0], kd1[1], kd1[2], kd1[3]};
                *(LAS u32x4*)(L + HG_VT + (2 * p) * HG_RT + 16 * wq) = (u32x4){vt0[0], vt0[1], vt0[2], vt0[3]};
                *(LAS u32x4*)(L + HG_VT + (2 * p + 1) * HG_RT + 16 * wq) = (u32x4){vt1[0], vt1[1], vt1[2], vt1[3]};
            }
            __syncthreads();
            if (c + 1 < HSCLEN / 32) { const size_t t0 = (size_t)tc + 32 + 8 * wq;
#pragma unroll
                for (int i = 0; i < 8; ++i) { xf[i] = *(const unsigned*)(hlf + (t0 + i) * AW + gcol); xv[i] = *(const unsigned*)(hv + (t0 + i) * AW + gcol); if (READOUT) xq[i] = *(const unsigned*)(hq + (t0 + i) * AW + gcol); } }
            u32x4 gg0, gg1;
            if (READOUT) { const u32x4* gp = (const u32x4*)(hg + (size_t)(tc + nt) * AW + h * HD + nvg * 16); gg0 = gp[0]; gg1 = gp[1]; }
            if (READOUT) {
                f32x16 X, Y;
#pragma unroll
                for (int i = 0; i < 16; ++i) { X[i] = 0.f; Y[i] = 0.f; }
#pragma unroll
                for (int st = 0; st < 8; ++st) {
                    const bf16x8 a = *(const LAS bf16x8*)(L + HG_KM + r * HG_RS + 32 * st + 16 * hh), b = *(const LAS bf16x8*)(L + HG_QM + r * HG_RS + 32 * st + 16 * hh);
                    X = __builtin_amdgcn_mfma_f32_32x32x16_bf16(a, b, X, 0, 0, 0);
                }
#pragma unroll
                for (int i = 0; i < 16; ++i) if (crow(i, hh) > r) X[i] = 0.f;
#pragma unroll
                for (int kb = 0; kb < 4; ++kb)
#pragma unroll
                    for (int st = 0; st < 2; ++st) {
                        const LAS u32x2* qp = (const LAS u32x2*)(L + HG_QD + r * HG_RD + (kb * 32 + 16 * st + 4 * hh) * 2);
                        const u32x2 a0 = qp[0], a1 = qp[2]; const u32x4 av = {a0.x, a0.y, a1.x, a1.y};
                        Y = __builtin_amdgcn_mfma_f32_32x32x16_bf16(__builtin_bit_cast(bf16x8, av), pack8(S[kb], st), Y, 0, 0, 0);
                    }
#pragma unroll
                for (int st = 0; st < 2; ++st) {
                    const LAS u32x2* vp = (const LAS u32x2*)(L + HG_VT + (wq * 32 + r) * HG_RT + (16 * st + 4 * hh) * 2);
                    const u32x2 b0 = vp[0], b1 = vp[2]; const u32x4 bv = {b0.x, b0.y, b1.x, b1.y};
                    Y = __builtin_amdgcn_mfma_f32_32x32x16_bf16(pack8(X, st), __builtin_bit_cast(bf16x8, bv), Y, 0, 0, 0);
                }
#pragma unroll
                for (int i = 0; i < 16; ++i) *(LAS float*)(L + HG_O + crow(i, hh) * 512 + (wq * 32 + r) * 4) = Y[i];
            }
#pragma unroll
            for (int kb = 0; kb < 4; ++kb) {
#pragma unroll
                for (int g4 = 0; g4 < 4; ++g4) { const f32x4 d = *(const LAS f32x4*)(L + HG_DL + (kb * 32 + 8 * g4 + 4 * hh) * 4);
#pragma unroll
                    for (int j = 0; j < 4; ++j) S[kb][4 * g4 + j] *= d[j]; }
#pragma unroll
                for (int st = 0; st < 2; ++st) {
                    const bf16x8 a = *(const LAS bf16x8*)(L + HG_KDT + (kb * 32 + r) * HG_RT + 32 * st + 16 * hh), b = *(const LAS bf16x8*)(L + HG_VT + (wq * 32 + r) * HG_RT + 32 * st + 16 * hh);
                    S[kb] = __builtin_amdgcn_mfma_f32_32x32x16_bf16(a, b, S[kb], 0, 0, 0);
                }
            }
            __syncthreads();
            if (READOUT) {
                f32x4 o[4]; float ss = 0.f;
#pragma unroll
                for (int j = 0; j < 4; ++j) { o[j] = *(const LAS f32x4*)(L + HG_O + nt * 512 + (nvg * 16 + 4 * j) * 4); ss += (o[j].x * o[j].x + o[j].y * o[j].y) + (o[j].z * o[j].z + o[j].w * o[j].w); }
                ss += __shfl_xor(ss, 1); ss += __shfl_xor(ss, 2); ss += __shfl_xor(ss, 4);
                const float rr = 1.f / sqrtf(ss * (1.f / HD) + EPS);
                const unsigned gw[8] = {gg0.x, gg0.y, gg0.z, gg0.w, gg1.x, gg1.y, gg1.z, gg1.w};
                u32x4 o8;
#pragma unroll
                for (int j = 0; j < 4; ++j) {
                    const float g0 = siluf_(bflo(gw[2 * j])), g1 = siluf_(bfhi(gw[2 * j])), g2 = siluf_(bflo(gw[2 * j + 1])), g3 = siluf_(bfhi(gw[2 * j + 1]));
                    const float sc = rr * MSCALE;
                    int wv = __builtin_amdgcn_cvt_pk_fp8_f32(sat8(o[j].x * sc * gn[j].x * g0), sat8(o[j].y * sc * gn[j].y * g1), 0, false);
                    wv = __builtin_amdgcn_cvt_pk_fp8_f32(sat8(o[j].z * sc * gn[j].z * g2), sat8(o[j].w * sc * gn[j].w * g3), wv, true);
                    o8[j] = (unsigned)wv;
                }
                *(u32x4*)((unsigned char*)mixed + (size_t)(tc + nt) * D_ + AW + h * HD + nvg * 16) = o8;
            }
        }
        if (!READOUT) {
#pragma unroll
            for (int kb = 0; kb < 4; ++kb)
#pragma unroll
                for (int i = 0; i < 16; ++i) hst[(size_t)(kb * 32 + crow(i, hh)) * HD + wq * 32 + r] = S[kb][i];
            if (wq == 0) *(f32x2*)(wsp<float>(F, WS_HDEC) + ((size_t)sc * NH + h) * HD + 2 * p) = (f32x2){__expf(sumbl0), __expf(sumbl1)};
        }
        __syncthreads();
    }
}
DI void hgrn_scan(Frame& F) {
    float* hst = wsp<float>(F, WS_HST); const float* hdec = wsp<float>(F, WS_HDEC);
    for (int e = F.bid * NTHREADS + F.tid; e < NH * HD * HD; e += F.G * NTHREADS) {
        const int hk = e >> 7;
        float cur = 0.f;
#pragma unroll 1
        for (int sc0 = 0; sc0 < HSC; sc0 += 8) {
            float tmp[8], dc[8];
#pragma unroll
            for (int j = 0; j < 8; ++j) { tmp[j] = hst[(size_t)(sc0 + j) * (NH * HD * HD) + e]; dc[j] = hdec[(size_t)(sc0 + j) * (NH * HD) + hk]; }
#pragma unroll
            for (int j = 0; j < 8; ++j) { hst[(size_t)(sc0 + j) * (NH * HD * HD) + e] = cur; cur = dc[j] * cur + tmp[j]; }
        }
    }
}

constexpr int AT_KSTR = 272, AT_VSTR = 520;
constexpr int AT_K_OFF = 0, AT_V_OFF = 256 * AT_KSTR, AT_PRE_OFF = AT_V_OFF + 128 * AT_VSTR;
static_assert(AT_PRE_OFF + 516 * 4 <= MISC_OFF, "attention LDS map");
DI void p3_attn(Frame& F) {
    LAS unsigned char* Kl = F.lds + AT_K_OFF; LAS unsigned char* Vl = F.lds + AT_V_OFF; LAS int* pre = (LAS int*)(F.lds + AT_PRE_OFF);
    const bf16* q = wsp<bf16>(F, WS_Q); const bf16* kg = wsp<bf16>(F, WS_K); const bf16* vt = wsp<bf16>(F, WS_VT);
    const int* list = wsp<int>(F, WS_LIST);
    bf16* po = (bf16*)F.out;
    f32x2* pml = wsp<f32x2>(F, WS_PML);
    const unsigned* gcnt = F.ctl + CW_GCNT;
    const int tid = F.tid, lane = F.lane, w = F.wave, r = lane & 31, hh = lane >> 5;
    if (w == 0) {
        int c[8], s = 0;
#pragma unroll
        for (int k = 0; k < 8; ++k) { const unsigned cc = __hip_atomic_load(gcnt + lane * 8 + k, RLX_AGENT); c[k] = 1 + (int)((cc + 255u) >> 8); s += c[k]; }
        int incl = s;
#pragma unroll
        for (int o = 1; o < 64; o <<= 1) { const int t = __shfl_up(incl, o); if (lane >= o) incl += t; }
        int run = incl - s;
#pragma unroll
        for (int k = 0; k < 8; ++k) { pre[lane * 8 + k] = run; run += c[k]; }
        if (lane == 63) pre[512] = incl;
    }
    __syncthreads();
    const int total = pre[512];
    const int ti0 = (int)(((long)total * F.bid) / F.G), ti1 = (int)(((long)total * (F.bid + 1)) / F.G);
    int staged = -1;
    for (int ti = ti0; ti < ti1; ++ti) {
        int lo = 0, hi = 511;
        while (lo < hi) { const int mid = (lo + hi + 1) >> 1; if (pre[mid] <= ti) lo = mid; else hi = mid - 1; }
        const int h = lo >> 6, n = lo & 63, seg = ti - pre[lo];
        const int cnt = (int)__hip_atomic_load(gcnt + lo, RLX_AGENT);
        const int nvalid = seg == 0 ? 256 : min(256, cnt - (seg - 1) * 256);
        const int ei = w * 32 + r; const bool valid = ei < nvalid;
        int t, slot;
        if (seg == 0) { t = n * LBLK + ei; slot = 3; }
        else { const int e = valid ? list[(size_t)h * LSTRIDE + list_off(n) + (seg - 1) * 256 + ei] : 0; t = e >> 2; slot = e & 3; }
        bf16x8 Qf[8];
        { const bf16x8* qp = (const bf16x8*)(q + (size_t)t * AW + h * HD + 8 * hh);
#pragma unroll
          for (int s = 0; s < 8; ++s) Qf[s] = qp[2 * s]; }
        if (staged != lo) {
        if (staged >= 0) __syncthreads();
        staged = lo;
#pragma unroll
        for (int p = 0; p < 8; ++p) {
            const int idx = p * NTHREADS + tid;
            { const int row = idx >> 4, pc = idx & 15; const u32x4 v = *(const u32x4*)(kg + (size_t)(n * LBLK + row) * AW + h * HD + pc * 8); *(LAS u32x4*)(Kl + row * AT_KSTR + pc * 16) = v; }
            { const int d = idx >> 5, pc = idx & 31; const u32x4 v = *(const u32x4*)(vt + (size_t)(h * HD + d) * S_ + n * LBLK + pc * 8);
              LAS u32x2* dst = (LAS u32x2*)(Vl + d * AT_VSTR + pc * 16); dst[0] = (u32x2){v.x, v.y}; dst[1] = (u32x2){v.z, v.w}; }
        }
        __syncthreads();
        }
        f32x16 X[8];
#pragma unroll
        for (int kb = 0; kb < 8; ++kb) {
            f32x16 x;
            if (seg == 0 && kb > w) {
#pragma unroll
                for (int i = 0; i < 16; ++i) x[i] = -INFINITY;
            } else {
#pragma unroll
                for (int i = 0; i < 16; ++i) x[i] = 0.f;
                __builtin_amdgcn_s_setprio(1);
#pragma unroll
                for (int s = 0; s < 8; ++s) { const bf16x8 a = *(const LAS bf16x8*)(Kl + (kb * 32 + r) * AT_KSTR + 32 * s + 16 * hh); x = __builtin_amdgcn_mfma_f32_32x32x16_bf16(a, Qf[s], x, 0, 0, 0); }
                __builtin_amdgcn_s_setprio(0);
                if (seg == 0 && kb == w) {
#pragma unroll
                    for (int i = 0; i < 16; ++i) if (crow(i, hh) > r) x[i] = -INFINITY;
                }
            }
            X[kb] = x;
        }
        float mx = -INFINITY;
#pragma unroll
        for (int kb = 0; kb < 8; ++kb)
#pragma unroll
            for (int i = 0; i < 16; ++i) mx = fmaxf(mx, X[kb][i]);
        mx = fmaxf(mx, __shfl_xor(mx, 32));
        float l = 0.f;
        u32x4 P[8][2];
#pragma unroll
        for (int kb = 0; kb < 8; ++kb)
#pragma unroll
            for (int s2 = 0; s2 < 2; ++s2) {
                float pe[8];
#pragma unroll
                for (int j = 0; j < 8; ++j) { pe[j] = __builtin_amdgcn_exp2f(X[kb][8 * s2 + j] - mx); l += pe[j]; }
                P[kb][s2] = (u32x4){pk2(pe[0], pe[1]), pk2(pe[2], pe[3]), pk2(pe[4], pe[5]), pk2(pe[6], pe[7])};
            }
        l += __shfl_xor(l, 32);
        f32x16 O[4];
#pragma unroll
        for (int db = 0; db < 4; ++db)
#pragma unroll
            for (int i = 0; i < 16; ++i) O[db][i] = 0.f;
#pragma unroll
        for (int kb = 0; kb < 8; ++kb)
#pragma unroll
            for (int s2 = 0; s2 < 2; ++s2) {
                const bf16x8 bfrag = __builtin_bit_cast(bf16x8, P[kb][s2]);
                __builtin_amdgcn_s_setprio(1);
#pragma unroll
                for (int db = 0; db < 4; ++db) {
                    const LAS u32x2* vp = (const LAS u32x2*)(Vl + (db * 32 + r) * AT_VSTR + (kb * 32 + 16 * s2 + 4 * hh) * 2);
                    const u32x2 a0 = vp[0], a1 = vp[2];
                    const u32x4 av = {a0.x, a0.y, a1.x, a1.y};
                    O[db] = __builtin_amdgcn_mfma_f32_32x32x16_bf16(__builtin_bit_cast(bf16x8, av), bfrag, O[db], 0, 0, 0);
                }
                __builtin_amdgcn_s_setprio(0);
            }
        if (valid) {
            const float inv = 1.f / l;
            bf16* orow = po + ((size_t)(t * NH + h) * 4 + slot) * HD;
#pragma unroll
            for (int db = 0; db < 4; ++db)
#pragma unroll
                for (int g4 = 0; g4 < 4; ++g4) {
                    u32x2 o; o.x = pk2(O[db][4 * g4 + 0] * inv, O[db][4 * g4 + 1] * inv); o.y = pk2(O[db][4 * g4 + 2] * inv, O[db][4 * g4 + 3] * inv);
                    *(u32x2*)(orow + db * 32 + 8 * g4 + 4 * hh) = o;
                }
            if (hh == 0) pml[(size_t)(t * NH + h) * 4 + slot] = (f32x2){mx, l};
        }
    }
    __syncthreads();
}

DI void p4_combine(Frame& F) {
    const bf16* po = (const bf16*)F.out; const f32x2* pml = wsp<f32x2>(F, WS_PML); bf16* mixed = wsp<bf16>(F, WS_MIX);
    const size_t total = (size_t)S_ * NH * 16, stride = (size_t)F.G * NTHREADS;
    for (size_t w0 = (size_t)F.bid * NTHREADS + F.tid; w0 < total; w0 += 2 * stride) {
        f32x2 ml[2][4]; u32x4 pv[2][4]; int nvv[2];
#pragma unroll
        for (int u = 0; u < 2; ++u) { const size_t wi = w0 + u * stride;
            if (wi < total) { const int c16 = (int)(wi & 15); const size_t th = wi >> 4; const int t = (int)(th >> 3); const int nv = min(3, t >> 8); nvv[u] = nv;
#pragma unroll
                for (int j = 0; j < 4; ++j) { const bool on = (j == 3) || (j < nv); ml[u][j] = on ? pml[th * 4 + j] : (f32x2){-INFINITY, 0.f}; pv[u][j] = on ? *(const u32x4*)(po + (th * 4 + j) * HD + c16 * 8) : (u32x4){0u, 0u, 0u, 0u}; } } }
#pragma unroll
        for (int u = 0; u < 2; ++u) { const size_t wi = w0 + u * stride;
            if (wi < total) { const int c16 = (int)(wi & 15); const size_t th = wi >> 4; const int t = (int)(th >> 3), h = (int)(th & 7); const int nv = nvv[u];
                float M = -INFINITY;
#pragma unroll
                for (int j = 0; j < 4; ++j) M = fmaxf(M, ml[u][j].x);
                float wj[4], W = 0.f;
#pragma unroll
                for (int j = 0; j < 4; ++j) { wj[j] = ((j == 3) || (j < nv)) ? __builtin_amdgcn_exp2f(ml[u][j].x - M) * ml[u][j].y : 0.f; W += wj[j]; }
                const float iW = 1.f / W;
                float o[8];
#pragma unroll
                for (int i = 0; i < 8; ++i) o[i] = 0.f;
#pragma unroll
                for (int j = 0; j < 4; ++j) { const u32x4 v = pv[u][j]; const float ww = wj[j] * iW;
                    o[0] += ww * bflo(v.x); o[1] += ww * bfhi(v.x); o[2] += ww * bflo(v.y); o[3] += ww * bfhi(v.y);
                    o[4] += ww * bflo(v.z); o[5] += ww * bfhi(v.z); o[6] += ww * bflo(v.w); o[7] += ww * bfhi(v.w); }
                int w0 = __builtin_amdgcn_cvt_pk_fp8_f32(sat8(o[0] * MSCALE), sat8(o[1] * MSCALE), 0, false); w0 = __builtin_amdgcn_cvt_pk_fp8_f32(sat8(o[2] * MSCALE), sat8(o[3] * MSCALE), w0, true);
                int w1 = __builtin_amdgcn_cvt_pk_fp8_f32(sat8(o[4] * MSCALE), sat8(o[5] * MSCALE), 0, false); w1 = __builtin_amdgcn_cvt_pk_fp8_f32(sat8(o[6] * MSCALE), sat8(o[7] * MSCALE), w1, true);
                *(u32x2*)((unsigned char*)mixed + (size_t)t * D_ + h * HD + c16 * 8) = (u32x2){(unsigned)w0, (unsigned)w1}; } }
    }
}

struct Epi2 {
    static constexpr bool PERM = false, AFTER_DRAIN = false;
    const float* x; float* out; bf16* hb; float* ssq;
    DI void operator()(const pg8::f32x4 (&acc)[2][2][4][2], const pg8::Unit& u, int wr, int wc, int fr, int fq) const {
        asm volatile("" : "+v"(fr), "+v"(fq));
        const int row0 = u.pm * 256 + wr * 64 + fr, col0 = u.pn * 256 + wc * 32 + 4 * fq;
#pragma unroll
        for (int ai = 0; ai < 2; ++ai)
#pragma unroll
            for (int m = 0; m < 4; ++m) {
                const int row = row0 + ai * 128 + m * 16; const size_t off = (size_t)row * D_ + col0; float s = 0.f;
#pragma unroll
                for (int bj = 0; bj < 2; ++bj)
#pragma unroll
                    for (int n = 0; n < 2; ++n) {
                        const f32x4 v = *(const f32x4*)(x + off + bj * 128 + n * 16) + acc[ai][bj][m][n] * (1.f / (MSCALE * W1SCALE));
                        u32x2 b; b.x = pk2(v[0], v[1]); b.y = pk2(v[2], v[3]); *(u32x2*)(hb + off + bj * 128 + n * 16) = b;
                        s += (v[0] * v[0] + v[1] * v[1]) + (v[2] * v[2] + v[3] * v[3]);
                    }
                s += __shfl_xor(s, 16); s += __shfl_xor(s, 32);
                if (fq == 0) ssq[(size_t)row * 32 + u.pn * 4 + wc] = s;
                if (m & 1) asm volatile("" ::: "memory");
            }
    }
};
struct EpiB {
    static constexpr bool PERM = true, AFTER_DRAIN = false;
    bf16* O; int ldc;
    DI void operator()(const pg8::f32x4 (&acc)[2][2][4][2], const pg8::Unit& u, int wr, int wc, int fr, int fq) const {
        asm volatile("" : "+v"(fr), "+v"(fq));
        const int row0 = u.pm * 256 + wr * 64 + fr, col0 = u.pn * 256 + wc * 32 + 8 * fq;
#pragma unroll
        for (int ai = 0; ai < 2; ++ai)
#pragma unroll
            for (int m = 0; m < 4; ++m) { bf16* rowp = O + (size_t)(row0 + ai * 128 + m * 16) * ldc + col0;
#pragma unroll
                for (int bj = 0; bj < 2; ++bj) { const f32x4 v0 = acc[ai][bj][m][0], v1 = acc[ai][bj][m][1];
                    u32x4 w; w.x = pk2(v0[0], v0[1]); w.y = pk2(v0[2], v0[3]); w.z = pk2(v1[0], v1[1]); w.w = pk2(v1[2], v1[3]);
                    *(u32x4*)(rowp + bj * 128) = w; } }
    }
};
struct EpiP {
    static constexpr bool PERM = false, AFTER_DRAIN = false;
    bf16* O;
    DI void operator()(const pg8::f32x4 (&acc)[2][2][4][2], const pg8::Unit& u, int wr, int wc, int fr, int fq) const {
        asm volatile("" : "+v"(fr), "+v"(fq));
        const int row0 = u.pm * 256 + wr * 64 + fr, col0 = u.pn * 256 + wc * 32 + 4 * fq;
#pragma unroll
        for (int ai = 0; ai < 2; ++ai)
#pragma unroll
            for (int m = 0; m < 4; ++m) { const size_t off = (size_t)(row0 + ai * 128 + m * 16) * D_ + col0;
#pragma unroll
                for (int bj = 0; bj < 2; ++bj)
#pragma unroll
                    for (int n = 0; n < 2; ++n) { const f32x4 v = acc[ai][bj][m][n]; u32x2 b; b.x = pk2(v[0], v[1]); b.y = pk2(v[2], v[3]); *(u32x2*)(O + off + bj * 128 + n * 16) = b; } }
    }
};
struct Epi4 {
    static constexpr bool PERM = false, AFTER_DRAIN = false;
    bf16* h3b; const bf16* hb; const bf16* ple; const float* rs3; float* ssq;
    DI void operator()(const pg8::f32x4 (&acc)[2][2][4][2], const pg8::Unit& u, int wr, int wc, int fr, int fq) const {
        asm volatile("" : "+v"(fr), "+v"(fq));
        const int row0 = u.pm * 256 + wr * 64 + fr, col0 = u.pn * 256 + wc * 32 + 4 * fq;
#pragma unroll
        for (int ai = 0; ai < 2; ++ai)
#pragma unroll
            for (int m = 0; m < 4; ++m) {
                const int row = row0 + ai * 128 + m * 16; const size_t off = (size_t)row * D_ + col0; float s = 0.f; const float rs = rs3[row];
#pragma unroll
                for (int bj = 0; bj < 2; ++bj)
#pragma unroll
                    for (int n = 0; n < 2; ++n) {
                        const u32x2 pw = *(const u32x2*)(ple + off + bj * 128 + n * 16);
                        const f32x4 pv = {bflo(pw.x), bfhi(pw.x), bflo(pw.y), bfhi(pw.y)};
                        const u32x2 hw = *(const u32x2*)(hb + off + bj * 128 + n * 16);
                        f32x4 v = {bflo(hw.x), bfhi(hw.x), bflo(hw.y), bfhi(hw.y)};
#pragma unroll
                        for (int i = 0; i < 4; ++i) v[i] += sigmoidf_(acc[ai][bj][m][n][i] * rs) * pv[i];
                        { u32x2 hw3; hw3.x = pk2(v[0], v[1]); hw3.y = pk2(v[2], v[3]); *(u32x2*)(h3b + off + bj * 128 + n * 16) = hw3; }
                        s += (v[0] * v[0] + v[1] * v[1]) + (v[2] * v[2] + v[3] * v[3]);
                    }
                s += __shfl_xor(s, 16); s += __shfl_xor(s, 32);
                if (fq == 0) ssq[(size_t)row * 32 + u.pn * 4 + wc] = s;
                if (m & 1) asm volatile("" ::: "memory");
            }
    }
};

DI unsigned fkey(float f, unsigned lowbits, unsigned mask) { unsigned u = __float_as_uint(f); u = (u & 0x80000000u) ? ~u : (u | 0x80000000u); return (u & ~mask) | lowbits; }
DI float fval(unsigned k, unsigned mask) { unsigned u = k & ~mask; u = (u & 0x80000000u) ? (u & 0x7fffffffu) : ~u; return __uint_as_float(u); }
template <int N> DI void bitonic_sort_desc(unsigned (&v)[N]) {
#pragma unroll
    for (int k = 2; k <= N; k <<= 1)
#pragma unroll
        for (int j = k >> 1; j > 0; j >>= 1)
#pragma unroll
            for (int i = 0; i < N; ++i) { const int l = i ^ j;
                if (l > i) { const bool desc = ((i & k) == 0); const unsigned a = v[i], b = v[l]; v[i] = desc ? max(a, b) : min(a, b); v[l] = desc ? min(a, b) : max(a, b); } }
}
DI void merge_top16(unsigned (&a)[16], const unsigned (&b)[16]) {
#pragma unroll
    for (int i = 0; i < 16; ++i) a[i] = max(a[i], b[15 - i]);
#pragma unroll
    for (int j = 8; j > 0; j >>= 1)
#pragma unroll
        for (int i = 0; i < 16; ++i) { const int l = i ^ j; if (l > i) { const unsigned x = a[i], y = a[l]; a[i] = max(x, y); a[l] = min(x, y); } }
}
DI void p7_route(Frame& F) {
    const bf16* qry = wsp<bf16>(F, WS_QRY); const bf16* skb = wsp<bf16>(F, WS_SKB);
    float* stat = wsp<float>(F, WS_STAT); const float* ssq2 = wsp<float>(F, WS_SSQ2);
    int* pidx = wsp<int>(F, WS_PIDX); float* pgate = wsp<float>(F, WS_PGATE);
    LAS unsigned* tops = (LAS unsigned*)F.lds;
    const int tid = F.tid, lane = F.lane, w = F.wave, r = lane & 31, hh = lane >> 5;
    const int tg = w & 3, p = w >> 2;
    for (int it = F.bid; it < (S_ / 128) * 2; it += F.G) {
        const int hg = it & 1, tb = it >> 1;
        const int t = tb * 128 + tg * 32 + r;
        float ss = 0.f;
        { const f32x4* sp = (const f32x4*)(ssq2 + (size_t)t * 32);
#pragma unroll
          for (int j = 0; j < 8; ++j) { const f32x4 v = sp[j]; ss += (v.x + v.y) + (v.z + v.w); } }
        const float rs2 = 1.f / sqrtf(ss * (1.f / D_) + EPS);
        if (hg == 0 && p == 0 && hh == 0) stat[ST_RS2 + t] = rs2;
        for (int hq = 0; hq < 4; ++hq) {
            const int h = hg * 4 + hq;
            bf16x8 Bq[8];
            { const bf16x8* qp = (const bf16x8*)(qry + (size_t)t * D_ + h * 256 + p * 128 + 8 * hh);
#pragma unroll
              for (int s = 0; s < 8; ++s) Bq[s] = qp[2 * s]; }
            unsigned kv[4][16];
            const bf16* kbase = skb + (size_t)((h * 2 + p) * NKEY) * 128;
#pragma unroll
            for (int kt = 0; kt < 4; ++kt) {
                f32x16 x;
#pragma unroll
                for (int i = 0; i < 16; ++i) x[i] = 0.f;
                const bf16x8* ap = (const bf16x8*)(kbase + (size_t)(kt * 32 + r) * 128 + 8 * hh);
#pragma unroll
                for (int s = 0; s < 8; ++s) x = __builtin_amdgcn_mfma_f32_32x32x16_bf16(ap[2 * s], Bq[s], x, 0, 0, 0);
#pragma unroll
                for (int i = 0; i < 16; ++i) { const int key = kt * 32 + crow(i, hh); kv[kt][i] = fkey(x[i] * rs2, (unsigned)(127 - key), 127u); }
            }
#pragma unroll
            for (int kt = 0; kt < 4; ++kt) bitonic_sort_desc<16>(kv[kt]);
            merge_top16(kv[0], kv[1]); merge_top16(kv[2], kv[3]); merge_top16(kv[0], kv[2]);
            unsigned (&tk)[16] = kv[0];
            {
                unsigned ok[16];
#pragma unroll
                for (int i = 0; i < 16; ++i) ok[i] = (unsigned)__shfl_xor((int)tk[i], 32);
                merge_top16(tk, ok);
            }
            if (hh == 0) {
                LAS u32x4* dst = (LAS u32x4*)(tops + (((tg * 32 + r) * 4 + hq) * 2 + p) * 16);
                dst[0] = (u32x4){tk[0], tk[1], tk[2], tk[3]}; dst[1] = (u32x4){tk[4], tk[5], tk[6], tk[7]}; dst[2] = (u32x4){tk[8], tk[9], tk[10], tk[11]}; dst[3] = (u32x4){tk[12], tk[13], tk[14], tk[15]};
            }
        }
        __syncthreads();
        {
            const int tl = tid & 127, hq = tid >> 7, h = hg * 4 + hq;
            const int tt = tb * 128 + tl;
            unsigned ka[16], kb[16];
            { const LAS u32x4* s = (const LAS u32x4*)(tops + ((tl * 4 + hq) * 2) * 16);
#pragma unroll
              for (int j = 0; j < 4; ++j) { const u32x4 a = s[j], b = s[4 + j]; ka[4 * j] = a.x; ka[4 * j + 1] = a.y; ka[4 * j + 2] = a.z; ka[4 * j + 3] = a.w; kb[4 * j] = b.x; kb[4 * j + 1] = b.y; kb[4 * j + 2] = b.z; kb[4 * j + 3] = b.w; } }
            float va[16], vb[16];
#pragma unroll
            for (int i = 0; i < 16; ++i) { va[i] = fval(ka[i], 127u); vb[i] = fval(kb[i], 127u); }
            unsigned cc[4][16];
#pragma unroll
            for (int gq = 0; gq < 4; ++gq)
#pragma unroll
                for (int k = 0; k < 16; ++k) cc[gq][k] = 0u;
            {
                int cnt = 0;
#pragma unroll
                for (int i = 0; i < 16; ++i)
#pragma unroll
                    for (int j = 0; j < 16; ++j) if ((i + 1) * (j + 1) <= 16) { cc[cnt >> 4][cnt & 15] = fkey(va[i] + vb[j], (unsigned)(255 - (i * 16 + j)), 255u); ++cnt; }
            }
#pragma unroll
            for (int gq = 0; gq < 4; ++gq) bitonic_sort_desc<16>(cc[gq]);
            merge_top16(cc[0], cc[1]); merge_top16(cc[2], cc[3]); merge_top16(cc[0], cc[2]);
            unsigned (&ck)[16] = cc[0];
            float sv[16]; float mxv = -INFINITY;
#pragma unroll
            for (int i = 0; i < 16; ++i) { sv[i] = fval(ck[i], 255u); mxv = fmaxf(mxv, sv[i]); }
            float den = 0.f;
#pragma unroll
            for (int i = 0; i < 16; ++i) { sv[i] = __expf(sv[i] - mxv); den += sv[i]; }
            const float iden = 1.f / den;
            int ev[16];
#pragma unroll
            for (int i = 0; i < 16; ++i) {
                const int pos = 255 - (int)(ck[i] & 255u), ci = pos >> 4, cj = pos & 15;
                unsigned ea = 0u, eb = 0u;
#pragma unroll
                for (int k = 0; k < 16; ++k) { ea = (ci == k) ? ka[k] : ea; eb = (cj == k) ? kb[k] : eb; }
                ev[i] = (int)((127u - (ea & 127u)) * 128u + (127u - (eb & 127u)));
                sv[i] *= iden;
            }
            u32x4* io = (u32x4*)(pidx + (size_t)tt * 128 + h * 16); f32x4* go = (f32x4*)(pgate + (size_t)tt * 128 + h * 16);
#pragma unroll
            for (int j = 0; j < 4; ++j) { io[j] = (u32x4){(unsigned)ev[4 * j], (unsigned)ev[4 * j + 1], (unsigned)ev[4 * j + 2], (unsigned)ev[4 * j + 3]}; go[j] = (f32x4){sv[4 * j], sv[4 * j + 1], sv[4 * j + 2], sv[4 * j + 3]}; }
        }
        __syncthreads();
    }
}

DI float gelu_erf(float v) {
    const float av = fabsf(v), t = __builtin_amdgcn_rcpf(av * 0.2316418882f + 1.0f);
    float q = t * 0.5307027145f + (-0.7265760135f); q = q * t + 0.7107068705f; q = q * t + (-0.142248368f); q = q * t + 0.127414796f; q = q * t;
    const float e = __builtin_amdgcn_exp2f((v * v) * (-0.72134752044f));
    const float m = v * (q * e);
    return v < 0.f ? m : v - m;
}
DI void p8_peer_sliced(Frame& F) {
    const unsigned char* down = wsp<unsigned char>(F, WS_DOWN); const unsigned char* up = wsp<unsigned char>(F, WS_UP);
    bf16* hb = wsp<bf16>(F, WS_H1B); float* stat = wsp<float>(F, WS_STAT);
    const int* pidx = wsp<int>(F, WS_PIDX); const float* pgate = wsp<float>(F, WS_PGATE);
    const int lane = F.lane, g = lane >> 3, l8 = lane & 7;
    const int qA = 16 * l8 + g, qB = qA + 8;
    LAS int* wsI = (LAS int*)(F.lds + F.wave * 10240) + lane;
    LAS float* wsF = (LAS float*)wsI;
#define PS(i, f) (((i) * 5 + (f)) * 64)
    for (int tbase = (F.bid * NWAVES + F.wave) * 8; tbase < S_; tbase += F.G * NWAVES * 8) {
#pragma unroll
        for (int i = 0; i < 8; ++i) { wsI[PS(i, 0)] = pidx[(unsigned)((tbase + i) * 128 + qA)]; wsI[PS(i, 1)] = pidx[(unsigned)((tbase + i) * 128 + qB)]; wsF[PS(i, 2)] = 0.f; wsF[PS(i, 3)] = 0.f; wsF[PS(i, 4)] = 0.f; }
        for (int s = 0; s < 16; ++s) {
#pragma unroll 1
            for (int i = 0; i < 8; ++i) {
                int ln = lane; asm volatile("" : "+v"(ln));
                const bool b0 = ln & 1, b1 = ln & 2, b2 = ln & 4;
                const int exA = wsI[PS(i, 0)], exB = wsI[PS(i, 1)];
                f32x2 hf[8];
                { const u32x4* hp = (const u32x4*)(hb + (unsigned)((tbase + i) * D_ + 128 * s + 16 * l8)); const u32x4 a = hp[0], b = hp[1];
                  hf[0] = (f32x2){bflo(a.x), bfhi(a.x)}; hf[1] = (f32x2){bflo(a.y), bfhi(a.y)}; hf[2] = (f32x2){bflo(a.z), bfhi(a.z)}; hf[3] = (f32x2){bflo(a.w), bfhi(a.w)};
                  hf[4] = (f32x2){bflo(b.x), bfhi(b.x)}; hf[5] = (f32x2){bflo(b.y), bfhi(b.y)}; hf[6] = (f32x2){bflo(b.z), bfhi(b.z)}; hf[7] = (f32x2){bflo(b.w), bfhi(b.w)}; }
                float pv[16];
#pragma unroll
                for (int hb2 = 0; hb2 < 1; ++hb2) {
                    u32x4 rv[16];
#pragma unroll
                    for (int j8 = 0; j8 < 16; ++j8) { const int jj = j8;
                        const int ex = __shfl((jj & 1) ? exB : exA, g * 8 + (jj >> 1));
                        rv[j8] = *(const u32x4*)(down + (unsigned)(ex * D_ + 128 * s + 16 * l8)); }
#pragma unroll
                    for (int j8 = 0; j8 < 16; ++j8) { f32x2 a2 = {0.f, 0.f};
#pragma unroll
                        for (int q = 0; q < 4; ++q) { a2 += hf[2 * q] * __builtin_amdgcn_cvt_pk_f32_fp8((int)rv[j8][q], false); a2 += hf[2 * q + 1] * __builtin_amdgcn_cvt_pk_f32_fp8((int)rv[j8][q], true); }
                        pv[j8] = a2.x + a2.y; }
                    __builtin_amdgcn_sched_barrier(0);
                }
                float p8[8], p4[4];
#pragma unroll
                for (int k = 0; k < 8; ++k) { const float snd = b2 ? pv[k] : pv[k + 8], kp = b2 ? pv[k + 8] : pv[k]; p8[k] = kp + __shfl_xor(snd, 4); }
#pragma unroll
                for (int k = 0; k < 4; ++k) { const float snd = b1 ? p8[k] : p8[k + 4], kp = b1 ? p8[k + 4] : p8[k]; p4[k] = kp + __shfl_xor(snd, 2); }
                { const float snd0 = b0 ? p4[0] : p4[2], kp0 = b0 ? p4[2] : p4[0], snd1 = b0 ? p4[1] : p4[3], kp1 = b0 ? p4[3] : p4[1];
                  wsF[PS(i, 2)] += kp0 + __shfl_xor(snd0, 1); wsF[PS(i, 3)] += kp1 + __shfl_xor(snd1, 1); }
            }
        }
#pragma unroll 1
        for (int i = 0; i < 8; ++i) {
            const float rs2 = stat[ST_RS2 + tbase + i] * (1.f / DSCALE);
            wsF[PS(i, 2)] = gelu_erf(wsF[PS(i, 2)] * rs2) * pgate[(unsigned)((tbase + i) * 128 + qA)] * (1.f / USCALE);
            wsF[PS(i, 3)] = gelu_erf(wsF[PS(i, 3)] * rs2) * pgate[(unsigned)((tbase + i) * 128 + qB)] * (1.f / USCALE);
        }
        for (int s = 0; s < 16; ++s) {
#pragma unroll 1
            for (int i = 0; i < 8; ++i) {
                int ln = lane; asm volatile("" : "+v"(ln));
                const bool b3 = ln & 8, b4 = ln & 16, b5 = ln & 32;
                const int exA = wsI[PS(i, 0)], exB = wsI[PS(i, 1)]; const float aA = wsF[PS(i, 2)], aB = wsF[PS(i, 3)];
                f32x2 acc2[8];
#pragma unroll
                for (int k = 0; k < 8; ++k) acc2[k] = (f32x2){0.f, 0.f};
#pragma unroll
                for (int hb2 = 0; hb2 < 1; ++hb2) {
                    u32x4 rv[16]; float av[16];
#pragma unroll
                    for (int j8 = 0; j8 < 16; ++j8) { const int jj = j8;
                        const int ex = __shfl((jj & 1) ? exB : exA, g * 8 + (jj >> 1));
                        av[j8] = __shfl((jj & 1) ? aB : aA, g * 8 + (jj >> 1));
                        rv[j8] = *(const u32x4*)(up + (unsigned)(ex * D_ + 128 * s + 16 * l8)); }
#pragma unroll
                    for (int j8 = 0; j8 < 16; ++j8) { const f32x2 a2 = {av[j8], av[j8]};
#pragma unroll
                        for (int q = 0; q < 4; ++q) { acc2[2 * q] += a2 * __builtin_amdgcn_cvt_pk_f32_fp8((int)rv[j8][q], false); acc2[2 * q + 1] += a2 * __builtin_amdgcn_cvt_pk_f32_fp8((int)rv[j8][q], true); } }
                    __builtin_amdgcn_sched_barrier(0);
                }
                float acc[16];
#pragma unroll
                for (int k = 0; k < 8; ++k) { acc[2 * k] = acc2[k].x; acc[2 * k + 1] = acc2[k].y; }
                float p8[8], p4[4];
#pragma unroll
                for (int k = 0; k < 8; ++k) { const float snd = b5 ? acc[k] : acc[k + 8], kp = b5 ? acc[k + 8] : acc[k]; p8[k] = kp + __shfl_xor(snd, 32); }
#pragma unroll
                for (int k = 0; k < 4; ++k) { const float snd = b4 ? p8[k] : p8[k + 4], kp = b4 ? p8[k + 4] : p8[k]; p4[k] = kp + __shfl_xor(snd, 16); }
                const float snd0 = b3 ? p4[0] : p4[2], kp0 = b3 ? p4[2] : p4[0], snd1 = b3 ? p4[1] : p4[3], kp1 = b3 ? p4[3] : p4[1];
                const float o0 = kp0 + __shfl_xor(snd0, 8), o1 = kp1 + __shfl_xor(snd1, 8);
                const unsigned off = (unsigned)((tbase + i) * D_ + 128 * s + 16 * l8 + 2 * g);
                const unsigned hw = *(const unsigned*)(hb + off);
                f32x2 x = {bflo(hw) + o0, bfhi(hw) + o1};
                *(unsigned*)(hb + off) = pk2(x.x, x.y);
                wsF[PS(i, 4)] += x.x * x.x + x.y * x.y;
            }
        }
#pragma unroll 1
        for (int i = 0; i < 8; ++i) { const float ss = wave_sum(wsF[PS(i, 4)]); if (lane == 0) stat[ST_RS3 + tbase + i] = 1.f / sqrtf(ss * (1.f / D_) + EPS); }
    }
#undef PS
}

DI void p10_final(Frame& F) {
    const float* ssq4 = wsp<float>(F, WS_SSQ4); const float* gain = F.in[15]; const bf16* h3b = wsp<bf16>(F, WS_QRY);
    const int NGW = F.G * NWAVES;
    f32x4 gr[8];
#pragma unroll
    for (int j = 0; j < 4; ++j) { gr[2 * j] = ((const f32x4*)gain)[2 * F.lane + 128 * j]; gr[2 * j + 1] = ((const f32x4*)gain)[2 * F.lane + 128 * j + 1]; }
    for (int m0 = F.bid * NWAVES + F.wave; m0 < S_; m0 += 4 * NGW) {
        float sv[4]; u32x4 w[4][4];
#pragma unroll
        for (int u = 0; u < 4; ++u) { const int m = m0 + u * NGW;
            if (m < S_) { sv[u] = (F.lane < 32) ? ssq4[(size_t)m * 32 + F.lane] : 0.f; const u32x4* hr = (const u32x4*)(h3b + (size_t)m * D_) + F.lane;
#pragma unroll
                for (int j = 0; j < 4; ++j) w[u][j] = hr[64 * j]; } }
#pragma unroll
        for (int u = 0; u < 4; ++u) { const int m = m0 + u * NGW;
            if (m < S_) { const float rs = 1.f / sqrtf(wave_sum(sv[u]) * (1.f / D_) + EPS); f32x4* xr = (f32x4*)(F.out + (size_t)m * D_) + 2 * F.lane;
#pragma unroll
                for (int j = 0; j < 4; ++j) { const u32x4 ww = w[u][j];
                    xr[128 * j] = (f32x4){bflo(ww.x), bfhi(ww.x), bflo(ww.y), bfhi(ww.y)} * rs * gr[2 * j];
                    xr[128 * j + 1] = (f32x4){bflo(ww.z), bfhi(ww.z), bflo(ww.w), bfhi(ww.w)} * rs * gr[2 * j + 1]; } } }
    }
}

constexpr int NPHASES = 11;
struct Args { const float* in[16]; float* out; unsigned char* ws; int ph_lo, ph_hi; };
DI int lane_id() { return (int)__builtin_amdgcn_mbcnt_hi(~0u, __builtin_amdgcn_mbcnt_lo(~0u, 0u)); }
DI Frame make_frame(LAS unsigned char* lds, int wave0) {
    typedef const Args __attribute__((address_space(4))) * cargs_t;
    cargs_t ap = (cargs_t)__builtin_amdgcn_kernarg_segment_ptr();
    asm volatile("" : "+s"(ap));
    Frame F;
    F.lds = lds;
    F.tid = threadIdx.x; F.lane = F.tid & 63; F.wave = __builtin_amdgcn_readfirstlane(F.tid >> 6); (void)wave0;
    F.G = gridDim.x; F.bid = blockIdx.x;
#pragma unroll
    for (int i = 0; i < 16; ++i) F.in[i] = ap->in[i];
    F.out = ap->out; F.ws = ap->ws; F.ctl = (unsigned*)(ap->ws + WS_CTL);
    return F;
}
__global__ void __launch_bounds__(NTHREADS, 2) mega_fwd(Args args) {
    extern __shared__ __attribute__((aligned(16))) unsigned char lds_[];
    LAS unsigned char* lds = (LAS unsigned char*)lds_;
    volatile LAS unsigned* MISC = (volatile LAS unsigned*)(lds + MISC_OFF);
    const int wave0 = __builtin_amdgcn_readfirstlane(threadIdx.x >> 6);
    if (threadIdx.x < 64) MISC[threadIdx.x] = 0u;
    __syncthreads();
    const int lo = args.ph_lo, hi = args.ph_hi;
    XcdBarrier bar; bar.bar = (unsigned*)(args.ws + WS_CTL) + CW_BAR; bar.x = 0; bar.st = nullptr;
    if (hi - lo > 1) bar = xcd_barrier_post((unsigned*)(args.ws + WS_CTL) + CW_BAR, MISC + 8, (int)threadIdx.x);
#ifdef ONLY_PHASE
#define IN(k) ((k) == ONLY_PHASE && lo <= (k) && (k) < hi)
#else
#define IN(k) (lo <= (k) && (k) < hi)
#endif
#ifdef TIME_PHASE
#define STAMP(k) do { if (blockIdx.x == 0 && threadIdx.x == 0) { const unsigned long long _t = __builtin_amdgcn_s_memrealtime(); MISC[16 + 2 * (k)] = (unsigned)_t; MISC[17 + 2 * (k)] = (unsigned)(_t >> 32); } } while (0)
#else
#define STAMP(k) do { } while (0)
#endif
#define SEAM(k) do { if (IN(k) && IN((k) + 1)) xcd_barrier(bar, (int)threadIdx.x); STAMP((k) + 1); } while (0)
    STAMP(0);

    if (IN(0)) { Frame F = make_frame(lds, wave0); p0_prologue(F); }
    SEAM(0);
    if (IN(1)) {
        Frame F = make_frame(lds, wave0);
        const float* stat = wsp<float>(F, WS_STAT);
        {
            pg8::Gemm g{(const bf16*)F.out, wsp<bf16>(F, WS_W1T), S_, 3 * AW, D_ / 2}; pg8::StaticOrder S; S.init(S_, 3 * AW, F.G, F.bid);
            Epi1<0> E{wsp<bf16>(F, WS_Q), wsp<bf16>(F, WS_K), wsp<bf16>(F, WS_VT), wsp<bf16>(F, WS_HQ), wsp<bf16>(F, WS_HLF), wsp<bf16>(F, WS_HV), wsp<bf16>(F, WS_HG), wsp<float>(F, WS_KPART), stat + ST_RS1Q};
            pg8::gemm_phase<Epi1<0>, pg8::StaticOrder, PG8_ALIGN, PG8_SP2, true>(F.lds, g, S, E, F.tid); }
        {
            pg8::Gemm g{wsp<bf16>(F, WS_XB), wsp<bf16>(F, WS_W1TB), S_, 4 * AW, D_}; pg8::StaticOrder S; S.init(S_, 4 * AW, F.G, F.bid);
            Epi1<3> E{wsp<bf16>(F, WS_Q), wsp<bf16>(F, WS_K), wsp<bf16>(F, WS_VT), wsp<bf16>(F, WS_HQ), wsp<bf16>(F, WS_HLF), wsp<bf16>(F, WS_HV), wsp<bf16>(F, WS_HG), wsp<float>(F, WS_KPART), stat + ST_RS1};
            int tid2 = F.tid; asm volatile("" : "+v"(tid2));
            pg8::gemm_phase<Epi1<3>, pg8::StaticOrder, PG8_ALIGN, PG8_SP2, false>(F.lds, g, S, E, tid2); }
    }
    SEAM(1);
    if (IN(2)) {
        Frame F = make_frame(lds, wave0);
        p2_gate(F);
        hgrn_mfma<false>(F);
    }
    SEAM(2);
    if (IN(3)) { Frame F = make_frame(lds, wave0); p3_attn(F);
        hgrn_scan(F); }
    SEAM(3);
    if (IN(4)) {
        Frame F = make_frame(lds, wave0);
        p4_combine(F);
        hgrn_mfma<true>(F);
    }
    SEAM(4);
    if (IN(5)) {
        Frame F = make_frame(lds, wave0);
        pg8::Gemm g{wsp<bf16>(F, WS_MIX), wsp<bf16>(F, WS_W2T), S_, D_, D_ / 2}; pg8::StaticOrder S; S.init(S_, D_, F.G, F.bid);
        Epi2 E{F.in[0], F.out, wsp<bf16>(F, WS_H1B), wsp<float>(F, WS_SSQ2)};
        pg8::gemm_phase<Epi2, pg8::StaticOrder, PG8_ALIGN, PG8_SP2, true>(F.lds, g, S, E, F.tid);
    }
    SEAM(5);
    if (IN(6)) {
        Frame F = make_frame(lds, wave0);
        pg8::Gemm g{wsp<bf16>(F, WS_H1B), wsp<bf16>(F, WS_WQT), S_, D_, D_}; pg8::StaticOrder S; S.init(S_, D_, F.G, F.bid);
        EpiB E{wsp<bf16>(F, WS_QRY), D_};
        pg8::gemm_phase<EpiB, pg8::StaticOrder, PG8_ALIGN, PG8_SP2>(F.lds, g, S, E, F.tid);
    }
    SEAM(6);
    if (IN(7)) { Frame F = make_frame(lds, wave0); p7_route(F); }
    SEAM(7);
    if (IN(8)) { Frame F = make_frame(lds, wave0); p8_peer_sliced(F); }
    SEAM(8);
    if (IN(9)) {
        { Frame F = make_frame(lds, wave0); pg8::StaticOrder S; S.init(S_, D_, F.G, F.bid);
          pg8::Gemm g{wsp<bf16>(F, WS_PB), wsp<bf16>(F, WS_WPT), S_, D_, PLE}; EpiP E{wsp<bf16>(F, WS_PLE)};
          pg8::gemm_phase<EpiP, pg8::StaticOrder, PG8_ALIGN, PG8_SP2>(F.lds, g, S, E, F.tid); }
        { Frame F = make_frame(lds, wave0); pg8::StaticOrder S; S.init(S_, D_, F.G, F.bid);
          pg8::Gemm g{wsp<bf16>(F, WS_H1B), wsp<bf16>(F, WS_WGT), S_, D_, D_}; Epi4 E{wsp<bf16>(F, WS_QRY), wsp<bf16>(F, WS_H1B), wsp<bf16>(F, WS_PLE), wsp<float>(F, WS_STAT) + ST_RS3, wsp<float>(F, WS_SSQ4)};
          pg8::gemm_phase<Epi4, pg8::StaticOrder, PG8_ALIGN, PG8_SP2>(F.lds, g, S, E, F.tid); }
    }
    SEAM(9);
    if (IN(10)) { Frame F = make_frame(lds, wave0); p10_final(F); }
#ifdef TIME_PHASE
    if (blockIdx.x == 0) {
        __syncthreads();
        if (threadIdx.x == 0) {
            const unsigned long long tend = __builtin_amdgcn_s_memrealtime();
            const unsigned long long a = ((unsigned long long)MISC[17 + 2 * TIME_PHASE] << 32) | MISC[16 + 2 * TIME_PHASE];
            const unsigned long long b = (TIME_PHASE == 10) ? tend : (((unsigned long long)MISC[19 + 2 * TIME_PHASE] << 32) | MISC[18 + 2 * TIME_PHASE]);
            const unsigned long long wait = 10ull * (b - a);
            while (__builtin_amdgcn_s_memrealtime() - tend < wait) __builtin_amdgcn_s_sleep(32);
        }
    }
#endif
#undef IN
#undef SEAM
}

extern "C" void kernel_launch(void* const* d_in, const int* in_sizes, int n_in, void* d_out, int out_size, void* d_ws, size_t ws_size, hipStream_t stream) {
    static int grid = 0;
    if (grid == 0) {
        if (n_in != 16 || out_size != S_ * D_ || ws_size < WS_END) { fprintf(stderr, "kernel_launch: unexpected problem (n_in %d, out %d, ws %zu < %zu)\n", n_in, out_size, ws_size, (size_t)WS_END); grid = -1; return; }
        int dev = 0, cus = 0, per_cu = 0;
        if (hipGetDevice(&dev) != hipSuccess || hipDeviceGetAttribute(&cus, hipDeviceAttributeMultiprocessorCount, dev) != hipSuccess) { grid = -1; return; }
        if (hipFuncSetAttribute((const void*)mega_fwd, hipFuncAttributeMaxDynamicSharedMemorySize, LDS_BYTES) != hipSuccess) { fprintf(stderr, "kernel_launch: hipFuncSetAttribute failed\n"); grid = -1; return; }
        if (hipOccupancyMaxActiveBlocksPerMultiprocessor(&per_cu, (const void*)mega_fwd, NTHREADS, LDS_BYTES) != hipSuccess || per_cu < 1) { fprintf(stderr, "kernel_launch: occupancy query says %d\n", per_cu); (void)hipGetLastError(); }
        grid = cus;
    }
    if (grid < 0) return;
    (void)hipMemsetAsync((char*)d_ws + WS_CTL, 0, CTL_ZERO_BYTES, stream);
    Args a{};
    for (int i = 0; i < 16; ++i) a.in[i] = (const float*)d_in[i];
    a.out = (float*)d_out; a.ws = (unsigned char*)d_ws;
#if MK_PER_PHASE
    for (int ph = 0; ph < NPHASES; ++ph) {
        a.ph_lo = ph; a.ph_hi = ph + 1;
        hipLaunchKernelGGL(mega_fwd, dim3(grid), dim3(NTHREADS), LDS_BYTES, stream, a);
    }
#else
    a.ph_lo = 0; a.ph_hi = NPHASES;
    void* kargs[] = {&a};
    hipError_t e = hipLaunchCooperativeKernel((const void*)mega_fwd, dim3(grid), dim3(NTHREADS), kargs, LDS_BYTES, stream);
    if (e != hipSuccess) fprintf(stderr, "kernel_launch: cooperative launch failed: %s\n", hipGetErrorString(e));
#endif
}
```

```cpp
#include <hip/hip_runtime.h>
#include <cstdio>
#include <cstdint>

#ifndef MK_PER_PHASE
#define MK_PER_PHASE 0
#endif

namespace pg8 {
#define PG8_LAS __attribute__((address_space(3)))
typedef unsigned short bf16_t;
typedef short bf16x8 __attribute__((ext_vector_type(8)));
typedef float f32x4 __attribute__((ext_vector_type(4)));
typedef unsigned u32x4 __attribute__((ext_vector_type(4)));
constexpr int BM = 256, BK = 64, HALF = 128, HTB = HALF * BK * 2, STAGE_BYTES = 8 * HTB, NXCD = 8, WGM = 8;

__host__ __device__ __forceinline__ int lds_byte(int r, int c) { const int st = (r >> 4) * 2 + (c >> 5), rr = r & 15, cc = c & 31, ob = rr * 64 + cc * 2; return st * 1024 + (ob ^ (((ob >> 9) & 1) << 5)); }
__host__ __device__ __forceinline__ void stage_rc(int b, int& R, int& C) { const int st = b / 1024, sb = b % 1024, swz = sb ^ (((sb >> 9) & 1) << 5); R = (st >> 1) * 16 + swz / 64; C = (st & 1) * 32 + (swz % 64) / 2; }
__host__ __device__ __forceinline__ int perm32(int rho) { const int n = rho >> 4, i = rho & 15; return 8 * (i >> 2) + 4 * n + (i & 3); }

struct Unit { int pm, pn; };
struct Gemm { const bf16_t* A; const bf16_t* Bt; int M, N, K; };

struct StaticOrder {
    int nM, nN, nwg, G, c;
    __host__ __device__ void init(int M, int N, int G_, int c_) { nM = M / BM; nN = N / BM; nwg = nM * nN; G = G_; c = c_; }
    __host__ __device__ bool next(int i, Unit& u) const {
        const long L = (long)i * G + c; if (L >= nwg) return false;
        int wgid = (int)L; { const int q = nwg / NXCD, r = nwg % NXCD, xcd = wgid % NXCD, off = wgid / NXCD; wgid = (xcd < r ? xcd * (q + 1) : r * (q + 1) + (xcd - r) * q) + off; }
        const int nig = WGM * nN, gid = wgid / nig, fm = gid * WGM, gsz = (nM - fm) < WGM ? (nM - fm) : WGM;
        u.pm = fm + ((wgid % nig) % gsz); u.pn = (wgid % nig) / gsz; return true;
    }
    __device__ __forceinline__ void a_ready(const Unit&) const {}
    __device__ __forceinline__ void done(const Unit&) const {}
};

typedef int i32x8 __attribute__((ext_vector_type(8)));
template <bool FP8> struct FragSel { typedef bf16x8 A_t[4][2]; typedef bf16x8 B_t[2][2]; };
template <> struct FragSel<true> { typedef i32x8 A_t[4]; typedef i32x8 B_t[2]; };
template <class Epi, class Sched, bool ALIGN_EPI = false, bool SP2 = false, bool FP8 = false>
__device__ __forceinline__ void gemm_phase(PG8_LAS unsigned char* lds, const Gemm g, const Sched& S, const Epi& E, const int tid) {
    const int wid = __builtin_amdgcn_readfirstlane(tid >> 6), lane = tid & 63, wr = wid >> 2, wc = wid & 3, fr = lane & 15, fq = lane >> 4;
    int K_ = g.K; asm volatile("" : "+s"(K_));
    const int K = K_, nt = K / BK;
    unsigned voffA[2], voffB[2];
#pragma unroll
    for (int i = 0; i < 2; ++i) { int R, C; stage_rc(tid * 16 + i * 8192, R, C); const int Rb = Epi::PERM ? ((R & ~31) + perm32(R & 31)) : R;
        voffA[i] = (unsigned)(R * K + C) * 2u; voffB[i] = (unsigned)(Rb * K + C) * 2u; }
    const size_t kstep = (size_t)(BK * 2);
    const size_t hstep = (size_t)HALF * K * 2;
    const size_t tstep = 2 * hstep;
    const unsigned ldsw = (unsigned)wid * 1024u;
    const int fcol = FP8 ? (16 * (fq & 1) + 32 * (fq >> 1)) : fq * 8;
    const int aoff = lds_byte(wr * 64 + fr, fcol), boff = lds_byte(wc * 32 + fr, fcol);

#define PG8_SA(b, h) (((b) * 2 + (h)) * HTB)
#define PG8_SB(b, h) ((4 + (b) * 2 + (h)) * HTB)
#define PG8_STAGE(bufoff, gbase, voff) do { _Pragma("unroll") for (int _i = 0; _i < 2; ++_i) \
        __builtin_amdgcn_global_load_lds((const unsigned*)((const char*)(gbase) + (voff)[_i]), (PG8_LAS unsigned*)(lds + (bufoff) + ldsw + _i * 8192), 16, 0, 0); } while (0)
#define PG8_LDA(dst, b, h) do { if constexpr (FP8) { _Pragma("unroll") for (int m = 0; m < 4; ++m) dst[m] = *(const PG8_LAS i32x8*)(lds + PG8_SA(b, h) + aoff + m * 2048); } \
        else { _Pragma("unroll") for (int m = 0; m < 4; ++m) _Pragma("unroll") for (int k = 0; k < 2; ++k) dst[m][k] = *(const PG8_LAS bf16x8*)(lds + PG8_SA(b, h) + aoff + m * 2048 + k * 1024); } } while (0)
#define PG8_LDB(dst, b, h) do { if constexpr (FP8) { _Pragma("unroll") for (int n = 0; n < 2; ++n) dst[n] = *(const PG8_LAS i32x8*)(lds + PG8_SB(b, h) + boff + n * 2048); } \
        else { _Pragma("unroll") for (int n = 0; n < 2; ++n) _Pragma("unroll") for (int k = 0; k < 2; ++k) dst[n][k] = *(const PG8_LAS bf16x8*)(lds + PG8_SB(b, h) + boff + n * 2048 + k * 1024); } } while (0)
#define PG8_MMA(ai, bj, At, Bt) do { __builtin_amdgcn_s_setprio(1); \
        if constexpr (FP8) { _Pragma("unroll") for (int m = 0; m < 4; ++m) _Pragma("unroll") for (int n = 0; n < 2; ++n) \
            asm volatile("v_mfma_scale_f32_16x16x128_f8f6f4 %0, %1, %2, %0, %3, %3 op_sel_hi:[0,0,0]" : "+v"(acc[ai][bj][m][n]) : "v"(Bt[n]), "v"(At[m]), "v"(one_scale)); } \
        else { _Pragma("unroll") for (int m = 0; m < 4; ++m) _Pragma("unroll") for (int n = 0; n < 2; ++n) _Pragma("unroll") for (int k = 0; k < 2; ++k) \
            acc[ai][bj][m][n] = __builtin_amdgcn_mfma_f32_16x16x32_bf16(Bt[n][k], At[m][k], acc[ai][bj][m][n], 0, 0, 0); } \
        __builtin_amdgcn_s_setprio(0); } while (0)
#define PG8_WAIT_V(n) asm volatile("s_waitcnt vmcnt(" #n ")" ::: "memory")
#define PG8_WAIT_L(n) asm volatile("s_waitcnt lgkmcnt(" #n ")" ::: "memory")
#define PG8_BAR __builtin_amdgcn_s_barrier()
#define PG8_SCHED __builtin_amdgcn_sched_barrier(0)
    int one_scale = 0x7f7f7f7f;
    asm volatile("" : "+v"(one_scale));
    Unit cur, nxt; int ui = 0;
    if (!S.next(0, cur)) return;
    f32x4 acc[2][2][4][2];
#pragma unroll
    for (int a = 0; a < 2; ++a)
#pragma unroll
        for (int b = 0; b < 2; ++b)
#pragma unroll
            for (int m = 0; m < 4; ++m)
#pragma unroll
                for (int n = 0; n < 2; ++n) acc[a][b][m][n] = (f32x4){0.f, 0.f, 0.f, 0.f};
    typename FragSel<FP8>::A_t At; typename FragSel<FP8>::B_t B0, B1;
    const char* cA = (const char*)g.A + (size_t)cur.pm * tstep; const char* cB = (const char*)g.Bt + (size_t)cur.pn * tstep;
    S.a_ready(cur);
    if constexpr (SP2) {
        PG8_STAGE(PG8_SB(0, 0), cB, voffB); PG8_STAGE(PG8_SB(0, 1), cB + hstep, voffB); PG8_STAGE(PG8_SA(0, 0), cA, voffA); PG8_STAGE(PG8_SA(0, 1), cA + hstep, voffA);
        if (wr == 1) PG8_BAR;
        PG8_WAIT_V(2); PG8_BAR;
        PG8_STAGE(PG8_SB(1, 0), cB + kstep, voffB); PG8_STAGE(PG8_SA(1, 0), cA + kstep, voffA); PG8_STAGE(PG8_SB(1, 1), cB + hstep + kstep, voffB);
        PG8_WAIT_V(6); PG8_BAR;
    } else {
        PG8_STAGE(PG8_SB(0, 0), cB, voffB); PG8_STAGE(PG8_SA(0, 0), cA, voffA); PG8_STAGE(PG8_SB(0, 1), cB + hstep, voffB); PG8_STAGE(PG8_SA(0, 1), cA + hstep, voffA);
        if (wr == 1) PG8_BAR;
        PG8_WAIT_V(4); PG8_BAR;
        PG8_STAGE(PG8_SB(1, 0), cB + kstep, voffB); PG8_STAGE(PG8_SA(1, 0), cA + kstep, voffA); PG8_STAGE(PG8_SB(1, 1), cB + hstep + kstep, voffB);
        PG8_WAIT_V(6); PG8_BAR;
    }
    for (;;) {
        const bool has_next = S.next(ui + 1, nxt);
        const char* nA = has_next ? (const char*)g.A + (size_t)nxt.pm * tstep : cA; const char* nB = has_next ? (const char*)g.Bt + (size_t)nxt.pn * tstep : cB;
        for (int t = 0; t < nt; t += 2) {
            const bool last = (t == nt - 2);
            const char* a1 = cA + (size_t)(t + 1) * kstep;
            const char* a2 = last ? nA : cA + (size_t)(t + 2) * kstep; const char* b2 = last ? nB : cB + (size_t)(t + 2) * kstep;
            const char* a3 = a2 + kstep; const char* b3 = b2 + kstep;
            if (last && has_next) S.a_ready(nxt);
            if constexpr (SP2) {
            PG8_LDB(B0, 0, 0); PG8_LDB(B1, 0, 1); PG8_SCHED; PG8_LDA(At, 0, 0); PG8_STAGE(PG8_SA(1, 1), a1 + hstep, voffA);
            PG8_WAIT_V(8); PG8_WAIT_L(0); PG8_BAR; PG8_MMA(0, 0, At, B0); PG8_MMA(0, 1, At, B1); PG8_BAR; PG8_SCHED;
            PG8_LDA(At, 0, 1); PG8_STAGE(PG8_SB(0, 0), b2, voffB); PG8_STAGE(PG8_SB(0, 1), b2 + hstep, voffB); PG8_STAGE(PG8_SA(0, 0), a2, voffA);
            PG8_WAIT_V(8); PG8_WAIT_L(0); PG8_BAR; PG8_MMA(1, 0, At, B0); PG8_MMA(1, 1, At, B1); PG8_BAR; PG8_SCHED;
            PG8_LDB(B0, 1, 0); PG8_LDB(B1, 1, 1); PG8_SCHED; PG8_LDA(At, 1, 0); PG8_STAGE(PG8_SA(0, 1), a2 + hstep, voffA);
            PG8_WAIT_V(8); PG8_WAIT_L(0); PG8_BAR; PG8_MMA(0, 0, At, B0); PG8_MMA(0, 1, At, B1); PG8_BAR; PG8_SCHED;
            PG8_LDA(At, 1, 1); PG8_STAGE(PG8_SB(1, 0), b3, voffB); PG8_STAGE(PG8_SB(1, 1), b3 + hstep, voffB); PG8_STAGE(PG8_SA(1, 0), a3, voffA);
            PG8_WAIT_V(8); PG8_WAIT_L(0); PG8_BAR; PG8_MMA(1, 0, At, B0); PG8_MMA(1, 1, At, B1); PG8_BAR; PG8_SCHED;
            } else {
            PG8_LDB(B0, 0, 0); PG8_SCHED; PG8_LDA(At, 0, 0); PG8_STAGE(PG8_SA(1, 1), a1 + hstep, voffA);
            PG8_WAIT_L(8); PG8_BAR; PG8_WAIT_L(0); PG8_MMA(0, 0, At, B0); PG8_BAR; PG8_SCHED;
            PG8_LDB(B1, 0, 1); PG8_STAGE(PG8_SB(0, 0), b2, voffB);
            PG8_BAR; PG8_WAIT_L(0); PG8_MMA(0, 1, At, B1); PG8_BAR;
            PG8_LDA(At, 0, 1); PG8_STAGE(PG8_SA(0, 0), a2, voffA);
            PG8_BAR; PG8_WAIT_L(0); PG8_MMA(1, 0, At, B0); PG8_BAR; PG8_SCHED;
            PG8_STAGE(PG8_SB(0, 1), b2 + hstep, voffB);
            PG8_WAIT_V(6); PG8_BAR; PG8_MMA(1, 1, At, B1); PG8_BAR;
            PG8_LDB(B0, 1, 0); PG8_SCHED; PG8_LDA(At, 1, 0); PG8_STAGE(PG8_SA(0, 1), a2 + hstep, voffA);
            PG8_WAIT_L(8); PG8_BAR; PG8_WAIT_L(0); PG8_MMA(0, 0, At, B0); PG8_BAR; PG8_SCHED;
            PG8_LDB(B1, 1, 1); PG8_STAGE(PG8_SB(1, 0), b3, voffB);
            PG8_BAR; PG8_WAIT_L(0); PG8_MMA(0, 1, At, B1); PG8_BAR;
            PG8_LDA(At, 1, 1); PG8_STAGE(PG8_SA(1, 0), a3, voffA);
            PG8_BAR; PG8_WAIT_L(0); PG8_MMA(1, 0, At, B0); PG8_BAR; PG8_SCHED;
            PG8_STAGE(PG8_SB(1, 1), b3 + hstep, voffB);
            PG8_WAIT_V(6); PG8_BAR; PG8_MMA(1, 1, At, B1); PG8_BAR;
            }
        }
        if constexpr (ALIGN_EPI) { if (wr == 0) PG8_BAR; }
        if constexpr (FP8) asm volatile("s_nop 15\n\ts_nop 15" ::: "memory");
        E(acc, cur, wr, wc, fr, fq); S.done(cur);
        if (!has_next) break;
#pragma unroll
        for (int a = 0; a < 2; ++a)
#pragma unroll
            for (int b = 0; b < 2; ++b)
#pragma unroll
                for (int m = 0; m < 4; ++m)
#pragma unroll
                    for (int n = 0; n < 2; ++n) acc[a][b][m][n] = (f32x4){0.f, 0.f, 0.f, 0.f};
        cur = nxt; cA = nA; cB = nB; ++ui;
        if constexpr (ALIGN_EPI) { if (wr == 1) PG8_BAR; }
    }
    PG8_WAIT_V(0);
    if constexpr (!ALIGN_EPI) { if (wr == 0) PG8_BAR; }
    PG8_BAR;
#undef PG8_SA
#undef PG8_SB
#undef PG8_STAGE
#undef PG8_LDA
#undef PG8_LDB
#undef PG8_MMA
#undef PG8_WAIT_V
#undef PG8_WAIT_L
#undef PG8_BAR
#undef PG8_SCHED
}
}

#define PG8_SP2 true
#define PG8_ALIGN true

constexpr int NWAVES = 8, NTHREADS = 512;
constexpr int S_ = 16384, D_ = 2048, NIN = 7168, AW = 1024, NH = 8, HD = 128, NBLK = 64, LBLK = 256;
constexpr int PLE = 256, NEXP = 16384, PH = 8, NKEY = 128, PTOP = 16;
constexpr float EPS = 1e-6f;
constexpr float QSCALE = 0.08838834764831845f * 1.4426950408889634f;
constexpr float XSCALE = 16.f, W1SCALE = 512.f;
constexpr float MSCALE = 8.f;
constexpr float OSCALE = 32.f;
constexpr float DSCALE = 512.f, USCALE = 32.f;
constexpr int HSC = 64, HSCLEN = 256, HSUB = 32;
constexpr int LSTRIDE = 256 * (63 * 64 / 2);
__host__ __device__ __forceinline__ int list_off(int n) { return 256 * (63 * n - (n * (n - 1)) / 2); }

constexpr size_t MiB = 1u << 20;
constexpr size_t WS_CTL = 0, CTL_ZERO_BYTES = 1 * MiB;
constexpr size_t WS_W1T = 2 * MiB  , WS_W1TB = 10 * MiB  , WS_W2T = 30 * MiB, WS_WQT = 38 * MiB, WS_WGT = 46 * MiB, WS_WPT = 54 * MiB, WS_SKB = 55 * MiB;
constexpr size_t WS_STAT = 56 * MiB;
constexpr size_t WS_SSQ2 = 57 * MiB, WS_SSQ4 = 59 * MiB;
constexpr size_t WS_KPART = 61 * MiB, WS_HDEC = 62 * MiB;
constexpr size_t WS_PB = 63 * MiB;
constexpr size_t WS_DOWN = 71 * MiB, WS_UP = 135 * MiB;
constexpr size_t WS_R1 = 199 * MiB;
constexpr size_t WS_XB = WS_R1, WS_LIST = WS_R1, WS_PML = WS_R1 + 16 * MiB, WS_HST = WS_R1 + 20 * MiB, WS_H1B = WS_R1;
constexpr size_t WS_R2 = 263 * MiB;
constexpr size_t WS_Q = WS_R2, WS_K = WS_R2 + 32 * MiB, WS_VT = WS_R2 + 64 * MiB, WS_MIX = WS_R2, WS_QRY = WS_R2, WS_PIDX = WS_R2 + 64 * MiB, WS_PGATE = WS_R2 + 72 * MiB;
constexpr size_t WS_R3 = 359 * MiB;
constexpr size_t WS_HQ = WS_R3, WS_HLF = WS_R3 + 32 * MiB, WS_HV = WS_R3 + 64 * MiB, WS_HG = WS_R3 + 96 * MiB, WS_PLE = WS_R3;
constexpr size_t WS_END = 487 * MiB;
constexpr int CW_BAR = 4096;
constexpr int CW_GCNT = 16384;
constexpr int ST_RS1 = 0, ST_LB = S_, ST_RS2 = S_ + 1024, ST_RS3 = 2 * S_ + 1024, ST_RS1Q = 3 * S_ + 1024;

constexpr int RING_BYTES = 131072;
constexpr int LDS_BYTES = 147456;
constexpr int MISC_OFF = LDS_BYTES - 256;

#define LAS __attribute__((address_space(3)))
typedef unsigned short bf16;
typedef unsigned u32x4 __attribute__((ext_vector_type(4)));
typedef unsigned u32x2 __attribute__((ext_vector_type(2)));
typedef float f32x4 __attribute__((ext_vector_type(4)));
typedef float f32x2 __attribute__((ext_vector_type(2)));
typedef float f32x16 __attribute__((ext_vector_type(16)));
typedef short bf16x8 __attribute__((ext_vector_type(8)));
typedef short s16x4 __attribute__((ext_vector_type(4)));
typedef __bf16 bf16x2n __attribute__((ext_vector_type(2)));
#define RLX_AGENT __ATOMIC_RELAXED, __HIP_MEMORY_SCOPE_AGENT
#define LDS_WAIT() asm volatile("s_waitcnt lgkmcnt(0)" ::: "memory")
#define DI __device__ __forceinline__

DI unsigned pk2(float lo, float hi) { f32x2 v = {lo, hi}; bf16x2n b = __builtin_convertvector(v, bf16x2n); return __builtin_bit_cast(unsigned, b); }
DI float sat8(float v) { return __builtin_amdgcn_fmed3f(v, -440.f, 440.f); }
DI float bflo(unsigned u) { return __uint_as_float(u << 16); }
DI float bfhi(unsigned u) { return __uint_as_float(u & 0xffff0000u); }
DI float wave_sum(float v) {
#pragma unroll
    for (int o = 1; o < 64; o <<= 1) v += __shfl_xor(v, o);
    return v;
}
DI float sigmoidf_(float x) { return 1.f / (1.f + __expf(-x)); }
DI float siluf_(float x) { return x / (1.f + __expf(-x)); }
DI int crow(int reg, int h) { return (reg & 3) + 8 * (reg >> 2) + 4 * h; }

#define XB_TMO      128
#define XB_XCNT(j)  (256  + 64 * (j))
#define XB_XSUB(j)  (1280 + 64 * (j))
#define XB_XGEN(j)  (2304 + 64 * (j))
#define XB_TOP      3328
#define XB_TOPGEN   3392
#define XCD_BAR_WORDS 3456
#define XB_SPIN_CAP (1u << 22)
DI unsigned xb_ld(unsigned* p)              { return __hip_atomic_load(p, __ATOMIC_RELAXED, __HIP_MEMORY_SCOPE_AGENT); }
DI unsigned xb_add(unsigned* p, unsigned v) { return __hip_atomic_fetch_add(p, v, __ATOMIC_RELAXED, __HIP_MEMORY_SCOPE_AGENT); }
DI unsigned xb_xcc_id() { return (unsigned)__builtin_amdgcn_s_getreg((3 << 11) | 20) & 0xFu; }
#define XB_SPIN(cond, bar) do { unsigned _sp = 0; while (cond) { __builtin_amdgcn_s_sleep(1); \
    if ((++_sp & 255u) == 0u) { if (xb_ld(&(bar)[XB_TMO])) break; if (_sp > XB_SPIN_CAP) { atomicAdd(&(bar)[XB_TMO], 1u); break; } } } } while (0)
struct XcdBarrier { unsigned* bar; unsigned x; volatile LAS unsigned* st; };
DI XcdBarrier xcd_barrier_post(unsigned* bar, volatile LAS unsigned* st, int tid) {
    XcdBarrier b; b.bar = bar; b.x = xb_xcc_id(); b.st = st;
    if (tid == 0) (void)xb_add(&bar[XB_XCNT(b.x)], 1u);
    return b;
}
DI void xcd_barrier_complete(unsigned* bar, unsigned x, unsigned& nloc, unsigned& nx) {
    const unsigned G = gridDim.x * gridDim.y * gridDim.z;
    unsigned sum, cnt, mine, sp = 0u;
    for (;;) {
        sum = 0u; cnt = 0u; mine = 0u;
#pragma unroll
        for (unsigned j = 0; j < 16; ++j) { const unsigned c = xb_ld(&bar[XB_XCNT(j)]); sum += c; cnt += (c > 0u) ? 1u : 0u; mine = (j == x) ? c : mine; }
        if (sum == G) break;
        __builtin_amdgcn_s_sleep(1);
        if ((++sp & 255u) == 0u) { if (xb_ld(&bar[XB_TMO])) break; if (sp > XB_SPIN_CAP) { atomicAdd(&bar[XB_TMO], 1u); break; } }
    }
    nloc = mine > 0u ? mine : 1u; nx = cnt > 0u ? cnt : 1u;
}
DI void xcd_barrier(const XcdBarrier& b, int tid) {
    asm volatile("s_waitcnt vmcnt(0)" ::: "memory");
    __syncthreads();
    if (tid == 0) {
        unsigned* bar = b.bar;
        __builtin_amdgcn_s_waitcnt(0);
        unsigned nloc = b.st[0], nx = b.st[1];
        if (nloc == 0u) { xcd_barrier_complete(bar, b.x, nloc, nx); b.st[0] = nloc; b.st[1] = nx; }
        const unsigned old = xb_add(&bar[XB_XSUB(b.x)], 1u);
        const unsigned gen = old / nloc;
        if (old + 1u == (gen + 1u) * nloc) {
            __builtin_amdgcn_fence(__ATOMIC_RELEASE, "agent");
            asm volatile("s_waitcnt vmcnt(0)" ::: "memory");
            const unsigned og = xb_add(&bar[XB_TOP], 1u);
            const unsigned tg = og / nx;
            if (og + 1u == (tg + 1u) * nx) xb_add(&bar[XB_TOPGEN], 1u);
            else XB_SPIN(xb_ld(&bar[XB_TOPGEN]) == tg, bar);
            __builtin_amdgcn_fence(__ATOMIC_ACQUIRE, "agent");
            xb_add(&bar[XB_XGEN(b.x)], 1u);
            asm volatile("s_waitcnt vmcnt(0)" ::: "memory");
        } else {
            XB_SPIN(xb_ld(&bar[XB_XGEN(b.x)]) == gen, bar);
            __builtin_amdgcn_fence(__ATOMIC_ACQUIRE, "agent");
            asm volatile("s_waitcnt vmcnt(0)" ::: "memory");
        }
    }
    __syncthreads();
}

struct Frame {
    LAS unsigned char* lds;
    unsigned* ctl;
    int tid, lane, wave, G, bid;
    const float* in[16];
    float* out;
    unsigned char* ws;
};
template <class T> DI T* wsp(const Frame& F, size_t off) { return (T*)(F.ws + off); }

constexpr int TP_PITCH = 65, TP_WAVE_BYTES = 64 * TP_PITCH * 4 + 64;
template <bool FP8 = false> DI void p0_transpose_item(const float* W, const float* gain, int K, int N, bf16* WT, LAS float* scr, int item, int lane, int nscaled = 0, float nscale = 1.f, float allscale = 1.f) {
    const int nblk = N / 64, kb = item / nblk, nb = item % nblk, k0 = 64 * kb, n0 = 64 * nb; const float osc = ((n0 < nscaled) ? nscale : 1.f) * allscale;
    const int kr = lane >> 4, n4 = (lane & 15) * 4;
    f32x4 v[16];
#pragma unroll
    for (int i = 0; i < 16; ++i) v[i] = *(const f32x4*)(W + (size_t)(k0 + 4 * i + kr) * N + n0 + n4);
#pragma unroll
    for (int i = 0; i < 16; ++i) { const int kk = 4 * i + kr; const float g = (gain ? gain[k0 + kk] : 1.f) * osc;
        scr[(n4 + 0) * TP_PITCH + kk] = v[i].x * g; scr[(n4 + 1) * TP_PITCH + kk] = v[i].y * g; scr[(n4 + 2) * TP_PITCH + kk] = v[i].z * g; scr[(n4 + 3) * TP_PITCH + kk] = v[i].w * g; }
    LDS_WAIT(); asm volatile("" ::: "memory");
    const int c = lane & 7, nn = lane >> 3;
#pragma unroll
    for (int j = 0; j < 8; ++j) { const int n = nn + 8 * j; const LAS float* sp = scr + n * TP_PITCH + 8 * c;
        if constexpr (FP8) {
            int w0 = __builtin_amdgcn_cvt_pk_fp8_f32(sp[0], sp[1], 0, false); w0 = __builtin_amdgcn_cvt_pk_fp8_f32(sp[2], sp[3], w0, true);
            int w1 = __builtin_amdgcn_cvt_pk_fp8_f32(sp[4], sp[5], 0, false); w1 = __builtin_amdgcn_cvt_pk_fp8_f32(sp[6], sp[7], w1, true);
            *(u32x2*)((unsigned char*)WT + (size_t)(n0 + n) * K + k0 + 8 * c) = (u32x2){(unsigned)w0, (unsigned)w1};
        } else {
            u32x4 o; o.x = pk2(sp[0], sp[1]); o.y = pk2(sp[2], sp[3]); o.z = pk2(sp[4], sp[5]); o.w = pk2(sp[6], sp[7]);
            *(u32x4*)(WT + (size_t)(n0 + n) * K + k0 + 8 * c) = o; } }
    LDS_WAIT(); asm volatile("" ::: "memory");
}
DI void p0_convert(const float* src, bf16* dst, size_t n8, const float* colgain, size_t gtid, size_t gstride) {
    for (size_t i = gtid; i < n8; i += gstride) {
        f32x4 a = *(const f32x4*)(src + i * 8), b = *(const f32x4*)(src + i * 8 + 4);
        if (colgain) { const int c = (int)((i * 8) & 2047); a = a * *(const f32x4*)(colgain + c); b = b * *(const f32x4*)(colgain + c + 4); }
        u32x4 o; o.x = pk2(a.x, a.y); o.y = pk2(a.z, a.w); o.z = pk2(b.x, b.y); o.w = pk2(b.z, b.w);
        *(u32x4*)(dst + i * 8) = o;
    }
}
DI void p0_convert_fp8(const float* src, unsigned char* dst, size_t nelem, const float* colgain, float scale, size_t gwave, size_t nwaves, int lane) {
    const size_t nunit = nelem / 2048;
    for (size_t u = gwave; u < nunit; u += nwaves) {
        const float* sp = src + u * 2048 + lane * 4; unsigned char* dp = dst + u * 2048 + lane * 4;
        f32x4 a[8];
#pragma unroll
        for (int q = 0; q < 8; ++q) a[q] = __builtin_nontemporal_load((const f32x4*)(sp + q * 256));
#pragma unroll
        for (int q = 0; q < 8; ++q) {
            f32x4 v = a[q];
            if (colgain) v = v * *(const f32x4*)(colgain + q * 256 + lane * 4);
            v = v * scale;
            int w = __builtin_amdgcn_cvt_pk_fp8_f32(v.x, v.y, 0, false);
            w = __builtin_amdgcn_cvt_pk_fp8_f32(v.z, v.w, w, true);
            __builtin_nontemporal_store((unsigned)w, (unsigned*)(dp + q * 256));
        }
    }
}
DI void p0_prologue(Frame& F) {
    LAS float* scr = (LAS float*)(F.lds + F.wave * TP_WAVE_BYTES);
    const int gw = F.bid * NWAVES + F.wave, NGW = F.G * NWAVES;
    const float* x = F.in[0];
    constexpr int I1 = (D_ / 64) * (NIN / 64), I2 = (D_ / 64) * (D_ / 64), IP = (PLE / 64) * (D_ / 64);
    constexpr int NITEMS = I1 + 3 * I2 + IP;
    for (int it = gw; it < NITEMS; it += NGW) {
        int r = it;
        if (r < I1) {
            const int nb = r % (NIN / 64);
            if (nb < 3 * AW / 64) p0_transpose_item<true>(F.in[3], F.in[2], D_, NIN, wsp<bf16>(F, WS_W1T), scr, r, F.lane, AW, QSCALE, W1SCALE);
            else p0_transpose_item<false>(F.in[3], F.in[2], D_, NIN, wsp<bf16>(F, WS_W1TB) - (size_t)3 * AW * D_, scr, r, F.lane);
            continue; } r -= I1;
        if (r < I2) { p0_transpose_item<true>(F.in[6], nullptr, D_, D_, wsp<bf16>(F, WS_W2T), scr, r, F.lane, 0, 1.f, W1SCALE); continue; } r -= I2;
        if (r < I2) { p0_transpose_item(F.in[8], F.in[7], D_, D_, wsp<bf16>(F, WS_WQT), scr, r, F.lane); continue; } r -= I2;
        if (r < I2) { p0_transpose_item(F.in[14], F.in[12], D_, D_, wsp<bf16>(F, WS_WGT), scr, r, F.lane); continue; } r -= I2;
        p0_transpose_item(F.in[13], nullptr, PLE, D_, wsp<bf16>(F, WS_WPT), scr, r, F.lane);
    }
    float* stat = wsp<float>(F, WS_STAT);
    bf16* xb = wsp<bf16>(F, WS_XB);
    for (int m = gw; m < S_; m += NGW) {
        const f32x4* xr = (const f32x4*)(x + (size_t)m * D_) + F.lane;
        f32x4 v[8]; float s = 0.f;
#pragma unroll
        for (int j = 0; j < 8; ++j) { v[j] = xr[64 * j]; s += (v[j].x * v[j].x + v[j].y * v[j].y) + (v[j].z * v[j].z + v[j].w * v[j].w); }
        s = wave_sum(s);
        if (F.lane == 0) { const float rs = 1.f / sqrtf(s * (1.f / D_) + EPS); stat[ST_RS1 + m] = rs; stat[ST_RS1Q + m] = rs * (1.f / (XSCALE * W1SCALE)); }
        u32x2* o8 = (u32x2*)(xb + (size_t)m * D_) + F.lane;
#pragma unroll
        for (int j = 0; j < 8; ++j) { u32x2 w; w.x = pk2(v[j].x, v[j].y); w.y = pk2(v[j].z, v[j].w); o8[64 * j] = w; }
        unsigned* o4 = (unsigned*)((unsigned char*)F.out + (size_t)m * D_) + F.lane;
#pragma unroll
        for (int j = 0; j < 8; ++j) { int w = __builtin_amdgcn_cvt_pk_fp8_f32(sat8(v[j].x * XSCALE), sat8(v[j].y * XSCALE), 0, false); w = __builtin_amdgcn_cvt_pk_fp8_f32(sat8(v[j].z * XSCALE), sat8(v[j].w * XSCALE), w, true); o4[64 * j] = (unsigned)w; }
    }
    const size_t gtid = (size_t)F.bid * NTHREADS + F.tid, gstride = (size_t)F.G * NTHREADS;
    p0_convert(F.in[1], wsp<bf16>(F, WS_PB), (size_t)S_ * PLE / 8, nullptr, gtid, gstride);
    p0_convert(F.in[9], wsp<bf16>(F, WS_SKB), (size_t)PH * 2 * NKEY * 128 / 8, nullptr, gtid, gstride);
    {
    p0_convert_fp8(F.in[10], wsp<unsigned char>(F, WS_DOWN), (size_t)NEXP * D_, F.in[7], DSCALE, (size_t)gw, (size_t)NGW, F.lane);
    p0_convert_fp8(F.in[11], wsp<unsigned char>(F, WS_UP), (size_t)NEXP * D_, nullptr, USCALE, (size_t)gw, (size_t)NGW, F.lane); }
    for (size_t i = gtid; i < 1024; i += gstride) { const float l0 = F.in[4][i], l1 = F.in[4][1024 + i]; stat[ST_LB + i] = 1.f / (1.f + __expf(l1 - l0)); }
}

template <int RBASE> struct Epi1 {
    static constexpr bool PERM = true, AFTER_DRAIN = false;
    bf16 *q, *k, *vt, *hq, *hlf, *hv, *hg; float* kpart; const float* rs1;
    template <int R> DI void run(const pg8::f32x4 (&acc)[2][2][4][2], const pg8::Unit& u, int wr, int wc, int fr, int fq, bf16* dst) const {
        const int cb = (u.pn & 3) * 256;
        const int row0 = u.pm * 256 + wr * 64 + fr;
        const int colw = cb + wc * 32 + 8 * fq;
        f32x4 cs[2][2];
        if (R == 1) { cs[0][0] = cs[0][1] = cs[1][0] = cs[1][1] = (f32x4){0.f, 0.f, 0.f, 0.f}; }
#pragma unroll
        for (int ai = 0; ai < 2; ++ai)
#pragma unroll
            for (int m = 0; m < 4; ++m) {
                const int row = row0 + ai * 128 + m * 16;
                const float rs = rs1[row];
#pragma unroll
                for (int bj = 0; bj < 2; ++bj) {
                    const f32x4 v0 = acc[ai][bj][m][0] * rs, v1 = acc[ai][bj][m][1] * rs;
                    const int col = colw + 128 * bj;
                    if (R == 1) { cs[bj][0] = cs[bj][0] + v0; cs[bj][1] = cs[bj][1] + v1; }
                    if (R == 2) {
                        bf16* p = dst + (size_t)col * S_ + row;
#pragma unroll
                        for (int i = 0; i < 4; ++i) { p[(size_t)i * S_] = (bf16)(pk2(v0[i], 0.f) & 0xffffu); p[(size_t)(i + 4) * S_] = (bf16)(pk2(v1[i], 0.f) & 0xffffu); }
                    } else {
                        u32x4 w; w.x = pk2(v0[0], v0[1]); w.y = pk2(v0[2], v0[3]); w.z = pk2(v1[0], v1[1]); w.w = pk2(v1[2], v1[3]);
                        *(u32x4*)(dst + (size_t)row * AW + col) = w;
                    }
                }
                asm volatile("" ::: "memory");
            }
        if (R == 1) {
#pragma unroll
            for (int bj = 0; bj < 2; ++bj)
#pragma unroll
                for (int n = 0; n < 2; ++n)
#pragma unroll
                    for (int i = 0; i < 4; ++i) {
                        float s = cs[bj][n][i];
                        s += __shfl_xor(s, 1); s += __shfl_xor(s, 2); s += __shfl_xor(s, 4); s += __shfl_xor(s, 8);
                        if (fr == 0) kpart[(size_t)(wr * NBLK + u.pm) * AW + colw + 128 * bj + 4 * n + i] = s;
                    }
        }
    }
    DI void operator()(const pg8::f32x4 (&acc)[2][2][4][2], const pg8::Unit& u, int wr, int wc, int fr, int fq) const {
        asm volatile("" : "+v"(fr), "+v"(fq));
        const int reg = RBASE + (u.pn >> 2);
        if constexpr (RBASE == 0) {
            if (reg == 1) run<1>(acc, u, wr, wc, fr, fq, k);
            else if (reg == 2) run<2>(acc, u, wr, wc, fr, fq, vt);
            else run<0>(acc, u, wr, wc, fr, fq, q);
        } else { bf16* dst = hq + (size_t)(reg - 3) * ((WS_HLF - WS_HQ) / 2); run<0>(acc, u, wr, wc, fr, fq, dst); }
    }
};

DI void ins3(float v, int i, float& v0, float& v1, float& v2, int& i0, int& i1, int& i2) {
    const bool c0 = v > v0, c1 = v > v1, c2 = v > v2;
    v2 = c1 ? v1 : (c2 ? v : v2); i2 = c1 ? i1 : (c2 ? i : i2);
    v1 = c0 ? v0 : (c1 ? v : v1); i1 = c0 ? i0 : (c1 ? i : i1);
    v0 = c0 ? v : v0; i0 = c0 ? i : i0;
}
DI void p2_gate(Frame& F) {
    LAS unsigned char* kmh = F.lds;
    LAS unsigned char* kml = F.lds + 64 * 272;
    LAS int* lcnt = (LAS int*)(F.lds + 2 * 64 * 272);
    LAS int* lbase = lcnt + 64;
    const float* kpart = wsp<float>(F, WS_KPART);
    const bf16* q = wsp<bf16>(F, WS_Q);
    unsigned* gcnt = F.ctl + CW_GCNT;
    int* list = wsp<int>(F, WS_LIST);
    const int tid = F.tid, lane = F.lane, w = F.wave, r = lane & 31, hh = lane >> 5;
    for (int it = F.bid; it < NH * 63; it += F.G) {
        const int h = it & 7, qb = 63 - (it >> 3);
        for (int i = tid; i < 64 * 64; i += NTHREADS) {
            const int n = i >> 6, d = 2 * (i & 63);
            f32x2 a = {0.f, 0.f};
            if (n < qb) { const f32x2 p0 = *(const f32x2*)(kpart + (size_t)n * AW + h * HD + d), p1 = *(const f32x2*)(kpart + (size_t)(NBLK + n) * AW + h * HD + d); a = p0 + p1; }
            const unsigned hi = pk2(a.x, a.y);
            const unsigned lo = pk2(a.x - bflo(hi), a.y - bfhi(hi));
            *(LAS unsigned*)(kmh + n * 272 + d * 2) = hi; *(LAS unsigned*)(kml + n * 272 + d * 2) = lo;
        }
        if (tid < 64) lcnt[tid] = 0;
        __syncthreads();
        const int t = qb * LBLK + w * 32 + r;
        bf16x8 Qf[8];
        { const bf16x8* qp = (const bf16x8*)(q + (size_t)t * AW + h * HD + 8 * hh);
#pragma unroll
          for (int s = 0; s < 8; ++s) Qf[s] = qp[2 * s]; }
        float v0 = -INFINITY, v1 = -INFINITY, v2 = -INFINITY; int i0 = -1, i1 = -1, i2 = -1;
#pragma unroll
        for (int nt = 0; nt < 2; ++nt) {
            if (nt * 32 < qb) {
                f32x16 x;
#pragma unroll
                for (int i = 0; i < 16; ++i) x[i] = 0.f;
#pragma unroll
                for (int s = 0; s < 8; ++s) {
                    const bf16x8 ah = *(const LAS bf16x8*)(kmh + (nt * 32 + r) * 272 + 32 * s + 16 * hh), al = *(const LAS bf16x8*)(kml + (nt * 32 + r) * 272 + 32 * s + 16 * hh);
                    x = __builtin_amdgcn_mfma_f32_32x32x16_bf16(ah, Qf[s], x, 0, 0, 0);
                    x = __builtin_amdgcn_mfma_f32_32x32x16_bf16(al, Qf[s], x, 0, 0, 0);
                }
#pragma unroll
                for (int i = 0; i < 16; ++i) { const int n = nt * 32 + crow(i, hh); ins3(n < qb ? x[i] : -INFINITY, n < qb ? n : -1, v0, v1, v2, i0, i1, i2); }
            }
        }
        {
            const float p0 = __shfl_xor(v0, 32), p1 = __shfl_xor(v1, 32), p2 = __shfl_xor(v2, 32);
            const int j0 = __shfl_xor(i0, 32), j1 = __shfl_xor(i1, 32), j2 = __shfl_xor(i2, 32);
            ins3(p0, j0, v0, v1, v2, i0, i1, i2);
            ins3(p1, j1, v0, v1, v2, i0, i1, i2);
            ins3(p2, j2, v0, v1, v2, i0, i1, i2);
        }
        int r0 = 0, r1 = 0, r2 = 0;
        if (hh == 0) {
            if (i0 >= 0) r0 = __hip_atomic_fetch_add(lcnt + i0, 1, __ATOMIC_RELAXED, __HIP_MEMORY_SCOPE_WORKGROUP);
            if (i1 >= 0) r1 = __hip_atomic_fetch_add(lcnt + i1, 1, __ATOMIC_RELAXED, __HIP_MEMORY_SCOPE_WORKGROUP);
            if (i2 >= 0) r2 = __hip_atomic_fetch_add(lcnt + i2, 1, __ATOMIC_RELAXED, __HIP_MEMORY_SCOPE_WORKGROUP);
        }
        __syncthreads();
        if (tid < 64) { const int c = lcnt[tid]; lbase[tid] = c ? (int)__hip_atomic_fetch_add(gcnt + h * NBLK + tid, (unsigned)c, RLX_AGENT) : 0; }
        __syncthreads();
        if (hh == 0) {
            int* lh = list + (size_t)h * LSTRIDE;
            if (i0 >= 0) lh[list_off(i0) + lbase[i0] + r0] = (t << 2) | 0;
            if (i1 >= 0) lh[list_off(i1) + lbase[i1] + r1] = (t << 2) | 1;
            if (i2 >= 0) lh[list_off(i2) + lbase[i2] + r2] = (t << 2) | 2;
        }
        __syncthreads();
    }
}

constexpr int HG_QM = 0, HG_KM = 8704, HG_QD = 17408, HG_KDT = 25856, HG_VT = 36096, HG_O = 46336, HG_TOT = 62720, HG_DL = 64768, HG_BYTES = 65280;
constexpr int HG_RS = 272, HG_RD = 264, HG_RT = 80;
static_assert(2 * HG_BYTES <= MISC_OFF, "hgrn LDS map");
DI bf16x8 pack8(const f32x16& x, int s) {
    u32x4 p; p.x = pk2(x[8 * s + 0], x[8 * s + 1]); p.y = pk2(x[8 * s + 2], x[8 * s + 3]); p.z = pk2(x[8 * s + 4], x[8 * s + 5]); p.w = pk2(x[8 * s + 6], x[8 * s + 7]);
    return __builtin_bit_cast(bf16x8, p);
}
template <bool READOUT> DI void hgrn_mfma(Frame& F) {
    const int w = F.wave, grp = w >> 2, wq = w & 3, lane = F.lane, r = lane & 31, hh = lane >> 5, p = lane;
    LAS unsigned char* L = F.lds + grp * HG_BYTES;
    const bf16* hq = wsp<bf16>(F, WS_HQ); const bf16* hlf = wsp<bf16>(F, WS_HLF); const bf16* hv = wsp<bf16>(F, WS_HV); const bf16* hg = wsp<bf16>(F, WS_HG);
    const float* lbp = wsp<float>(F, WS_STAT) + ST_LB;
    bf16* mixed = wsp<bf16>(F, WS_MIX);
    for (int base = F.bid * 2; base < NH * HSC; base += 2 * F.G) {
        const int it = base + grp, h = it & 7, sc = it >> 3;
        float* hst = wsp<float>(F, WS_HST) + ((size_t)sc * NH + h) * (HD * HD);
        f32x16 S[4];
#pragma unroll
        for (int kb = 0; kb < 4; ++kb)
#pragma unroll
            for (int i = 0; i < 16; ++i) S[kb][i] = READOUT ? hst[(size_t)(kb * 32 + crow(i, hh)) * HD + wq * 32 + r] : 0.f;
        const float lb0 = lbp[h * HD + 2 * p], lb1 = lbp[h * HD + 2 * p + 1];
        const int lt = wq * 64 + lane, nt = lt >> 3, nvg = lt & 7;
        f32x4 gn[4];
        if (READOUT) {
#pragma unroll
            for (int j = 0; j < 4; ++j) gn[j] = *(const f32x4*)(F.in[5] + h * HD + nvg * 16 + 4 * j);
        }
        float sumbl0 = 0.f, sumbl1 = 0.f;
        unsigned xf[8], xq[8], xv[8];
        const size_t gcol = (size_t)h * HD + 2 * p;
        {   const size_t t0 = (size_t)sc * HSCLEN + 8 * wq;
#pragma unroll
            for (int i = 0; i < 8; ++i) { xf[i] = *(const unsigned*)(hlf + (t0 + i) * AW + gcol); xv[i] = *(const unsigned*)(hv + (t0 + i) * AW + gcol); if (READOUT) xq[i] = *(const unsigned*)(hq + (t0 + i) * AW + gcol); } }
        for (int c = 0; c < HSCLEN / 32; ++c) {
            const int tc = sc * HSCLEN + c * 32;
            float bl0[8], bl1[8], f0[8], f1[8];
            {   float run0 = 0.f, run1 = 0.f;
#pragma unroll
                for (int i = 0; i < 8; ++i) {
                    const float fa = lb0 + (1.f - lb0) * sigmoidf_(bflo(xf[i])), fb = lb1 + (1.f - lb1) * sigmoidf_(bfhi(xf[i]));
                    run0 += __logf(fa); run1 += __logf(fb); bl0[i] = run0; bl1[i] = run1; f0[i] = fa; f1[i] = fb;
                }
                *(LAS f32x2*)(L + HG_TOT + (wq * 128 + 2 * p) * 4) = (f32x2){run0, run1};
            }
            __syncthreads();
            {
                float off0 = 0.f, off1 = 0.f, bm0, bm1, be0, be1;
                {   f32x2 tq[4];
#pragma unroll
                    for (int q = 0; q < 4; ++q) tq[q] = *(const LAS f32x2*)(L + HG_TOT + (q * 128 + 2 * p) * 4);
#pragma unroll
                    for (int q = 0; q < 4; ++q) if (q < wq) { off0 += tq[q].x; off1 += tq[q].y; }
                    bm0 = tq[0].x + tq[1].x; bm1 = tq[0].y + tq[1].y; be0 = bm0 + tq[2].x + tq[3].x; be1 = bm1 + tq[2].y + tq[3].y; }
                if (wq == 0) { *(LAS f32x2*)(L + HG_DL + 2 * p * 4) = (f32x2){__expf(be0), __expf(be1)}; sumbl0 += be0; sumbl1 += be1; }
                const float em0 = __expf(-bm0), em1 = __expf(-bm1), ek0 = __expf(bm0 - be0), ek1 = __expf(bm1 - be1);
                unsigned kd0[4], kd1[4], vt0[4], vt1[4];
#pragma unroll
                for (int i = 0; i < 8; ++i) {
                    const int t = 8 * wq + i;
                    const float b0 = bl0[i] + off0, b1 = bl1[i] + off1;
                    const float k0 = 1.f - f0[i], k1 = 1.f - f1[i];
                    const float kdv0 = k0 * __expf(be0 - b0), kdv1 = k1 * __expf(be1 - b1);
                    if (READOUT) {
                        const float q0 = siluf_(bflo(xq[i])), q1 = siluf_(bfhi(xq[i]));
                        const float qd0 = q0 * __expf(b0), qd1 = q1 * __expf(b1);
                        *(LAS unsigned*)(L + HG_QD + t * HG_RD + 4 * p) = pk2(qd0, qd1);
                        *(LAS unsigned*)(L + HG_QM + t * HG_RS + 4 * p) = pk2(qd0 * em0, qd1 * em1);
                        *(LAS unsigned*)(L + HG_KM + t * HG_RS + 4 * p) = pk2(kdv0 * ek0, kdv1 * ek1);
                    }
                    if (i & 1) { kd0[i >> 1] |= pk2(0.f, kdv0) ; kd1[i >> 1] |= pk2(0.f, kdv1); vt0[i >> 1] |= xv[i] << 16; vt1[i >> 1] |= xv[i] & 0xffff0000u; }
                    else { kd0[i >> 1] = pk2(kdv0, 0.f); kd1[i >> 1] = pk2(kdv1, 0.f); vt0[i >> 1] = xv[i] & 0xffffu; vt1[i >> 1] = xv[i] >> 16; }
                }
                *(LAS u32x4*)(L + HG_KDT + (2 * p) * HG_RT + 16 * wq) = (u32x4){kd0[0], kd0[1], kd0[2], kd0[3]};
                *(LAS u32x4*)(L + HG_KDT + (2 * p + 1) * HG_RT + 16 * wq) = (u32x4){kd1[0], kd1[1], kd1[2], kd1[3]};
                *(LAS u32x4*)(L + HG_VT + (2 * p) * HG_RT + 16 * wq) = (u32x4){vt0[0], vt0[1], vt0[2], vt0[3]};
                *(LAS u32x4*)(L + HG_VT + (2 * p + 1) * HG_RT + 16 * wq) = (u32x4){vt1[0], vt1[1], vt1[2], vt1[3]};
            }
            __syncthreads();
            if (c + 1 < HSCLEN / 32) { const size_t t0 = (size_t)tc + 32 + 8 * wq;
#pragma unroll
                for (int i = 0; i < 8; ++i) { xf[i] = *(const unsigned*)(hlf + (t0 + i) * AW + gcol); xv[i] = *(const unsigned*)(hv + (t0 + i) * AW + gcol); if (READOUT) xq[i] = *(const unsigned*)(hq + (t0 + i) * AW + gcol); } }
            u32x4 gg0, gg1;
            if (READOUT) { const u32x4* gp = (const u32x4*)(hg + (size_t)(tc + nt) * AW + h * HD + nvg * 16); gg0 = gp[0]; gg1 = gp[1]; }
            if (READOUT) {
                f32x16 X, Y;
#pragma unroll
                for (int i = 0; i < 16; ++i) { X[i] = 0.f; Y[i] = 0.f; }
#pragma unroll
                for (int st = 0; st < 8; ++st) {
                    const bf16x8 a = *(const LAS bf16x8*)(L + HG_KM + r * HG_RS + 32 * st + 16 * hh), b = *(const LAS bf16x8*)(L + HG_QM + r * HG_RS + 32 * st + 16 * hh);
                    X = __builtin_amdgcn_mfma_f32_32x32x16_bf16(a, b, X, 0, 0, 0);
                }
#pragma unroll
                for (int i = 0; i < 16; ++i) if (crow(i, hh) > r) X[i] = 0.f;
#pragma unroll
                for (int kb = 0; kb < 4; ++kb)
#pragma unroll
                    for (int st = 0; st < 2; ++st) {
                        const LAS u32x2* qp = (const LAS u32x2*)(L + HG_QD + r * HG_RD + (kb * 32 + 16 * st + 4 * hh) * 2);
                        const u32x2 a0 = qp[0], a1 = qp[2]; const u32x4 av = {a0.x, a0.y, a1.x, a1.y};
                        Y = __builtin_amdgcn_mfma_f32_32x32x16_bf16(__builtin_bit_cast(bf16x8, av), pack8(S[kb], st), Y, 0, 0, 0);
                    }
#pragma unroll
                for (int st = 0; st < 2; ++st) {
                    const LAS u32x2* vp = (const LAS u32x2*)(L + HG_VT + (wq * 32 + r) * HG_RT + (16 * st + 4 * hh) * 2);
                    const u32x2 b0 = vp[0], b1 = vp[2]; const u32x4 bv = {b0.x, b0.y, b1.x, b1.y};
                    Y = __builtin_amdgcn_mfma_f32_32x32x16_bf16(pack8(X, st), __builtin_bit_cast(bf16x8, bv), Y, 0, 0, 0);
                }
#pragma unroll
                for (int i = 0; i < 16; ++i) *(LAS float*)(L + HG_O + crow(i, hh) * 512 + (wq * 32 + r) * 4) = Y[i];
            }
#pragma unroll
            for (int kb = 0; kb < 4; ++kb) {
#pragma unroll
                for (int g4 = 0; g4 < 4; ++g4) { const f32x4 d = *(const LAS f32x4*)(L + HG_DL + (kb * 32 + 8 * g4 + 4 * hh) * 4);
#pragma unroll
                    for (int j = 0; j < 4; ++j) S[kb][4 * g4 + j] *= d[j]; }
#pragma unroll
                for (int st = 0; st < 2; ++st) {
                    const bf16x8 a = *(const LAS bf16x8*)(L + HG_KDT + (kb * 32 + r) * HG_RT + 32 * st + 16 * hh), b = *(const LAS bf16x8*)(L + HG_VT + (wq * 32 + r) * HG_RT + 32 * st + 16 * hh);
                    S[kb] = __builtin_amdgcn_mfma_f32_32x32x16_bf16(a, b, S[kb], 0, 0, 0);
                }
            }
            __syncthreads();
            if (READOUT) {
                f32x4 o[4]; float ss = 0.f;
#pragma unroll
                for (int j = 0; j < 4; ++j) { o[j] = *(const LAS f32x4*)(L + HG_O + nt * 512 + (nvg * 16 + 4 * j) * 4); ss += (o[j].x * o[j].x + o[j].y * o[j].y) + (o[j].z * o[j].z + o[j].w * o[j].w); }
                ss += __shfl_xor(ss, 1); ss += __shfl_xor(ss, 2); ss += __shfl_xor(ss, 4);
                const float rr = 1.f / sqrtf(ss * (1.f / HD) + EPS);
                const unsigned gw[8] = {gg0.x, gg0.y, gg0.z, gg0.w, gg1.x, gg1.y, gg1.z, gg1.w};
                u32x4 o8;
#pragma unroll
                for (int j = 0; j < 4; ++j) {
                    const float g0 = siluf_(bflo(gw[2 * j])), g1 = siluf_(bfhi(gw[2 * j])), g2 = siluf_(bflo(gw[2 * j + 1])), g3 = siluf_(bfhi(gw[2 * j + 1]));
                    const float sc = rr * MSCALE;
                    int wv = __builtin_amdgcn_cvt_pk_fp8_f32(sat8(o[j].x * sc * gn[j].x * g0), sat8(o[j].y * sc * gn[j].y * g1), 0, false);
                    wv = __builtin_amdgcn_cvt_pk_fp8_f32(sat8(o[j].z * sc * gn[j].z * g2), sat8(o[j].w * sc * gn[j].w * g3), wv, true);
                    o8[j] = (unsigned)wv;
                }
                *(u32x4*)((unsigned char*)mixed + (size_t)(tc + nt) * D_ + AW + h * HD + nvg * 16) = o8;
            }
        }
        if (!READOUT) {
#pragma unroll
            for (int kb = 0; kb < 4; ++kb)
#pragma unroll
                for (int i = 0; i < 16; ++i) hst[(size_t)(kb * 32 + crow(i, hh)) * HD + wq * 32 + r] = S[kb][i];
            if (wq == 0) *(f32x2*)(wsp<float>(F, WS_HDEC) + ((size_t)sc * NH + h) * HD + 2 * p) = (f32x2){__expf(sumbl0), __expf(sumbl1)};
        }
        __syncthreads();
    }
}
DI void hgrn_scan(Frame& F) {
    float* hst = wsp<float>(F, WS_HST); const float* hdec = wsp<float>(F, WS_HDEC);
    for (int e = F.bid * NTHREADS + F.tid; e < NH * HD * HD; e += F.G * NTHREADS) {
        const int hk = e >> 7;
        float cur = 0.f;
#pragma unroll 1
        for (int sc0 = 0; sc0 < HSC; sc0 += 8) {
            float tmp[8], dc[8];
#pragma unroll
            for (int j = 0; j < 8; ++j) { tmp[j] = hst[(size_t)(sc0 + j) * (NH * HD * HD) + e]; dc[j] = hdec[(size_t)(sc0 + j) * (NH * HD) + hk]; }
#pragma unroll
            for (int j = 0; j < 8; ++j) { hst[(size_t)(sc0 + j) * (NH * HD * HD) + e] = cur; cur = dc[j] * cur + tmp[j]; }
        }
    }
}

constexpr int AT_KSTR = 272, AT_VSTR = 520;
constexpr int AT_K_OFF = 0, AT_V_OFF = 256 * AT_KSTR, AT_PRE_OFF = AT_V_OFF + 128 * AT_VSTR;
static_assert(AT_PRE_OFF + (520 + 512) * 4 <= MISC_OFF, "attention LDS map");
DI void p3_attn(Frame& F) {
    LAS unsigned char* Kl = F.lds + AT_K_OFF; LAS unsigned char* Vl = F.lds + AT_V_OFF; LAS int* pre = (LAS int*)(F.lds + AT_PRE_OFF); LAS int* cntl = pre + 520;
    const bf16* q = wsp<bf16>(F, WS_Q); const bf16* kg = wsp<bf16>(F, WS_K); const bf16* vt = wsp<bf16>(F, WS_VT);
    const int* list = wsp<int>(F, WS_LIST);
    bf16* po = (bf16*)F.out;
    f32x2* pml = wsp<f32x2>(F, WS_PML);
    const unsigned* gcnt = F.ctl + CW_GCNT;
    const int tid = F.tid, lane = F.lane, w = F.wave, r = lane & 31, hh = lane >> 5;
    if (w == 0) {
        int c[8], s = 0;
#pragma unroll
        for (int k = 0; k < 8; ++k) { const unsigned cc = __hip_atomic_load(gcnt + lane * 8 + k, RLX_AGENT); cntl[lane * 8 + k] = (int)cc; c[k] = 1 + (int)((cc + 255u) >> 8); s += c[k]; }
        int incl = s;
#pragma unroll
        for (int o = 1; o < 64; o <<= 1) { const int t = __shfl_up(incl, o); if (lane >= o) incl += t; }
        int run = incl - s;
#pragma unroll
        for (int k = 0; k < 8; ++k) { pre[lane * 8 + k] = run; run += c[k]; }
        if (lane == 63) pre[512] = incl;
    }
    __syncthreads();
    const int total = pre[512];
    const int ti0 = (int)(((long)total * F.bid) / F.G), ti1 = (int)(((long)total * (F.bid + 1)) / F.G);
    int staged = -1;
#define AT_DECODE(ti_, lo_, seg_, nvalid_) do { int _l = 0, _h = 511; while (_l < _h) { const int _m = (_l + _h + 1) >> 1; if (pre[_m] <= (ti_)) _l = _m; else _h = _m - 1; } \
        lo_ = _l; seg_ = (ti_) - pre[_l]; nvalid_ = seg_ == 0 ? 256 : min(256, cntl[_l] - (seg_ - 1) * 256); } while (0)
#define AT_ENTRY(lo_, seg_, nvalid_) (((seg_) == 0) ? ((((lo_) & 63) * LBLK + ei) << 2 | 3) : ((ei < (nvalid_)) ? list[(unsigned)(((lo_) >> 6) * LSTRIDE + list_off((lo_) & 63) + ((seg_) - 1) * 256 + ei)] : 0))
    const int ei = w * 32 + r;
    int lo = 0, seg = 0, nvalid = 0, e = 0;
    bf16x8 Qf[8];
    if (ti0 < ti1) {
        AT_DECODE(ti0, lo, seg, nvalid); e = AT_ENTRY(lo, seg, nvalid);
        const bf16x8* qp = (const bf16x8*)(q + (unsigned)((e >> 2) * AW + (lo >> 6) * HD + 8 * hh));
#pragma unroll
        for (int s = 0; s < 8; ++s) Qf[s] = qp[2 * s];
    }
    for (int ti = ti0; ti < ti1; ++ti) {
        const int h = lo >> 6, n = lo & 63;
        const bool valid = ei < nvalid;
        const int t = e >> 2, slot = e & 3;
        int lo2 = lo, seg2 = 0, nvalid2 = 0, e2 = 0;
        const bool has_next = ti + 1 < ti1;
        if (has_next) { AT_DECODE(ti + 1, lo2, seg2, nvalid2); e2 = AT_ENTRY(lo2, seg2, nvalid2); }
        if (staged != lo) {
        if (staged >= 0) __syncthreads();
        staged = lo;
#pragma unroll
        for (int p = 0; p < 8; ++p) {
            const int idx = p * NTHREADS + tid;
            { const int row = idx >> 4, pc = idx & 15; const u32x4 v = *(const u32x4*)(kg + (unsigned)((n * LBLK + row) * AW + h * HD + pc * 8)); *(LAS u32x4*)(Kl + row * AT_KSTR + pc * 16) = v; }
            { const int d = idx >> 5, pc = idx & 31; const u32x4 v = *(const u32x4*)(vt + (unsigned)((h * HD + d) * S_ + n * LBLK + pc * 8));
              LAS u32x2* dst = (LAS u32x2*)(Vl + d * AT_VSTR + pc * 16); dst[0] = (u32x2){v.x, v.y}; dst[1] = (u32x2){v.z, v.w}; }
        }
        __syncthreads();
        }
        f32x16 X[8];
        bf16x8 Ac[8], An[4];
#pragma unroll
        for (int s = 0; s < 8; ++s) Ac[s] = *(const LAS bf16x8*)(Kl + r * AT_KSTR + 32 * s + 16 * hh);
#pragma unroll
        for (int kb = 0; kb < 8; ++kb) {
            if (kb < 7) {
#pragma unroll
                for (int s = 0; s < 4; ++s) An[s] = *(const LAS bf16x8*)(Kl + ((kb + 1) * 32 + r) * AT_KSTR + 32 * s + 16 * hh);
            }
            f32x16 x;
            if (seg == 0 && kb > w) {
#pragma unroll
                for (int i = 0; i < 16; ++i) x[i] = -INFINITY;
            } else {
#pragma unroll
                for (int i = 0; i < 16; ++i) x[i] = 0.f;
                __builtin_amdgcn_s_setprio(1);
#pragma unroll
                for (int s = 0; s < 8; ++s) x = __builtin_amdgcn_mfma_f32_32x32x16_bf16(Ac[s], Qf[s], x, 0, 0, 0);
                __builtin_amdgcn_s_setprio(0);
                if (seg == 0 && kb == w) {
#pragma unroll
                    for (int i = 0; i < 16; ++i) if (crow(i, hh) > r) x[i] = -INFINITY;
                }
            }
            X[kb] = x;
            if (kb < 7) {
#pragma unroll
                for (int s = 0; s < 4; ++s) Ac[s] = An[s];
#pragma unroll
                for (int s = 4; s < 8; ++s) Ac[s] = *(const LAS bf16x8*)(Kl + ((kb + 1) * 32 + r) * AT_KSTR + 32 * s + 16 * hh);
            }
        }
        if (has_next) {
            const bf16x8* qp = (const bf16x8*)(q + (unsigned)((e2 >> 2) * AW + (lo2 >> 6) * HD + 8 * hh));
#pragma unroll
            for (int s = 0; s < 8; ++s) Qf[s] = qp[2 * s];
        }
        float mx = -INFINITY;
#pragma unroll
        for (int kb = 0; kb < 8; ++kb)
#pragma unroll
            for (int i = 0; i < 16; ++i) mx = fmaxf(mx, X[kb][i]);
        mx = fmaxf(mx, __shfl_xor(mx, 32));
        float l = 0.f;
        u32x4 P[8][2];
#pragma unroll
        for (int kb = 0; kb < 8; ++kb)
#pragma unroll
            for (int s2 = 0; s2 < 2; ++s2) {
                float pe[8];
#pragma unroll
                for (int j = 0; j < 8; ++j) { pe[j] = __builtin_amdgcn_exp2f(X[kb][8 * s2 + j] - mx); l += pe[j]; }
                P[kb][s2] = (u32x4){pk2(pe[0], pe[1]), pk2(pe[2], pe[3]), pk2(pe[4], pe[5]), pk2(pe[6], pe[7])};
            }
        l += __shfl_xor(l, 32);
        f32x16 O[4];
#pragma unroll
        for (int db = 0; db < 4; ++db)
#pragma unroll
            for (int i = 0; i < 16; ++i) O[db][i] = 0.f;
#pragma unroll
        for (int kb = 0; kb < 8; ++kb)
#pragma unroll
            for (int s2 = 0; s2 < 2; ++s2) {
                const bf16x8 bfrag = __builtin_bit_cast(bf16x8, P[kb][s2]);
                __builtin_amdgcn_s_setprio(1);
#pragma unroll
                for (int db = 0; db < 4; ++db) {
                    const LAS u32x2* vp = (const LAS u32x2*)(Vl + (db * 32 + r) * AT_VSTR + (kb * 32 + 16 * s2 + 4 * hh) * 2);
                    const u32x2 a0 = vp[0], a1 = vp[2];
                    const u32x4 av = {a0.x, a0.y, a1.x, a1.y};
                    O[db] = __builtin_amdgcn_mfma_f32_32x32x16_bf16(__builtin_bit_cast(bf16x8, av), bfrag, O[db], 0, 0, 0);
                }
                __builtin_amdgcn_s_setprio(0);
            }
        {
            const float inv = OSCALE / l;
            unsigned char* orow = (unsigned char*)po + (unsigned)(((t * NH + h) * 4 + slot) * HD) + 16 * hh;
#pragma unroll
            for (int db = 0; db < 4; ++db) {
                unsigned pk[4];
#pragma unroll
                for (int g4 = 0; g4 < 4; ++g4) { int wv = __builtin_amdgcn_cvt_pk_fp8_f32(O[db][4 * g4 + 0] * inv, O[db][4 * g4 + 1] * inv, 0, false); wv = __builtin_amdgcn_cvt_pk_fp8_f32(O[db][4 * g4 + 2] * inv, O[db][4 * g4 + 3] * inv, wv, true); pk[g4] = (unsigned)wv; }
                const unsigned rcv0 = (unsigned)__shfl_xor((int)(hh ? pk[0] : pk[2]), 32), rcv1 = (unsigned)__shfl_xor((int)(hh ? pk[1] : pk[3]), 32);
                const u32x4 ov = hh ? (u32x4){rcv0, pk[2], rcv1, pk[3]} : (u32x4){pk[0], rcv0, pk[1], rcv1};
                if (valid) *(u32x4*)(orow + db * 32) = ov;
            }
            if (valid && hh == 0) pml[(unsigned)((t * NH + h) * 4 + slot)] = (f32x2){mx, l};
        }
        lo = lo2; seg = seg2; nvalid = nvalid2; e = e2;
    }
#undef AT_DECODE
#undef AT_ENTRY
    __syncthreads();
}

DI void p4_combine(Frame& F) {
    const bf16* po = (const bf16*)F.out; const f32x2* pml = wsp<f32x2>(F, WS_PML); bf16* mixed = wsp<bf16>(F, WS_MIX);
    const size_t total = (size_t)S_ * NH * 16, stride = (size_t)F.G * NTHREADS;
    for (size_t w0 = (size_t)F.bid * NTHREADS + F.tid; w0 < total; w0 += 2 * stride) {
        f32x2 ml[2][4]; u32x2 pv[2][4]; int nvv[2];
#pragma unroll
        for (int u = 0; u < 2; ++u) { const size_t wi = w0 + u * stride;
            if (wi < total) { const int c16 = (int)(wi & 15); const size_t th = wi >> 4; const int t = (int)(th >> 3); const int nv = min(3, t >> 8); nvv[u] = nv;
#pragma unroll
                for (int j = 0; j < 4; ++j) { const bool on = (j == 3) || (j < nv); ml[u][j] = on ? pml[th * 4 + j] : (f32x2){-INFINITY, 0.f}; pv[u][j] = on ? *(const u32x2*)((const unsigned char*)po + (th * 4 + j) * HD + c16 * 8) : (u32x2){0u, 0u}; } } }
#pragma unroll
        for (int u = 0; u < 2; ++u) { const size_t wi = w0 + u * stride;
            if (wi < total) { const int c16 = (int)(wi & 15); const size_t th = wi >> 4; const int t = (int)(th >> 3), h = (int)(th & 7); const int nv = nvv[u];
                float M = -INFINITY;
#pragma unroll
                for (int j = 0; j < 4; ++j) M = fmaxf(M, ml[u][j].x);
                float wj[4], W = 0.f;
#pragma unroll
                for (int j = 0; j < 4; ++j) { wj[j] = ((j == 3) || (j < nv)) ? __builtin_amdgcn_exp2f(ml[u][j].x - M) * ml[u][j].y : 0.f; W += wj[j]; }
                const float iW = 1.f / W;
                float o[8];
#pragma unroll
                for (int i = 0; i < 8; ++i) o[i] = 0.f;
#pragma unroll
                for (int j = 0; j < 4; ++j) { const u32x2 v = pv[u][j]; const float ww = wj[j] * iW * (1.f / OSCALE);
                    const f32x2 a0 = __builtin_amdgcn_cvt_pk_f32_fp8((int)v.x, false), a1 = __builtin_amdgcn_cvt_pk_f32_fp8((int)v.x, true), a2 = __builtin_amdgcn_cvt_pk_f32_fp8((int)v.y, false), a3 = __builtin_amdgcn_cvt_pk_f32_fp8((int)v.y, true);
                    o[0] += ww * a0.x; o[1] += ww * a0.y; o[2] += ww * a1.x; o[3] += ww * a1.y; o[4] += ww * a2.x; o[5] += ww * a2.y; o[6] += ww * a3.x; o[7] += ww * a3.y; }
                int w0 = __builtin_amdgcn_cvt_pk_fp8_f32(sat8(o[0] * MSCALE), sat8(o[1] * MSCALE), 0, false); w0 = __builtin_amdgcn_cvt_pk_fp8_f32(sat8(o[2] * MSCALE), sat8(o[3] * MSCALE), w0, true);
                int w1 = __builtin_amdgcn_cvt_pk_fp8_f32(sat8(o[4] * MSCALE), sat8(o[5] * MSCALE), 0, false); w1 = __builtin_amdgcn_cvt_pk_fp8_f32(sat8(o[6] * MSCALE), sat8(o[7] * MSCALE), w1, true);
                *(u32x2*)((unsigned char*)mixed + (size_t)t * D_ + h * HD + c16 * 8) = (u32x2){(unsigned)w0, (unsigned)w1}; } }
    }
}

struct Epi2 {
    static constexpr bool PERM = false, AFTER_DRAIN = false;
    const float* x; float* out; bf16* hb; float* ssq;
    DI void operator()(const pg8::f32x4 (&acc)[2][2][4][2], const pg8::Unit& u, int wr, int wc, int fr, int fq) const {
        asm volatile("" : "+v"(fr), "+v"(fq));
        const int row0 = u.pm * 256 + wr * 64 + fr, col0 = u.pn * 256 + wc * 32 + 4 * fq;
#pragma unroll
        for (int ai = 0; ai < 2; ++ai)
#pragma unroll
            for (int m = 0; m < 4; ++m) {
                const int row = row0 + ai * 128 + m * 16; const size_t off = (size_t)row * D_ + col0; float s = 0.f;
#pragma unroll
                for (int bj = 0; bj < 2; ++bj)
#pragma unroll
                    for (int n = 0; n < 2; ++n) {
                        const f32x4 v = *(const f32x4*)(x + off + bj * 128 + n * 16) + acc[ai][bj][m][n] * (1.f / (MSCALE * W1SCALE));
                        u32x2 b; b.x = pk2(v[0], v[1]); b.y = pk2(v[2], v[3]); *(u32x2*)(hb + off + bj * 128 + n * 16) = b;
                        s += (v[0] * v[0] + v[1] * v[1]) + (v[2] * v[2] + v[3] * v[3]);
                    }
                s += __shfl_xor(s, 16); s += __shfl_xor(s, 32);
                if (fq == 0) ssq[(size_t)row * 32 + u.pn * 4 + wc] = s;
                if (m & 1) asm volatile("" ::: "memory");
            }
    }
};
struct EpiB {
    static constexpr bool PERM = true, AFTER_DRAIN = false;
    bf16* O; int ldc;
    DI void operator()(const pg8::f32x4 (&acc)[2][2][4][2], const pg8::Unit& u, int wr, int wc, int fr, int fq) const {
        asm volatile("" : "+v"(fr), "+v"(fq));
        const int row0 = u.pm * 256 + wr * 64 + fr, col0 = u.pn * 256 + wc * 32 + 8 * fq;
#pragma unroll
        for (int ai = 0; ai < 2; ++ai)
#pragma unroll
            for (int m = 0; m < 4; ++m) { bf16* rowp = O + (size_t)(row0 + ai * 128 + m * 16) * ldc + col0;
#pragma unroll
                for (int bj = 0; bj < 2; ++bj) { const f32x4 v0 = acc[ai][bj][m][0], v1 = acc[ai][bj][m][1];
                    u32x4 w; w.x = pk2(v0[0], v0[1]); w.y = pk2(v0[2], v0[3]); w.z = pk2(v1[0], v1[1]); w.w = pk2(v1[2], v1[3]);
                    *(u32x4*)(rowp + bj * 128) = w; } }
    }
};
struct EpiP {
    static constexpr bool PERM = false, AFTER_DRAIN = false;
    bf16* O;
    DI void operator()(const pg8::f32x4 (&acc)[2][2][4][2], const pg8::Unit& u, int wr, int wc, int fr, int fq) const {
        asm volatile("" : "+v"(fr), "+v"(fq));
        const int row0 = u.pm * 256 + wr * 64 + fr, col0 = u.pn * 256 + wc * 32 + 4 * fq;
#pragma unroll
        for (int ai = 0; ai < 2; ++ai)
#pragma unroll
            for (int m = 0; m < 4; ++m) { const size_t off = (size_t)(row0 + ai * 128 + m * 16) * D_ + col0;
#pragma unroll
                for (int bj = 0; bj < 2; ++bj)
#pragma unroll
                    for (int n = 0; n < 2; ++n) { const f32x4 v = acc[ai][bj][m][n]; u32x2 b; b.x = pk2(v[0], v[1]); b.y = pk2(v[2], v[3]); *(u32x2*)(O + off + bj * 128 + n * 16) = b; } }
    }
};
struct Epi4 {
    static constexpr bool PERM = false, AFTER_DRAIN = false;
    bf16* h3b; const bf16* hb; const bf16* ple; const float* rs3; float* ssq;
    DI void operator()(const pg8::f32x4 (&acc)[2][2][4][2], const pg8::Unit& u, int wr, int wc, int fr, int fq) const {
        asm volatile("" : "+v"(fr), "+v"(fq));
        const int row0 = u.pm * 256 + wr * 64 + fr, col0 = u.pn * 256 + wc * 32 + 4 * fq;
#pragma unroll
        for (int ai = 0; ai < 2; ++ai)
#pragma unroll
            for (int m = 0; m < 4; ++m) {
                const int row = row0 + ai * 128 + m * 16; const size_t off = (size_t)row * D_ + col0; float s = 0.f; const float rs = rs3[row];
#pragma unroll
                for (int bj = 0; bj < 2; ++bj)
#pragma unroll
                    for (int n = 0; n < 2; ++n) {
                        const u32x2 pw = *(const u32x2*)(ple + off + bj * 128 + n * 16);
                        const f32x4 pv = {bflo(pw.x), bfhi(pw.x), bflo(pw.y), bfhi(pw.y)};
                        const u32x2 hw = *(const u32x2*)(hb + off + bj * 128 + n * 16);
                        f32x4 v = {bflo(hw.x), bfhi(hw.x), bflo(hw.y), bfhi(hw.y)};
#pragma unroll
                        for (int i = 0; i < 4; ++i) v[i] += sigmoidf_(acc[ai][bj][m][n][i] * rs) * pv[i];
                        { u32x2 hw3; hw3.x = pk2(v[0], v[1]); hw3.y = pk2(v[2], v[3]); *(u32x2*)(h3b + off + bj * 128 + n * 16) = hw3; }
                        s += (v[0] * v[0] + v[1] * v[1]) + (v[2] * v[2] + v[3] * v[3]);
                    }
                s += __shfl_xor(s, 16); s += __shfl_xor(s, 32);
                if (fq == 0) ssq[(size_t)row * 32 + u.pn * 4 + wc] = s;
                if (m & 1) asm volatile("" ::: "memory");
            }
    }
};

DI unsigned fkey(float f, unsigned lowbits, unsigned mask) { unsigned u = __float_as_uint(f); u = (u & 0x80000000u) ? ~u : (u | 0x80000000u); return (u & ~mask) | lowbits; }
DI float fval(unsigned k, unsigned mask) { unsigned u = k & ~mask; u = (u & 0x80000000u) ? (u & 0x7fffffffu) : ~u; return __uint_as_float(u); }
template <int N> DI void bitonic_sort_desc(unsigned (&v)[N]) {
#pragma unroll
    for (int k = 2; k <= N; k <<= 1)
#pragma unroll
        for (int j = k >> 1; j > 0; j >>= 1)
#pragma unroll
            for (int i = 0; i < N; ++i) { const int l = i ^ j;
                if (l > i) { const bool desc = ((i & k) == 0); const unsigned a = v[i], b = v[l]; v[i] = desc ? max(a, b) : min(a, b); v[l] = desc ? min(a, b) : max(a, b); } }
}
DI void merge_top16(unsigned (&a)[16], const unsigned (&b)[16]) {
#pragma unroll
    for (int i = 0; i < 16; ++i) a[i] = max(a[i], b[15 - i]);
#pragma unroll
    for (int j = 8; j > 0; j >>= 1)
#pragma unroll
        for (int i = 0; i < 16; ++i) { const int l = i ^ j; if (l > i) { const unsigned x = a[i], y = a[l]; a[i] = max(x, y); a[l] = min(x, y); } }
}
DI void p7_route(Frame& F) {
    const bf16* qry = wsp<bf16>(F, WS_QRY); const bf16* skb = wsp<bf16>(F, WS_SKB);
    float* stat = wsp<float>(F, WS_STAT); const float* ssq2 = wsp<float>(F, WS_SSQ2);
    int* pidx = wsp<int>(F, WS_PIDX); float* pgate = wsp<float>(F, WS_PGATE);
    LAS unsigned* tops = (LAS unsigned*)F.lds;
    const int tid = F.tid, lane = F.lane, w = F.wave, r = lane & 31, hh = lane >> 5;
    const int tg = w & 3, p = w >> 2;
    for (int it = F.bid; it < (S_ / 128) * 2; it += F.G) {
        const int hg = it & 1, tb = it >> 1;
        const int t = tb * 128 + tg * 32 + r;
        float ss = 0.f;
        { const f32x4* sp = (const f32x4*)(ssq2 + (size_t)t * 32);
#pragma unroll
          for (int j = 0; j < 8; ++j) { const f32x4 v = sp[j]; ss += (v.x + v.y) + (v.z + v.w); } }
        const float rs2 = 1.f / sqrtf(ss * (1.f / D_) + EPS);
        if (hg == 0 && p == 0 && hh == 0) stat[ST_RS2 + t] = rs2;
        for (int hq = 0; hq < 4; ++hq) {
            const int h = hg * 4 + hq;
            bf16x8 Bq[8];
            { const bf16x8* qp = (const bf16x8*)(qry + (size_t)t * D_ + h * 256 + p * 128 + 8 * hh);
#pragma unroll
              for (int s = 0; s < 8; ++s) Bq[s] = qp[2 * s]; }
            unsigned kv[4][16];
            const bf16* kbase = skb + (size_t)((h * 2 + p) * NKEY) * 128;
#pragma unroll
            for (int kt = 0; kt < 4; ++kt) {
                f32x16 x;
#pragma unroll
                for (int i = 0; i < 16; ++i) x[i] = 0.f;
                const bf16x8* ap = (const bf16x8*)(kbase + (size_t)(kt * 32 + r) * 128 + 8 * hh);
#pragma unroll
                for (int s = 0; s < 8; ++s) x = __builtin_amdgcn_mfma_f32_32x32x16_bf16(ap[2 * s], Bq[s], x, 0, 0, 0);
#pragma unroll
                for (int i = 0; i < 16; ++i) { const int key = kt * 32 + crow(i, hh); kv[kt][i] = fkey(x[i] * rs2, (unsigned)(127 - key), 127u); }
            }
#pragma unroll
            for (int kt = 0; kt < 4; ++kt) bitonic_sort_desc<16>(kv[kt]);
            merge_top16(kv[0], kv[1]); merge_top16(kv[2], kv[3]); merge_top16(kv[0], kv[2]);
            unsigned (&tk)[16] = kv[0];
            {
                unsigned ok[16];
#pragma unroll
                for (int i = 0; i < 16; ++i) ok[i] = (unsigned)__shfl_xor((int)tk[i], 32);
                merge_top16(tk, ok);
            }
            if (hh == 0) {
                LAS u32x4* dst = (LAS u32x4*)(tops + (((tg * 32 + r) * 4 + hq) * 2 + p) * 16);
                dst[0] = (u32x4){tk[0], tk[1], tk[2], tk[3]}; dst[1] = (u32x4){tk[4], tk[5], tk[6], tk[7]}; dst[2] = (u32x4){tk[8], tk[9], tk[10], tk[11]}; dst[3] = (u32x4){tk[12], tk[13], tk[14], tk[15]};
            }
        }
        __syncthreads();
        {
            const int tl = tid & 127, hq = tid >> 7, h = hg * 4 + hq;
            const int tt = tb * 128 + tl;
            unsigned ka[16], kb[16];
            { const LAS u32x4* s = (const LAS u32x4*)(tops + ((tl * 4 + hq) * 2) * 16);
#pragma unroll
              for (int j = 0; j < 4; ++j) { const u32x4 a = s[j], b = s[4 + j]; ka[4 * j] = a.x; ka[4 * j + 1] = a.y; ka[4 * j + 2] = a.z; ka[4 * j + 3] = a.w; kb[4 * j] = b.x; kb[4 * j + 1] = b.y; kb[4 * j + 2] = b.z; kb[4 * j + 3] = b.w; } }
            float va[16], vb[16];
#pragma unroll
            for (int i = 0; i < 16; ++i) { va[i] = fval(ka[i], 127u); vb[i] = fval(kb[i], 127u); }
            unsigned cc[4][16];
#pragma unroll
            for (int gq = 0; gq < 4; ++gq)
#pragma unroll
                for (int k = 0; k < 16; ++k) cc[gq][k] = 0u;
            {
                int cnt = 0;
#pragma unroll
                for (int i = 0; i < 16; ++i)
#pragma unroll
                    for (int j = 0; j < 16; ++j) if ((i + 1) * (j + 1) <= 16) { cc[cnt >> 4][cnt & 15] = fkey(va[i] + vb[j], (unsigned)(255 - (i * 16 + j)), 255u); ++cnt; }
            }
#pragma unroll
            for (int gq = 0; gq < 4; ++gq) bitonic_sort_desc<16>(cc[gq]);
            merge_top16(cc[0], cc[1]); merge_top16(cc[2], cc[3]); merge_top16(cc[0], cc[2]);
            unsigned (&ck)[16] = cc[0];
            float sv[16]; float mxv = -INFINITY;
#pragma unroll
            for (int i = 0; i < 16; ++i) { sv[i] = fval(ck[i], 255u); mxv = fmaxf(mxv, sv[i]); }
            float den = 0.f;
#pragma unroll
            for (int i = 0; i < 16; ++i) { sv[i] = __expf(sv[i] - mxv); den += sv[i]; }
            const float iden = 1.f / den;
            int ev[16];
#pragma unroll
            for (int i = 0; i < 16; ++i) {
                const int pos = 255 - (int)(ck[i] & 255u), ci = pos >> 4, cj = pos & 15;
                unsigned ea = 0u, eb = 0u;
#pragma unroll
                for (int k = 0; k < 16; ++k) { ea = (ci == k) ? ka[k] : ea; eb = (cj == k) ? kb[k] : eb; }
                ev[i] = (int)((127u - (ea & 127u)) * 128u + (127u - (eb & 127u)));
                sv[i] *= iden;
            }
            u32x4* io = (u32x4*)(pidx + (size_t)tt * 128 + h * 16); f32x4* go = (f32x4*)(pgate + (size_t)tt * 128 + h * 16);
#pragma unroll
            for (int j = 0; j < 4; ++j) { io[j] = (u32x4){(unsigned)ev[4 * j], (unsigned)ev[4 * j + 1], (unsigned)ev[4 * j + 2], (unsigned)ev[4 * j + 3]}; go[j] = (f32x4){sv[4 * j], sv[4 * j + 1], sv[4 * j + 2], sv[4 * j + 3]}; }
        }
        __syncthreads();
    }
}

DI float gelu_erf(float v) {
    const float av = fabsf(v), t = __builtin_amdgcn_rcpf(av * 0.2316418882f + 1.0f);
    float q = t * 0.5307027145f + (-0.7265760135f); q = q * t + 0.7107068705f; q = q * t + (-0.142248368f); q = q * t + 0.127414796f; q = q * t;
    const float e = __builtin_amdgcn_exp2f((v * v) * (-0.72134752044f));
    const float m = v * (q * e);
    return v < 0.f ? m : v - m;
}
DI void p8_peer_sliced(Frame& F) {
    const unsigned char* down = wsp<unsigned char>(F, WS_DOWN); const unsigned char* up = wsp<unsigned char>(F, WS_UP);
    bf16* hb = wsp<bf16>(F, WS_H1B); float* stat = wsp<float>(F, WS_STAT);
    const int* pidx = wsp<int>(F, WS_PIDX); const float* pgate = wsp<float>(F, WS_PGATE);
    const int lane = F.lane, g = lane >> 3, l8 = lane & 7;
    const int qA = 16 * l8 + g, qB = qA + 8;
    LAS int* wsI = (LAS int*)(F.lds + F.wave * 10240) + lane;
    LAS float* wsF = (LAS float*)wsI;
#define PS(i, f) (((i) * 5 + (f)) * 64)
    for (int tbase = (F.bid * NWAVES + F.wave) * 8; tbase < S_; tbase += F.G * NWAVES * 8) {
#pragma unroll
        for (int i = 0; i < 8; ++i) { wsI[PS(i, 0)] = pidx[(unsigned)((tbase + i) * 128 + qA)]; wsI[PS(i, 1)] = pidx[(unsigned)((tbase + i) * 128 + qB)]; wsF[PS(i, 2)] = 0.f; wsF[PS(i, 3)] = 0.f; wsF[PS(i, 4)] = 0.f; }
        for (int s = 0; s < 16; ++s) {
#pragma unroll 1
            for (int i = 0; i < 8; ++i) {
                int ln = lane; asm volatile("" : "+v"(ln));
                const bool b0 = ln & 1, b1 = ln & 2, b2 = ln & 4;
                const int exA = wsI[PS(i, 0)], exB = wsI[PS(i, 1)];
                f32x2 hf[8];
                { const u32x4* hp = (const u32x4*)(hb + (unsigned)((tbase + i) * D_ + 128 * s + 16 * l8)); const u32x4 a = hp[0], b = hp[1];
                  hf[0] = (f32x2){bflo(a.x), bfhi(a.x)}; hf[1] = (f32x2){bflo(a.y), bfhi(a.y)}; hf[2] = (f32x2){bflo(a.z), bfhi(a.z)}; hf[3] = (f32x2){bflo(a.w), bfhi(a.w)};
                  hf[4] = (f32x2){bflo(b.x), bfhi(b.x)}; hf[5] = (f32x2){bflo(b.y), bfhi(b.y)}; hf[6] = (f32x2){bflo(b.z), bfhi(b.z)}; hf[7] = (f32x2){bflo(b.w), bfhi(b.w)}; }
                float pv[16];
#pragma unroll
                for (int hb2 = 0; hb2 < 1; ++hb2) {
                    u32x4 rv[16];
#pragma unroll
                    for (int j8 = 0; j8 < 16; ++j8) { const int jj = j8;
                        const int ex = __shfl((jj & 1) ? exB : exA, g * 8 + (jj >> 1));
                        rv[j8] = *(const u32x4*)(down + (unsigned)(ex * D_ + 128 * s + 16 * l8)); }
#pragma unroll
                    for (int j8 = 0; j8 < 16; ++j8) { f32x2 a2 = {0.f, 0.f};
#pragma unroll
                        for (int q = 0; q < 4; ++q) { a2 += hf[2 * q] * __builtin_amdgcn_cvt_pk_f32_fp8((int)rv[j8][q], false); a2 += hf[2 * q + 1] * __builtin_amdgcn_cvt_pk_f32_fp8((int)rv[j8][q], true); }
                        pv[j8] = a2.x + a2.y; }
                    __builtin_amdgcn_sched_barrier(0);
                }
                float p8[8], p4[4];
#pragma unroll
                for (int k = 0; k < 8; ++k) { const float snd = b2 ? pv[k] : pv[k + 8], kp = b2 ? pv[k + 8] : pv[k]; p8[k] = kp + __shfl_xor(snd, 4); }
#pragma unroll
                for (int k = 0; k < 4; ++k) { const float snd = b1 ? p8[k] : p8[k + 4], kp = b1 ? p8[k + 4] : p8[k]; p4[k] = kp + __shfl_xor(snd, 2); }
                { const float snd0 = b0 ? p4[0] : p4[2], kp0 = b0 ? p4[2] : p4[0], snd1 = b0 ? p4[1] : p4[3], kp1 = b0 ? p4[3] : p4[1];
                  wsF[PS(i, 2)] += kp0 + __shfl_xor(snd0, 1); wsF[PS(i, 3)] += kp1 + __shfl_xor(snd1, 1); }
            }
        }
#pragma unroll 1
        for (int i = 0; i < 8; ++i) {
            const float rs2 = stat[ST_RS2 + tbase + i] * (1.f / DSCALE);
            wsF[PS(i, 2)] = gelu_erf(wsF[PS(i, 2)] * rs2) * pgate[(unsigned)((tbase + i) * 128 + qA)] * (1.f / USCALE);
            wsF[PS(i, 3)] = gelu_erf(wsF[PS(i, 3)] * rs2) * pgate[(unsigned)((tbase + i) * 128 + qB)] * (1.f / USCALE);
        }
        for (int s = 0; s < 16; ++s) {
#pragma unroll 1
            for (int i = 0; i < 8; ++i) {
                int ln = lane; asm volatile("" : "+v"(ln));
                const bool b3 = ln & 8, b4 = ln & 16, b5 = ln & 32;
                const int exA = wsI[PS(i, 0)], exB = wsI[PS(i, 1)]; const float aA = wsF[PS(i, 2)], aB = wsF[PS(i, 3)];
                f32x2 acc2[8];
#pragma unroll
                for (int k = 0; k < 8; ++k) acc2[k] = (f32x2){0.f, 0.f};
#pragma unroll
                for (int hb2 = 0; hb2 < 1; ++hb2) {
                    u32x4 rv[16]; float av[16];
#pragma unroll
                    for (int j8 = 0; j8 < 16; ++j8) { const int jj = j8;
                        const int ex = __shfl((jj & 1) ? exB : exA, g * 8 + (jj >> 1));
                        av[j8] = __shfl((jj & 1) ? aB : aA, g * 8 + (jj >> 1));
                        rv[j8] = *(const u32x4*)(up + (unsigned)(ex * D_ + 128 * s + 16 * l8)); }
#pragma unroll
                    for (int j8 = 0; j8 < 16; ++j8) { const f32x2 a2 = {av[j8], av[j8]};
#pragma unroll
                        for (int q = 0; q < 4; ++q) { acc2[2 * q] += a2 * __builtin_amdgcn_cvt_pk_f32_fp8((int)rv[j8][q], false); acc2[2 * q + 1] += a2 * __builtin_amdgcn_cvt_pk_f32_fp8((int)rv[j8][q], true); } }
                    __builtin_amdgcn_sched_barrier(0);
                }
                float acc[16];
#pragma unroll
                for (int k = 0; k < 8; ++k) { acc[2 * k] = acc2[k].x; acc[2 * k + 1] = acc2[k].y; }
                float p8[8], p4[4];
#pragma unroll
                for (int k = 0; k < 8; ++k) { const float snd = b5 ? acc[k] : acc[k + 8], kp = b5 ? acc[k + 8] : acc[k]; p8[k] = kp + __shfl_xor(snd, 32); }
#pragma unroll
                for (int k = 0; k < 4; ++k) { const float snd = b4 ? p8[k] : p8[k + 4], kp = b4 ? p8[k + 4] : p8[k]; p4[k] = kp + __shfl_xor(snd, 16); }
                const float snd0 = b3 ? p4[0] : p4[2], kp0 = b3 ? p4[2] : p4[0], snd1 = b3 ? p4[1] : p4[3], kp1 = b3 ? p4[3] : p4[1];
                const float o0 = kp0 + __shfl_xor(snd0, 8), o1 = kp1 + __shfl_xor(snd1, 8);
                const unsigned off = (unsigned)((tbase + i) * D_ + 128 * s + 16 * l8 + 2 * g);
                const unsigned hw = *(const unsigned*)(hb + off);
                f32x2 x = {bflo(hw) + o0, bfhi(hw) + o1};
                *(unsigned*)(hb + off) = pk2(x.x, x.y);
                wsF[PS(i, 4)] += x.x * x.x + x.y * x.y;
            }
        }
#pragma unroll 1
        for (int i = 0; i < 8; ++i) { const float ss = wave_sum(wsF[PS(i, 4)]); if (lane == 0) stat[ST_RS3 + tbase + i] = 1.f / sqrtf(ss * (1.f / D_) + EPS); }
    }
#undef PS
}

DI void p10_final(Frame& F) {
    const float* ssq4 = wsp<float>(F, WS_SSQ4); const float* gain = F.in[15]; const bf16* h3b = wsp<bf16>(F, WS_QRY);
    const int NGW = F.G * NWAVES;
    f32x4 gr[8];
#pragma unroll
    for (int j = 0; j < 4; ++j) { gr[2 * j] = ((const f32x4*)gain)[2 * F.lane + 128 * j]; gr[2 * j + 1] = ((const f32x4*)gain)[2 * F.lane + 128 * j + 1]; }
    for (int m0 = F.bid * NWAVES + F.wave; m0 < S_; m0 += 4 * NGW) {
        float sv[4]; u32x4 w[4][4];
#pragma unroll
        for (int u = 0; u < 4; ++u) { const int m = m0 + u * NGW;
            if (m < S_) { sv[u] = (F.lane < 32) ? ssq4[(size_t)m * 32 + F.lane] : 0.f; const u32x4* hr = (const u32x4*)(h3b + (size_t)m * D_) + F.lane;
#pragma unroll
                for (int j = 0; j < 4; ++j) w[u][j] = hr[64 * j]; } }
#pragma unroll
        for (int u = 0; u < 4; ++u) { const int m = m0 + u * NGW;
            if (m < S_) { const float rs = 1.f / sqrtf(wave_sum(sv[u]) * (1.f / D_) + EPS); f32x4* xr = (f32x4*)(F.out + (size_t)m * D_) + 2 * F.lane;
#pragma unroll
                for (int j = 0; j < 4; ++j) { const u32x4 ww = w[u][j];
                    xr[128 * j] = (f32x4){bflo(ww.x), bfhi(ww.x), bflo(ww.y), bfhi(ww.y)} * rs * gr[2 * j];
                    xr[128 * j + 1] = (f32x4){bflo(ww.z), bfhi(ww.z), bflo(ww.w), bfhi(ww.w)} * rs * gr[2 * j + 1]; } } }
    }
}

constexpr int NPHASES = 11;
struct Args { const float* in[16]; float* out; unsigned char* ws; int ph_lo, ph_hi; };
DI int lane_id() { return (int)__builtin_amdgcn_mbcnt_hi(~0u, __builtin_amdgcn_mbcnt_lo(~0u, 0u)); }
DI Frame make_frame(LAS unsigned char* lds, int wave0) {
    typedef const Args __attribute__((address_space(4))) * cargs_t;
    cargs_t ap = (cargs_t)__builtin_amdgcn_kernarg_segment_ptr();
    asm volatile("" : "+s"(ap));
    Frame F;
    F.lds = lds;
    F.tid = threadIdx.x; F.lane = F.tid & 63; F.wave = __builtin_amdgcn_readfirstlane(F.tid >> 6); (void)wave0;
    F.G = gridDim.x; F.bid = blockIdx.x;
#pragma unroll
    for (int i = 0; i < 16; ++i) F.in[i] = ap->in[i];
    F.out = ap->out; F.ws = ap->ws; F.ctl = (unsigned*)(ap->ws + WS_CTL);
    return F;
}
__global__ void __launch_bounds__(NTHREADS, 2) mega_fwd(Args args) {
    extern __shared__ __attribute__((aligned(16))) unsigned char lds_[];
    LAS unsigned char* lds = (LAS unsigned char*)lds_;
    volatile LAS unsigned* MISC = (volatile LAS unsigned*)(lds + MISC_OFF);
    const int wave0 = __builtin_amdgcn_readfirstlane(threadIdx.x >> 6);
    if (threadIdx.x < 64) MISC[threadIdx.x] = 0u;
    __syncthreads();
    const int lo = args.ph_lo, hi = args.ph_hi;
    XcdBarrier bar; bar.bar = (unsigned*)(args.ws + WS_CTL) + CW_BAR; bar.x = 0; bar.st = nullptr;
    if (hi - lo > 1) bar = xcd_barrier_post((unsigned*)(args.ws + WS_CTL) + CW_BAR, MISC + 8, (int)threadIdx.x);
#ifdef ONLY_PHASE
#define IN(k) ((k) == ONLY_PHASE && lo <= (k) && (k) < hi)
#else
#define IN(k) (lo <= (k) && (k) < hi)
#endif
#ifdef TIME_PHASE
#define STAMP(k) do { if (blockIdx.x == 0 && threadIdx.x == 0) { const unsigned long long _t = __builtin_amdgcn_s_memrealtime(); MISC[16 + 2 * (k)] = (unsigned)_t; MISC[17 + 2 * (k)] = (unsigned)(_t >> 32); } } while (0)
#else
#define STAMP(k) do { } while (0)
#endif
#define SEAM(k) do { if (IN(k) && IN((k) + 1)) xcd_barrier(bar, (int)threadIdx.x); STAMP((k) + 1); } while (0)
    STAMP(0);

    if (IN(0)) { Frame F = make_frame(lds, wave0); p0_prologue(F); }
    SEAM(0);
    if (IN(1)) {
        Frame F = make_frame(lds, wave0);
        const float* stat = wsp<float>(F, WS_STAT);
        {
            pg8::Gemm g{(const bf16*)F.out, wsp<bf16>(F, WS_W1T), S_, 3 * AW, D_ / 2}; pg8::StaticOrder S; S.init(S_, 3 * AW, F.G, F.bid);
            Epi1<0> E{wsp<bf16>(F, WS_Q), wsp<bf16>(F, WS_K), wsp<bf16>(F, WS_VT), wsp<bf16>(F, WS_HQ), wsp<bf16>(F, WS_HLF), wsp<bf16>(F, WS_HV), wsp<bf16>(F, WS_HG), wsp<float>(F, WS_KPART), stat + ST_RS1Q};
            pg8::gemm_phase<Epi1<0>, pg8::StaticOrder, PG8_ALIGN, PG8_SP2, true>(F.lds, g, S, E, F.tid); }
        {
            pg8::Gemm g{wsp<bf16>(F, WS_XB), wsp<bf16>(F, WS_W1TB), S_, 4 * AW, D_}; pg8::StaticOrder S; S.init(S_, 4 * AW, F.G, F.bid);
            Epi1<3> E{wsp<bf16>(F, WS_Q), wsp<bf16>(F, WS_K), wsp<bf16>(F, WS_VT), wsp<bf16>(F, WS_HQ), wsp<bf16>(F, WS_HLF), wsp<bf16>(F, WS_HV), wsp<bf16>(F, WS_HG), wsp<float>(F, WS_KPART), stat + ST_RS1};
            int tid2 = F.tid; asm volatile("" : "+v"(tid2));
            pg8::gemm_phase<Epi1<3>, pg8::StaticOrder, PG8_ALIGN, PG8_SP2, false>(F.lds, g, S, E, tid2); }
    }
    SEAM(1);
    if (IN(2)) {
        Frame F = make_frame(lds, wave0);
        p2_gate(F);
        hgrn_mfma<false>(F);
    }
    SEAM(2);
    if (IN(3)) { Frame F = make_frame(lds, wave0); p3_attn(F);
        hgrn_scan(F); }
    SEAM(3);
    if (IN(4)) {
        Frame F = make_frame(lds, wave0);
        p4_combine(F);
        hgrn_mfma<true>(F);
    }
    SEAM(4);
    if (IN(5)) {
        Frame F = make_frame(lds, wave0);
        pg8::Gemm g{wsp<bf16>(F, WS_MIX), wsp<bf16>(F, WS_W2T), S_, D_, D_ / 2}; pg8::StaticOrder S; S.init(S_, D_, F.G, F.bid);
        Epi2 E{F.in[0], F.out, wsp<bf16>(F, WS_H1B), wsp<float>(F, WS_SSQ2)};
        pg8::gemm_phase<Epi2, pg8::StaticOrder, PG8_ALIGN, PG8_SP2, true>(F.lds, g, S, E, F.tid);
    }
    SEAM(5);
    if (IN(6)) {
        Frame F = make_frame(lds, wave0);
        pg8::Gemm g{wsp<bf16>(F, WS_H1B), wsp<bf16>(F, WS_WQT), S_, D_, D_}; pg8::StaticOrder S; S.init(S_, D_, F.G, F.bid);
        EpiB E{wsp<bf16>(F, WS_QRY), D_};
        pg8::gemm_phase<EpiB, pg8::StaticOrder, PG8_ALIGN, PG8_SP2>(F.lds, g, S, E, F.tid);
    }
    SEAM(6);
    if (IN(7)) { Frame F = make_frame(lds, wave0); p7_route(F); }
    SEAM(7);
    if (IN(8)) { Frame F = make_frame(lds, wave0); p8_peer_sliced(F); }
    SEAM(8);
    if (IN(9)) {
        { Frame F = make_frame(lds, wave0); pg8::StaticOrder S; S.init(S_, D_, F.G, F.bid);
          pg8::Gemm g{wsp<bf16>(F, WS_PB), wsp<bf16>(F, WS_WPT), S_, D_, PLE}; EpiP E{wsp<bf16>(F, WS_PLE)};
          pg8::gemm_phase<EpiP, pg8::StaticOrder, PG8_ALIGN, PG8_SP2>(F.lds, g, S, E, F.tid); }
        { Frame F = make_frame(lds, wave0); pg8::StaticOrder S; S.init(S_, D_, F.G, F.bid);
          pg8::Gemm g{wsp<bf16>(F, WS_H1B), wsp<bf16>(F, WS_WGT), S_, D_, D_}; Epi4 E{wsp<bf16>(F, WS_QRY), wsp<bf16>(F, WS_H1B), wsp<bf16>(F, WS_PLE), wsp<float>(F, WS_STAT) + ST_RS3, wsp<float>(F, WS_SSQ4)};
          pg8::gemm_phase<Epi4, pg8::StaticOrder, PG8_ALIGN, PG8_SP2>(F.lds, g, S, E, F.tid); }
    }
    SEAM(9);
    if (IN(10)) { Frame F = make_frame(lds, wave0); p10_final(F); }
#ifdef TIME_PHASE
    if (blockIdx.x == 0) {
        __syncthreads();
        if (threadIdx.x == 0) {
            const unsigned long long tend = __builtin_amdgcn_s_memrealtime();
            const unsigned long long a = ((unsigned long long)MISC[17 + 2 * TIME_PHASE] << 32) | MISC[16 + 2 * TIME_PHASE];
            const unsigned long long b = (TIME_PHASE == 10) ? tend : (((unsigned long long)MISC[19 + 2 * TIME_PHASE] << 32) | MISC[18 + 2 * TIME_PHASE]);
            const unsigned long long wait = 10ull * (b - a);
            while (__builtin_amdgcn_s_memrealtime() - tend < wait) __builtin_amdgcn_s_sleep(32);
        }
    }
#endif
#undef IN
#undef SEAM
}

extern "C" void kernel_launch(void* const* d_in, const int* in_sizes, int n_in, void* d_out, int out_size, void* d_ws, size_t ws_size, hipStream_t stream) {
    static int grid = 0;
    if (grid == 0) {
        if (n_in != 16 || out_size != S_ * D_ || ws_size < WS_END) { fprintf(stderr, "kernel_launch: unexpected problem (n_in %d, out %d, ws %zu < %zu)\n", n_in, out_size, ws_size, (size_t)WS_END); grid = -1; return; }
        int dev = 0, cus = 0, per_cu = 0;
        if (hipGetDevice(&dev) != hipSuccess || hipDeviceGetAttribute(&cus, hipDeviceAttributeMultiprocessorCount, dev) != hipSuccess) { grid = -1; return; }
        if (hipFuncSetAttribute((const void*)mega_fwd, hipFuncAttributeMaxDynamicSharedMemorySize, LDS_BYTES) != hipSuccess) { fprintf(stderr, "kernel_launch: hipFuncSetAttribute failed\n"); grid = -1; return; }
        if (hipOccupancyMaxActiveBlocksPerMultiprocessor(&per_cu, (const void*)mega_fwd, NTHREADS, LDS_BYTES) != hipSuccess || per_cu < 1) { fprintf(stderr, "kernel_launch: occupancy query says %d\n", per_cu); (void)hipGetLastError(); }
        grid = cus;
    }
    if (grid < 0) return;
    (void)hipMemsetAsync((char*)d_ws + WS_CTL, 0, CTL_ZERO_BYTES, stream);
    Args a{};
    for (int i = 0; i < 16; ++i) a.in[i] = (const float*)d_in[i];
    a.out = (float*)d_out; a.ws = (unsigned char*)d_ws;
#if MK_PER_PHASE
    for (int ph = 0; ph < NPHASES; ++ph) {
        a.ph_lo = ph; a.ph_hi = ph + 1;
        hipLaunchKernelGGL(mega_fwd, dim3(grid), dim3(NTHREADS), LDS_BYTES, stream, a);
    }
#else
    a.ph_lo = 0; a.ph_hi = NPHASES;
    void* kargs[] = {&a};
    hipError_t e = hipLaunchCooperativeKernel((const void*)mega_fwd, dim3(grid), dim3(NTHREADS), kargs, LDS_BYTES, stream);
    if (e != hipSuccess) fprintf(stderr, "kernel_launch: cooperative launch failed: %s\n", hipGetErrorString(e));
#endif
}
```

```cpp
#include <hip/hip_runtime.h>
#include <cstdio>
#include <cstdint>

#ifndef MK_PER_PHASE
#define MK_PER_PHASE 0
#endif

namespace pg8 {
#define PG8_LAS __attribute__((address_space(3)))
typedef unsigned short bf16_t;
typedef short bf16x8 __attribute__((ext_vector_type(8)));
typedef float f32x4 __attribute__((ext_vector_type(4)));
typedef unsigned u32x4 __attribute__((ext_vector_type(4)));
constexpr int BM = 256, BK = 64, HALF = 128, HTB = HALF * BK * 2, STAGE_BYTES = 8 * HTB, NXCD = 8, WGM = 8;

__host__ __device__ __forceinline__ int lds_byte(int r, int c) { const int st = (r >> 4) * 2 + (c >> 5), rr = r & 15, cc = c & 31, ob = rr * 64 + cc * 2; return st * 1024 + (ob ^ (((ob >> 9) & 1) << 5)); }
__host__ __device__ __forceinline__ void stage_rc(int b, int& R, int& C) { const int st = b / 1024, sb = b % 1024, swz = sb ^ (((sb >> 9) & 1) << 5); R = (st >> 1) * 16 + swz / 64; C = (st & 1) * 32 + (swz % 64) / 2; }
__host__ __device__ __forceinline__ int perm32(int rho) { const int n = rho >> 4, i = rho & 15; return 8 * (i >> 2) + 4 * n + (i & 3); }

struct Unit { int pm, pn; };
struct Gemm { const bf16_t* A; const bf16_t* Bt; int M, N, K; };

struct StaticOrder {
    int nM, nN, nwg, G, c;
    __host__ __device__ void init(int M, int N, int G_, int c_) { nM = M / BM; nN = N / BM; nwg = nM * nN; G = G_; c = c_; }
    __host__ __device__ bool next(int i, Unit& u) const {
        const long L = (long)i * G + c; if (L >= nwg) return false;
        int wgid = (int)L; { const int q = nwg / NXCD, r = nwg % NXCD, xcd = wgid % NXCD, off = wgid / NXCD; wgid = (xcd < r ? xcd * (q + 1) : r * (q + 1) + (xcd - r) * q) + off; }
        const int nig = WGM * nN, gid = wgid / nig, fm = gid * WGM, gsz = (nM - fm) < WGM ? (nM - fm) : WGM;
        u.pm = fm + ((wgid % nig) % gsz); u.pn = (wgid % nig) / gsz; return true;
    }
    __device__ __forceinline__ void a_ready(const Unit&) const {}
    __device__ __forceinline__ void done(const Unit&) const {}
};

typedef int i32x8 __attribute__((ext_vector_type(8)));
template <bool FP8> struct FragSel { typedef bf16x8 A_t[4][2]; typedef bf16x8 B_t[2][2]; };
template <> struct FragSel<true> { typedef i32x8 A_t[4]; typedef i32x8 B_t[2]; };
template <class Epi, class Sched, bool ALIGN_EPI = false, bool SP2 = false, bool FP8 = false>
__device__ __forceinline__ void gemm_phase(PG8_LAS unsigned char* lds, const Gemm g, const Sched& S, const Epi& E, const int tid) {
    const int wid = __builtin_amdgcn_readfirstlane(tid >> 6), lane = tid & 63, wr = wid >> 2, wc = wid & 3, fr = lane & 15, fq = lane >> 4;
    int K_ = g.K; asm volatile("" : "+s"(K_));
    const int K = K_, nt = K / BK;
    unsigned voffA[2], voffB[2];
#pragma unroll
    for (int i = 0; i < 2; ++i) { int R, C; stage_rc(tid * 16 + i * 8192, R, C); const int Rb = Epi::PERM ? ((R & ~31) + perm32(R & 31)) : R;
        voffA[i] = (unsigned)(R * K + C) * 2u; voffB[i] = (unsigned)(Rb * K + C) * 2u; }
    const size_t kstep = (size_t)(BK * 2);
    const size_t hstep = (size_t)HALF * K * 2;
    const size_t tstep = 2 * hstep;
    const unsigned ldsw = (unsigned)wid * 1024u;
    const int fcol = FP8 ? (16 * (fq & 1) + 32 * (fq >> 1)) : fq * 8;
    const int aoff = lds_byte(wr * 64 + fr, fcol), boff = lds_byte(wc * 32 + fr, fcol);

#define PG8_SA(b, h) (((b) * 2 + (h)) * HTB)
#define PG8_SB(b, h) ((4 + (b) * 2 + (h)) * HTB)
#define PG8_STAGE(bufoff, gbase, voff) do { _Pragma("unroll") for (int _i = 0; _i < 2; ++_i) \
        __builtin_amdgcn_global_load_lds((const unsigned*)((const char*)(gbase) + (voff)[_i]), (PG8_LAS unsigned*)(lds + (bufoff) + ldsw + _i * 8192), 16, 0, 0); } while (0)
#define PG8_LDA(dst, b, h) do { if constexpr (FP8) { _Pragma("unroll") for (int m = 0; m < 4; ++m) dst[m] = *(const PG8_LAS i32x8*)(lds + PG8_SA(b, h) + aoff + m * 2048); } \
        else { _Pragma("unroll") for (int m = 0; m < 4; ++m) _Pragma("unroll") for (int k = 0; k < 2; ++k) dst[m][k] = *(const PG8_LAS bf16x8*)(lds + PG8_SA(b, h) + aoff + m * 2048 + k * 1024); } } while (0)
#define PG8_LDB(dst, b, h) do { if constexpr (FP8) { _Pragma("unroll") for (int n = 0; n < 2; ++n) dst[n] = *(const PG8_LAS i32x8*)(lds + PG8_SB(b, h) + boff + n * 2048); } \
        else { _Pragma("unroll") for (int n = 0; n < 2; ++n) _Pragma("unroll") for (int k = 0; k < 2; ++k) dst[n][k] = *(const PG8_LAS bf16x8*)(lds + PG8_SB(b, h) + boff + n * 2048 + k * 1024); } } while (0)
#define PG8_MMA(ai, bj, At, Bt) do { __builtin_amdgcn_s_setprio(1); \
        if constexpr (FP8) { _Pragma("unroll") for (int m = 0; m < 4; ++m) _Pragma("unroll") for (int n = 0; n < 2; ++n) \
            asm volatile("v_mfma_scale_f32_16x16x128_f8f6f4 %0, %1, %2, %0, %3, %3 op_sel_hi:[0,0,0]" : "+v"(acc[ai][bj][m][n]) : "v"(Bt[n]), "v"(At[m]), "v"(one_scale)); } \
        else { _Pragma("unroll") for (int m = 0; m < 4; ++m) _Pragma("unroll") for (int n = 0; n < 2; ++n) _Pragma("unroll") for (int k = 0; k < 2; ++k) \
            acc[ai][bj][m][n] = __builtin_amdgcn_mfma_f32_16x16x32_bf16(Bt[n][k], At[m][k], acc[ai][bj][m][n], 0, 0, 0); } \
        __builtin_amdgcn_s_setprio(0); } while (0)
#define PG8_WAIT_V(n) asm volatile("s_waitcnt vmcnt(" #n ")" ::: "memory")
#define PG8_WAIT_L(n) asm volatile("s_waitcnt lgkmcnt(" #n ")" ::: "memory")
#define PG8_BAR __builtin_amdgcn_s_barrier()
#define PG8_SCHED __builtin_amdgcn_sched_barrier(0)
    int one_scale = 0x7f7f7f7f;
    asm volatile("" : "+v"(one_scale));
    Unit cur, nxt; int ui = 0;
    if (!S.next(0, cur)) return;
    f32x4 acc[2][2][4][2];
#pragma unroll
    for (int a = 0; a < 2; ++a)
#pragma unroll
        for (int b = 0; b < 2; ++b)
#pragma unroll
            for (int m = 0; m < 4; ++m)
#pragma unroll
                for (int n = 0; n < 2; ++n) acc[a][b][m][n] = (f32x4){0.f, 0.f, 0.f, 0.f};
    typename FragSel<FP8>::A_t At; typename FragSel<FP8>::B_t B0, B1;
    const char* cA = (const char*)g.A + (size_t)cur.pm * tstep; const char* cB = (const char*)g.Bt + (size_t)cur.pn * tstep;
    S.a_ready(cur);
    if constexpr (SP2) {
        PG8_STAGE(PG8_SB(0, 0), cB, voffB); PG8_STAGE(PG8_SB(0, 1), cB + hstep, voffB); PG8_STAGE(PG8_SA(0, 0), cA, voffA); PG8_STAGE(PG8_SA(0, 1), cA + hstep, voffA);
        if (wr == 1) PG8_BAR;
        PG8_WAIT_V(2); PG8_BAR;
        PG8_STAGE(PG8_SB(1, 0), cB + kstep, voffB); PG8_STAGE(PG8_SA(1, 0), cA + kstep, voffA); PG8_STAGE(PG8_SB(1, 1), cB + hstep + kstep, voffB);
        PG8_WAIT_V(6); PG8_BAR;
    } else {
        PG8_STAGE(PG8_SB(0, 0), cB, voffB); PG8_STAGE(PG8_SA(0, 0), cA, voffA); PG8_STAGE(PG8_SB(0, 1), cB + hstep, voffB); PG8_STAGE(PG8_SA(0, 1), cA + hstep, voffA);
        if (wr == 1) PG8_BAR;
        PG8_WAIT_V(4); PG8_BAR;
        PG8_STAGE(PG8_SB(1, 0), cB + kstep, voffB); PG8_STAGE(PG8_SA(1, 0), cA + kstep, voffA); PG8_STAGE(PG8_SB(1, 1), cB + hstep + kstep, voffB);
        PG8_WAIT_V(6); PG8_BAR;
    }
    for (;;) {
        const bool has_next = S.next(ui + 1, nxt);
        const char* nA = has_next ? (const char*)g.A + (size_t)nxt.pm * tstep : cA; const char* nB = has_next ? (const char*)g.Bt + (size_t)nxt.pn * tstep : cB;
        for (int t = 0; t < nt; t += 2) {
            const bool last = (t == nt - 2);
            const char* a1 = cA + (size_t)(t + 1) * kstep;
            const char* a2 = last ? nA : cA + (size_t)(t + 2) * kstep; const char* b2 = last ? nB : cB + (size_t)(t + 2) * kstep;
            const char* a3 = a2 + kstep; const char* b3 = b2 + kstep;
            if (last && has_next) S.a_ready(nxt);
            if constexpr (SP2) {
            PG8_LDB(B0, 0, 0); PG8_LDB(B1, 0, 1); PG8_SCHED; PG8_LDA(At, 0, 0); PG8_STAGE(PG8_SA(1, 1), a1 + hstep, voffA);
            PG8_WAIT_V(8); PG8_WAIT_L(0); PG8_BAR; PG8_MMA(0, 0, At, B0); PG8_MMA(0, 1, At, B1); PG8_BAR; PG8_SCHED;
            PG8_LDA(At, 0, 1); PG8_STAGE(PG8_SB(0, 0), b2, voffB); PG8_STAGE(PG8_SB(0, 1), b2 + hstep, voffB); PG8_STAGE(PG8_SA(0, 0), a2, voffA);
            PG8_WAIT_V(8); PG8_WAIT_L(0); PG8_BAR; PG8_MMA(1, 0, At, B0); PG8_MMA(1, 1, At, B1); PG8_BAR; PG8_SCHED;
            PG8_LDB(B0, 1, 0); PG8_LDB(B1, 1, 1); PG8_SCHED; PG8_LDA(At, 1, 0); PG8_STAGE(PG8_SA(0, 1), a2 + hstep, voffA);
            PG8_WAIT_V(8); PG8_WAIT_L(0); PG8_BAR; PG8_MMA(0, 0, At, B0); PG8_MMA(0, 1, At, B1); PG8_BAR; PG8_SCHED;
            PG8_LDA(At, 1, 1); PG8_STAGE(PG8_SB(1, 0), b3, voffB); PG8_STAGE(PG8_SB(1, 1), b3 + hstep, voffB); PG8_STAGE(PG8_SA(1, 0), a3, voffA);
            PG8_WAIT_V(8); PG8_WAIT_L(0); PG8_BAR; PG8_MMA(1, 0, At, B0); PG8_MMA(1, 1, At, B1); PG8_BAR; PG8_SCHED;
            } else {
            PG8_LDB(B0, 0, 0); PG8_SCHED; PG8_LDA(At, 0, 0); PG8_STAGE(PG8_SA(1, 1), a1 + hstep, voffA);
            PG8_WAIT_L(8); PG8_BAR; PG8_WAIT_L(0); PG8_MMA(0, 0, At, B0); PG8_BAR; PG8_SCHED;
            PG8_LDB(B1, 0, 1); PG8_STAGE(PG8_SB(0, 0), b2, voffB);
            PG8_BAR; PG8_WAIT_L(0); PG8_MMA(0, 1, At, B1); PG8_BAR;
            PG8_LDA(At, 0, 1); PG8_STAGE(PG8_SA(0, 0), a2, voffA);
            PG8_BAR; PG8_WAIT_L(0); PG8_MMA(1, 0, At, B0); PG8_BAR; PG8_SCHED;
            PG8_STAGE(PG8_SB(0, 1), b2 + hstep, voffB);
            PG8_WAIT_V(6); PG8_BAR; PG8_MMA(1, 1, At, B1); PG8_BAR;
            PG8_LDB(B0, 1, 0); PG8_SCHED; PG8_LDA(At, 1, 0); PG8_STAGE(PG8_SA(0, 1), a2 + hstep, voffA);
            PG8_WAIT_L(8); PG8_BAR; PG8_WAIT_L(0); PG8_MMA(0, 0, At, B0); PG8_BAR; PG8_SCHED;
            PG8_LDB(B1, 1, 1); PG8_STAGE(PG8_SB(1, 0), b3, voffB);
            PG8_BAR; PG8_WAIT_L(0); PG8_MMA(0, 1, At, B1); PG8_BAR;
            PG8_LDA(At, 1, 1); PG8_STAGE(PG8_SA(1, 0), a3, voffA);
            PG8_BAR; PG8_WAIT_L(0); PG8_MMA(1, 0, At, B0); PG8_BAR; PG8_SCHED;
            PG8_STAGE(PG8_SB(1, 1), b3 + hstep, voffB);
            PG8_WAIT_V(6); PG8_BAR; PG8_MMA(1, 1, At, B1); PG8_BAR;
            }
        }
        if constexpr (ALIGN_EPI) { if (wr == 0) PG8_BAR; }
        if constexpr (FP8) asm volatile("s_nop 15\n\ts_nop 15" ::: "memory");
        E(acc, cur, wr, wc, fr, fq); S.done(cur);
        if (!has_next) break;
#pragma unroll
        for (int a = 0; a < 2; ++a)
#pragma unroll
            for (int b = 0; b < 2; ++b)
#pragma unroll
                for (int m = 0; m < 4; ++m)
#pragma unroll
                    for (int n = 0; n < 2; ++n) acc[a][b][m][n] = (f32x4){0.f, 0.f, 0.f, 0.f};
        cur = nxt; cA = nA; cB = nB; ++ui;
        if constexpr (ALIGN_EPI) { if (wr == 1) PG8_BAR; }
    }
    PG8_WAIT_V(0);
    if constexpr (!ALIGN_EPI) { if (wr == 0) PG8_BAR; }
    PG8_BAR;
#undef PG8_SA
#undef PG8_SB
#undef PG8_STAGE
#undef PG8_LDA
#undef PG8_LDB
#undef PG8_MMA
#undef PG8_WAIT_V
#undef PG8_WAIT_L
#undef PG8_BAR
#undef PG8_SCHED
}
}

#define PG8_SP2 true
#define PG8_ALIGN true

constexpr int NWAVES = 8, NTHREADS = 512;
constexpr int S_ = 16384, D_ = 2048, NIN = 7168, AW = 1024, NH = 8, HD = 128, NBLK = 64, LBLK = 256;
constexpr int PLE = 256, NEXP = 16384, PH = 8, NKEY = 128, PTOP = 16;
constexpr float EPS = 1e-6f;
constexpr float QSCALE = 0.08838834764831845f * 1.4426950408889634f;
constexpr float XSCALE = 16.f, W1SCALE = 512.f;
constexpr float MSCALE = 8.f;
constexpr float OSCALE = 32.f;
constexpr float DSCALE = 512.f, USCALE = 32.f;
constexpr int HSC = 64, HSCLEN = 256, HSUB = 32;
constexpr int LSTRIDE = 256 * (63 * 64 / 2);
__host__ __device__ __forceinline__ int list_off(int n) { return 256 * (63 * n - (n * (n - 1)) / 2); }

constexpr size_t MiB = 1u << 20;
constexpr size_t WS_CTL = 0, CTL_ZERO_BYTES = 1 * MiB;
constexpr size_t WS_W1T = 2 * MiB  , WS_W1TB = 10 * MiB  , WS_W2T = 30 * MiB, WS_WQT = 38 * MiB, WS_WGT = 46 * MiB, WS_WPT = 54 * MiB, WS_SKB = 55 * MiB;
constexpr size_t WS_STAT = 56 * MiB;
constexpr size_t WS_SSQ2 = 57 * MiB, WS_SSQ4 = 59 * MiB;
constexpr size_t WS_KPART = 61 * MiB, WS_HDEC = 62 * MiB;
constexpr size_t WS_PB = 63 * MiB;
constexpr size_t WS_DOWN = 71 * MiB, WS_UP = 135 * MiB;
constexpr size_t WS_R1 = 199 * MiB;
constexpr size_t WS_XB = WS_R1, WS_LIST = WS_R1, WS_PML = WS_R1 + 16 * MiB, WS_HST = WS_R1 + 20 * MiB, WS_H1B = WS_R1;
constexpr size_t WS_R2 = 263 * MiB;
constexpr size_t WS_Q = WS_R2, WS_K = WS_R2 + 32 * MiB, WS_VT = WS_R2 + 64 * MiB, WS_MIX = WS_R2, WS_QRY = WS_R2, WS_PIDX = WS_R2 + 64 * MiB, WS_PGATE = WS_R2 + 72 * MiB;
constexpr size_t WS_R3 = 359 * MiB;
constexpr size_t WS_HQ = WS_R3, WS_HLF = WS_R3 + 32 * MiB, WS_HV = WS_R3 + 64 * MiB, WS_HG = WS_R3 + 96 * MiB, WS_PLE = WS_R3;
constexpr size_t WS_END = 487 * MiB;
constexpr int CW_BAR = 4096;
constexpr int CW_GCNT = 16384;
constexpr int ST_RS1 = 0, ST_LB = S_, ST_RS2 = S_ + 1024, ST_RS3 = 2 * S_ + 1024, ST_RS1Q = 3 * S_ + 1024;

constexpr int RING_BYTES = 131072;
constexpr int LDS_BYTES = 147456;
constexpr int MISC_OFF = LDS_BYTES - 256;

#define LAS __attribute__((address_space(3)))
typedef unsigned short bf16;
typedef unsigned u32x4 __attribute__((ext_vector_type(4)));
typedef unsigned u32x2 __attribute__((ext_vector_type(2)));
typedef float f32x4 __attribute__((ext_vector_type(4)));
typedef float f32x2 __attribute__((ext_vector_type(2)));
typedef float f32x16 __attribute__((ext_vector_type(16)));
typedef short bf16x8 __attribute__((ext_vector_type(8)));
typedef short s16x4 __attribute__((ext_vector_type(4)));
typedef __bf16 bf16x2n __attribute__((ext_vector_type(2)));
#define RLX_AGENT __ATOMIC_RELAXED, __HIP_MEMORY_SCOPE_AGENT
#define LDS_WAIT() asm volatile("s_waitcnt lgkmcnt(0)" ::: "memory")
#define DI __device__ __forceinline__

DI unsigned pk2(float lo, float hi) { f32x2 v = {lo, hi}; bf16x2n b = __builtin_convertvector(v, bf16x2n); return __builtin_bit_cast(unsigned, b); }
DI float sat8(float v) { return __builtin_amdgcn_fmed3f(v, -440.f, 440.f); }
DI float bflo(unsigned u) { return __uint_as_float(u << 16); }
DI float bfhi(unsigned u) { return __uint_as_float(u & 0xffff0000u); }
DI float wave_sum(float v) {
#pragma unroll
    for (int o = 1; o < 64; o <<= 1) v += __shfl_xor(v, o);
    return v;
}
DI float sigmoidf_(float x) { return 1.f / (1.f + __expf(-x)); }
DI float siluf_(float x) { return x / (1.f + __expf(-x)); }
DI int crow(int reg, int h) { return (reg & 3) + 8 * (reg >> 2) + 4 * h; }

#define XB_TMO      128
#define XB_XCNT(j)  (256  + 64 * (j))
#define XB_XSUB(j)  (1280 + 64 * (j))
#define XB_XGEN(j)  (2304 + 64 * (j))
#define XB_TOP      3328
#define XB_TOPGEN   3392
#define XCD_BAR_WORDS 3456
#define XB_SPIN_CAP (1u << 22)
DI unsigned xb_ld(unsigned* p)              { return __hip_atomic_load(p, __ATOMIC_RELAXED, __HIP_MEMORY_SCOPE_AGENT); }
DI unsigned xb_add(unsigned* p, unsigned v) { return __hip_atomic_fetch_add(p, v, __ATOMIC_RELAXED, __HIP_MEMORY_SCOPE_AGENT); }
DI unsigned xb_xcc_id() { return (unsigned)__builtin_amdgcn_s_getreg((3 << 11) | 20) & 0xFu; }
#define XB_SPIN(cond, bar) do { unsigned _sp = 0; while (cond) { __builtin_amdgcn_s_sleep(1); \
    if ((++_sp & 255u) == 0u) { if (xb_ld(&(bar)[XB_TMO])) break; if (_sp > XB_SPIN_CAP) { atomicAdd(&(bar)[XB_TMO], 1u); break; } } } } while (0)
struct XcdBarrier { unsigned* bar; unsigned x; volatile LAS unsigned* st; };
DI XcdBarrier xcd_barrier_post(unsigned* bar, volatile LAS unsigned* st, int tid) {
    XcdBarrier b; b.bar = bar; b.x = xb_xcc_id(); b.st = st;
    if (tid == 0) (void)xb_add(&bar[XB_XCNT(b.x)], 1u);
    return b;
}
DI void xcd_barrier_complete(unsigned* bar, unsigned x, unsigned& nloc, unsigned& nx) {
    const unsigned G = gridDim.x * gridDim.y * gridDim.z;
    unsigned sum, cnt, mine, sp = 0u;
    for (;;) {
        sum = 0u; cnt = 0u; mine = 0u;
#pragma unroll
        for (unsigned j = 0; j < 16; ++j) { const unsigned c = xb_ld(&bar[XB_XCNT(j)]); sum += c; cnt += (c > 0u) ? 1u : 0u; mine = (j == x) ? c : mine; }
        if (sum == G) break;
        __builtin_amdgcn_s_sleep(1);
        if ((++sp & 255u) == 0u) { if (xb_ld(&bar[XB_TMO])) break; if (sp > XB_SPIN_CAP) { atomicAdd(&bar[XB_TMO], 1u); break; } }
    }
    nloc = mine > 0u ? mine : 1u; nx = cnt > 0u ? cnt : 1u;
}
DI void xcd_barrier(const XcdBarrier& b, int tid) {
    asm volatile("s_waitcnt vmcnt(0)" ::: "memory");
    __syncthreads();
    if (tid == 0) {
        unsigned* bar = b.bar;
        __builtin_amdgcn_s_waitcnt(0);
        unsigned nloc = b.st[0], nx = b.st[1];
        if (nloc == 0u) { xcd_barrier_complete(bar, b.x, nloc, nx); b.st[0] = nloc; b.st[1] = nx; }
        const unsigned old = xb_add(&bar[XB_XSUB(b.x)], 1u);
        const unsigned gen = old / nloc;
        if (old + 1u == (gen + 1u) * nloc) {
            __builtin_amdgcn_fence(__ATOMIC_RELEASE, "agent");
            asm volatile("s_waitcnt vmcnt(0)" ::: "memory");
            const unsigned og = xb_add(&bar[XB_TOP], 1u);
            const unsigned tg = og / nx;
            if (og + 1u == (tg + 1u) * nx) xb_add(&bar[XB_TOPGEN], 1u);
            else XB_SPIN(xb_ld(&bar[XB_TOPGEN]) == tg, bar);
            __builtin_amdgcn_fence(__ATOMIC_ACQUIRE, "agent");
            xb_add(&bar[XB_XGEN(b.x)], 1u);
            asm volatile("s_waitcnt vmcnt(0)" ::: "memory");
        } else {
            XB_SPIN(xb_ld(&bar[XB_XGEN(b.x)]) == gen, bar);
            __builtin_amdgcn_fence(__ATOMIC_ACQUIRE, "agent");
            asm volatile("s_waitcnt vmcnt(0)" ::: "memory");
        }
    }
    __syncthreads();
}

struct Frame {
    LAS unsigned char* lds;
    unsigned* ctl;
    int tid, lane, wave, G, bid;
    const float* in[16];
    float* out;
    unsigned char* ws;
};
template <class T> DI T* wsp(const Frame& F, size_t off) { return (T*)(F.ws + off); }

constexpr int TP_PITCH = 65, TP_WAVE_BYTES = 64 * TP_PITCH * 4 + 64;
template <bool FP8 = false> DI void p0_transpose_item(const float* W, const float* gain, int K, int N, bf16* WT, LAS float* scr, int item, int lane, int nscaled = 0, float nscale = 1.f, float allscale = 1.f) {
    const int nblk = N / 64, kb = item / nblk, nb = item % nblk, k0 = 64 * kb, n0 = 64 * nb; const float osc = ((n0 < nscaled) ? nscale : 1.f) * allscale;
    const int kr = lane >> 4, n4 = (lane & 15) * 4;
    f32x4 v[16];
#pragma unroll
    for (int i = 0; i < 16; ++i) v[i] = *(const f32x4*)(W + (size_t)(k0 + 4 * i + kr) * N + n0 + n4);
#pragma unroll
    for (int i = 0; i < 16; ++i) { const int kk = 4 * i + kr; const float g = (gain ? gain[k0 + kk] : 1.f) * osc;
        scr[(n4 + 0) * TP_PITCH + kk] = v[i].x * g; scr[(n4 + 1) * TP_PITCH + kk] = v[i].y * g; scr[(n4 + 2) * TP_PITCH + kk] = v[i].z * g; scr[(n4 + 3) * TP_PITCH + kk] = v[i].w * g; }
    LDS_WAIT(); asm volatile("" ::: "memory");
    const int c = lane & 7, nn = lane >> 3;
#pragma unroll
    for (int j = 0; j < 8; ++j) { const int n = nn + 8 * j; const LAS float* sp = scr + n * TP_PITCH + 8 * c;
        if constexpr (FP8) {
            int w0 = __builtin_amdgcn_cvt_pk_fp8_f32(sp[0], sp[1], 0, false); w0 = __builtin_amdgcn_cvt_pk_fp8_f32(sp[2], sp[3], w0, true);
            int w1 = __builtin_amdgcn_cvt_pk_fp8_f32(sp[4], sp[5], 0, false); w1 = __builtin_amdgcn_cvt_pk_fp8_f32(sp[6], sp[7], w1, true);
            *(u32x2*)((unsigned char*)WT + (size_t)(n0 + n) * K + k0 + 8 * c) = (u32x2){(unsigned)w0, (unsigned)w1};
        } else {
            u32x4 o; o.x = pk2(sp[0], sp[1]); o.y = pk2(sp[2], sp[3]); o.z = pk2(sp[4], sp[5]); o.w = pk2(sp[6], sp[7]);
            *(u32x4*)(WT + (size_t)(n0 + n) * K + k0 + 8 * c) = o; } }
    LDS_WAIT(); asm volatile("" ::: "memory");
}
DI void p0_convert(const float* src, bf16* dst, size_t n8, const float* colgain, size_t gtid, size_t gstride) {
    for (size_t i = gtid; i < n8; i += gstride) {
        f32x4 a = *(const f32x4*)(src + i * 8), b = *(const f32x4*)(src + i * 8 + 4);
        if (colgain) { const int c = (int)((i * 8) & 2047); a = a * *(const f32x4*)(colgain + c); b = b * *(const f32x4*)(colgain + c + 4); }
        u32x4 o; o.x = pk2(a.x, a.y); o.y = pk2(a.z, a.w); o.z = pk2(b.x, b.y); o.w = pk2(b.z, b.w);
        *(u32x4*)(dst + i * 8) = o;
    }
}
DI void p0_convert_fp8(const float* src, unsigned char* dst, size_t nelem, const float* colgain, float scale, size_t gwave, size_t nwaves, int lane) {
    const size_t nunit = nelem / 2048;
    for (size_t u = gwave; u < nunit; u += nwaves) {
        const float* sp = src + u * 2048 + lane * 4; unsigned char* dp = dst + u * 2048 + lane * 4;
        f32x4 a[8];
#pragma unroll
        for (int q = 0; q < 8; ++q) a[q] = __builtin_nontemporal_load((const f32x4*)(sp + q * 256));
#pragma unroll
        for (int q = 0; q < 8; ++q) {
            f32x4 v = a[q];
            if (colgain) v = v * *(const f32x4*)(colgain + q * 256 + lane * 4);
            v = v * scale;
            int w = __builtin_amdgcn_cvt_pk_fp8_f32(v.x, v.y, 0, false);
            w = __builtin_amdgcn_cvt_pk_fp8_f32(v.z, v.w, w, true);
            __builtin_nontemporal_store((unsigned)w, (unsigned*)(dp + q * 256));
        }
    }
}
DI void p0_prologue(Frame& F) {
    LAS float* scr = (LAS float*)(F.lds + F.wave * TP_WAVE_BYTES);
    const int gw = F.bid * NWAVES + F.wave, NGW = F.G * NWAVES;
    const float* x = F.in[0];
    constexpr int I1 = (D_ / 64) * (NIN / 64), I2 = (D_ / 64) * (D_ / 64), IP = (PLE / 64) * (D_ / 64);
    constexpr int NITEMS = I1 + 3 * I2 + IP;
    for (int it = gw; it < NITEMS; it += NGW) {
        int r = it;
        if (r < I1) {
            const int nb = r % (NIN / 64);
            if (nb < 3 * AW / 64) p0_transpose_item<true>(F.in[3], F.in[2], D_, NIN, wsp<bf16>(F, WS_W1T), scr, r, F.lane, AW, QSCALE, W1SCALE);
            else p0_transpose_item<false>(F.in[3], F.in[2], D_, NIN, wsp<bf16>(F, WS_W1TB) - (size_t)3 * AW * D_, scr, r, F.lane);
            continue; } r -= I1;
        if (r < I2) { p0_transpose_item<true>(F.in[6], nullptr, D_, D_, wsp<bf16>(F, WS_W2T), scr, r, F.lane, 0, 1.f, W1SCALE); continue; } r -= I2;
        if (r < I2) { p0_transpose_item(F.in[8], F.in[7], D_, D_, wsp<bf16>(F, WS_WQT), scr, r, F.lane); continue; } r -= I2;
        if (r < I2) { p0_transpose_item(F.in[14], F.in[12], D_, D_, wsp<bf16>(F, WS_WGT), scr, r, F.lane); continue; } r -= I2;
        p0_transpose_item(F.in[13], nullptr, PLE, D_, wsp<bf16>(F, WS_WPT), scr, r, F.lane);
    }
    float* stat = wsp<float>(F, WS_STAT);
    bf16* xb = wsp<bf16>(F, WS_XB);
    for (int m = gw; m < S_; m += NGW) {
        const f32x4* xr = (const f32x4*)(x + (size_t)m * D_) + F.lane;
        f32x4 v[8]; float s = 0.f;
#pragma unroll
        for (int j = 0; j < 8; ++j) { v[j] = xr[64 * j]; s += (v[j].x * v[j].x + v[j].y * v[j].y) + (v[j].z * v[j].z + v[j].w * v[j].w); }
        s = wave_sum(s);
        if (F.lane == 0) { const float rs = 1.f / sqrtf(s * (1.f / D_) + EPS); stat[ST_RS1 + m] = rs; stat[ST_RS1Q + m] = rs * (1.f / (XSCALE * W1SCALE)); }
        u32x2* o8 = (u32x2*)(xb + (size_t)m * D_) + F.lane;
#pragma unroll
        for (int j = 0; j < 8; ++j) { u32x2 w; w.x = pk2(v[j].x, v[j].y); w.y = pk2(v[j].z, v[j].w); o8[64 * j] = w; }
        unsigned* o4 = (unsigned*)((unsigned char*)F.out + (size_t)m * D_) + F.lane;
#pragma unroll
        for (int j = 0; j < 8; ++j) { int w = __builtin_amdgcn_cvt_pk_fp8_f32(sat8(v[j].x * XSCALE), sat8(v[j].y * XSCALE), 0, false); w = __builtin_amdgcn_cvt_pk_fp8_f32(sat8(v[j].z * XSCALE), sat8(v[j].w * XSCALE), w, true); o4[64 * j] = (unsigned)w; }
    }
    const size_t gtid = (size_t)F.bid * NTHREADS + F.tid, gstride = (size_t)F.G * NTHREADS;
    p0_convert(F.in[1], wsp<bf16>(F, WS_PB), (size_t)S_ * PLE / 8, nullptr, gtid, gstride);
    p0_convert(F.in[9], wsp<bf16>(F, WS_SKB), (size_t)PH * 2 * NKEY * 128 / 8, nullptr, gtid, gstride);
    {
    p0_convert_fp8(F.in[10], wsp<unsigned char>(F, WS_DOWN), (size_t)NEXP * D_, F.in[7], DSCALE, (size_t)gw, (size_t)NGW, F.lane);
    p0_convert_fp8(F.in[11], wsp<unsigned char>(F, WS_UP), (size_t)NEXP * D_, nullptr, USCALE, (size_t)gw, (size_t)NGW, F.lane); }
    for (size_t i = gtid; i < 1024; i += gstride) { const float l0 = F.in[4][i], l1 = F.in[4][1024 + i]; stat[ST_LB + i] = 1.f / (1.f + __expf(l1 - l0)); }
}

template <int RBASE> struct Epi1 {
    static constexpr bool PERM = true, AFTER_DRAIN = false;
    bf16 *q, *k, *vt, *hq, *hlf, *hv, *hg; float* kpart; const float* rs1;
    template <int R> DI void run(const pg8::f32x4 (&acc)[2][2][4][2], const pg8::Unit& u, int wr, int wc, int fr, int fq, bf16* dst) const {
        const int cb = (u.pn & 3) * 256;
        const int row0 = u.pm * 256 + wr * 64 + fr;
        const int colw = cb + wc * 32 + 8 * fq;
        f32x4 cs[2][2];
        if (R == 1) { cs[0][0] = cs[0][1] = cs[1][0] = cs[1][1] = (f32x4){0.f, 0.f, 0.f, 0.f}; }
#pragma unroll
        for (int ai = 0; ai < 2; ++ai)
#pragma unroll
            for (int m = 0; m < 4; ++m) {
                const int row = row0 + ai * 128 + m * 16;
                const float rs = rs1[row];
#pragma unroll
                for (int bj = 0; bj < 2; ++bj) {
                    const f32x4 v0 = acc[ai][bj][m][0] * rs, v1 = acc[ai][bj][m][1] * rs;
                    const int col = colw + 128 * bj;
                    if (R == 1) { cs[bj][0] = cs[bj][0] + v0; cs[bj][1] = cs[bj][1] + v1; }
                    if (R == 2) {
                        bf16* p = dst + (size_t)col * S_ + row;
#pragma unroll
                        for (int i = 0; i < 4; ++i) { p[(size_t)i * S_] = (bf16)(pk2(v0[i], 0.f) & 0xffffu); p[(size_t)(i + 4) * S_] = (bf16)(pk2(v1[i], 0.f) & 0xffffu); }
                    } else {
                        u32x4 w; w.x = pk2(v0[0], v0[1]); w.y = pk2(v0[2], v0[3]); w.z = pk2(v1[0], v1[1]); w.w = pk2(v1[2], v1[3]);
                        *(u32x4*)(dst + (size_t)row * AW + col) = w;
                    }
                }
                asm volatile("" ::: "memory");
            }
        if (R == 1) {
#pragma unroll
            for (int bj = 0; bj < 2; ++bj)
#pragma unroll
                for (int n = 0; n < 2; ++n)
#pragma unroll
                    for (int i = 0; i < 4; ++i) {
                        float s = cs[bj][n][i];
                        s += __shfl_xor(s, 1); s += __shfl_xor(s, 2); s += __shfl_xor(s, 4); s += __shfl_xor(s, 8);
                        if (fr == 0) kpart[(size_t)(wr * NBLK + u.pm) * AW + colw + 128 * bj + 4 * n + i] = s;
                    }
        }
    }
    DI void operator()(const pg8::f32x4 (&acc)[2][2][4][2], const pg8::Unit& u, int wr, int wc, int fr, int fq) const {
        asm volatile("" : "+v"(fr), "+v"(fq));
        const int reg = RBASE + (u.pn >> 2);
        if constexpr (RBASE == 0) {
            if (reg == 1) run<1>(acc, u, wr, wc, fr, fq, k);
            else if (reg == 2) run<2>(acc, u, wr, wc, fr, fq, vt);
            else run<0>(acc, u, wr, wc, fr, fq, q);
        } else { bf16* dst = hq + (size_t)(reg - 3) * ((WS_HLF - WS_HQ) / 2); run<0>(acc, u, wr, wc, fr, fq, dst); }
    }
};

DI void ins3(float v, int i, float& v0, float& v1, float& v2, int& i0, int& i1, int& i2) {
    const bool c0 = v > v0, c1 = v > v1, c2 = v > v2;
    v2 = c1 ? v1 : (c2 ? v : v2); i2 = c1 ? i1 : (c2 ? i : i2);
    v1 = c0 ? v0 : (c1 ? v : v1); i1 = c0 ? i0 : (c1 ? i : i1);
    v0 = c0 ? v : v0; i0 = c0 ? i : i0;
}
DI void p2_gate(Frame& F) {
    LAS unsigned char* kmh = F.lds;
    LAS unsigned char* kml = F.lds + 64 * 272;
    LAS int* lcnt = (LAS int*)(F.lds + 2 * 64 * 272);
    LAS int* lbase = lcnt + 64;
    const float* kpart = wsp<float>(F, WS_KPART);
    const bf16* q = wsp<bf16>(F, WS_Q);
    unsigned* gcnt = F.ctl + CW_GCNT;
    int* list = wsp<int>(F, WS_LIST);
    const int tid = F.tid, lane = F.lane, w = F.wave, r = lane & 31, hh = lane >> 5;
    for (int it = F.bid; it < NH * 63; it += F.G) {
        const int h = it & 7, qb = 63 - (it >> 3);
        for (int i = tid; i < 64 * 64; i += NTHREADS) {
            const int n = i >> 6, d = 2 * (i & 63);
            f32x2 a = {0.f, 0.f};
            if (n < qb) { const f32x2 p0 = *(const f32x2*)(kpart + (size_t)n * AW + h * HD + d), p1 = *(const f32x2*)(kpart + (size_t)(NBLK + n) * AW + h * HD + d); a = p0 + p1; }
            const unsigned hi = pk2(a.x, a.y);
            const unsigned lo = pk2(a.x - bflo(hi), a.y - bfhi(hi));
            *(LAS unsigned*)(kmh + n * 272 + d * 2) = hi; *(LAS unsigned*)(kml + n * 272 + d * 2) = lo;
        }
        if (tid < 64) lcnt[tid] = 0;
        __syncthreads();
        const int t = qb * LBLK + w * 32 + r;
        bf16x8 Qf[8];
        { const bf16x8* qp = (const bf16x8*)(q + (size_t)t * AW + h * HD + 8 * hh);
#pragma unroll
          for (int s = 0; s < 8; ++s) Qf[s] = qp[2 * s]; }
        float v0 = -INFINITY, v1 = -INFINITY, v2 = -INFINITY; int i0 = -1, i1 = -1, i2 = -1;
#pragma unroll
        for (int nt = 0; nt < 2; ++nt) {
            if (nt * 32 < qb) {
                f32x16 x;
#pragma unroll
                for (int i = 0; i < 16; ++i) x[i] = 0.f;
#pragma unroll
                for (int s = 0; s < 8; ++s) {
                    const bf16x8 ah = *(const LAS bf16x8*)(kmh + (nt * 32 + r) * 272 + 32 * s + 16 * hh), al = *(const LAS bf16x8*)(kml + (nt * 32 + r) * 272 + 32 * s + 16 * hh);
                    x = __builtin_amdgcn_mfma_f32_32x32x16_bf16(ah, Qf[s], x, 0, 0, 0);
                    x = __builtin_amdgcn_mfma_f32_32x32x16_bf16(al, Qf[s], x, 0, 0, 0);
                }
#pragma unroll
                for (int i = 0; i < 16; ++i) { const int n = nt * 32 + crow(i, hh); ins3(n < qb ? x[i] : -INFINITY, n < qb ? n : -1, v0, v1, v2, i0, i1, i2); }
            }
        }
        {
            const float p0 = __shfl_xor(v0, 32), p1 = __shfl_xor(v1, 32), p2 = __shfl_xor(v2, 32);
            const int j0 = __shfl_xor(i0, 32), j1 = __shfl_xor(i1, 32), j2 = __shfl_xor(i2, 32);
            ins3(p0, j0, v0, v1, v2, i0, i1, i2);
            ins3(p1, j1, v0, v1, v2, i0, i1, i2);
            ins3(p2, j2, v0, v1, v2, i0, i1, i2);
        }
        int r0 = 0, r1 = 0, r2 = 0;
        if (hh == 0) {
            if (i0 >= 0) r0 = __hip_atomic_fetch_add(lcnt + i0, 1, __ATOMIC_RELAXED, __HIP_MEMORY_SCOPE_WORKGROUP);
            if (i1 >= 0) r1 = __hip_atomic_fetch_add(lcnt + i1, 1, __ATOMIC_RELAXED, __HIP_MEMORY_SCOPE_WORKGROUP);
            if (i2 >= 0) r2 = __hip_atomic_fetch_add(lcnt + i2, 1, __ATOMIC_RELAXED, __HIP_MEMORY_SCOPE_WORKGROUP);
        }
        __syncthreads();
        if (tid < 64) { const int c = lcnt[tid]; lbase[tid] = c ? (int)__hip_atomic_fetch_add(gcnt + h * NBLK + tid, (unsigned)c, RLX_AGENT) : 0; }
        __syncthreads();
        if (hh == 0) {
            int* lh = list + (size_t)h * LSTRIDE;
            if (i0 >= 0) lh[list_off(i0) + lbase[i0] + r0] = (t << 2) | 0;
            if (i1 >= 0) lh[list_off(i1) + lbase[i1] + r1] = (t << 2) | 1;
            if (i2 >= 0) lh[list_off(i2) + lbase[i2] + r2] = (t << 2) | 2;
        }
        __syncthreads();
    }
}

constexpr int HG_QM = 0, HG_KM = 8704, HG_QD = 17408, HG_KDT = 25856, HG_VT = 36096, HG_O = 46336, HG_TOT = 62720, HG_DL = 64768, HG_BYTES = 65280;
constexpr int HG_RS = 272, HG_RD = 264, HG_RT = 80;
static_assert(2 * HG_BYTES <= MISC_OFF, "hgrn LDS map");
DI bf16x8 pack8(const f32x16& x, int s) {
    u32x4 p; p.x = pk2(x[8 * s + 0], x[8 * s + 1]); p.y = pk2(x[8 * s + 2], x[8 * s + 3]); p.z = pk2(x[8 * s + 4], x[8 * s + 5]); p.w = pk2(x[8 * s + 6], x[8 * s + 7]);
    return __builtin_bit_cast(bf16x8, p);
}
template <bool READOUT> DI void hgrn_mfma(Frame& F) {
    const int w = F.wave, grp = w >> 2, wq = w & 3, lane = F.lane, r = lane & 31, hh = lane >> 5, p = lane;
    LAS unsigned char* L = F.lds + grp * HG_BYTES;
    const bf16* hq = wsp<bf16>(F, WS_HQ); const bf16* hlf = wsp<bf16>(F, WS_HLF); const bf16* hv = wsp<bf16>(F, WS_HV); const bf16* hg = wsp<bf16>(F, WS_HG);
    const float* lbp = wsp<float>(F, WS_STAT) + ST_LB;
    bf16* mixed = wsp<bf16>(F, WS_MIX);
    for (int base = F.bid * 2; base < NH * HSC; base += 2 * F.G) {
        const int it = base + grp, h = it & 7, sc = it >> 3;
        float* hst = wsp<float>(F, WS_HST) + ((size_t)sc * NH + h) * (HD * HD);
        f32x16 S[4];
#pragma unroll
        for (int kb = 0; kb < 4; ++kb)
#pragma unroll
            for (int i = 0; i < 16; ++i) S[kb][i] = READOUT ? hst[(size_t)(kb * 32 + crow(i, hh)) * HD + wq * 32 + r] : 0.f;
        const float lb0 = lbp[h * HD + 2 * p], lb1 = lbp[h * HD + 2 * p + 1];
        const int lt = wq * 64 + lane, nt = lt >> 3, nvg = lt & 7;
        f32x4 gn[4];
        if (READOUT) {
#pragma unroll
            for (int j = 0; j < 4; ++j) gn[j] = *(const f32x4*)(F.in[5] + h * HD + nvg * 16 + 4 * j);
        }
        float sumbl0 = 0.f, sumbl1 = 0.f;
        unsigned xf[8], xq[8], xv[8];
        const size_t gcol = (size_t)h * HD + 2 * p;
        {   const size_t t0 = (size_t)sc * HSCLEN + 8 * wq;
#pragma unroll
            for (int i = 0; i < 8; ++i) { xf[i] = *(const unsigned*)(hlf + (t0 + i) * AW + gcol); xv[i] = *(const unsigned*)(hv + (t0 + i) * AW + gcol); if (READOUT) xq[i] = *(const unsigned*)(hq + (t0 + i) * AW + gcol); } }
        for (int c = 0; c < HSCLEN / 32; ++c) {
            const int tc = sc * HSCLEN + c * 32;
            float bl0[8], bl1[8], f0[8], f1[8];
            {   float run0 = 0.f, run1 = 0.f;
#pragma unroll
                for (int i = 0; i < 8; ++i) {
                    const float fa = lb0 + (1.f - lb0) * sigmoidf_(bflo(xf[i])), fb = lb1 + (1.f - lb1) * sigmoidf_(bfhi(xf[i]));
                    run0 += __logf(fa); run1 += __logf(fb); bl0[i] = run0; bl1[i] = run1; f0[i] = fa; f1[i] = fb;
                }
                *(LAS f32x2*)(L + HG_TOT + (wq * 128 + 2 * p) * 4) = (f32x2){run0, run1};
            }
            __syncthreads();
            {
                float off0 = 0.f, off1 = 0.f, bm0, bm1, be0, be1;
                {   f32x2 tq[4];
#pragma unroll
                    for (int q = 0; q < 4; ++q) tq[q] = *(const LAS f32x2*)(L + HG_TOT + (q * 128 + 2 * p) * 4);
#pragma unroll
                    for (int q = 0; q < 4; ++q) if (q < wq) { off0 += tq[q].x; off1 += tq[q].y; }
                    bm0 = tq[0].x + tq[1].x; bm1 = tq[0].y + tq[1].y; be0 = bm0 + tq[2].x + tq[3].x; be1 = bm1 + tq[2].y + tq[3].y; }
                if (wq == 0) { *(LAS f32x2*)(L + HG_DL + 2 * p * 4) = (f32x2){__expf(be0), __expf(be1)}; sumbl0 += be0; sumbl1 += be1; }
                const float em0 = __expf(-bm0), em1 = __expf(-bm1), ek0 = __expf(bm0 - be0), ek1 = __expf(bm1 - be1);
                unsigned kd0[4], kd1[4], vt0[4], vt1[4];
#pragma unroll
                for (int i = 0; i < 8; ++i) {
                    const int t = 8 * wq + i;
                    const float b0 = bl0[i] + off0, b1 = bl1[i] + off1;
                    const float k0 = 1.f - f0[i], k1 = 1.f - f1[i];
                    const float kdv0 = k0 * __expf(be0 - b0), kdv1 = k1 * __expf(be1 - b1);
                    if (READOUT) {
                        const float q0 = siluf_(bflo(xq[i])), q1 = siluf_(bfhi(xq[i]));
                        const float qd0 = q0 * __expf(b0), qd1 = q1 * __expf(b1);
                        *(LAS unsigned*)(L + HG_QD + t * HG_RD + 4 * p) = pk2(qd0, qd1);
                        *(LAS unsigned*)(L + HG_QM + t * HG_RS + 4 * p) = pk2(qd0 * em0, qd1 * em1);
                        *(LAS unsigned*)(L + HG_KM + t * HG_RS + 4 * p) = pk2(kdv0 * ek0, kdv1 * ek1);
                    }
                    if (i & 1) { kd0[i >> 1] |= pk2(0.f, kdv0) ; kd1[i >> 1] |= pk2(0.f, kdv1); vt0[i >> 1] |= xv[i] << 16; vt1[i >> 1] |= xv[i] & 0xffff0000u; }
                    else { kd0[i >> 1] = pk2(kdv0, 0.f); kd1[i >> 1] = pk2(kdv1, 0.f); vt0[i >> 1] = xv[i] & 0xffffu; vt1[i >> 1] = xv[i] >> 16; }
                }
                *(LAS u32x4*)(L + HG_KDT + (2 * p) * HG_RT + 16 * wq) = (u32x4){kd0[0], kd0[1], kd0[2], kd0[3]};
                *(LAS u32x4*)(L + HG_KDT + (2 * p + 1) * HG_RT + 16 * wq) = (u32x4){kd1[0], kd1[1], kd1[2], kd1[3]};
                *(LAS u32x4*)(L + HG_VT + (2 * p) * HG_RT + 16 * wq) = (u32x4){vt0[0], vt0[1], vt0[2], vt0[3]};
                *(LAS u32x4*)(L + HG_VT + (2 * p + 1) * HG_RT + 16 * wq) = (u32x4){vt1[0], vt1[1], vt1[2], vt1[3]};
            }
            __syncthreads();
            if (c + 1 < HSCLEN / 32) { const size_t t0 = (size_t)tc + 32 + 8 * wq;
#pragma unroll
                for (int i = 0; i < 8; ++i) { xf[i] = *(const unsigned*)(hlf + (t0 + i) * AW + gcol); xv[i] = *(const unsigned*)(hv + (t0 + i) * AW + gcol); if (READOUT) xq[i] = *(const unsigned*)(hq + (t0 + i) * AW + gcol); } }
            u32x4 gg0, gg1;
            if (READOUT) { const u32x4* gp = (const u32x4*)(hg + (size_t)(tc + nt) * AW + h * HD + nvg * 16); gg0 = gp[0]; gg1 = gp[1]; }
            if (READOUT) {
                f32x16 X, Y;
#pragma unroll
                for (int i = 0; i < 16; ++i) { X[i] = 0.f; Y[i] = 0.f; }
#pragma unroll
                for (int st = 0; st < 8; ++st) {
                    const bf16x8 a = *(const LAS bf16x8*)(L + HG_KM + r * HG_RS + 32 * st + 16 * hh), b = *(const LAS bf16x8*)(L + HG_QM + r * HG_RS + 32 * st + 16 * hh);
                    X = __builtin_amdgcn_mfma_f32_32x32x16_bf16(a, b, X, 0, 0, 0);
                }
#pragma unroll
                for (int i = 0; i < 16; ++i) if (crow(i, hh) > r) X[i] = 0.f;
#pragma unroll
                for (int kb = 0; kb < 4; ++kb)
#pragma unroll
                    for (int st = 0; st < 2; ++st) {
                        const LAS u32x2* qp = (const LAS u32x2*)(L + HG_QD + r * HG_RD + (kb * 32 + 16 * st + 4 * hh) * 2);
                        const u32x2 a0 = qp[0], a1 = qp[2]; const u32x4 av = {a0.x, a0.y, a1.x, a1.y};
                        Y = __builtin_amdgcn_mfma_f32_32x32x16_bf16(__builtin_bit_cast(bf16x8, av), pack8(S[kb], st), Y, 0, 0, 0);
                    }
#pragma unroll
                for (int st = 0; st < 2; ++st) {
                    const LAS u32x2* vp = (const LAS u32x2*)(L + HG_VT + (wq * 32 + r) * HG_RT + (16 * st + 4 * hh) * 2);
                    const u32x2 b0 = vp[0], b1 = vp[2]; const u32x4 bv = {b0.x, b0.y, b1.x, b1.y};
                    Y = __builtin_amdgcn_mfma_f32_32x32x16_bf16(pack8(X, st), __builtin_bit_cast(bf16x8, bv), Y, 0, 0, 0);
                }
#pragma unroll
                for (int i = 0; i < 16; ++i) *(LAS float*)(L + HG_O + crow(i, hh) * 512 + (wq * 32 + r) * 4) = Y[i];
            }
#pragma unroll
            for (int kb = 0; kb < 4; ++kb) {
#pragma unroll
                for (int g4 = 0; g4 < 4; ++g4) { const f32x4 d = *(const LAS f32x4*)(L + HG_DL + (kb * 32 + 8 * g4 + 4 * hh) * 4);
#pragma unroll
                    for (int j = 0; j < 4; ++j) S[kb][4 * g4 + j] *= d[j]; }
#pragma unroll
                for (int st = 0; st < 2; ++st) {
                    const bf16x8 a = *(const LAS bf16x8*)(L + HG_KDT + (kb * 32 + r) * HG_RT + 32 * st + 16 * hh), b = *(const LAS bf16x8*)(L + HG_VT + (wq * 32 + r) * HG_RT + 32 * st + 16 * hh);
                    S[kb] = __builtin_amdgcn_mfma_f32_32x32x16_bf16(a, b, S[kb], 0, 0, 0);
                }
            }
            __syncthreads();
            if (READOUT) {
                f32x4 o[4]; float ss = 0.f;
#pragma unroll
                for (int j = 0; j < 4; ++j) { o[j] = *(const LAS f32x4*)(L + HG_O + nt * 512 + (nvg * 16 + 4 * j) * 4); ss += (o[j].x * o[j].x + o[j].y * o[j].y) + (o[j].z * o[j].z + o[j].w * o[j].w); }
                ss += __shfl_xor(ss, 1); ss += __shfl_xor(ss, 2); ss += __shfl_xor(ss, 4);
                const float rr = 1.f / sqrtf(ss * (1.f / HD) + EPS);
                const unsigned gw[8] = {gg0.x, gg0.y, gg0.z, gg0.w, gg1.x, gg1.y, gg1.z, gg1.w};
                u32x4 o8;
#pragma unroll
                for (int j = 0; j < 4; ++j) {
                    const float g0 = siluf_(bflo(gw[2 * j])), g1 = siluf_(bfhi(gw[2 * j])), g2 = siluf_(bflo(gw[2 * j + 1])), g3 = siluf_(bfhi(gw[2 * j + 1]));
                    const float sc = rr * MSCALE;
                    int wv = __builtin_amdgcn_cvt_pk_fp8_f32(sat8(o[j].x * sc * gn[j].x * g0), sat8(o[j].y * sc * gn[j].y * g1), 0, false);
                    wv = __builtin_amdgcn_cvt_pk_fp8_f32(sat8(o[j].z * sc * gn[j].z * g2), sat8(o[j].w * sc * gn[j].w * g3), wv, true);
                    o8[j] = (unsigned)wv;
                }
                *(u32x4*)((unsigned char*)mixed + (size_t)(tc + nt) * D_ + AW + h * HD + nvg * 16) = o8;
            }
        }
        if (!READOUT) {
#pragma unroll
            for (int kb = 0; kb < 4; ++kb)
#pragma unroll
                for (int i = 0; i < 16; ++i) hst[(size_t)(kb * 32 + crow(i, hh)) * HD + wq * 32 + r] = S[kb][i];
            if (wq == 0) *(f32x2*)(wsp<float>(F, WS_HDEC) + ((size_t)sc * NH + h) * HD + 2 * p) = (f32x2){__expf(sumbl0), __expf(sumbl1)};
        }
        __syncthreads();
    }
}
DI void hgrn_scan(Frame& F) {
    float* hst = wsp<float>(F, WS_HST); const float* hdec = wsp<float>(F, WS_HDEC);
    for (int e = F.bid * NTHREADS + F.tid; e < NH * HD * HD; e += F.G * NTHREADS) {
        const int hk = e >> 7;
        float cur = 0.f;
#pragma unroll 1
        for (int sc0 = 0; sc0 < HSC; sc0 += 8) {
            float tmp[8], dc[8];
#pragma unroll
            for (int j = 0; j < 8; ++j) { tmp[j] = hst[(size_t)(sc0 + j) * (NH * HD * HD) + e]; dc[j] = hdec[(size_t)(sc0 + j) * (NH * HD) + hk]; }
#pragma unroll
            for (int j = 0; j < 8; ++j) { hst[(size_t)(sc0 + j) * (NH * HD * HD) + e] = cur; cur = dc[j] * cur + tmp[j]; }
        }
    }
}

constexpr int AT_KSTR = 272, AT_VSTR = 520;
constexpr int AT_K_OFF = 0, AT_V_OFF = 256 * AT_KSTR, AT_PRE_OFF = AT_V_OFF + 128 * AT_VSTR;
static_assert(AT_PRE_OFF + (520 + 512) * 4 <= MISC_OFF, "attention LDS map");
DI void p3_attn(Frame& F) {
    LAS unsigned char* Kl = F.lds + AT_K_OFF; LAS unsigned char* Vl = F.lds + AT_V_OFF; LAS int* pre = (LAS int*)(F.lds + AT_PRE_OFF); LAS int* cntl = pre + 520;
    const bf16* q = wsp<bf16>(F, WS_Q); const bf16* kg = wsp<bf16>(F, WS_K); const bf16* vt = wsp<bf16>(F, WS_VT);
    const int* list = wsp<int>(F, WS_LIST);
    bf16* po = (bf16*)F.out;
    f32x2* pml = wsp<f32x2>(F, WS_PML);
    const unsigned* gcnt = F.ctl + CW_GCNT;
    const int tid = F.tid, lane = F.lane, w = F.wave, r = lane & 31, hh = lane >> 5;
    if (w == 0) {
        int c[8], s = 0;
#pragma unroll
        for (int k = 0; k < 8; ++k) { const unsigned cc = __hip_atomic_load(gcnt + lane * 8 + k, RLX_AGENT); cntl[lane * 8 + k] = (int)cc; c[k] = 1 + (int)((cc + 255u) >> 8); s += c[k]; }
        int incl = s;
#pragma unroll
        for (int o = 1; o < 64; o <<= 1) { const int t = __shfl_up(incl, o); if (lane >= o) incl += t; }
        int run = incl - s;
#pragma unroll
        for (int k = 0; k < 8; ++k) { pre[lane * 8 + k] = run; run += c[k]; }
        if (lane == 63) pre[512] = incl;
    }
    __syncthreads();
    const int total = pre[512];
    const int ti0 = (int)(((long)total * F.bid) / F.G), ti1 = (int)(((long)total * (F.bid + 1)) / F.G);
    int staged = -1;
#define AT_DECODE(ti_, lo_, seg_, nvalid_) do { int _l = 0, _h = 511; while (_l < _h) { const int _m = (_l + _h + 1) >> 1; if (pre[_m] <= (ti_)) _l = _m; else _h = _m - 1; } \
        lo_ = _l; seg_ = (ti_) - pre[_l]; nvalid_ = seg_ == 0 ? 256 : min(256, cntl[_l] - (seg_ - 1) * 256); } while (0)
#define AT_ENTRY(lo_, seg_, nvalid_) (((seg_) == 0) ? ((((lo_) & 63) * LBLK + ei) << 2 | 3) : ((ei < (nvalid_)) ? list[(unsigned)(((lo_) >> 6) * LSTRIDE + list_off((lo_) & 63) + ((seg_) - 1) * 256 + ei)] : 0))
    const int ei = w * 32 + r;
    int lo = 0, seg = 0, nvalid = 0, e = 0;
    bf16x8 Qf[8];
    if (ti0 < ti1) {
        AT_DECODE(ti0, lo, seg, nvalid); e = AT_ENTRY(lo, seg, nvalid);
        const bf16x8* qp = (const bf16x8*)(q + (unsigned)((e >> 2) * AW + (lo >> 6) * HD + 8 * hh));
#pragma unroll
        for (int s = 0; s < 8; ++s) Qf[s] = qp[2 * s];
    }
    for (int ti = ti0; ti < ti1; ++ti) {
        const int h = lo >> 6, n = lo & 63;
        const bool valid = ei < nvalid;
        const int t = e >> 2, slot = e & 3;
        int lo2 = lo, seg2 = 0, nvalid2 = 0, e2 = 0;
        const bool has_next = ti + 1 < ti1;
        if (has_next) { AT_DECODE(ti + 1, lo2, seg2, nvalid2); e2 = AT_ENTRY(lo2, seg2, nvalid2); }
        if (staged != lo) {
        if (staged >= 0) __syncthreads();
        staged = lo;
#pragma unroll
        for (int p = 0; p < 8; ++p) {
            const int idx = p * NTHREADS + tid;
            { const int row = idx >> 4, pc = idx & 15; const u32x4 v = *(const u32x4*)(kg + (unsigned)((n * LBLK + row) * AW + h * HD + pc * 8)); *(LAS u32x4*)(Kl + row * AT_KSTR + pc * 16) = v; }
            { const int d = idx >> 5, pc = idx & 31; const u32x4 v = *(const u32x4*)(vt + (unsigned)((h * HD + d) * S_ + n * LBLK + pc * 8));
              LAS u32x2* dst = (LAS u32x2*)(Vl + d * AT_VSTR + pc * 16); dst[0] = (u32x2){v.x, v.y}; dst[1] = (u32x2){v.z, v.w}; }
        }
        __syncthreads();
        }
        f32x16 X[8];
        bf16x8 Ac[8], An[4];
#pragma unroll
        for (int s = 0; s < 8; ++s) Ac[s] = *(const LAS bf16x8*)(Kl + r * AT_KSTR + 32 * s + 16 * hh);
#pragma unroll
        for (int kb = 0; kb < 8; ++kb) {
            if (kb < 7) {
#pragma unroll
                for (int s = 0; s < 4; ++s) An[s] = *(const LAS bf16x8*)(Kl + ((kb + 1) * 32 + r) * AT_KSTR + 32 * s + 16 * hh);
            }
            f32x16 x;
            if (seg == 0 && kb > w) {
#pragma unroll
                for (int i = 0; i < 16; ++i) x[i] = -INFINITY;
            } else {
#pragma unroll
                for (int i = 0; i < 16; ++i) x[i] = 0.f;
                __builtin_amdgcn_s_setprio(1);
#pragma unroll
                for (int s = 0; s < 8; ++s) x = __builtin_amdgcn_mfma_f32_32x32x16_bf16(Ac[s], Qf[s], x, 0, 0, 0);
                __builtin_amdgcn_s_setprio(0);
                if (seg == 0 && kb == w) {
#pragma unroll
                    for (int i = 0; i < 16; ++i) if (crow(i, hh) > r) x[i] = -INFINITY;
                }
            }
            X[kb] = x;
            if (kb < 7) {
#pragma unroll
                for (int s = 0; s < 4; ++s) Ac[s] = An[s];
#pragma unroll
                for (int s = 4; s < 8; ++s) Ac[s] = *(const LAS bf16x8*)(Kl + ((kb + 1) * 32 + r) * AT_KSTR + 32 * s + 16 * hh);
            }
        }
        if (has_next) {
            const bf16x8* qp = (const bf16x8*)(q + (unsigned)((e2 >> 2) * AW + (lo2 >> 6) * HD + 8 * hh));
#pragma unroll
            for (int s = 0; s < 8; ++s) Qf[s] = qp[2 * s];
        }
        float mx = -INFINITY;
#pragma unroll
        for (int kb = 0; kb < 8; ++kb)
#pragma unroll
            for (int i = 0; i < 16; ++i) mx = fmaxf(mx, X[kb][i]);
        mx = fmaxf(mx, __shfl_xor(mx, 32));
        float l = 0.f;
        u32x4 P[8][2];
#pragma unroll
        for (int kb = 0; kb < 8; ++kb)
#pragma unroll
            for (int s2 = 0; s2 < 2; ++s2) {
                float pe[8];
#pragma unroll
                for (int j = 0; j < 8; ++j) { pe[j] = __builtin_amdgcn_exp2f(X[kb][8 * s2 + j] - mx); l += pe[j]; }
                P[kb][s2] = (u32x4){pk2(pe[0], pe[1]), pk2(pe[2], pe[3]), pk2(pe[4], pe[5]), pk2(pe[6], pe[7])};
            }
        l += __shfl_xor(l, 32);
        f32x16 O[4];
#pragma unroll
        for (int db = 0; db < 4; ++db)
#pragma unroll
            for (int i = 0; i < 16; ++i) O[db][i] = 0.f;
#pragma unroll
        for (int kb = 0; kb < 8; ++kb)
#pragma unroll
            for (int s2 = 0; s2 < 2; ++s2) {
                const bf16x8 bfrag = __builtin_bit_cast(bf16x8, P[kb][s2]);
                __builtin_amdgcn_s_setprio(1);
#pragma unroll
                for (int db = 0; db < 4; ++db) {
                    const LAS u32x2* vp = (const LAS u32x2*)(Vl + (db * 32 + r) * AT_VSTR + (kb * 32 + 16 * s2 + 4 * hh) * 2);
                    const u32x2 a0 = vp[0], a1 = vp[2];
                    const u32x4 av = {a0.x, a0.y, a1.x, a1.y};
                    O[db] = __builtin_amdgcn_mfma_f32_32x32x16_bf16(__builtin_bit_cast(bf16x8, av), bfrag, O[db], 0, 0, 0);
                }
                __builtin_amdgcn_s_setprio(0);
            }
        {
            const float inv = OSCALE / l;
            unsigned char* orow = (unsigned char*)po + (unsigned)(((t * NH + h) * 4 + slot) * HD) + 16 * hh;
#pragma unroll
            for (int db = 0; db < 4; ++db) {
                unsigned pk[4];
#pragma unroll
                for (int g4 = 0; g4 < 4; ++g4) { int wv = __builtin_amdgcn_cvt_pk_fp8_f32(O[db][4 * g4 + 0] * inv, O[db][4 * g4 + 1] * inv, 0, false); wv = __builtin_amdgcn_cvt_pk_fp8_f32(O[db][4 * g4 + 2] * inv, O[db][4 * g4 + 3] * inv, wv, true); pk[g4] = (unsigned)wv; }
                const unsigned rcv0 = (unsigned)__shfl_xor((int)(hh ? pk[0] : pk[2]), 32), rcv1 = (unsigned)__shfl_xor((int)(hh ? pk[1] : pk[3]), 32);
                const u32x4 ov = hh ? (u32x4){rcv0, pk[2], rcv1, pk[3]} : (u32x4){pk[0], rcv0, pk[1], rcv1};
                if (valid) *(u32x4*)(orow + db * 32) = ov;
            }
            if (valid && hh == 0) pml[(unsigned)((t * NH + h) * 4 + slot)] = (f32x2){mx, l};
        }
        lo = lo2; seg = seg2; nvalid = nvalid2; e = e2;
    }
#undef AT_DECODE
#undef AT_ENTRY
    __syncthreads();
}

DI void p4_combine(Frame& F) {
    const bf16* po = (const bf16*)F.out; const f32x2* pml = wsp<f32x2>(F, WS_PML); bf16* mixed = wsp<bf16>(F, WS_MIX);
    const size_t total = (size_t)S_ * NH * 16, stride = (size_t)F.G * NTHREADS;
    for (size_t w0 = (size_t)F.bid * NTHREADS + F.tid; w0 < total; w0 += 2 * stride) {
        f32x2 ml[2][4]; u32x2 pv[2][4]; int nvv[2];
#pragma unroll
        for (int u = 0; u < 2; ++u) { const size_t wi = w0 + u * stride;
            if (wi < total) { const int c16 = (int)(wi & 15); const size_t th = wi >> 4; const int t = (int)(th >> 3); const int nv = min(3, t >> 8); nvv[u] = nv;
#pragma unroll
                for (int j = 0; j < 4; ++j) { const bool on = (j == 3) || (j < nv); ml[u][j] = on ? pml[th * 4 + j] : (f32x2){-INFINITY, 0.f}; pv[u][j] = on ? *(const u32x2*)((const unsigned char*)po + (th * 4 + j) * HD + c16 * 8) : (u32x2){0u, 0u}; } } }
#pragma unroll
        for (int u = 0; u < 2; ++u) { const size_t wi = w0 + u * stride;
            if (wi < total) { const int c16 = (int)(wi & 15); const size_t th = wi >> 4; const int t = (int)(th >> 3), h = (int)(th & 7); const int nv = nvv[u];
                float M = -INFINITY;
#pragma unroll
                for (int j = 0; j < 4; ++j) M = fmaxf(M, ml[u][j].x);
                float wj[4], W = 0.f;
#pragma unroll
                for (int j = 0; j < 4; ++j) { wj[j] = ((j == 3) || (j < nv)) ? __builtin_amdgcn_exp2f(ml[u][j].x - M) * ml[u][j].y : 0.f; W += wj[j]; }
                const float iW = 1.f / W;
                float o[8];
#pragma unroll
                for (int i = 0; i < 8; ++i) o[i] = 0.f;
#pragma unroll
                for (int j = 0; j < 4; ++j) { const u32x2 v = pv[u][j]; const float ww = wj[j] * iW * (1.f / OSCALE);
                    const f32x2 a0 = __builtin_amdgcn_cvt_pk_f32_fp8((int)v.x, false), a1 = __builtin_amdgcn_cvt_pk_f32_fp8((int)v.x, true), a2 = __builtin_amdgcn_cvt_pk_f32_fp8((int)v.y, false), a3 = __builtin_amdgcn_cvt_pk_f32_fp8((int)v.y, true);
                    o[0] += ww * a0.x; o[1] += ww * a0.y; o[2] += ww * a1.x; o[3] += ww * a1.y; o[4] += ww * a2.x; o[5] += ww * a2.y; o[6] += ww * a3.x; o[7] += ww * a3.y; }
                int w0 = __builtin_amdgcn_cvt_pk_fp8_f32(sat8(o[0] * MSCALE), sat8(o[1] * MSCALE), 0, false); w0 = __builtin_amdgcn_cvt_pk_fp8_f32(sat8(o[2] * MSCALE), sat8(o[3] * MSCALE), w0, true);
                int w1 = __builtin_amdgcn_cvt_pk_fp8_f32(sat8(o[4] * MSCALE), sat8(o[5] * MSCALE), 0, false); w1 = __builtin_amdgcn_cvt_pk_fp8_f32(sat8(o[6] * MSCALE), sat8(o[7] * MSCALE), w1, true);
                *(u32x2*)((unsigned char*)mixed + (size_t)t * D_ + h * HD + c16 * 8) = (u32x2){(unsigned)w0, (unsigned)w1}; } }
    }
}

struct Epi2 {
    static constexpr bool PERM = true, AFTER_DRAIN = false;
    const float* x; float* out; bf16* hb; float* ssq;
    DI void operator()(const pg8::f32x4 (&acc)[2][2][4][2], const pg8::Unit& u, int wr, int wc, int fr, int fq) const {
        asm volatile("" : "+v"(fr), "+v"(fq));
        const int row0 = u.pm * 256 + wr * 64 + fr, col0 = u.pn * 256 + wc * 32 + 8 * fq;
#pragma unroll
        for (int ai = 0; ai < 2; ++ai)
#pragma unroll
            for (int m = 0; m < 4; ++m) {
                const int row = row0 + ai * 128 + m * 16; const size_t off = (size_t)row * D_ + col0; float s = 0.f;
#pragma unroll
                for (int bj = 0; bj < 2; ++bj) {
                    const f32x4 v0 = *(const f32x4*)(x + off + bj * 128) + acc[ai][bj][m][0] * (1.f / (MSCALE * W1SCALE));
                    const f32x4 v1 = *(const f32x4*)(x + off + bj * 128 + 4) + acc[ai][bj][m][1] * (1.f / (MSCALE * W1SCALE));
                    u32x4 b; b.x = pk2(v0[0], v0[1]); b.y = pk2(v0[2], v0[3]); b.z = pk2(v1[0], v1[1]); b.w = pk2(v1[2], v1[3]);
                    *(u32x4*)(hb + off + bj * 128) = b;
                    s += (v0[0] * v0[0] + v0[1] * v0[1]) + (v0[2] * v0[2] + v0[3] * v0[3]) + (v1[0] * v1[0] + v1[1] * v1[1]) + (v1[2] * v1[2] + v1[3] * v1[3]);
                }
                s += __shfl_xor(s, 16); s += __shfl_xor(s, 32);
                if (fq == 0) ssq[(size_t)row * 32 + u.pn * 4 + wc] = s;
                if (m & 1) asm volatile("" ::: "memory");
            }
    }
};
struct EpiB {
    static constexpr bool PERM = true, AFTER_DRAIN = false;
    bf16* O; int ldc;
    DI void operator()(const pg8::f32x4 (&acc)[2][2][4][2], const pg8::Unit& u, int wr, int wc, int fr, int fq) const {
        asm volatile("" : "+v"(fr), "+v"(fq));
        const int row0 = u.pm * 256 + wr * 64 + fr, col0 = u.pn * 256 + wc * 32 + 8 * fq;
#pragma unroll
        for (int ai = 0; ai < 2; ++ai)
#pragma unroll
            for (int m = 0; m < 4; ++m) { bf16* rowp = O + (size_t)(row0 + ai * 128 + m * 16) * ldc + col0;
#pragma unroll
                for (int bj = 0; bj < 2; ++bj) { const f32x4 v0 = acc[ai][bj][m][0], v1 = acc[ai][bj][m][1];
                    u32x4 w; w.x = pk2(v0[0], v0[1]); w.y = pk2(v0[2], v0[3]); w.z = pk2(v1[0], v1[1]); w.w = pk2(v1[2], v1[3]);
                    *(u32x4*)(rowp + bj * 128) = w; } }
    }
};
struct EpiP {
    static constexpr bool PERM = true, AFTER_DRAIN = false;
    bf16* O;
    DI void operator()(const pg8::f32x4 (&acc)[2][2][4][2], const pg8::Unit& u, int wr, int wc, int fr, int fq) const {
        asm volatile("" : "+v"(fr), "+v"(fq));
        const int row0 = u.pm * 256 + wr * 64 + fr, col0 = u.pn * 256 + wc * 32 + 8 * fq;
#pragma unroll
        for (int ai = 0; ai < 2; ++ai)
#pragma unroll
            for (int m = 0; m < 4; ++m) { const size_t off = (size_t)(row0 + ai * 128 + m * 16) * D_ + col0;
#pragma unroll
                for (int bj = 0; bj < 2; ++bj) { const f32x4 v0 = acc[ai][bj][m][0], v1 = acc[ai][bj][m][1];
                    u32x4 w; w.x = pk2(v0[0], v0[1]); w.y = pk2(v0[2], v0[3]); w.z = pk2(v1[0], v1[1]); w.w = pk2(v1[2], v1[3]);
                    *(u32x4*)(O + off + bj * 128) = w; } }
    }
};
struct Epi4 {
    static constexpr bool PERM = true, AFTER_DRAIN = false;
    bf16* h3b; const bf16* hb; const bf16* ple; const float* rs3; float* ssq;
    DI void operator()(const pg8::f32x4 (&acc)[2][2][4][2], const pg8::Unit& u, int wr, int wc, int fr, int fq) const {
        asm volatile("" : "+v"(fr), "+v"(fq));
        const int row0 = u.pm * 256 + wr * 64 + fr, col0 = u.pn * 256 + wc * 32 + 8 * fq;
#pragma unroll
        for (int ai = 0; ai < 2; ++ai)
#pragma unroll
            for (int m = 0; m < 4; ++m) {
                const int row = row0 + ai * 128 + m * 16; const size_t off = (size_t)row * D_ + col0; float s = 0.f; const float rs = rs3[row];
#pragma unroll
                for (int bj = 0; bj < 2; ++bj) {
                    const u32x4 pw = *(const u32x4*)(ple + off + bj * 128), hw = *(const u32x4*)(hb + off + bj * 128);
                    const float pv[8] = {bflo(pw.x), bfhi(pw.x), bflo(pw.y), bfhi(pw.y), bflo(pw.z), bfhi(pw.z), bflo(pw.w), bfhi(pw.w)};
                    float v[8] = {bflo(hw.x), bfhi(hw.x), bflo(hw.y), bfhi(hw.y), bflo(hw.z), bfhi(hw.z), bflo(hw.w), bfhi(hw.w)};
#pragma unroll
                    for (int i = 0; i < 4; ++i) { v[i] += sigmoidf_(acc[ai][bj][m][0][i] * rs) * pv[i]; v[4 + i] += sigmoidf_(acc[ai][bj][m][1][i] * rs) * pv[4 + i]; }
                    u32x4 o; o.x = pk2(v[0], v[1]); o.y = pk2(v[2], v[3]); o.z = pk2(v[4], v[5]); o.w = pk2(v[6], v[7]);
                    *(u32x4*)(h3b + off + bj * 128) = o;
#pragma unroll
                    for (int i = 0; i < 8; ++i) s += v[i] * v[i];
                }
                s += __shfl_xor(s, 16); s += __shfl_xor(s, 32);
                if (fq == 0) ssq[(size_t)row * 32 + u.pn * 4 + wc] = s;
                if (m & 1) asm volatile("" ::: "memory");
            }
    }
};

DI unsigned fkey(float f, unsigned lowbits, unsigned mask) { unsigned u = __float_as_uint(f); u = (u & 0x80000000u) ? ~u : (u | 0x80000000u); return (u & ~mask) | lowbits; }
DI float fval(unsigned k, unsigned mask) { unsigned u = k & ~mask; u = (u & 0x80000000u) ? (u & 0x7fffffffu) : ~u; return __uint_as_float(u); }
template <int N> DI void bitonic_sort_desc(unsigned (&v)[N]) {
#pragma unroll
    for (int k = 2; k <= N; k <<= 1)
#pragma unroll
        for (int j = k >> 1; j > 0; j >>= 1)
#pragma unroll
            for (int i = 0; i < N; ++i) { const int l = i ^ j;
                if (l > i) { const bool desc = ((i & k) == 0); const unsigned a = v[i], b = v[l]; v[i] = desc ? max(a, b) : min(a, b); v[l] = desc ? min(a, b) : max(a, b); } }
}
DI void merge_top16(unsigned (&a)[16], const unsigned (&b)[16]) {
#pragma unroll
    for (int i = 0; i < 16; ++i) a[i] = max(a[i], b[15 - i]);
#pragma unroll
    for (int j = 8; j > 0; j >>= 1)
#pragma unroll
        for (int i = 0; i < 16; ++i) { const int l = i ^ j; if (l > i) { const unsigned x = a[i], y = a[l]; a[i] = max(x, y); a[l] = min(x, y); } }
}
DI void p7_route(Frame& F) {
    const bf16* qry = wsp<bf16>(F, WS_QRY); const bf16* skb = wsp<bf16>(F, WS_SKB);
    float* stat = wsp<float>(F, WS_STAT); const float* ssq2 = wsp<float>(F, WS_SSQ2);
    int* pidx = wsp<int>(F, WS_PIDX); float* pgate = wsp<float>(F, WS_PGATE);
    LAS unsigned* tops = (LAS unsigned*)F.lds;
    const int tid = F.tid, lane = F.lane, w = F.wave, r = lane & 31, hh = lane >> 5;
    const int tg = w & 3, p = w >> 2;
    for (int it = F.bid; it < (S_ / 128) * 2; it += F.G) {
        const int hg = it & 1, tb = it >> 1;
        const int t = tb * 128 + tg * 32 + r;
        float ss = 0.f;
        { const f32x4* sp = (const f32x4*)(ssq2 + (size_t)t * 32);
#pragma unroll
          for (int j = 0; j < 8; ++j) { const f32x4 v = sp[j]; ss += (v.x + v.y) + (v.z + v.w); } }
        const float rs2 = 1.f / sqrtf(ss * (1.f / D_) + EPS);
        if (hg == 0 && p == 0 && hh == 0) stat[ST_RS2 + t] = rs2;
        for (int hq = 0; hq < 4; ++hq) {
            const int h = hg * 4 + hq;
            bf16x8 Bq[8];
            { const bf16x8* qp = (const bf16x8*)(qry + (size_t)t * D_ + h * 256 + p * 128 + 8 * hh);
#pragma unroll
              for (int s = 0; s < 8; ++s) Bq[s] = qp[2 * s]; }
            unsigned kv[4][16];
            const bf16* kbase = skb + (size_t)((h * 2 + p) * NKEY) * 128;
#pragma unroll
            for (int kt = 0; kt < 4; ++kt) {
                f32x16 x;
#pragma unroll
                for (int i = 0; i < 16; ++i) x[i] = 0.f;
                const bf16x8* ap = (const bf16x8*)(kbase + (size_t)(kt * 32 + r) * 128 + 8 * hh);
#pragma unroll
                for (int s = 0; s < 8; ++s) x = __builtin_amdgcn_mfma_f32_32x32x16_bf16(ap[2 * s], Bq[s], x, 0, 0, 0);
#pragma unroll
                for (int i = 0; i < 16; ++i) { const int key = kt * 32 + crow(i, hh); kv[kt][i] = fkey(x[i] * rs2, (unsigned)(127 - key), 127u); }
            }
#pragma unroll
            for (int kt = 0; kt < 4; ++kt) bitonic_sort_desc<16>(kv[kt]);
            merge_top16(kv[0], kv[1]); merge_top16(kv[2], kv[3]); merge_top16(kv[0], kv[2]);
            unsigned (&tk)[16] = kv[0];
            {
                unsigned ok[16];
#pragma unroll
                for (int i = 0; i < 16; ++i) ok[i] = (unsigned)__shfl_xor((int)tk[i], 32);
                merge_top16(tk, ok);
            }
            if (hh == 0) {
                LAS u32x4* dst = (LAS u32x4*)(tops + (((tg * 32 + r) * 4 + hq) * 2 + p) * 16);
                dst[0] = (u32x4){tk[0], tk[1], tk[2], tk[3]}; dst[1] = (u32x4){tk[4], tk[5], tk[6], tk[7]}; dst[2] = (u32x4){tk[8], tk[9], tk[10], tk[11]}; dst[3] = (u32x4){tk[12], tk[13], tk[14], tk[15]};
            }
        }
        __syncthreads();
        {
            const int tl = tid & 127, hq = tid >> 7, h = hg * 4 + hq;
            const int tt = tb * 128 + tl;
            unsigned ka[16], kb[16];
            { const LAS u32x4* s = (const LAS u32x4*)(tops + ((tl * 4 + hq) * 2) * 16);
#pragma unroll
              for (int j = 0; j < 4; ++j) { const u32x4 a = s[j], b = s[4 + j]; ka[4 * j] = a.x; ka[4 * j + 1] = a.y; ka[4 * j + 2] = a.z; ka[4 * j + 3] = a.w; kb[4 * j] = b.x; kb[4 * j + 1] = b.y; kb[4 * j + 2] = b.z; kb[4 * j + 3] = b.w; } }
            float va[16], vb[16];
#pragma unroll
            for (int i = 0; i < 16; ++i) { va[i] = fval(ka[i], 127u); vb[i] = fval(kb[i], 127u); }
            unsigned cc[4][16];
#pragma unroll
            for (int gq = 0; gq < 4; ++gq)
#pragma unroll
                for (int k = 0; k < 16; ++k) cc[gq][k] = 0u;
            {
                int cnt = 0;
#pragma unroll
                for (int i = 0; i < 16; ++i)
#pragma unroll
                    for (int j = 0; j < 16; ++j) if ((i + 1) * (j + 1) <= 16) { cc[cnt >> 4][cnt & 15] = fkey(va[i] + vb[j], (unsigned)(255 - (i * 16 + j)), 255u); ++cnt; }
            }
#pragma unroll
            for (int gq = 0; gq < 4; ++gq) bitonic_sort_desc<16>(cc[gq]);
            merge_top16(cc[0], cc[1]); merge_top16(cc[2], cc[3]); merge_top16(cc[0], cc[2]);
            unsigned (&ck)[16] = cc[0];
            float sv[16]; float mxv = -INFINITY;
#pragma unroll
            for (int i = 0; i < 16; ++i) { sv[i] = fval(ck[i], 255u); mxv = fmaxf(mxv, sv[i]); }
            float den = 0.f;
#pragma unroll
            for (int i = 0; i < 16; ++i) { sv[i] = __expf(sv[i] - mxv); den += sv[i]; }
            const float iden = 1.f / den;
            int ev[16];
#pragma unroll
            for (int i = 0; i < 16; ++i) {
                const int pos = 255 - (int)(ck[i] & 255u), ci = pos >> 4, cj = pos & 15;
                unsigned ea = 0u, eb = 0u;
#pragma unroll
                for (int k = 0; k < 16; ++k) { ea = (ci == k) ? ka[k] : ea; eb = (cj == k) ? kb[k] : eb; }
                ev[i] = (int)((127u - (ea & 127u)) * 128u + (127u - (eb & 127u)));
                sv[i] *= iden;
            }
            u32x4* io = (u32x4*)(pidx + (size_t)tt * 128 + h * 16); f32x4* go = (f32x4*)(pgate + (size_t)tt * 128 + h * 16);
#pragma unroll
            for (int j = 0; j < 4; ++j) { io[j] = (u32x4){(unsigned)ev[4 * j], (unsigned)ev[4 * j + 1], (unsigned)ev[4 * j + 2], (unsigned)ev[4 * j + 3]}; go[j] = (f32x4){sv[4 * j], sv[4 * j + 1], sv[4 * j + 2], sv[4 * j + 3]}; }
        }
        __syncthreads();
    }
}

DI float gelu_erf(float v) {
    const float av = fabsf(v), t = __builtin_amdgcn_rcpf(av * 0.2316418882f + 1.0f);
    float q = t * 0.5307027145f + (-0.7265760135f); q = q * t + 0.7107068705f; q = q * t + (-0.142248368f); q = q * t + 0.127414796f; q = q * t;
    const float e = __builtin_amdgcn_exp2f((v * v) * (-0.72134752044f));
    const float m = v * (q * e);
    return v < 0.f ? m : v - m;
}
DI void p8_peer_sliced(Frame& F) {
    const unsigned char* down = wsp<unsigned char>(F, WS_DOWN); const unsigned char* up = wsp<unsigned char>(F, WS_UP);
    bf16* hb = wsp<bf16>(F, WS_H1B); float* stat = wsp<float>(F, WS_STAT);
    const int* pidx = wsp<int>(F, WS_PIDX); const float* pgate = wsp<float>(F, WS_PGATE);
    const int lane = F.lane, g = lane >> 3, l8 = lane & 7;
    const int qA = 16 * l8 + g, qB = qA + 8;
    LAS int* wsI = (LAS int*)(F.lds + F.wave * 10240) + lane;
    LAS float* wsF = (LAS float*)wsI;
#define PS(i, f) (((i) * 5 + (f)) * 64)
    for (int tbase = (F.bid * NWAVES + F.wave) * 8; tbase < S_; tbase += F.G * NWAVES * 8) {
#pragma unroll
        for (int i = 0; i < 8; ++i) { wsI[PS(i, 0)] = pidx[(unsigned)((tbase + i) * 128 + qA)]; wsI[PS(i, 1)] = pidx[(unsigned)((tbase + i) * 128 + qB)]; wsF[PS(i, 2)] = 0.f; wsF[PS(i, 3)] = 0.f; wsF[PS(i, 4)] = 0.f; }
        for (int s = 0; s < 16; ++s) {
#pragma unroll 1
            for (int i = 0; i < 8; ++i) {
                int ln = lane; asm volatile("" : "+v"(ln));
                const bool b0 = ln & 1, b1 = ln & 2, b2 = ln & 4;
                const int exA = wsI[PS(i, 0)], exB = wsI[PS(i, 1)];
                f32x2 hf[8];
                { const u32x4* hp = (const u32x4*)(hb + (unsigned)((tbase + i) * D_ + 128 * s + 16 * l8)); const u32x4 a = hp[0], b = hp[1];
                  hf[0] = (f32x2){bflo(a.x), bfhi(a.x)}; hf[1] = (f32x2){bflo(a.y), bfhi(a.y)}; hf[2] = (f32x2){bflo(a.z), bfhi(a.z)}; hf[3] = (f32x2){bflo(a.w), bfhi(a.w)};
                  hf[4] = (f32x2){bflo(b.x), bfhi(b.x)}; hf[5] = (f32x2){bflo(b.y), bfhi(b.y)}; hf[6] = (f32x2){bflo(b.z), bfhi(b.z)}; hf[7] = (f32x2){bflo(b.w), bfhi(b.w)}; }
                float pv[16];
#pragma unroll
                for (int hb2 = 0; hb2 < 1; ++hb2) {
                    u32x4 rv[16];
#pragma unroll
                    for (int j8 = 0; j8 < 16; ++j8) { const int jj = j8;
                        const int ex = __shfl((jj & 1) ? exB : exA, g * 8 + (jj >> 1));
                        rv[j8] = *(const u32x4*)(down + (unsigned)(ex * D_ + 128 * s + 16 * l8)); }
#pragma unroll
                    for (int j8 = 0; j8 < 16; ++j8) { f32x2 a2 = {0.f, 0.f};
#pragma unroll
                        for (int q = 0; q < 4; ++q) { a2 += hf[2 * q] * __builtin_amdgcn_cvt_pk_f32_fp8((int)rv[j8][q], false); a2 += hf[2 * q + 1] * __builtin_amdgcn_cvt_pk_f32_fp8((int)rv[j8][q], true); }
                        pv[j8] = a2.x + a2.y; }
                    __builtin_amdgcn_sched_barrier(0);
                }
                float p8[8], p4[4];
#pragma unroll
                for (int k = 0; k < 8; ++k) { const float snd = b2 ? pv[k] : pv[k + 8], kp = b2 ? pv[k + 8] : pv[k]; p8[k] = kp + __shfl_xor(snd, 4); }
#pragma unroll
                for (int k = 0; k < 4; ++k) { const float snd = b1 ? p8[k] : p8[k + 4], kp = b1 ? p8[k + 4] : p8[k]; p4[k] = kp + __shfl_xor(snd, 2); }
                { const float snd0 = b0 ? p4[0] : p4[2], kp0 = b0 ? p4[2] : p4[0], snd1 = b0 ? p4[1] : p4[3], kp1 = b0 ? p4[3] : p4[1];
                  wsF[PS(i, 2)] += kp0 + __shfl_xor(snd0, 1); wsF[PS(i, 3)] += kp1 + __shfl_xor(snd1, 1); }
            }
        }
#pragma unroll 1
        for (int i = 0; i < 8; ++i) {
            const float rs2 = stat[ST_RS2 + tbase + i] * (1.f / DSCALE);
            wsF[PS(i, 2)] = gelu_erf(wsF[PS(i, 2)] * rs2) * pgate[(unsigned)((tbase + i) * 128 + qA)] * (1.f / USCALE);
            wsF[PS(i, 3)] = gelu_erf(wsF[PS(i, 3)] * rs2) * pgate[(unsigned)((tbase + i) * 128 + qB)] * (1.f / USCALE);
        }
        for (int s = 0; s < 16; ++s) {
#pragma unroll 1
            for (int i = 0; i < 8; ++i) {
                int ln = lane; asm volatile("" : "+v"(ln));
                const bool b3 = ln & 8, b4 = ln & 16, b5 = ln & 32;
                const int exA = wsI[PS(i, 0)], exB = wsI[PS(i, 1)]; const float aA = wsF[PS(i, 2)], aB = wsF[PS(i, 3)];
                f32x2 acc2[8];
#pragma unroll
                for (int k = 0; k < 8; ++k) acc2[k] = (f32x2){0.f, 0.f};
#pragma unroll
                for (int hb2 = 0; hb2 < 1; ++hb2) {
                    u32x4 rv[16]; float av[16];
#pragma unroll
                    for (int j8 = 0; j8 < 16; ++j8) { const int jj = j8;
                        const int ex = __shfl((jj & 1) ? exB : exA, g * 8 + (jj >> 1));
                        av[j8] = __shfl((jj & 1) ? aB : aA, g * 8 + (jj >> 1));
                        rv[j8] = *(const u32x4*)(up + (unsigned)(ex * D_ + 128 * s + 16 * l8)); }
#pragma unroll
                    for (int j8 = 0; j8 < 16; ++j8) { const f32x2 a2 = {av[j8], av[j8]};
#pragma unroll
                        for (int q = 0; q < 4; ++q) { acc2[2 * q] += a2 * __builtin_amdgcn_cvt_pk_f32_fp8((int)rv[j8][q], false); acc2[2 * q + 1] += a2 * __builtin_amdgcn_cvt_pk_f32_fp8((int)rv[j8][q], true); } }
                    __builtin_amdgcn_sched_barrier(0);
                }
                float acc[16];
#pragma unroll
                for (int k = 0; k < 8; ++k) { acc[2 * k] = acc2[k].x; acc[2 * k + 1] = acc2[k].y; }
                float p8[8], p4[4];
#pragma unroll
                for (int k = 0; k < 8; ++k) { const float snd = b5 ? acc[k] : acc[k + 8], kp = b5 ? acc[k + 8] : acc[k]; p8[k] = kp + __shfl_xor(snd, 32); }
#pragma unroll
                for (int k = 0; k < 4; ++k) { const float snd = b4 ? p8[k] : p8[k + 4], kp = b4 ? p8[k + 4] : p8[k]; p4[k] = kp + __shfl_xor(snd, 16); }
                const float snd0 = b3 ? p4[0] : p4[2], kp0 = b3 ? p4[2] : p4[0], snd1 = b3 ? p4[1] : p4[3], kp1 = b3 ? p4[3] : p4[1];
                const float o0 = kp0 + __shfl_xor(snd0, 8), o1 = kp1 + __shfl_xor(snd1, 8);
                const unsigned off = (unsigned)((tbase + i) * D_ + 128 * s + 16 * l8 + 2 * g);
                const unsigned hw = *(const unsigned*)(hb + off);
                f32x2 x = {bflo(hw) + o0, bfhi(hw) + o1};
                *(unsigned*)(hb + off) = pk2(x.x, x.y);
                wsF[PS(i, 4)] += x.x * x.x + x.y * x.y;
            }
        }
#pragma unroll 1
        for (int i = 0; i < 8; ++i) { const float ss = wave_sum(wsF[PS(i, 4)]); if (lane == 0) stat[ST_RS3 + tbase + i] = 1.f / sqrtf(ss * (1.f / D_) + EPS); }
    }
#undef PS
}

DI void p10_final(Frame& F) {
    const float* ssq4 = wsp<float>(F, WS_SSQ4); const float* gain = F.in[15]; const bf16* h3b = wsp<bf16>(F, WS_QRY);
    const int NGW = F.G * NWAVES;
    f32x4 gr[8];
#pragma unroll
    for (int j = 0; j < 4; ++j) { gr[2 * j] = ((const f32x4*)gain)[2 * F.lane + 128 * j]; gr[2 * j + 1] = ((const f32x4*)gain)[2 * F.lane + 128 * j + 1]; }
    for (int m0 = F.bid * NWAVES + F.wave; m0 < S_; m0 += 4 * NGW) {
        float sv[4]; u32x4 w[4][4];
#pragma unroll
        for (int u = 0; u < 4; ++u) { const int m = m0 + u * NGW;
            if (m < S_) { sv[u] = (F.lane < 32) ? ssq4[(size_t)m * 32 + F.lane] : 0.f; const u32x4* hr = (const u32x4*)(h3b + (size_t)m * D_) + F.lane;
#pragma unroll
                for (int j = 0; j < 4; ++j) w[u][j] = hr[64 * j]; } }
#pragma unroll
        for (int u = 0; u < 4; ++u) { const int m = m0 + u * NGW;
            if (m < S_) { const float rs = 1.f / sqrtf(wave_sum(sv[u]) * (1.f / D_) + EPS); f32x4* xr = (f32x4*)(F.out + (size_t)m * D_) + 2 * F.lane;
#pragma unroll
                for (int j = 0; j < 4; ++j) { const u32x4 ww = w[u][j];
                    xr[128 * j] = (f32x4){bflo(ww.x), bfhi(ww.x), bflo(ww.y), bfhi(ww.y)} * rs * gr[2 * j];
                    xr[128 * j + 1] = (f32x4){bflo(ww.z), bfhi(ww.z), bflo(ww.w), bfhi(ww.w)} * rs * gr[2 * j + 1]; } } }
    }
}

constexpr int NPHASES = 11;
struct Args { const float* in[16]; float* out; unsigned char* ws; int ph_lo, ph_hi; };
DI int lane_id() { return (int)__builtin_amdgcn_mbcnt_hi(~0u, __builtin_amdgcn_mbcnt_lo(~0u, 0u)); }
DI Frame make_frame(LAS unsigned char* lds, int wave0) {
    typedef const Args __attribute__((address_space(4))) * cargs_t;
    cargs_t ap = (cargs_t)__builtin_amdgcn_kernarg_segment_ptr();
    asm volatile("" : "+s"(ap));
    Frame F;
    F.lds = lds;
    F.tid = threadIdx.x; F.lane = F.tid & 63; F.wave = __builtin_amdgcn_readfirstlane(F.tid >> 6); (void)wave0;
    F.G = gridDim.x; F.bid = blockIdx.x;
#pragma unroll
    for (int i = 0; i < 16; ++i) F.in[i] = ap->in[i];
    F.out = ap->out; F.ws = ap->ws; F.ctl = (unsigned*)(ap->ws + WS_CTL);
    return F;
}
__global__ void __launch_bounds__(NTHREADS, 2) mega_fwd(Args args) {
    extern __shared__ __attribute__((aligned(16))) unsigned char lds_[];
    LAS unsigned char* lds = (LAS unsigned char*)lds_;
    volatile LAS unsigned* MISC = (volatile LAS unsigned*)(lds + MISC_OFF);
    const int wave0 = __builtin_amdgcn_readfirstlane(threadIdx.x >> 6);
    if (threadIdx.x < 64) MISC[threadIdx.x] = 0u;
    __syncthreads();
    const int lo = args.ph_lo, hi = args.ph_hi;
    XcdBarrier bar; bar.bar = (unsigned*)(args.ws + WS_CTL) + CW_BAR; bar.x = 0; bar.st = nullptr;
    if (hi - lo > 1) bar = xcd_barrier_post((unsigned*)(args.ws + WS_CTL) + CW_BAR, MISC + 8, (int)threadIdx.x);
#ifdef ONLY_PHASE
#define IN(k) ((k) == ONLY_PHASE && lo <= (k) && (k) < hi)
#else
#define IN(k) (lo <= (k) && (k) < hi)
#endif
#ifdef TIME_PHASE
#define STAMP(k) do { if (blockIdx.x == 0 && threadIdx.x == 0) { const unsigned long long _t = __builtin_amdgcn_s_memrealtime(); MISC[16 + 2 * (k)] = (unsigned)_t; MISC[17 + 2 * (k)] = (unsigned)(_t >> 32); } } while (0)
#else
#define STAMP(k) do { } while (0)
#endif
#define SEAM(k) do { if (IN(k) && IN((k) + 1)) xcd_barrier(bar, (int)threadIdx.x); STAMP((k) + 1); } while (0)
    STAMP(0);

    if (IN(0)) { Frame F = make_frame(lds, wave0); p0_prologue(F); }
    SEAM(0);
    if (IN(1)) {
        Frame F = make_frame(lds, wave0);
        const float* stat = wsp<float>(F, WS_STAT);
        {
            pg8::Gemm g{(const bf16*)F.out, wsp<bf16>(F, WS_W1T), S_, 3 * AW, D_ / 2}; pg8::StaticOrder S; S.init(S_, 3 * AW, F.G, F.bid);
            Epi1<0> E{wsp<bf16>(F, WS_Q), wsp<bf16>(F, WS_K), wsp<bf16>(F, WS_VT), wsp<bf16>(F, WS_HQ), wsp<bf16>(F, WS_HLF), wsp<bf16>(F, WS_HV), wsp<bf16>(F, WS_HG), wsp<float>(F, WS_KPART), stat + ST_RS1Q};
            pg8::gemm_phase<Epi1<0>, pg8::StaticOrder, PG8_ALIGN, PG8_SP2, true>(F.lds, g, S, E, F.tid); }
        {
            pg8::Gemm g{wsp<bf16>(F, WS_XB), wsp<bf16>(F, WS_W1TB), S_, 4 * AW, D_}; pg8::StaticOrder S; S.init(S_, 4 * AW, F.G, F.bid);
            Epi1<3> E{wsp<bf16>(F, WS_Q), wsp<bf16>(F, WS_K), wsp<bf16>(F, WS_VT), wsp<bf16>(F, WS_HQ), wsp<bf16>(F, WS_HLF), wsp<bf16>(F, WS_HV), wsp<bf16>(F, WS_HG), wsp<float>(F, WS_KPART), stat + ST_RS1};
            int tid2 = F.tid; asm volatile("" : "+v"(tid2));
            pg8::gemm_phase<Epi1<3>, pg8::StaticOrder, PG8_ALIGN, PG8_SP2, false>(F.lds, g, S, E, tid2); }
    }
    SEAM(1);
    if (IN(2)) {
        Frame F = make_frame(lds, wave0);
        p2_gate(F);
        hgrn_mfma<false>(F);
    }
    SEAM(2);
    if (IN(3)) { Frame F = make_frame(lds, wave0); p3_attn(F);
        hgrn_scan(F); }
    SEAM(3);
    if (IN(4)) {
        Frame F = make_frame(lds, wave0);
        p4_combine(F);
        hgrn_mfma<true>(F);
    }
    SEAM(4);
    if (IN(5)) {
        Frame F = make_frame(lds, wave0);
        pg8::Gemm g{wsp<bf16>(F, WS_MIX), wsp<bf16>(F, WS_W2T), S_, D_, D_ / 2}; pg8::StaticOrder S; S.init(S_, D_, F.G, F.bid);
        Epi2 E{F.in[0], F.out, wsp<bf16>(F, WS_H1B), wsp<float>(F, WS_SSQ2)};
        pg8::gemm_phase<Epi2, pg8::StaticOrder, PG8_ALIGN, PG8_SP2, true>(F.lds, g, S, E, F.tid);
    }
    SEAM(5);
    if (IN(6)) {
        Frame F = make_frame(lds, wave0);
        pg8::Gemm g{wsp<bf16>(F, WS_H1B), wsp<bf16>(F, WS_WQT), S_, D_, D_}; pg8::StaticOrder S; S.init(S_, D_, F.G, F.bid);
        EpiB E{wsp<bf16>(F, WS_QRY), D_};
        pg8::gemm_phase<EpiB, pg8::StaticOrder, PG8_ALIGN, PG8_SP2>(F.lds, g, S, E, F.tid);
    }
    SEAM(6);
    if (IN(7)) { Frame F = make_frame(lds, wave0); p7_route(F); }
    SEAM(7);
    if (IN(8)) { Frame F = make_frame(lds, wave0); p8_peer_sliced(F); }
    SEAM(8);
    if (IN(9)) {
        { Frame F = make_frame(lds, wave0); pg8::StaticOrder S; S.init(S_, D_, F.G, F.bid);
          pg8::Gemm g{wsp<bf16>(F, WS_PB), wsp<bf16>(F, WS_WPT), S_, D_, PLE}; EpiP E{wsp<bf16>(F, WS_PLE)};
          pg8::gemm_phase<EpiP, pg8::StaticOrder, PG8_ALIGN, PG8_SP2>(F.lds, g, S, E, F.tid); }
        { Frame F = make_frame(lds, wave0); pg8::StaticOrder S; S.init(S_, D_, F.G, F.bid);
          pg8::Gemm g{wsp<bf16>(F, WS_H1B), wsp<bf16>(F, WS_WGT), S_, D_, D_}; Epi4 E{wsp<bf16>(F, WS_QRY), wsp<bf16>(F, WS_H1B), wsp<bf16>(F, WS_PLE), wsp<float>(F, WS_STAT) + ST_RS3, wsp<float>(F, WS_SSQ4)};
          pg8::gemm_phase<Epi4, pg8::StaticOrder, PG8_ALIGN, PG8_SP2>(F.lds, g, S, E, F.tid); }
    }
    SEAM(9);
    if (IN(10)) { Frame F = make_frame(lds, wave0); p10_final(F); }
#ifdef TIME_PHASE
    if (blockIdx.x == 0) {
        __syncthreads();
        if (threadIdx.x == 0) {
            const unsigned long long tend = __builtin_amdgcn_s_memrealtime();
            const unsigned long long a = ((unsigned long long)MISC[17 + 2 * TIME_PHASE] << 32) | MISC[16 + 2 * TIME_PHASE];
            const unsigned long long b = (TIME_PHASE == 10) ? tend : (((unsigned long long)MISC[19 + 2 * TIME_PHASE] << 32) | MISC[18 + 2 * TIME_PHASE]);
            const unsigned long long wait = 10ull * (b - a);
            while (__builtin_amdgcn_s_memrealtime() - tend < wait) __builtin_amdgcn_s_sleep(32);
        }
    }
#endif
#undef IN
#undef SEAM
}

extern "C" void kernel_launch(void* const* d_in, const int* in_sizes, int n_in, void* d_out, int out_size, void* d_ws, size_t ws_size, hipStream_t stream) {
    static int grid = 0;
    if (grid == 0) {
        if (n_in != 16 || out_size != S_ * D_ || ws_size < WS_END) { fprintf(stderr, "kernel_launch: unexpected problem (n_in %d, out %d, ws %zu < %zu)\n", n_in, out_size, ws_size, (size_t)WS_END); grid = -1; return; }
        int dev = 0, cus = 0, per_cu = 0;
        if (hipGetDevice(&dev) != hipSuccess || hipDeviceGetAttribute(&cus, hipDeviceAttributeMultiprocessorCount, dev) != hipSuccess) { grid = -1; return; }
        if (hipFuncSetAttribute((const void*)mega_fwd, hipFuncAttributeMaxDynamicSharedMemorySize, LDS_BYTES) != hipSuccess) { fprintf(stderr, "kernel_launch: hipFuncSetAttribute failed\n"); grid = -1; return; }
        if (hipOccupancyMaxActiveBlocksPerMultiprocessor(&per_cu, (const void*)mega_fwd, NTHREADS, LDS_BYTES) != hipSuccess || per_cu < 1) { fprintf(stderr, "kernel_launch: occupancy query says %d\n", per_cu); (void)hipGetLastError(); }
        grid = cus;
    }
    if (grid < 0) return;
    (void)hipMemsetAsync((char*)d_ws + WS_CTL, 0, CTL_ZERO_BYTES, stream);
    Args a{};
    for (int i = 0; i < 16; ++i) a.in[i] = (const float*)d_in[i];
    a.out = (float*)d_out; a.ws = (unsigned char*)d_ws;
#if MK_PER_PHASE
    for (int ph = 0; ph < NPHASES; ++ph) {
        a.ph_lo = ph; a.ph_hi = ph + 1;
        hipLaunchKernelGGL(mega_fwd, dim3(grid), dim3(NTHREADS), LDS_BYTES, stream, a);
    }
#else
    a.ph_lo = 0; a.ph_hi = NPHASES;
    void* kargs[] = {&a};
    hipError_t e = hipLaunchCooperativeKernel((const void*)mega_fwd, dim3(grid), dim3(NTHREADS), kargs, LDS_BYTES, stream);
    if (e != hipSuccess) fprintf(stderr, "kernel_launch: cooperative launch failed: %s\n", hipGetErrorString(e));
#endif
}
```

```cpp
#include <hip/hip_runtime.h>
#include <cstdio>
#include <cstdint>

#ifndef MK_PER_PHASE
#define MK_PER_PHASE 0
#endif

namespace pg8 {
#define PG8_LAS __attribute__((address_space(3)))
typedef unsigned short bf16_t;
typedef short bf16x8 __attribute__((ext_vector_type(8)));
typedef float f32x4 __attribute__((ext_vector_type(4)));
typedef unsigned u32x4 __attribute__((ext_vector_type(4)));
constexpr int BM = 256, BK = 64, HALF = 128, HTB = HALF * BK * 2, STAGE_BYTES = 8 * HTB, NXCD = 8, WGM = 8;

__host__ __device__ __forceinline__ int lds_byte(int r, int c) { const int st = (r >> 4) * 2 + (c >> 5), rr = r & 15, cc = c & 31, ob = rr * 64 + cc * 2; return st * 1024 + (ob ^ (((ob >> 9) & 1) << 5)); }
__host__ __device__ __forceinline__ void stage_rc(int b, int& R, int& C) { const int st = b / 1024, sb = b % 1024, swz = sb ^ (((sb >> 9) & 1) << 5); R = (st >> 1) * 16 + swz / 64; C = (st & 1) * 32 + (swz % 64) / 2; }
__host__ __device__ __forceinline__ int perm32(int rho) { const int n = rho >> 4, i = rho & 15; return 8 * (i >> 2) + 4 * n + (i & 3); }

struct Unit { int pm, pn; };
struct Gemm { const bf16_t* A; const bf16_t* Bt; int M, N, K; };

struct StaticOrder {
    int nM, nN, nwg, G, c;
    __host__ __device__ void init(int M, int N, int G_, int c_) { nM = M / BM; nN = N / BM; nwg = nM * nN; G = G_; c = c_; }
    __host__ __device__ bool next(int i, Unit& u) const {
        const long L = (long)i * G + c; if (L >= nwg) return false;
        int wgid = (int)L; { const int q = nwg / NXCD, r = nwg % NXCD, xcd = wgid % NXCD, off = wgid / NXCD; wgid = (xcd < r ? xcd * (q + 1) : r * (q + 1) + (xcd - r) * q) + off; }
        const int nig = WGM * nN, gid = wgid / nig, fm = gid * WGM, gsz = (nM - fm) < WGM ? (nM - fm) : WGM;
        u.pm = fm + ((wgid % nig) % gsz); u.pn = (wgid % nig) / gsz; return true;
    }
    __device__ __forceinline__ void a_ready(const Unit&) const {}
    __device__ __forceinline__ void done(const Unit&) const {}
};

typedef int i32x8 __attribute__((ext_vector_type(8)));
template <bool FP8> struct FragSel { typedef bf16x8 A_t[4][2]; typedef bf16x8 B_t[2][2]; };
template <> struct FragSel<true> { typedef i32x8 A_t[4]; typedef i32x8 B_t[2]; };
template <class Epi, class Sched, bool ALIGN_EPI = false, bool SP2 = false, bool FP8 = false>
__device__ __forceinline__ void gemm_phase(PG8_LAS unsigned char* lds, const Gemm g, const Sched& S, const Epi& E, const int tid) {
    const int wid = __builtin_amdgcn_readfirstlane(tid >> 6), lane = tid & 63, wr = wid >> 2, wc = wid & 3, fr = lane & 15, fq = lane >> 4;
    int K_ = g.K; asm volatile("" : "+s"(K_));
    const int K = K_, nt = K / BK;
    unsigned voffA[2], voffB[2];
#pragma unroll
    for (int i = 0; i < 2; ++i) { int R, C; stage_rc(tid * 16 + i * 8192, R, C); const int Rb = Epi::PERM ? ((R & ~31) + perm32(R & 31)) : R;
        voffA[i] = (unsigned)(R * K + C) * 2u; voffB[i] = (unsigned)(Rb * K + C) * 2u; }
    const size_t kstep = (size_t)(BK * 2);
    const size_t hstep = (size_t)HALF * K * 2;
    const size_t tstep = 2 * hstep;
    const unsigned ldsw = (unsigned)wid * 1024u;
    const int fcol = FP8 ? (16 * (fq & 1) + 32 * (fq >> 1)) : fq * 8;
    const int aoff = lds_byte(wr * 64 + fr, fcol), boff = lds_byte(wc * 32 + fr, fcol);

#define PG8_SA(b, h) (((b) * 2 + (h)) * HTB)
#define PG8_SB(b, h) ((4 + (b) * 2 + (h)) * HTB)
#define PG8_STAGE(bufoff, gbase, voff) do { _Pragma("unroll") for (int _i = 0; _i < 2; ++_i) \
        __builtin_amdgcn_global_load_lds((const unsigned*)((const char*)(gbase) + (voff)[_i]), (PG8_LAS unsigned*)(lds + (bufoff) + ldsw + _i * 8192), 16, 0, 0); } while (0)
#define PG8_LDA(dst, b, h) do { if constexpr (FP8) { _Pragma("unroll") for (int m = 0; m < 4; ++m) dst[m] = *(const PG8_LAS i32x8*)(lds + PG8_SA(b, h) + aoff + m * 2048); } \
        else { _Pragma("unroll") for (int m = 0; m < 4; ++m) _Pragma("unroll") for (int k = 0; k < 2; ++k) dst[m][k] = *(const PG8_LAS bf16x8*)(lds + PG8_SA(b, h) + aoff + m * 2048 + k * 1024); } } while (0)
#define PG8_LDB(dst, b, h) do { if constexpr (FP8) { _Pragma("unroll") for (int n = 0; n < 2; ++n) dst[n] = *(const PG8_LAS i32x8*)(lds + PG8_SB(b, h) + boff + n * 2048); } \
        else { _Pragma("unroll") for (int n = 0; n < 2; ++n) _Pragma("unroll") for (int k = 0; k < 2; ++k) dst[n][k] = *(const PG8_LAS bf16x8*)(lds + PG8_SB(b, h) + boff + n * 2048 + k * 1024); } } while (0)
#define PG8_MMA(ai, bj, At, Bt) do { __builtin_amdgcn_s_setprio(1); \
        if constexpr (FP8) { _Pragma("unroll") for (int m = 0; m < 4; ++m) _Pragma("unroll") for (int n = 0; n < 2; ++n) \
            asm volatile("v_mfma_scale_f32_16x16x128_f8f6f4 %0, %1, %2, %0, %3, %3 op_sel_hi:[0,0,0]" : "+v"(acc[ai][bj][m][n]) : "v"(Bt[n]), "v"(At[m]), "v"(one_scale)); } \
        else { _Pragma("unroll") for (int m = 0; m < 4; ++m) _Pragma("unroll") for (int n = 0; n < 2; ++n) _Pragma("unroll") for (int k = 0; k < 2; ++k) \
            acc[ai][bj][m][n] = __builtin_amdgcn_mfma_f32_16x16x32_bf16(Bt[n][k], At[m][k], acc[ai][bj][m][n], 0, 0, 0); } \
        __builtin_amdgcn_s_setprio(0); } while (0)
#define PG8_WAIT_V(n) asm volatile("s_waitcnt vmcnt(" #n ")" ::: "memory")
#define PG8_WAIT_L(n) asm volatile("s_waitcnt lgkmcnt(" #n ")" ::: "memory")
#define PG8_BAR __builtin_amdgcn_s_barrier()
#define PG8_SCHED __builtin_amdgcn_sched_barrier(0)
    int one_scale = 0x7f7f7f7f;
    asm volatile("" : "+v"(one_scale));
    Unit cur, nxt; int ui = 0;
    if (!S.next(0, cur)) return;
    f32x4 acc[2][2][4][2];
#pragma unroll
    for (int a = 0; a < 2; ++a)
#pragma unroll
        for (int b = 0; b < 2; ++b)
#pragma unroll
            for (int m = 0; m < 4; ++m)
#pragma unroll
                for (int n = 0; n < 2; ++n) acc[a][b][m][n] = (f32x4){0.f, 0.f, 0.f, 0.f};
    typename FragSel<FP8>::A_t At; typename FragSel<FP8>::B_t B0, B1;
    const char* cA = (const char*)g.A + (size_t)cur.pm * tstep; const char* cB = (const char*)g.Bt + (size_t)cur.pn * tstep;
    S.a_ready(cur);
    if constexpr (SP2) {
        PG8_STAGE(PG8_SB(0, 0), cB, voffB); PG8_STAGE(PG8_SB(0, 1), cB + hstep, voffB); PG8_STAGE(PG8_SA(0, 0), cA, voffA); PG8_STAGE(PG8_SA(0, 1), cA + hstep, voffA);
        if (wr == 1) PG8_BAR;
        PG8_WAIT_V(2); PG8_BAR;
        PG8_STAGE(PG8_SB(1, 0), cB + kstep, voffB); PG8_STAGE(PG8_SA(1, 0), cA + kstep, voffA); PG8_STAGE(PG8_SB(1, 1), cB + hstep + kstep, voffB);
        PG8_WAIT_V(6); PG8_BAR;
    } else {
        PG8_STAGE(PG8_SB(0, 0), cB, voffB); PG8_STAGE(PG8_SA(0, 0), cA, voffA); PG8_STAGE(PG8_SB(0, 1), cB + hstep, voffB); PG8_STAGE(PG8_SA(0, 1), cA + hstep, voffA);
        if (wr == 1) PG8_BAR;
        PG8_WAIT_V(4); PG8_BAR;
        PG8_STAGE(PG8_SB(1, 0), cB + kstep, voffB); PG8_STAGE(PG8_SA(1, 0), cA + kstep, voffA); PG8_STAGE(PG8_SB(1, 1), cB + hstep + kstep, voffB);
        PG8_WAIT_V(6); PG8_BAR;
    }
    for (;;) {
        const bool has_next = S.next(ui + 1, nxt);
        const char* nA = has_next ? (const char*)g.A + (size_t)nxt.pm * tstep : cA; const char* nB = has_next ? (const char*)g.Bt + (size_t)nxt.pn * tstep : cB;
        for (int t = 0; t < nt; t += 2) {
            const bool last = (t == nt - 2);
            const char* a1 = cA + (size_t)(t + 1) * kstep;
            const char* a2 = last ? nA : cA + (size_t)(t + 2) * kstep; const char* b2 = last ? nB : cB + (size_t)(t + 2) * kstep;
            const char* a3 = a2 + kstep; const char* b3 = b2 + kstep;
            if (last && has_next) S.a_ready(nxt);
            if constexpr (SP2) {
            PG8_LDB(B0, 0, 0); PG8_LDB(B1, 0, 1); PG8_SCHED; PG8_LDA(At, 0, 0); PG8_STAGE(PG8_SA(1, 1), a1 + hstep, voffA);
            PG8_WAIT_V(8); PG8_WAIT_L(0); PG8_BAR; PG8_MMA(0, 0, At, B0); PG8_MMA(0, 1, At, B1); PG8_BAR; PG8_SCHED;
            PG8_LDA(At, 0, 1); PG8_STAGE(PG8_SB(0, 0), b2, voffB); PG8_STAGE(PG8_SB(0, 1), b2 + hstep, voffB); PG8_STAGE(PG8_SA(0, 0), a2, voffA);
            PG8_WAIT_V(8); PG8_WAIT_L(0); PG8_BAR; PG8_MMA(1, 0, At, B0); PG8_MMA(1, 1, At, B1); PG8_BAR; PG8_SCHED;
            PG8_LDB(B0, 1, 0); PG8_LDB(B1, 1, 1); PG8_SCHED; PG8_LDA(At, 1, 0); PG8_STAGE(PG8_SA(0, 1), a2 + hstep, voffA);
            PG8_WAIT_V(8); PG8_WAIT_L(0); PG8_BAR; PG8_MMA(0, 0, At, B0); PG8_MMA(0, 1, At, B1); PG8_BAR; PG8_SCHED;
            PG8_LDA(At, 1, 1); PG8_STAGE(PG8_SB(1, 0), b3, voffB); PG8_STAGE(PG8_SB(1, 1), b3 + hstep, voffB); PG8_STAGE(PG8_SA(1, 0), a3, voffA);
            PG8_WAIT_V(8); PG8_WAIT_L(0); PG8_BAR; PG8_MMA(1, 0, At, B0); PG8_MMA(1, 1, At, B1); PG8_BAR; PG8_SCHED;
            } else {
            PG8_LDB(B0, 0, 0); PG8_SCHED; PG8_LDA(At, 0, 0); PG8_STAGE(PG8_SA(1, 1), a1 + hstep, voffA);
            PG8_WAIT_L(8); PG8_BAR; PG8_WAIT_L(0); PG8_MMA(0, 0, At, B0); PG8_BAR; PG8_SCHED;
            PG8_LDB(B1, 0, 1); PG8_STAGE(PG8_SB(0, 0), b2, voffB);
            PG8_BAR; PG8_WAIT_L(0); PG8_MMA(0, 1, At, B1); PG8_BAR;
            PG8_LDA(At, 0, 1); PG8_STAGE(PG8_SA(0, 0), a2, voffA);
            PG8_BAR; PG8_WAIT_L(0); PG8_MMA(1, 0, At, B0); PG8_BAR; PG8_SCHED;
            PG8_STAGE(PG8_SB(0, 1), b2 + hstep, voffB);
            PG8_WAIT_V(6); PG8_BAR; PG8_MMA(1, 1, At, B1); PG8_BAR;
            PG8_LDB(B0, 1, 0); PG8_SCHED; PG8_LDA(At, 1, 0); PG8_STAGE(PG8_SA(0, 1), a2 + hstep, voffA);
            PG8_WAIT_L(8); PG8_BAR; PG8_WAIT_L(0); PG8_MMA(0, 0, At, B0); PG8_BAR; PG8_SCHED;
            PG8_LDB(B1, 1, 1); PG8_STAGE(PG8_SB(1, 0), b3, voffB);
            PG8_BAR; PG8_WAIT_L(0); PG8_MMA(0, 1, At, B1); PG8_BAR;
            PG8_LDA(At, 1, 1); PG8_STAGE(PG8_SA(1, 0), a3, voffA);
            PG8_BAR; PG8_WAIT_L(0); PG8_MMA(1, 0, At, B0); PG8_BAR; PG8_SCHED;
            PG8_STAGE(PG8_SB(1, 1), b3 + hstep, voffB);
            PG8_WAIT_V(6); PG8_BAR; PG8_MMA(1, 1, At, B1); PG8_BAR;
            }
        }
        if constexpr (ALIGN_EPI) { if (wr == 0) PG8_BAR; }
        if constexpr (FP8) asm volatile("s_nop 15\n\ts_nop 15" ::: "memory");
        E(acc, cur, wr, wc, fr, fq); S.done(cur);
        if (!has_next) break;
#pragma unroll
        for (int a = 0; a < 2; ++a)
#pragma unroll
            for (int b = 0; b < 2; ++b)
#pragma unroll
                for (int m = 0; m < 4; ++m)
#pragma unroll
                    for (int n = 0; n < 2; ++n) acc[a][b][m][n] = (f32x4){0.f, 0.f, 0.f, 0.f};
        cur = nxt; cA = nA; cB = nB; ++ui;
        if constexpr (ALIGN_EPI) { if (wr == 1) PG8_BAR; }
    }
    PG8_WAIT_V(0);
    if constexpr (!ALIGN_EPI) { if (wr == 0) PG8_BAR; }
    PG8_BAR;
#undef PG8_SA
#undef PG8_SB
#undef PG8_STAGE
#undef PG8_LDA
#undef PG8_LDB
#undef PG8_MMA
#undef PG8_WAIT_V
#undef PG8_WAIT_L
#undef PG8_BAR
#undef PG8_SCHED
}
}

#define PG8_SP2 true
#define PG8_ALIGN true

constexpr int NWAVES = 8, NTHREADS = 512;
constexpr int S_ = 16384, D_ = 2048, NIN = 7168, AW = 1024, NH = 8, HD = 128, NBLK = 64, LBLK = 256;
constexpr int PLE = 256, NEXP = 16384, PH = 8, NKEY = 128, PTOP = 16;
constexpr float EPS = 1e-6f;
constexpr float QSCALE = 0.08838834764831845f * 1.4426950408889634f;
constexpr float XSCALE = 16.f, W1SCALE = 512.f;
constexpr float MSCALE = 8.f;
constexpr float OSCALE = 32.f;
constexpr float DSCALE = 512.f, USCALE = 32.f;
constexpr int HSC = 64, HSCLEN = 256, HSUB = 32;
constexpr int LSTRIDE = 256 * (63 * 64 / 2);
__host__ __device__ __forceinline__ int list_off(int n) { return 256 * (63 * n - (n * (n - 1)) / 2); }

constexpr size_t MiB = 1u << 20;
constexpr size_t WS_CTL = 0, CTL_ZERO_BYTES = 1 * MiB;
constexpr size_t WS_W1T = 2 * MiB  , WS_W1TB = 10 * MiB  , WS_W2T = 30 * MiB, WS_WQT = 38 * MiB, WS_WGT = 46 * MiB, WS_WPT = 54 * MiB, WS_SKB = 55 * MiB;
constexpr size_t WS_STAT = 56 * MiB;
constexpr size_t WS_SSQ2 = 57 * MiB, WS_SSQ4 = 59 * MiB;
constexpr size_t WS_KPART = 61 * MiB, WS_HDEC = 62 * MiB;
constexpr size_t WS_PB = 63 * MiB;
constexpr size_t WS_DOWN = 71 * MiB, WS_UP = 135 * MiB;
constexpr size_t WS_R1 = 199 * MiB;
constexpr size_t WS_XB = WS_R1, WS_LIST = WS_R1, WS_PML = WS_R1 + 16 * MiB, WS_HST = WS_R1 + 20 * MiB, WS_H1B = WS_R1;
constexpr size_t WS_R2 = 263 * MiB;
constexpr size_t WS_Q = WS_R2, WS_K = WS_R2 + 32 * MiB, WS_VT = WS_R2 + 64 * MiB, WS_MIX = WS_R2, WS_QRY = WS_R2, WS_PIDX = WS_R2 + 64 * MiB, WS_PGATE = WS_R2 + 72 * MiB;
constexpr size_t WS_R3 = 359 * MiB;
constexpr size_t WS_HQ = WS_R3, WS_HLF = WS_R3 + 32 * MiB, WS_HV = WS_R3 + 64 * MiB, WS_HG = WS_R3 + 96 * MiB, WS_PLE = WS_R3;
constexpr size_t WS_END = 487 * MiB;
constexpr int CW_BAR = 4096;
constexpr int CW_GCNT = 16384;
constexpr int ST_RS1 = 0, ST_LB = S_, ST_RS2 = S_ + 1024, ST_RS3 = 2 * S_ + 1024, ST_RS1Q = 3 * S_ + 1024;

constexpr int RING_BYTES = 131072;
constexpr int LDS_BYTES = 147456;
constexpr int MISC_OFF = LDS_BYTES - 256;

#define LAS __attribute__((address_space(3)))
typedef unsigned short bf16;
typedef unsigned u32x4 __attribute__((ext_vector_type(4)));
typedef unsigned u32x2 __attribute__((ext_vector_type(2)));
typedef float f32x4 __attribute__((ext_vector_type(4)));
typedef float f32x2 __attribute__((ext_vector_type(2)));
typedef float f32x16 __attribute__((ext_vector_type(16)));
typedef short bf16x8 __attribute__((ext_vector_type(8)));
typedef short s16x4 __attribute__((ext_vector_type(4)));
typedef __bf16 bf16x2n __attribute__((ext_vector_type(2)));
#define RLX_AGENT __ATOMIC_RELAXED, __HIP_MEMORY_SCOPE_AGENT
#define LDS_WAIT() asm volatile("s_waitcnt lgkmcnt(0)" ::: "memory")
#define DI __device__ __forceinline__

DI unsigned pk2(float lo, float hi) { f32x2 v = {lo, hi}; bf16x2n b = __builtin_convertvector(v, bf16x2n); return __builtin_bit_cast(unsigned, b); }
DI float sat8(float v) { return __builtin_amdgcn_fmed3f(v, -440.f, 440.f); }
DI float bflo(unsigned u) { return __uint_as_float(u << 16); }
DI float bfhi(unsigned u) { return __uint_as_float(u & 0xffff0000u); }
DI float wave_sum(float v) {
#pragma unroll
    for (int o = 1; o < 64; o <<= 1) v += __shfl_xor(v, o);
    return v;
}
DI float sigmoidf_(float x) { return __builtin_amdgcn_rcpf(1.f + __expf(-x)); }
DI float siluf_(float x) { return x * __builtin_amdgcn_rcpf(1.f + __expf(-x)); }
DI int crow(int reg, int h) { return (reg & 3) + 8 * (reg >> 2) + 4 * h; }

#define XB_TMO      128
#define XB_XCNT(j)  (256  + 64 * (j))
#define XB_XSUB(j)  (1280 + 64 * (j))
#define XB_XGEN(j)  (2304 + 64 * (j))
#define XB_TOP      3328
#define XB_TOPGEN   3392
#define XCD_BAR_WORDS 3456
#define XB_SPIN_CAP (1u << 22)
DI unsigned xb_ld(unsigned* p)              { return __hip_atomic_load(p, __ATOMIC_RELAXED, __HIP_MEMORY_SCOPE_AGENT); }
DI unsigned xb_add(unsigned* p, unsigned v) { return __hip_atomic_fetch_add(p, v, __ATOMIC_RELAXED, __HIP_MEMORY_SCOPE_AGENT); }
DI unsigned xb_xcc_id() { return (unsigned)__builtin_amdgcn_s_getreg((3 << 11) | 20) & 0xFu; }
#define XB_SPIN(cond, bar) do { unsigned _sp = 0; while (cond) { __builtin_amdgcn_s_sleep(1); \
    if ((++_sp & 255u) == 0u) { if (xb_ld(&(bar)[XB_TMO])) break; if (_sp > XB_SPIN_CAP) { atomicAdd(&(bar)[XB_TMO], 1u); break; } } } } while (0)
struct XcdBarrier { unsigned* bar; unsigned x; volatile LAS unsigned* st; };
DI XcdBarrier xcd_barrier_post(unsigned* bar, volatile LAS unsigned* st, int tid) {
    XcdBarrier b; b.bar = bar; b.x = xb_xcc_id(); b.st = st;
    if (tid == 0) (void)xb_add(&bar[XB_XCNT(b.x)], 1u);
    return b;
}
DI void xcd_barrier_complete(unsigned* bar, unsigned x, unsigned& nloc, unsigned& nx) {
    const unsigned G = gridDim.x * gridDim.y * gridDim.z;
    unsigned sum, cnt, mine, sp = 0u;
    for (;;) {
        sum = 0u; cnt = 0u; mine = 0u;
#pragma unroll
        for (unsigned j = 0; j < 16; ++j) { const unsigned c = xb_ld(&bar[XB_XCNT(j)]); sum += c; cnt += (c > 0u) ? 1u : 0u; mine = (j == x) ? c : mine; }
        if (sum == G) break;
        __builtin_amdgcn_s_sleep(1);
        if ((++sp & 255u) == 0u) { if (xb_ld(&bar[XB_TMO])) break; if (sp > XB_SPIN_CAP) { atomicAdd(&bar[XB_TMO], 1u); break; } }
    }
    nloc = mine > 0u ? mine : 1u; nx = cnt > 0u ? cnt : 1u;
}
DI void xcd_barrier(const XcdBarrier& b, int tid) {
    asm volatile("s_waitcnt vmcnt(0)" ::: "memory");
    __syncthreads();
    if (tid == 0) {
        unsigned* bar = b.bar;
        __builtin_amdgcn_s_waitcnt(0);
        unsigned nloc = b.st[0], nx = b.st[1];
        if (nloc == 0u) { xcd_barrier_complete(bar, b.x, nloc, nx); b.st[0] = nloc; b.st[1] = nx; }
        const unsigned old = xb_add(&bar[XB_XSUB(b.x)], 1u);
        const unsigned gen = old / nloc;
        if (old + 1u == (gen + 1u) * nloc) {
            __builtin_amdgcn_fence(__ATOMIC_RELEASE, "agent");
            asm volatile("s_waitcnt vmcnt(0)" ::: "memory");
            const unsigned og = xb_add(&bar[XB_TOP], 1u);
            const unsigned tg = og / nx;
            if (og + 1u == (tg + 1u) * nx) xb_add(&bar[XB_TOPGEN], 1u);
            else XB_SPIN(xb_ld(&bar[XB_TOPGEN]) == tg, bar);
            __builtin_amdgcn_fence(__ATOMIC_ACQUIRE, "agent");
            xb_add(&bar[XB_XGEN(b.x)], 1u);
            asm volatile("s_waitcnt vmcnt(0)" ::: "memory");
        } else {
            XB_SPIN(xb_ld(&bar[XB_XGEN(b.x)]) == gen, bar);
            __builtin_amdgcn_fence(__ATOMIC_ACQUIRE, "agent");
            asm volatile("s_waitcnt vmcnt(0)" ::: "memory");
        }
    }
    __syncthreads();
}

struct Frame {
    LAS unsigned char* lds;
    unsigned* ctl;
    int tid, lane, wave, G, bid;
    const float* in[16];
    float* out;
    unsigned char* ws;
};
template <class T> DI T* wsp(const Frame& F, size_t off) { return (T*)(F.ws + off); }

constexpr int TP_PITCH = 65, TP_WAVE_BYTES = 64 * TP_PITCH * 4 + 64;
template <bool FP8 = false> DI void p0_transpose_item(const float* W, const float* gain, int K, int N, bf16* WT, LAS float* scr, int item, int lane, int nscaled = 0, float nscale = 1.f, float allscale = 1.f) {
    const int nblk = N / 64, kb = item / nblk, nb = item % nblk, k0 = 64 * kb, n0 = 64 * nb; const float osc = ((n0 < nscaled) ? nscale : 1.f) * allscale;
    const int kr = lane >> 4, n4 = (lane & 15) * 4;
    f32x4 v[16];
#pragma unroll
    for (int i = 0; i < 16; ++i) v[i] = *(const f32x4*)(W + (size_t)(k0 + 4 * i + kr) * N + n0 + n4);
#pragma unroll
    for (int i = 0; i < 16; ++i) { const int kk = 4 * i + kr; const float g = (gain ? gain[k0 + kk] : 1.f) * osc;
        scr[(n4 + 0) * TP_PITCH + kk] = v[i].x * g; scr[(n4 + 1) * TP_PITCH + kk] = v[i].y * g; scr[(n4 + 2) * TP_PITCH + kk] = v[i].z * g; scr[(n4 + 3) * TP_PITCH + kk] = v[i].w * g; }
    LDS_WAIT(); asm volatile("" ::: "memory");
    const int c = lane & 7, nn = lane >> 3;
#pragma unroll
    for (int j = 0; j < 8; ++j) { const int n = nn + 8 * j; const LAS float* sp = scr + n * TP_PITCH + 8 * c;
        if constexpr (FP8) {
            int w0 = __builtin_amdgcn_cvt_pk_fp8_f32(sp[0], sp[1], 0, false); w0 = __builtin_amdgcn_cvt_pk_fp8_f32(sp[2], sp[3], w0, true);
            int w1 = __builtin_amdgcn_cvt_pk_fp8_f32(sp[4], sp[5], 0, false); w1 = __builtin_amdgcn_cvt_pk_fp8_f32(sp[6], sp[7], w1, true);
            *(u32x2*)((unsigned char*)WT + (size_t)(n0 + n) * K + k0 + 8 * c) = (u32x2){(unsigned)w0, (unsigned)w1};
        } else {
            u32x4 o; o.x = pk2(sp[0], sp[1]); o.y = pk2(sp[2], sp[3]); o.z = pk2(sp[4], sp[5]); o.w = pk2(sp[6], sp[7]);
            *(u32x4*)(WT + (size_t)(n0 + n) * K + k0 + 8 * c) = o; } }
    LDS_WAIT(); asm volatile("" ::: "memory");
}
DI void p0_convert(const float* src, bf16* dst, size_t n8, const float* colgain, size_t gtid, size_t gstride) {
    for (size_t i = gtid; i < n8; i += gstride) {
        f32x4 a = *(const f32x4*)(src + i * 8), b = *(const f32x4*)(src + i * 8 + 4);
        if (colgain) { const int c = (int)((i * 8) & 2047); a = a * *(const f32x4*)(colgain + c); b = b * *(const f32x4*)(colgain + c + 4); }
        u32x4 o; o.x = pk2(a.x, a.y); o.y = pk2(a.z, a.w); o.z = pk2(b.x, b.y); o.w = pk2(b.z, b.w);
        *(u32x4*)(dst + i * 8) = o;
    }
}
DI void p0_convert_fp8(const float* src, unsigned char* dst, size_t nelem, const float* colgain, float scale, size_t gwave, size_t nwaves, int lane) {
    const size_t nunit = nelem / 2048;
    for (size_t u = gwave; u < nunit; u += nwaves) {
        const float* sp = src + u * 2048 + lane * 4; unsigned char* dp = dst + u * 2048 + lane * 4;
        f32x4 a[8];
#pragma unroll
        for (int q = 0; q < 8; ++q) a[q] = __builtin_nontemporal_load((const f32x4*)(sp + q * 256));
#pragma unroll
        for (int q = 0; q < 8; ++q) {
            f32x4 v = a[q];
            if (colgain) v = v * *(const f32x4*)(colgain + q * 256 + lane * 4);
            v = v * scale;
            int w = __builtin_amdgcn_cvt_pk_fp8_f32(v.x, v.y, 0, false);
            w = __builtin_amdgcn_cvt_pk_fp8_f32(v.z, v.w, w, true);
            __builtin_nontemporal_store((unsigned)w, (unsigned*)(dp + q * 256));
        }
    }
}
DI void p0_prologue(Frame& F) {
    LAS float* scr = (LAS float*)(F.lds + F.wave * TP_WAVE_BYTES);
    const int gw = F.bid * NWAVES + F.wave, NGW = F.G * NWAVES;
    const float* x = F.in[0];
    constexpr int I1 = (D_ / 64) * (NIN / 64), I2 = (D_ / 64) * (D_ / 64), IP = (PLE / 64) * (D_ / 64);
    constexpr int NITEMS = I1 + 3 * I2 + IP;
    for (int it = gw; it < NITEMS; it += NGW) {
        int r = it;
        if (r < I1) {
            const int nb = r % (NIN / 64);
            if (nb < 3 * AW / 64) p0_transpose_item<true>(F.in[3], F.in[2], D_, NIN, wsp<bf16>(F, WS_W1T), scr, r, F.lane, AW, QSCALE, W1SCALE);
            else p0_transpose_item<false>(F.in[3], F.in[2], D_, NIN, wsp<bf16>(F, WS_W1TB) - (size_t)3 * AW * D_, scr, r, F.lane);
            continue; } r -= I1;
        if (r < I2) { p0_transpose_item<true>(F.in[6], nullptr, D_, D_, wsp<bf16>(F, WS_W2T), scr, r, F.lane, 0, 1.f, W1SCALE); continue; } r -= I2;
        if (r < I2) { p0_transpose_item(F.in[8], F.in[7], D_, D_, wsp<bf16>(F, WS_WQT), scr, r, F.lane); continue; } r -= I2;
        if (r < I2) { p0_transpose_item(F.in[14], F.in[12], D_, D_, wsp<bf16>(F, WS_WGT), scr, r, F.lane); continue; } r -= I2;
        p0_transpose_item(F.in[13], nullptr, PLE, D_, wsp<bf16>(F, WS_WPT), scr, r, F.lane);
    }
    float* stat = wsp<float>(F, WS_STAT);
    bf16* xb = wsp<bf16>(F, WS_XB);
    for (int m = gw; m < S_; m += NGW) {
        const f32x4* xr = (const f32x4*)(x + (size_t)m * D_) + F.lane;
        f32x4 v[8]; float s = 0.f;
#pragma unroll
        for (int j = 0; j < 8; ++j) { v[j] = xr[64 * j]; s += (v[j].x * v[j].x + v[j].y * v[j].y) + (v[j].z * v[j].z + v[j].w * v[j].w); }
        s = wave_sum(s);
        if (F.lane == 0) { const float rs = 1.f / sqrtf(s * (1.f / D_) + EPS); stat[ST_RS1 + m] = rs; stat[ST_RS1Q + m] = rs * (1.f / (XSCALE * W1SCALE)); }
        u32x2* o8 = (u32x2*)(xb + (size_t)m * D_) + F.lane;
#pragma unroll
        for (int j = 0; j < 8; ++j) { u32x2 w; w.x = pk2(v[j].x, v[j].y); w.y = pk2(v[j].z, v[j].w); o8[64 * j] = w; }
        unsigned* o4 = (unsigned*)((unsigned char*)F.out + (size_t)m * D_) + F.lane;
#pragma unroll
        for (int j = 0; j < 8; ++j) { int w = __builtin_amdgcn_cvt_pk_fp8_f32(sat8(v[j].x * XSCALE), sat8(v[j].y * XSCALE), 0, false); w = __builtin_amdgcn_cvt_pk_fp8_f32(sat8(v[j].z * XSCALE), sat8(v[j].w * XSCALE), w, true); o4[64 * j] = (unsigned)w; }
    }
    const size_t gtid = (size_t)F.bid * NTHREADS + F.tid, gstride = (size_t)F.G * NTHREADS;
    p0_convert(F.in[1], wsp<bf16>(F, WS_PB), (size_t)S_ * PLE / 8, nullptr, gtid, gstride);
    p0_convert(F.in[9], wsp<bf16>(F, WS_SKB), (size_t)PH * 2 * NKEY * 128 / 8, nullptr, gtid, gstride);
    {
    p0_convert_fp8(F.in[10], wsp<unsigned char>(F, WS_DOWN), (size_t)NEXP * D_, F.in[7], DSCALE, (size_t)gw, (size_t)NGW, F.lane);
    p0_convert_fp8(F.in[11], wsp<unsigned char>(F, WS_UP), (size_t)NEXP * D_, nullptr, USCALE, (size_t)gw, (size_t)NGW, F.lane); }
    for (size_t i = gtid; i < 1024; i += gstride) { const float l0 = F.in[4][i], l1 = F.in[4][1024 + i]; stat[ST_LB + i] = 1.f / (1.f + __expf(l1 - l0)); }
}

template <int RBASE> struct Epi1 {
    static constexpr bool PERM = true, AFTER_DRAIN = false;
    bf16 *q, *k, *vt, *hq, *hlf, *hv, *hg; float* kpart; const float* rs1;
    template <int R> DI void run(const pg8::f32x4 (&acc)[2][2][4][2], const pg8::Unit& u, int wr, int wc, int fr, int fq, bf16* dst) const {
        const int cb = (u.pn & 3) * 256;
        const int row0 = u.pm * 256 + wr * 64 + fr;
        const int colw = cb + wc * 32 + 8 * fq;
        f32x4 cs[2][2];
        if (R == 1) { cs[0][0] = cs[0][1] = cs[1][0] = cs[1][1] = (f32x4){0.f, 0.f, 0.f, 0.f}; }
#pragma unroll
        for (int ai = 0; ai < 2; ++ai)
#pragma unroll
            for (int m = 0; m < 4; ++m) {
                const int row = row0 + ai * 128 + m * 16;
                const float rs = rs1[row];
#pragma unroll
                for (int bj = 0; bj < 2; ++bj) {
                    const f32x4 v0 = acc[ai][bj][m][0] * rs, v1 = acc[ai][bj][m][1] * rs;
                    const int col = colw + 128 * bj;
                    if (R == 1) { cs[bj][0] = cs[bj][0] + v0; cs[bj][1] = cs[bj][1] + v1; }
                    if (R == 2) {
                        bf16* p = dst + (size_t)col * S_ + row;
#pragma unroll
                        for (int i = 0; i < 4; ++i) { p[(size_t)i * S_] = (bf16)(pk2(v0[i], 0.f) & 0xffffu); p[(size_t)(i + 4) * S_] = (bf16)(pk2(v1[i], 0.f) & 0xffffu); }
                    } else {
                        u32x4 w; w.x = pk2(v0[0], v0[1]); w.y = pk2(v0[2], v0[3]); w.z = pk2(v1[0], v1[1]); w.w = pk2(v1[2], v1[3]);
                        *(u32x4*)(dst + (size_t)row * AW + col) = w;
                    }
                }
                asm volatile("" ::: "memory");
            }
        if (R == 1) {
#pragma unroll
            for (int bj = 0; bj < 2; ++bj)
#pragma unroll
                for (int n = 0; n < 2; ++n)
#pragma unroll
                    for (int i = 0; i < 4; ++i) {
                        float s = cs[bj][n][i];
                        s += __shfl_xor(s, 1); s += __shfl_xor(s, 2); s += __shfl_xor(s, 4); s += __shfl_xor(s, 8);
                        if (fr == 0) kpart[(size_t)(wr * NBLK + u.pm) * AW + colw + 128 * bj + 4 * n + i] = s;
                    }
        }
    }
    DI void operator()(const pg8::f32x4 (&acc)[2][2][4][2], const pg8::Unit& u, int wr, int wc, int fr, int fq) const {
        asm volatile("" : "+v"(fr), "+v"(fq));
        const int reg = RBASE + (u.pn >> 2);
        if constexpr (RBASE == 0) {
            if (reg == 1) run<1>(acc, u, wr, wc, fr, fq, k);
            else if (reg == 2) run<2>(acc, u, wr, wc, fr, fq, vt);
            else run<0>(acc, u, wr, wc, fr, fq, q);
        } else { bf16* dst = hq + (size_t)(reg - 3) * ((WS_HLF - WS_HQ) / 2); run<0>(acc, u, wr, wc, fr, fq, dst); }
    }
};

DI void ins3(float v, int i, float& v0, float& v1, float& v2, int& i0, int& i1, int& i2) {
    const bool c0 = v > v0, c1 = v > v1, c2 = v > v2;
    v2 = c1 ? v1 : (c2 ? v : v2); i2 = c1 ? i1 : (c2 ? i : i2);
    v1 = c0 ? v0 : (c1 ? v : v1); i1 = c0 ? i0 : (c1 ? i : i1);
    v0 = c0 ? v : v0; i0 = c0 ? i : i0;
}
DI void p2_gate(Frame& F) {
    LAS unsigned char* kmh = F.lds;
    LAS unsigned char* kml = F.lds + 64 * 272;
    LAS int* lcnt = (LAS int*)(F.lds + 2 * 64 * 272);
    LAS int* lbase = lcnt + 64;
    const float* kpart = wsp<float>(F, WS_KPART);
    const bf16* q = wsp<bf16>(F, WS_Q);
    unsigned* gcnt = F.ctl + CW_GCNT;
    int* list = wsp<int>(F, WS_LIST);
    const int tid = F.tid, lane = F.lane, w = F.wave, r = lane & 31, hh = lane >> 5;
    for (int it = F.bid; it < NH * 63; it += F.G) {
        const int h = it & 7, qb = 63 - (it >> 3);
        for (int i = tid; i < 64 * 64; i += NTHREADS) {
            const int n = i >> 6, d = 2 * (i & 63);
            f32x2 a = {0.f, 0.f};
            if (n < qb) { const f32x2 p0 = *(const f32x2*)(kpart + (size_t)n * AW + h * HD + d), p1 = *(const f32x2*)(kpart + (size_t)(NBLK + n) * AW + h * HD + d); a = p0 + p1; }
            const unsigned hi = pk2(a.x, a.y);
            const unsigned lo = pk2(a.x - bflo(hi), a.y - bfhi(hi));
            *(LAS unsigned*)(kmh + n * 272 + d * 2) = hi; *(LAS unsigned*)(kml + n * 272 + d * 2) = lo;
        }
        if (tid < 64) lcnt[tid] = 0;
        __syncthreads();
        const int t = qb * LBLK + w * 32 + r;
        bf16x8 Qf[8];
        { const bf16x8* qp = (const bf16x8*)(q + (size_t)t * AW + h * HD + 8 * hh);
#pragma unroll
          for (int s = 0; s < 8; ++s) Qf[s] = qp[2 * s]; }
        float v0 = -INFINITY, v1 = -INFINITY, v2 = -INFINITY; int i0 = -1, i1 = -1, i2 = -1;
#pragma unroll
        for (int nt = 0; nt < 2; ++nt) {
            if (nt * 32 < qb) {
                f32x16 x;
#pragma unroll
                for (int i = 0; i < 16; ++i) x[i] = 0.f;
#pragma unroll
                for (int s = 0; s < 8; ++s) {
                    const bf16x8 ah = *(const LAS bf16x8*)(kmh + (nt * 32 + r) * 272 + 32 * s + 16 * hh), al = *(const LAS bf16x8*)(kml + (nt * 32 + r) * 272 + 32 * s + 16 * hh);
                    x = __builtin_amdgcn_mfma_f32_32x32x16_bf16(ah, Qf[s], x, 0, 0, 0);
                    x = __builtin_amdgcn_mfma_f32_32x32x16_bf16(al, Qf[s], x, 0, 0, 0);
                }
#pragma unroll
                for (int i = 0; i < 16; ++i) { const int n = nt * 32 + crow(i, hh); ins3(n < qb ? x[i] : -INFINITY, n < qb ? n : -1, v0, v1, v2, i0, i1, i2); }
            }
        }
        {
            const float p0 = __shfl_xor(v0, 32), p1 = __shfl_xor(v1, 32), p2 = __shfl_xor(v2, 32);
            const int j0 = __shfl_xor(i0, 32), j1 = __shfl_xor(i1, 32), j2 = __shfl_xor(i2, 32);
            ins3(p0, j0, v0, v1, v2, i0, i1, i2);
            ins3(p1, j1, v0, v1, v2, i0, i1, i2);
            ins3(p2, j2, v0, v1, v2, i0, i1, i2);
        }
        int r0 = 0, r1 = 0, r2 = 0;
        if (hh == 0) {
            if (i0 >= 0) r0 = __hip_atomic_fetch_add(lcnt + i0, 1, __ATOMIC_RELAXED, __HIP_MEMORY_SCOPE_WORKGROUP);
            if (i1 >= 0) r1 = __hip_atomic_fetch_add(lcnt + i1, 1, __ATOMIC_RELAXED, __HIP_MEMORY_SCOPE_WORKGROUP);
            if (i2 >= 0) r2 = __hip_atomic_fetch_add(lcnt + i2, 1, __ATOMIC_RELAXED, __HIP_MEMORY_SCOPE_WORKGROUP);
        }
        __syncthreads();
        if (tid < 64) { const int c = lcnt[tid]; lbase[tid] = c ? (int)__hip_atomic_fetch_add(gcnt + h * NBLK + tid, (unsigned)c, RLX_AGENT) : 0; }
        __syncthreads();
        if (hh == 0) {
            int* lh = list + (size_t)h * LSTRIDE;
            if (i0 >= 0) lh[list_off(i0) + lbase[i0] + r0] = (t << 2) | 0;
            if (i1 >= 0) lh[list_off(i1) + lbase[i1] + r1] = (t << 2) | 1;
            if (i2 >= 0) lh[list_off(i2) + lbase[i2] + r2] = (t << 2) | 2;
        }
        __syncthreads();
    }
}

constexpr int HG_QM = 0, HG_KM = 8704, HG_QD = 17408, HG_KDT = 25856, HG_VT = 36096, HG_O = 46336, HG_TOT = 62720, HG_DL = 64768, HG_BYTES = 65280;
constexpr int HG_RS = 272, HG_RD = 264, HG_RT = 80;
static_assert(2 * HG_BYTES <= MISC_OFF, "hgrn LDS map");
DI bf16x8 pack8(const f32x16& x, int s) {
    u32x4 p; p.x = pk2(x[8 * s + 0], x[8 * s + 1]); p.y = pk2(x[8 * s + 2], x[8 * s + 3]); p.z = pk2(x[8 * s + 4], x[8 * s + 5]); p.w = pk2(x[8 * s + 6], x[8 * s + 7]);
    return __builtin_bit_cast(bf16x8, p);
}
template <bool READOUT> DI void hgrn_mfma(Frame& F) {
    const int w = F.wave, grp = w >> 2, wq = w & 3, lane = F.lane, r = lane & 31, hh = lane >> 5, p = lane;
    LAS unsigned char* L = F.lds + grp * HG_BYTES;
    const bf16* hq = wsp<bf16>(F, WS_HQ); const bf16* hlf = wsp<bf16>(F, WS_HLF); const bf16* hv = wsp<bf16>(F, WS_HV); const bf16* hg = wsp<bf16>(F, WS_HG);
    const float* lbp = wsp<float>(F, WS_STAT) + ST_LB;
    bf16* mixed = wsp<bf16>(F, WS_MIX);
    for (int base = F.bid * 2; base < NH * HSC; base += 2 * F.G) {
        const int it = base + grp, h = it & 7, sc = it >> 3;
        float* hst = wsp<float>(F, WS_HST) + ((size_t)sc * NH + h) * (HD * HD);
        f32x16 S[4];
#pragma unroll
        for (int kb = 0; kb < 4; ++kb)
#pragma unroll
            for (int i = 0; i < 16; ++i) S[kb][i] = READOUT ? hst[(unsigned)((kb * 32 + crow(i, hh)) * HD + wq * 32 + r)] : 0.f;
        const float lb0 = lbp[h * HD + 2 * p], lb1 = lbp[h * HD + 2 * p + 1];
        const int lt = wq * 64 + lane, nt = lt >> 3, nvg = lt & 7;
        f32x4 gn[4];
        if (READOUT) {
#pragma unroll
            for (int j = 0; j < 4; ++j) gn[j] = *(const f32x4*)(F.in[5] + h * HD + nvg * 16 + 4 * j);
        }
        float sumbl0 = 0.f, sumbl1 = 0.f;
        unsigned xf[8], xq[8], xv[8];
        const unsigned gcol = (unsigned)(h * HD + 2 * p);
        {   const unsigned t0 = (unsigned)(sc * HSCLEN + 8 * wq);
#pragma unroll
            for (int i = 0; i < 8; ++i) { xf[i] = *(const unsigned*)(hlf + (t0 + i) * AW + gcol); xv[i] = *(const unsigned*)(hv + (t0 + i) * AW + gcol); if (READOUT) xq[i] = *(const unsigned*)(hq + (t0 + i) * AW + gcol); } }
        for (int c = 0; c < HSCLEN / 32; ++c) {
            const int tc = sc * HSCLEN + c * 32;
            float bl0[8], bl1[8], f0[8], f1[8];
            {   float run0 = 0.f, run1 = 0.f;
#pragma unroll
                for (int i = 0; i < 8; ++i) {
                    const float fa = lb0 + (1.f - lb0) * sigmoidf_(bflo(xf[i])), fb = lb1 + (1.f - lb1) * sigmoidf_(bfhi(xf[i]));
                    run0 += __logf(fa); run1 += __logf(fb); bl0[i] = run0; bl1[i] = run1; f0[i] = fa; f1[i] = fb;
                }
                *(LAS f32x2*)(L + HG_TOT + (wq * 128 + 2 * p) * 4) = (f32x2){run0, run1};
            }
            __syncthreads();
            {
                float off0 = 0.f, off1 = 0.f, bm0, bm1, be0, be1;
                {   f32x2 tq[4];
#pragma unroll
                    for (int q = 0; q < 4; ++q) tq[q] = *(const LAS f32x2*)(L + HG_TOT + (q * 128 + 2 * p) * 4);
#pragma unroll
                    for (int q = 0; q < 4; ++q) if (q < wq) { off0 += tq[q].x; off1 += tq[q].y; }
                    bm0 = tq[0].x + tq[1].x; bm1 = tq[0].y + tq[1].y; be0 = bm0 + tq[2].x + tq[3].x; be1 = bm1 + tq[2].y + tq[3].y; }
                if (wq == 0) { *(LAS f32x2*)(L + HG_DL + 2 * p * 4) = (f32x2){__expf(be0), __expf(be1)}; sumbl0 += be0; sumbl1 += be1; }
                const float em0 = __expf(-bm0), em1 = __expf(-bm1), ek0 = __expf(bm0 - be0), ek1 = __expf(bm1 - be1);
                unsigned kd0[4], kd1[4], vt0[4], vt1[4];
#pragma unroll
                for (int i = 0; i < 8; ++i) {
                    const int t = 8 * wq + i;
                    const float b0 = bl0[i] + off0, b1 = bl1[i] + off1;
                    const float k0 = 1.f - f0[i], k1 = 1.f - f1[i];
                    const float kdv0 = k0 * __expf(be0 - b0), kdv1 = k1 * __expf(be1 - b1);
                    if (READOUT) {
                        const float q0 = siluf_(bflo(xq[i])), q1 = siluf_(bfhi(xq[i]));
                        const float qd0 = q0 * __expf(b0), qd1 = q1 * __expf(b1);
                        *(LAS unsigned*)(L + HG_QD + t * HG_RD + 4 * p) = pk2(qd0, qd1);
                        *(LAS unsigned*)(L + HG_QM + t * HG_RS + 4 * p) = pk2(qd0 * em0, qd1 * em1);
                        *(LAS unsigned*)(L + HG_KM + t * HG_RS + 4 * p) = pk2(kdv0 * ek0, kdv1 * ek1);
                    }
                    if (i & 1) { kd0[i >> 1] |= pk2(0.f, kdv0) ; kd1[i >> 1] |= pk2(0.f, kdv1); vt0[i >> 1] |= xv[i] << 16; vt1[i >> 1] |= xv[i] & 0xffff0000u; }
                    else { kd0[i >> 1] = pk2(kdv0, 0.f); kd1[i >> 1] = pk2(kdv1, 0.f); vt0[i >> 1] = xv[i] & 0xffffu; vt1[i >> 1] = xv[i] >> 16; }
                }
                *(LAS u32x4*)(L + HG_KDT + (2 * p) * HG_RT + 16 * wq) = (u32x4){kd0[0], kd0[1], kd0[2], kd0[3]};
                *(LAS u32x4*)(L + HG_KDT + (2 * p + 1) * HG_RT + 16 * wq) = (u32x4){kd1[0], kd1[1], kd1[2], kd1[3]};
                *(LAS u32x4*)(L + HG_VT + (2 * p) * HG_RT + 16 * wq) = (u32x4){vt0[0], vt0[1], vt0[2], vt0[3]};
                *(LAS u32x4*)(L + HG_VT + (2 * p + 1) * HG_RT + 16 * wq) = (u32x4){vt1[0], vt1[1], vt1[2], vt1[3]};
            }
            __syncthreads();
            if (c + 1 < HSCLEN / 32) { const unsigned t0 = (unsigned)(tc + 32 + 8 * wq);
#pragma unroll
                for (int i = 0; i < 8; ++i) { xf[i] = *(const unsigned*)(hlf + (t0 + i) * AW + gcol); xv[i] = *(const unsigned*)(hv + (t0 + i) * AW + gcol); if (READOUT) xq[i] = *(const unsigned*)(hq + (t0 + i) * AW + gcol); } }
            u32x4 gg0, gg1;
            if (READOUT) { const u32x4* gp = (const u32x4*)(hg + (unsigned)((tc + nt) * AW + h * HD + nvg * 16)); gg0 = gp[0]; gg1 = gp[1]; }
            if (READOUT) {
                f32x16 X, Y;
#pragma unroll
                for (int i = 0; i < 16; ++i) { X[i] = 0.f; Y[i] = 0.f; }
#pragma unroll
                for (int st = 0; st < 8; ++st) {
                    const bf16x8 a = *(const LAS bf16x8*)(L + HG_KM + r * HG_RS + 32 * st + 16 * hh), b = *(const LAS bf16x8*)(L + HG_QM + r * HG_RS + 32 * st + 16 * hh);
                    X = __builtin_amdgcn_mfma_f32_32x32x16_bf16(a, b, X, 0, 0, 0);
                }
#pragma unroll
                for (int i = 0; i < 16; ++i) if (crow(i, hh) > r) X[i] = 0.f;
#pragma unroll
                for (int kb = 0; kb < 4; ++kb)
#pragma unroll
                    for (int st = 0; st < 2; ++st) {
                        const LAS u32x2* qp = (const LAS u32x2*)(L + HG_QD + r * HG_RD + (kb * 32 + 16 * st + 4 * hh) * 2);
                        const u32x2 a0 = qp[0], a1 = qp[2]; const u32x4 av = {a0.x, a0.y, a1.x, a1.y};
                        Y = __builtin_amdgcn_mfma_f32_32x32x16_bf16(__builtin_bit_cast(bf16x8, av), pack8(S[kb], st), Y, 0, 0, 0);
                    }
#pragma unroll
                for (int st = 0; st < 2; ++st) {
                    const LAS u32x2* vp = (const LAS u32x2*)(L + HG_VT + (wq * 32 + r) * HG_RT + (16 * st + 4 * hh) * 2);
                    const u32x2 b0 = vp[0], b1 = vp[2]; const u32x4 bv = {b0.x, b0.y, b1.x, b1.y};
                    Y = __builtin_amdgcn_mfma_f32_32x32x16_bf16(pack8(X, st), __builtin_bit_cast(bf16x8, bv), Y, 0, 0, 0);
                }
#pragma unroll
                for (int i = 0; i < 16; ++i) *(LAS float*)(L + HG_O + crow(i, hh) * 512 + (wq * 32 + r) * 4) = Y[i];
            }
#pragma unroll
            for (int kb = 0; kb < 4; ++kb) {
#pragma unroll
                for (int g4 = 0; g4 < 4; ++g4) { const f32x4 d = *(const LAS f32x4*)(L + HG_DL + (kb * 32 + 8 * g4 + 4 * hh) * 4);
#pragma unroll
                    for (int j = 0; j < 4; ++j) S[kb][4 * g4 + j] *= d[j]; }
#pragma unroll
                for (int st = 0; st < 2; ++st) {
                    const bf16x8 a = *(const LAS bf16x8*)(L + HG_KDT + (kb * 32 + r) * HG_RT + 32 * st + 16 * hh), b = *(const LAS bf16x8*)(L + HG_VT + (wq * 32 + r) * HG_RT + 32 * st + 16 * hh);
                    S[kb] = __builtin_amdgcn_mfma_f32_32x32x16_bf16(a, b, S[kb], 0, 0, 0);
                }
            }
            __syncthreads();
            if (READOUT) {
                f32x4 o[4]; float ss = 0.f;
#pragma unroll
                for (int j = 0; j < 4; ++j) { o[j] = *(const LAS f32x4*)(L + HG_O + nt * 512 + (nvg * 16 + 4 * j) * 4); ss += (o[j].x * o[j].x + o[j].y * o[j].y) + (o[j].z * o[j].z + o[j].w * o[j].w); }
                ss += __shfl_xor(ss, 1); ss += __shfl_xor(ss, 2); ss += __shfl_xor(ss, 4);
                const float rr = 1.f / sqrtf(ss * (1.f / HD) + EPS);
                const unsigned gw[8] = {gg0.x, gg0.y, gg0.z, gg0.w, gg1.x, gg1.y, gg1.z, gg1.w};
                u32x4 o8;
#pragma unroll
                for (int j = 0; j < 4; ++j) {
                    const float g0 = siluf_(bflo(gw[2 * j])), g1 = siluf_(bfhi(gw[2 * j])), g2 = siluf_(bflo(gw[2 * j + 1])), g3 = siluf_(bfhi(gw[2 * j + 1]));
                    const float sc = rr * MSCALE;
                    int wv = __builtin_amdgcn_cvt_pk_fp8_f32(sat8(o[j].x * sc * gn[j].x * g0), sat8(o[j].y * sc * gn[j].y * g1), 0, false);
                    wv = __builtin_amdgcn_cvt_pk_fp8_f32(sat8(o[j].z * sc * gn[j].z * g2), sat8(o[j].w * sc * gn[j].w * g3), wv, true);
                    o8[j] = (unsigned)wv;
                }
                *(u32x4*)((unsigned char*)mixed + (unsigned)((tc + nt) * D_ + AW + h * HD + nvg * 16)) = o8;
            }
        }
        if (!READOUT) {
#pragma unroll
            for (int kb = 0; kb < 4; ++kb)
#pragma unroll
                for (int i = 0; i < 16; ++i) hst[(unsigned)((kb * 32 + crow(i, hh)) * HD + wq * 32 + r)] = S[kb][i];
            if (wq == 0) *(f32x2*)(wsp<float>(F, WS_HDEC) + ((size_t)sc * NH + h) * HD + 2 * p) = (f32x2){__expf(sumbl0), __expf(sumbl1)};
        }
        __syncthreads();
    }
}
DI void hgrn_scan(Frame& F) {
    float* hst = wsp<float>(F, WS_HST); const float* hdec = wsp<float>(F, WS_HDEC);
    for (int e = F.bid * NTHREADS + F.tid; e < NH * HD * HD; e += F.G * NTHREADS) {
        const int hk = e >> 7;
        float cur = 0.f;
#pragma unroll 1
        for (int sc0 = 0; sc0 < HSC; sc0 += 8) {
            float tmp[8], dc[8];
#pragma unroll
            for (int j = 0; j < 8; ++j) { tmp[j] = hst[(size_t)(sc0 + j) * (NH * HD * HD) + e]; dc[j] = hdec[(size_t)(sc0 + j) * (NH * HD) + hk]; }
#pragma unroll
            for (int j = 0; j < 8; ++j) { hst[(size_t)(sc0 + j) * (NH * HD * HD) + e] = cur; cur = dc[j] * cur + tmp[j]; }
        }
    }
}

constexpr int AT_KSTR = 272, AT_VSTR = 520;
constexpr int AT_K_OFF = 0, AT_V_OFF = 256 * AT_KSTR, AT_PRE_OFF = AT_V_OFF + 128 * AT_VSTR;
static_assert(AT_PRE_OFF + (520 + 512) * 4 <= MISC_OFF, "attention LDS map");
DI void p3_attn(Frame& F) {
    LAS unsigned char* Kl = F.lds + AT_K_OFF; LAS unsigned char* Vl = F.lds + AT_V_OFF; LAS int* pre = (LAS int*)(F.lds + AT_PRE_OFF); LAS int* cntl = pre + 520;
    const bf16* q = wsp<bf16>(F, WS_Q); const bf16* kg = wsp<bf16>(F, WS_K); const bf16* vt = wsp<bf16>(F, WS_VT);
    const int* list = wsp<int>(F, WS_LIST);
    bf16* po = (bf16*)F.out;
    f32x2* pml = wsp<f32x2>(F, WS_PML);
    const unsigned* gcnt = F.ctl + CW_GCNT;
    const int tid = F.tid, lane = F.lane, w = F.wave, r = lane & 31, hh = lane >> 5;
    if (w == 0) {
        int c[8], s = 0;
#pragma unroll
        for (int k = 0; k < 8; ++k) { const unsigned cc = __hip_atomic_load(gcnt + lane * 8 + k, RLX_AGENT); cntl[lane * 8 + k] = (int)cc; c[k] = 1 + (int)((cc + 255u) >> 8); s += c[k]; }
        int incl = s;
#pragma unroll
        for (int o = 1; o < 64; o <<= 1) { const int t = __shfl_up(incl, o); if (lane >= o) incl += t; }
        int run = incl - s;
#pragma unroll
        for (int k = 0; k < 8; ++k) { pre[lane * 8 + k] = run; run += c[k]; }
        if (lane == 63) pre[512] = incl;
    }
    __syncthreads();
    const int total = pre[512];
    const int ti0 = (int)(((long)total * F.bid) / F.G), ti1 = (int)(((long)total * (F.bid + 1)) / F.G);
    int staged = -1;
#define AT_DECODE(ti_, lo_, seg_, nvalid_) do { int _l = 0, _h = 511; while (_l < _h) { const int _m = (_l + _h + 1) >> 1; if (pre[_m] <= (ti_)) _l = _m; else _h = _m - 1; } \
        lo_ = _l; seg_ = (ti_) - pre[_l]; nvalid_ = seg_ == 0 ? 256 : min(256, cntl[_l] - (seg_ - 1) * 256); } while (0)
#define AT_ENTRY(lo_, seg_, nvalid_) (((seg_) == 0) ? ((((lo_) & 63) * LBLK + ei) << 2 | 3) : ((ei < (nvalid_)) ? list[(unsigned)(((lo_) >> 6) * LSTRIDE + list_off((lo_) & 63) + ((seg_) - 1) * 256 + ei)] : 0))
    const int ei = w * 32 + r;
    int lo = 0, seg = 0, nvalid = 0, e = 0;
    bf16x8 Qf[8];
    if (ti0 < ti1) {
        AT_DECODE(ti0, lo, seg, nvalid); e = AT_ENTRY(lo, seg, nvalid);
        const bf16x8* qp = (const bf16x8*)(q + (unsigned)((e >> 2) * AW + (lo >> 6) * HD + 8 * hh));
#pragma unroll
        for (int s = 0; s < 8; ++s) Qf[s] = qp[2 * s];
    }
    for (int ti = ti0; ti < ti1; ++ti) {
        const int h = lo >> 6, n = lo & 63;
        const bool valid = ei < nvalid;
        const int t = e >> 2, slot = e & 3;
        int lo2 = lo, seg2 = 0, nvalid2 = 0, e2 = 0;
        const bool has_next = ti + 1 < ti1;
        if (has_next) { AT_DECODE(ti + 1, lo2, seg2, nvalid2); e2 = AT_ENTRY(lo2, seg2, nvalid2); }
        if (staged != lo) {
        if (staged >= 0) __syncthreads();
        staged = lo;
#pragma unroll
        for (int p = 0; p < 8; ++p) {
            const int idx = p * NTHREADS + tid;
            { const int row = idx >> 4, pc = idx & 15; const u32x4 v = *(const u32x4*)(kg + (unsigned)((n * LBLK + row) * AW + h * HD + pc * 8)); *(LAS u32x4*)(Kl + row * AT_KSTR + pc * 16) = v; }
            { const int d = idx >> 5, pc = idx & 31; const u32x4 v = *(const u32x4*)(vt + (unsigned)((h * HD + d) * S_ + n * LBLK + pc * 8));
              LAS u32x2* dst = (LAS u32x2*)(Vl + d * AT_VSTR + pc * 16); dst[0] = (u32x2){v.x, v.y}; dst[1] = (u32x2){v.z, v.w}; }
        }
        __syncthreads();
        }
        f32x16 X[8];
        bf16x8 Ac[8], An[4];
#pragma unroll
        for (int s = 0; s < 8; ++s) Ac[s] = *(const LAS bf16x8*)(Kl + r * AT_KSTR + 32 * s + 16 * hh);
#pragma unroll
        for (int kb = 0; kb < 8; ++kb) {
            if (kb < 7) {
#pragma unroll
                for (int s = 0; s < 4; ++s) An[s] = *(const LAS bf16x8*)(Kl + ((kb + 1) * 32 + r) * AT_KSTR + 32 * s + 16 * hh);
            }
            f32x16 x;
            if (seg == 0 && kb > w) {
#pragma unroll
                for (int i = 0; i < 16; ++i) x[i] = -INFINITY;
            } else {
#pragma unroll
                for (int i = 0; i < 16; ++i) x[i] = 0.f;
                __builtin_amdgcn_s_setprio(1);
#pragma unroll
                for (int s = 0; s < 8; ++s) x = __builtin_amdgcn_mfma_f32_32x32x16_bf16(Ac[s], Qf[s], x, 0, 0, 0);
                __builtin_amdgcn_s_setprio(0);
                if (seg == 0 && kb == w) {
#pragma unroll
                    for (int i = 0; i < 16; ++i) if (crow(i, hh) > r) x[i] = -INFINITY;
                }
            }
            X[kb] = x;
            if (kb < 7) {
#pragma unroll
                for (int s = 0; s < 4; ++s) Ac[s] = An[s];
#pragma unroll
                for (int s = 4; s < 8; ++s) Ac[s] = *(const LAS bf16x8*)(Kl + ((kb + 1) * 32 + r) * AT_KSTR + 32 * s + 16 * hh);
            }
        }
        if (has_next) {
            const bf16x8* qp = (const bf16x8*)(q + (unsigned)((e2 >> 2) * AW + (lo2 >> 6) * HD + 8 * hh));
#pragma unroll
            for (int s = 0; s < 8; ++s) Qf[s] = qp[2 * s];
        }
        float mx = -INFINITY;
#pragma unroll
        for (int kb = 0; kb < 8; ++kb)
#pragma unroll
            for (int i = 0; i < 16; ++i) mx = fmaxf(mx, X[kb][i]);
        mx = fmaxf(mx, __shfl_xor(mx, 32));
        float l = 0.f;
        u32x4 P[8][2];
#pragma unroll
        for (int kb = 0; kb < 8; ++kb)
#pragma unroll
            for (int s2 = 0; s2 < 2; ++s2) {
                float pe[8];
#pragma unroll
                for (int j = 0; j < 8; ++j) { pe[j] = __builtin_amdgcn_exp2f(X[kb][8 * s2 + j] - mx); l += pe[j]; }
                P[kb][s2] = (u32x4){pk2(pe[0], pe[1]), pk2(pe[2], pe[3]), pk2(pe[4], pe[5]), pk2(pe[6], pe[7])};
            }
        l += __shfl_xor(l, 32);
        f32x16 O[4];
#pragma unroll
        for (int db = 0; db < 4; ++db)
#pragma unroll
            for (int i = 0; i < 16; ++i) O[db][i] = 0.f;
#pragma unroll
        for (int kb = 0; kb < 8; ++kb)
#pragma unroll
            for (int s2 = 0; s2 < 2; ++s2) {
                const bf16x8 bfrag = __builtin_bit_cast(bf16x8, P[kb][s2]);
                __builtin_amdgcn_s_setprio(1);
#pragma unroll
                for (int db = 0; db < 4; ++db) {
                    const LAS u32x2* vp = (const LAS u32x2*)(Vl + (db * 32 + r) * AT_VSTR + (kb * 32 + 16 * s2 + 4 * hh) * 2);
                    const u32x2 a0 = vp[0], a1 = vp[2];
                    const u32x4 av = {a0.x, a0.y, a1.x, a1.y};
                    O[db] = __builtin_amdgcn_mfma_f32_32x32x16_bf16(__builtin_bit_cast(bf16x8, av), bfrag, O[db], 0, 0, 0);
                }
                __builtin_amdgcn_s_setprio(0);
            }
        {
            const float inv = OSCALE / l;
            unsigned char* orow = (unsigned char*)po + (unsigned)(((t * NH + h) * 4 + slot) * HD) + 16 * hh;
#pragma unroll
            for (int db = 0; db < 4; ++db) {
                unsigned pk[4];
#pragma unroll
                for (int g4 = 0; g4 < 4; ++g4) { int wv = __builtin_amdgcn_cvt_pk_fp8_f32(O[db][4 * g4 + 0] * inv, O[db][4 * g4 + 1] * inv, 0, false); wv = __builtin_amdgcn_cvt_pk_fp8_f32(O[db][4 * g4 + 2] * inv, O[db][4 * g4 + 3] * inv, wv, true); pk[g4] = (unsigned)wv; }
                const unsigned rcv0 = (unsigned)__shfl_xor((int)(hh ? pk[0] : pk[2]), 32), rcv1 = (unsigned)__shfl_xor((int)(hh ? pk[1] : pk[3]), 32);
                const u32x4 ov = hh ? (u32x4){rcv0, pk[2], rcv1, pk[3]} : (u32x4){pk[0], rcv0, pk[1], rcv1};
                if (valid) *(u32x4*)(orow + db * 32) = ov;
            }
            if (valid && hh == 0) pml[(unsigned)((t * NH + h) * 4 + slot)] = (f32x2){mx, l};
        }
        lo = lo2; seg = seg2; nvalid = nvalid2; e = e2;
    }
#undef AT_DECODE
#undef AT_ENTRY
    __syncthreads();
}

DI void p4_combine(Frame& F) {
    const bf16* po = (const bf16*)F.out; const f32x2* pml = wsp<f32x2>(F, WS_PML); bf16* mixed = wsp<bf16>(F, WS_MIX);
    const size_t total = (size_t)S_ * NH * 16, stride = (size_t)F.G * NTHREADS;
    for (size_t w0 = (size_t)F.bid * NTHREADS + F.tid; w0 < total; w0 += 2 * stride) {
        f32x2 ml[2][4]; u32x2 pv[2][4]; int nvv[2];
#pragma unroll
        for (int u = 0; u < 2; ++u) { const size_t wi = w0 + u * stride;
            if (wi < total) { const int c16 = (int)(wi & 15); const size_t th = wi >> 4; const int t = (int)(th >> 3); const int nv = min(3, t >> 8); nvv[u] = nv;
#pragma unroll
                for (int j = 0; j < 4; ++j) { const bool on = (j == 3) || (j < nv); ml[u][j] = on ? pml[th * 4 + j] : (f32x2){-INFINITY, 0.f}; pv[u][j] = on ? *(const u32x2*)((const unsigned char*)po + (th * 4 + j) * HD + c16 * 8) : (u32x2){0u, 0u}; } } }
#pragma unroll
        for (int u = 0; u < 2; ++u) { const size_t wi = w0 + u * stride;
            if (wi < total) { const int c16 = (int)(wi & 15); const size_t th = wi >> 4; const int t = (int)(th >> 3), h = (int)(th & 7); const int nv = nvv[u];
                float M = -INFINITY;
#pragma unroll
                for (int j = 0; j < 4; ++j) M = fmaxf(M, ml[u][j].x);
                float wj[4], W = 0.f;
#pragma unroll
                for (int j = 0; j < 4; ++j) { wj[j] = ((j == 3) || (j < nv)) ? __builtin_amdgcn_exp2f(ml[u][j].x - M) * ml[u][j].y : 0.f; W += wj[j]; }
                const float iW = 1.f / W;
                float o[8];
#pragma unroll
                for (int i = 0; i < 8; ++i) o[i] = 0.f;
#pragma unroll
                for (int j = 0; j < 4; ++j) { const u32x2 v = pv[u][j]; const float ww = wj[j] * iW * (1.f / OSCALE);
                    const f32x2 a0 = __builtin_amdgcn_cvt_pk_f32_fp8((int)v.x, false), a1 = __builtin_amdgcn_cvt_pk_f32_fp8((int)v.x, true), a2 = __builtin_amdgcn_cvt_pk_f32_fp8((int)v.y, false), a3 = __builtin_amdgcn_cvt_pk_f32_fp8((int)v.y, true);
                    o[0] += ww * a0.x; o[1] += ww * a0.y; o[2] += ww * a1.x; o[3] += ww * a1.y; o[4] += ww * a2.x; o[5] += ww * a2.y; o[6] += ww * a3.x; o[7] += ww * a3.y; }
                int w0 = __builtin_amdgcn_cvt_pk_fp8_f32(sat8(o[0] * MSCALE), sat8(o[1] * MSCALE), 0, false); w0 = __builtin_amdgcn_cvt_pk_fp8_f32(sat8(o[2] * MSCALE), sat8(o[3] * MSCALE), w0, true);
                int w1 = __builtin_amdgcn_cvt_pk_fp8_f32(sat8(o[4] * MSCALE), sat8(o[5] * MSCALE), 0, false); w1 = __builtin_amdgcn_cvt_pk_fp8_f32(sat8(o[6] * MSCALE), sat8(o[7] * MSCALE), w1, true);
                *(u32x2*)((unsigned char*)mixed + (size_t)t * D_ + h * HD + c16 * 8) = (u32x2){(unsigned)w0, (unsigned)w1}; } }
    }
}

struct Epi2 {
    static constexpr bool PERM = true, AFTER_DRAIN = false;
    const float* x; float* out; bf16* hb; float* ssq;
    DI void operator()(const pg8::f32x4 (&acc)[2][2][4][2], const pg8::Unit& u, int wr, int wc, int fr, int fq) const {
        asm volatile("" : "+v"(fr), "+v"(fq));
        const int row0 = u.pm * 256 + wr * 64 + fr, col0 = u.pn * 256 + wc * 32 + 8 * fq;
#pragma unroll
        for (int ai = 0; ai < 2; ++ai)
#pragma unroll
            for (int m = 0; m < 4; ++m) {
                const int row = row0 + ai * 128 + m * 16; const size_t off = (size_t)row * D_ + col0; float s = 0.f;
#pragma unroll
                for (int bj = 0; bj < 2; ++bj) {
                    const f32x4 v0 = *(const f32x4*)(x + off + bj * 128) + acc[ai][bj][m][0] * (1.f / (MSCALE * W1SCALE));
                    const f32x4 v1 = *(const f32x4*)(x + off + bj * 128 + 4) + acc[ai][bj][m][1] * (1.f / (MSCALE * W1SCALE));
                    u32x4 b; b.x = pk2(v0[0], v0[1]); b.y = pk2(v0[2], v0[3]); b.z = pk2(v1[0], v1[1]); b.w = pk2(v1[2], v1[3]);
                    *(u32x4*)(hb + off + bj * 128) = b;
                    s += (v0[0] * v0[0] + v0[1] * v0[1]) + (v0[2] * v0[2] + v0[3] * v0[3]) + (v1[0] * v1[0] + v1[1] * v1[1]) + (v1[2] * v1[2] + v1[3] * v1[3]);
                }
                s += __shfl_xor(s, 16); s += __shfl_xor(s, 32);
                if (fq == 0) ssq[(size_t)row * 32 + u.pn * 4 + wc] = s;
                if (m & 1) asm volatile("" ::: "memory");
            }
    }
};
struct EpiB {
    static constexpr bool PERM = true, AFTER_DRAIN = false;
    bf16* O; int ldc;
    DI void operator()(const pg8::f32x4 (&acc)[2][2][4][2], const pg8::Unit& u, int wr, int wc, int fr, int fq) const {
        asm volatile("" : "+v"(fr), "+v"(fq));
        const int row0 = u.pm * 256 + wr * 64 + fr, col0 = u.pn * 256 + wc * 32 + 8 * fq;
#pragma unroll
        for (int ai = 0; ai < 2; ++ai)
#pragma unroll
            for (int m = 0; m < 4; ++m) { bf16* rowp = O + (size_t)(row0 + ai * 128 + m * 16) * ldc + col0;
#pragma unroll
                for (int bj = 0; bj < 2; ++bj) { const f32x4 v0 = acc[ai][bj][m][0], v1 = acc[ai][bj][m][1];
                    u32x4 w; w.x = pk2(v0[0], v0[1]); w.y = pk2(v0[2], v0[3]); w.z = pk2(v1[0], v1[1]); w.w = pk2(v1[2], v1[3]);
                    *(u32x4*)(rowp + bj * 128) = w; } }
    }
};
struct EpiP {
    static constexpr bool PERM = true, AFTER_DRAIN = false;
    bf16* O;
    DI void operator()(const pg8::f32x4 (&acc)[2][2][4][2], const pg8::Unit& u, int wr, int wc, int fr, int fq) const {
        asm volatile("" : "+v"(fr), "+v"(fq));
        const int row0 = u.pm * 256 + wr * 64 + fr, col0 = u.pn * 256 + wc * 32 + 8 * fq;
#pragma unroll
        for (int ai = 0; ai < 2; ++ai)
#pragma unroll
            for (int m = 0; m < 4; ++m) { const size_t off = (size_t)(row0 + ai * 128 + m * 16) * D_ + col0;
#pragma unroll
                for (int bj = 0; bj < 2; ++bj) { const f32x4 v0 = acc[ai][bj][m][0], v1 = acc[ai][bj][m][1];
                    u32x4 w; w.x = pk2(v0[0], v0[1]); w.y = pk2(v0[2], v0[3]); w.z = pk2(v1[0], v1[1]); w.w = pk2(v1[2], v1[3]);
                    *(u32x4*)(O + off + bj * 128) = w; } }
    }
};
struct Epi4 {
    static constexpr bool PERM = true, AFTER_DRAIN = false;
    bf16* h3b; const bf16* hb; const bf16* ple; const float* rs3; float* ssq;
    DI void operator()(const pg8::f32x4 (&acc)[2][2][4][2], const pg8::Unit& u, int wr, int wc, int fr, int fq) const {
        asm volatile("" : "+v"(fr), "+v"(fq));
        const int row0 = u.pm * 256 + wr * 64 + fr, col0 = u.pn * 256 + wc * 32 + 8 * fq;
#pragma unroll
        for (int ai = 0; ai < 2; ++ai)
#pragma unroll
            for (int m = 0; m < 4; ++m) {
                const int row = row0 + ai * 128 + m * 16; const size_t off = (size_t)row * D_ + col0; float s = 0.f; const float rs = rs3[row];
#pragma unroll
                for (int bj = 0; bj < 2; ++bj) {
                    const u32x4 pw = *(const u32x4*)(ple + off + bj * 128), hw = *(const u32x4*)(hb + off + bj * 128);
                    const float pv[8] = {bflo(pw.x), bfhi(pw.x), bflo(pw.y), bfhi(pw.y), bflo(pw.z), bfhi(pw.z), bflo(pw.w), bfhi(pw.w)};
                    float v[8] = {bflo(hw.x), bfhi(hw.x), bflo(hw.y), bfhi(hw.y), bflo(hw.z), bfhi(hw.z), bflo(hw.w), bfhi(hw.w)};
#pragma unroll
                    for (int i = 0; i < 4; ++i) { v[i] += sigmoidf_(acc[ai][bj][m][0][i] * rs) * pv[i]; v[4 + i] += sigmoidf_(acc[ai][bj][m][1][i] * rs) * pv[4 + i]; }
                    u32x4 o; o.x = pk2(v[0], v[1]); o.y = pk2(v[2], v[3]); o.z = pk2(v[4], v[5]); o.w = pk2(v[6], v[7]);
                    *(u32x4*)(h3b + off + bj * 128) = o;
#pragma unroll
                    for (int i = 0; i < 8; ++i) s += v[i] * v[i];
                }
                s += __shfl_xor(s, 16); s += __shfl_xor(s, 32);
                if (fq == 0) ssq[(size_t)row * 32 + u.pn * 4 + wc] = s;
                if (m & 1) asm volatile("" ::: "memory");
            }
    }
};

DI unsigned fkey(float f, unsigned lowbits, unsigned mask) { unsigned u = __float_as_uint(f); u = (u & 0x80000000u) ? ~u : (u | 0x80000000u); return (u & ~mask) | lowbits; }
DI float fval(unsigned k, unsigned mask) { unsigned u = k & ~mask; u = (u & 0x80000000u) ? (u & 0x7fffffffu) : ~u; return __uint_as_float(u); }
template <int N> DI void bitonic_sort_desc(unsigned (&v)[N]) {
#pragma unroll
    for (int k = 2; k <= N; k <<= 1)
#pragma unroll
        for (int j = k >> 1; j > 0; j >>= 1)
#pragma unroll
            for (int i = 0; i < N; ++i) { const int l = i ^ j;
                if (l > i) { const bool desc = ((i & k) == 0); const unsigned a = v[i], b = v[l]; v[i] = desc ? max(a, b) : min(a, b); v[l] = desc ? min(a, b) : max(a, b); } }
}
DI void merge_top16(unsigned (&a)[16], const unsigned (&b)[16]) {
#pragma unroll
    for (int i = 0; i < 16; ++i) a[i] = max(a[i], b[15 - i]);
#pragma unroll
    for (int j = 8; j > 0; j >>= 1)
#pragma unroll
        for (int i = 0; i < 16; ++i) { const int l = i ^ j; if (l > i) { const unsigned x = a[i], y = a[l]; a[i] = max(x, y); a[l] = min(x, y); } }
}
DI void p7_route(Frame& F) {
    const bf16* qry = wsp<bf16>(F, WS_QRY); const bf16* skb = wsp<bf16>(F, WS_SKB);
    float* stat = wsp<float>(F, WS_STAT); const float* ssq2 = wsp<float>(F, WS_SSQ2);
    int* pidx = wsp<int>(F, WS_PIDX); float* pgate = wsp<float>(F, WS_PGATE);
    LAS unsigned* tops = (LAS unsigned*)F.lds;
    const int tid = F.tid, lane = F.lane, w = F.wave, r = lane & 31, hh = lane >> 5;
    const int tg = w & 3, p = w >> 2;
    for (int it = F.bid; it < (S_ / 128) * 2; it += F.G) {
        const int hg = it & 1, tb = it >> 1;
        const int t = tb * 128 + tg * 32 + r;
        float ss = 0.f;
        { const f32x4* sp = (const f32x4*)(ssq2 + (size_t)t * 32);
#pragma unroll
          for (int j = 0; j < 8; ++j) { const f32x4 v = sp[j]; ss += (v.x + v.y) + (v.z + v.w); } }
        const float rs2 = 1.f / sqrtf(ss * (1.f / D_) + EPS);
        if (hg == 0 && p == 0 && hh == 0) stat[ST_RS2 + t] = rs2;
        for (int hq = 0; hq < 4; ++hq) {
            const int h = hg * 4 + hq;
            bf16x8 Bq[8];
            { const bf16x8* qp = (const bf16x8*)(qry + (size_t)t * D_ + h * 256 + p * 128 + 8 * hh);
#pragma unroll
              for (int s = 0; s < 8; ++s) Bq[s] = qp[2 * s]; }
            unsigned kv[4][16];
            const bf16* kbase = skb + (size_t)((h * 2 + p) * NKEY) * 128;
#pragma unroll
            for (int kt = 0; kt < 4; ++kt) {
                f32x16 x;
#pragma unroll
                for (int i = 0; i < 16; ++i) x[i] = 0.f;
                const bf16x8* ap = (const bf16x8*)(kbase + (size_t)(kt * 32 + r) * 128 + 8 * hh);
#pragma unroll
                for (int s = 0; s < 8; ++s) x = __builtin_amdgcn_mfma_f32_32x32x16_bf16(ap[2 * s], Bq[s], x, 0, 0, 0);
#pragma unroll
                for (int i = 0; i < 16; ++i) { const int key = kt * 32 + crow(i, hh); kv[kt][i] = fkey(x[i] * rs2, (unsigned)(127 - key), 127u); }
            }
#pragma unroll
            for (int kt = 0; kt < 4; ++kt) bitonic_sort_desc<16>(kv[kt]);
            merge_top16(kv[0], kv[1]); merge_top16(kv[2], kv[3]); merge_top16(kv[0], kv[2]);
            unsigned (&tk)[16] = kv[0];
            {
                unsigned ok[16];
#pragma unroll
                for (int i = 0; i < 16; ++i) ok[i] = (unsigned)__shfl_xor((int)tk[i], 32);
                merge_top16(tk, ok);
            }
            if (hh == 0) {
                LAS u32x4* dst = (LAS u32x4*)(tops + (((tg * 32 + r) * 4 + hq) * 2 + p) * 16);
                dst[0] = (u32x4){tk[0], tk[1], tk[2], tk[3]}; dst[1] = (u32x4){tk[4], tk[5], tk[6], tk[7]}; dst[2] = (u32x4){tk[8], tk[9], tk[10], tk[11]}; dst[3] = (u32x4){tk[12], tk[13], tk[14], tk[15]};
            }
        }
        __syncthreads();
        {
            const int tl = tid & 127, hq = tid >> 7, h = hg * 4 + hq;
            const int tt = tb * 128 + tl;
            unsigned ka[16], kb[16];
            { const LAS u32x4* s = (const LAS u32x4*)(tops + ((tl * 4 + hq) * 2) * 16);
#pragma unroll
              for (int j = 0; j < 4; ++j) { const u32x4 a = s[j], b = s[4 + j]; ka[4 * j] = a.x; ka[4 * j + 1] = a.y; ka[4 * j + 2] = a.z; ka[4 * j + 3] = a.w; kb[4 * j] = b.x; kb[4 * j + 1] = b.y; kb[4 * j + 2] = b.z; kb[4 * j + 3] = b.w; } }
            float va[16], vb[16];
#pragma unroll
            for (int i = 0; i < 16; ++i) { va[i] = fval(ka[i], 127u); vb[i] = fval(kb[i], 127u); }
            unsigned cc[4][16];
#pragma unroll
            for (int gq = 0; gq < 4; ++gq)
#pragma unroll
                for (int k = 0; k < 16; ++k) cc[gq][k] = 0u;
            {
                int cnt = 0;
#pragma unroll
                for (int i = 0; i < 16; ++i)
#pragma unroll
                    for (int j = 0; j < 16; ++j) if ((i + 1) * (j + 1) <= 16) { cc[cnt >> 4][cnt & 15] = fkey(va[i] + vb[j], (unsigned)(255 - (i * 16 + j)), 255u); ++cnt; }
            }
#pragma unroll
            for (int gq = 0; gq < 4; ++gq) bitonic_sort_desc<16>(cc[gq]);
            merge_top16(cc[0], cc[1]); merge_top16(cc[2], cc[3]); merge_top16(cc[0], cc[2]);
            unsigned (&ck)[16] = cc[0];
            float sv[16]; float mxv = -INFINITY;
#pragma unroll
            for (int i = 0; i < 16; ++i) { sv[i] = fval(ck[i], 255u); mxv = fmaxf(mxv, sv[i]); }
            float den = 0.f;
#pragma unroll
            for (int i = 0; i < 16; ++i) { sv[i] = __expf(sv[i] - mxv); den += sv[i]; }
            const float iden = 1.f / den;
            int ev[16];
#pragma unroll
            for (int i = 0; i < 16; ++i) {
                const int pos = 255 - (int)(ck[i] & 255u), ci = pos >> 4, cj = pos & 15;
                unsigned ea = 0u, eb = 0u;
#pragma unroll
                for (int k = 0; k < 16; ++k) { ea = (ci == k) ? ka[k] : ea; eb = (cj == k) ? kb[k] : eb; }
                ev[i] = (int)((127u - (ea & 127u)) * 128u + (127u - (eb & 127u)));
                sv[i] *= iden;
            }
            u32x4* io = (u32x4*)(pidx + (size_t)tt * 128 + h * 16); f32x4* go = (f32x4*)(pgate + (size_t)tt * 128 + h * 16);
#pragma unroll
            for (int j = 0; j < 4; ++j) { io[j] = (u32x4){(unsigned)ev[4 * j], (unsigned)ev[4 * j + 1], (unsigned)ev[4 * j + 2], (unsigned)ev[4 * j + 3]}; go[j] = (f32x4){sv[4 * j], sv[4 * j + 1], sv[4 * j + 2], sv[4 * j + 3]}; }
        }
        __syncthreads();
    }
}

DI float gelu_erf(float v) {
    const float av = fabsf(v), t = __builtin_amdgcn_rcpf(av * 0.2316418882f + 1.0f);
    float q = t * 0.5307027145f + (-0.7265760135f); q = q * t + 0.7107068705f; q = q * t + (-0.142248368f); q = q * t + 0.127414796f; q = q * t;
    const float e = __builtin_amdgcn_exp2f((v * v) * (-0.72134752044f));
    const float m = v * (q * e);
    return v < 0.f ? m : v - m;
}
DI float dpp_xor1(float v) { return __builtin_bit_cast(float, __builtin_amdgcn_update_dpp(0, __builtin_bit_cast(int, v), 0xB1, 0xF, 0xF, false)); }
DI float dpp_xor2(float v) { return __builtin_bit_cast(float, __builtin_amdgcn_update_dpp(0, __builtin_bit_cast(int, v), 0x4E, 0xF, 0xF, false)); }
DI float dpp_xor4(float v) { int t = __builtin_amdgcn_update_dpp(0, __builtin_bit_cast(int, v), 0x141, 0xF, 0xF, false);
                             t = __builtin_amdgcn_update_dpp(0, t, 0x1B, 0xF, 0xF, false); return __builtin_bit_cast(float, t); }
DI float dpp_xor8(float v) { return __builtin_bit_cast(float, __builtin_amdgcn_update_dpp(0, __builtin_bit_cast(int, v), 0x128, 0xF, 0xF, false)); }
DI float swap32_sum(float x, float y) { asm volatile("s_nop 1\n\tv_permlane32_swap_b32 %0, %1" : "+v"(x), "+v"(y)); return x + y; }
DI float swap16_sum(float x, float y) { asm volatile("s_nop 1\n\tv_permlane16_swap_b32 %0, %1" : "+v"(x), "+v"(y)); return x + y; }
DI void p8_peer_sliced(Frame& F) {
    const unsigned char* down = wsp<unsigned char>(F, WS_DOWN); const unsigned char* up = wsp<unsigned char>(F, WS_UP);
    bf16* hb = wsp<bf16>(F, WS_H1B); float* stat = wsp<float>(F, WS_STAT);
    const int* pidx = wsp<int>(F, WS_PIDX); const float* pgate = wsp<float>(F, WS_PGATE);
    const int lane = F.lane, g = lane >> 3, l8 = lane & 7;
    LAS unsigned char* wsB = F.lds + F.wave * 10240;
#define P8_TI(i) ((LAS int*)(wsB + (i) * 1280))
#define P8_TD(i) ((LAS float*)(wsB + (i) * 1280 + 512))
#define P8_SS(i) ((LAS float*)(wsB + (i) * 1280 + 1024))
    const int jjA = 8 * (lane & 1) + 4 * ((lane >> 1) & 1) + 2 * ((lane >> 2) & 1);
    const int posA = g * 16 + jjA;
    for (int tbase = (F.bid * NWAVES + F.wave) * 8; tbase < S_; tbase += F.G * NWAVES * 8) {
#pragma unroll
        for (int i = 0; i < 8; ++i) {
            const int e0 = pidx[(unsigned)((tbase + i) * 128 + lane)], e1 = pidx[(unsigned)((tbase + i) * 128 + 64 + lane)];
            P8_TI(i)[(lane & 7) * 16 + (lane >> 3)] = e0; P8_TI(i)[(lane & 7) * 16 + 8 + (lane >> 3)] = e1;
            P8_TD(i)[lane] = 0.f; P8_TD(i)[64 + lane] = 0.f; P8_SS(i)[lane] = 0.f;
        }
        for (int s = 0; s < 16; ++s) {
#pragma unroll 1
            for (int i = 0; i < 8; ++i) {
                int ln = lane; asm volatile("" : "+v"(ln));
                const bool b0 = ln & 1, b1 = ln & 2, b2 = ln & 4;
                u32x4 exv[4];
#pragma unroll
                for (int k = 0; k < 4; ++k) exv[k] = *(const LAS u32x4*)(P8_TI(i) + g * 16 + 4 * k);
                f32x2 hf[8];
                { const u32x4* hp = (const u32x4*)(hb + (unsigned)((tbase + i) * D_ + 128 * s + 16 * l8)); const u32x4 a = hp[0], b = hp[1];
                  hf[0] = (f32x2){bflo(a.x), bfhi(a.x)}; hf[1] = (f32x2){bflo(a.y), bfhi(a.y)}; hf[2] = (f32x2){bflo(a.z), bfhi(a.z)}; hf[3] = (f32x2){bflo(a.w), bfhi(a.w)};
                  hf[4] = (f32x2){bflo(b.x), bfhi(b.x)}; hf[5] = (f32x2){bflo(b.y), bfhi(b.y)}; hf[6] = (f32x2){bflo(b.z), bfhi(b.z)}; hf[7] = (f32x2){bflo(b.w), bfhi(b.w)}; }
                float pv[16];
                {
                    u32x4 rv[16];
#pragma unroll
                    for (int jj = 0; jj < 16; ++jj) rv[jj] = *(const u32x4*)(down + (unsigned)((int)exv[jj >> 2][jj & 3] * D_ + 128 * s + 16 * l8));
#pragma unroll
                    for (int jj = 0; jj < 16; ++jj) { f32x2 a2 = {0.f, 0.f};
#pragma unroll
                        for (int q = 0; q < 4; ++q) { a2 += hf[2 * q] * __builtin_amdgcn_cvt_pk_f32_fp8((int)rv[jj][q], false); a2 += hf[2 * q + 1] * __builtin_amdgcn_cvt_pk_f32_fp8((int)rv[jj][q], true); }
                        pv[jj] = a2.x + a2.y; }
                    __builtin_amdgcn_sched_barrier(0);
                }
                float p8[8], p4[4];
#pragma unroll
                for (int k = 0; k < 8; ++k) { const float snd = b0 ? pv[k] : pv[k + 8], kp = b0 ? pv[k + 8] : pv[k]; p8[k] = kp + dpp_xor1(snd); }
#pragma unroll
                for (int k = 0; k < 4; ++k) { const float snd = b1 ? p8[k] : p8[k + 4], kp = b1 ? p8[k + 4] : p8[k]; p4[k] = kp + dpp_xor2(snd); }
                { const float snd0 = b2 ? p4[0] : p4[2], kp0 = b2 ? p4[2] : p4[0], snd1 = b2 ? p4[1] : p4[3], kp1 = b2 ? p4[3] : p4[1];
                  LAS f32x2* td = (LAS f32x2*)(P8_TD(i) + posA); f32x2 d = *td; d.x += kp0 + dpp_xor4(snd0); d.y += kp1 + dpp_xor4(snd1); *td = d; }
            }
        }
#pragma unroll 1
        for (int i = 0; i < 8; ++i) {
            const float rs2 = stat[ST_RS2 + tbase + i] * (1.f / DSCALE);
            LAS f32x2* td = (LAS f32x2*)(P8_TD(i) + posA); f32x2 d = *td;
            d.x = gelu_erf(d.x * rs2) * pgate[(unsigned)((tbase + i) * 128 + 8 * jjA + g)] * (1.f / USCALE);
            d.y = gelu_erf(d.y * rs2) * pgate[(unsigned)((tbase + i) * 128 + 8 * (jjA + 1) + g)] * (1.f / USCALE);
            *td = d;
        }
        for (int s = 0; s < 16; ++s) {
#pragma unroll 1
            for (int i = 0; i < 8; ++i) {
                int ln = lane; asm volatile("" : "+v"(ln));
                const bool b3 = ln & 8;
                u32x4 exv[4]; f32x4 avv[4];
#pragma unroll
                for (int k = 0; k < 4; ++k) { exv[k] = *(const LAS u32x4*)(P8_TI(i) + g * 16 + 4 * k); avv[k] = *(const LAS f32x4*)(P8_TD(i) + g * 16 + 4 * k); }
                f32x2 acc2[8];
#pragma unroll
                for (int k = 0; k < 8; ++k) acc2[k] = (f32x2){0.f, 0.f};
                {
                    u32x4 rv[16];
#pragma unroll
                    for (int jj = 0; jj < 16; ++jj) rv[jj] = *(const u32x4*)(up + (unsigned)((int)exv[jj >> 2][jj & 3] * D_ + 128 * s + 16 * l8));
#pragma unroll
                    for (int jj = 0; jj < 16; ++jj) { const float av = avv[jj >> 2][jj & 3]; const f32x2 a2 = {av, av};
#pragma unroll
                        for (int q = 0; q < 4; ++q) { acc2[2 * q] += a2 * __builtin_amdgcn_cvt_pk_f32_fp8((int)rv[jj][q], false); acc2[2 * q + 1] += a2 * __builtin_amdgcn_cvt_pk_f32_fp8((int)rv[jj][q], true); } }
                    __builtin_amdgcn_sched_barrier(0);
                }
                float acc[16];
#pragma unroll
                for (int k = 0; k < 8; ++k) { acc[2 * k] = acc2[k].x; acc[2 * k + 1] = acc2[k].y; }
                float p8[8], p4[4];
#pragma unroll
                for (int k = 0; k < 8; ++k) p8[k] = swap32_sum(acc[k], acc[k + 8]);
#pragma unroll
                for (int k = 0; k < 4; ++k) p4[k] = swap16_sum(p8[k], p8[k + 4]);
                const float snd0 = b3 ? p4[0] : p4[2], kp0 = b3 ? p4[2] : p4[0], snd1 = b3 ? p4[1] : p4[3], kp1 = b3 ? p4[3] : p4[1];
                const float o0 = kp0 + dpp_xor8(snd0), o1 = kp1 + dpp_xor8(snd1);
                const unsigned off = (unsigned)((tbase + i) * D_ + 128 * s + 16 * l8 + 2 * g);
                const unsigned hw = *(const unsigned*)(hb + off);
                f32x2 x = {bflo(hw) + o0, bfhi(hw) + o1};
                *(unsigned*)(hb + off) = pk2(x.x, x.y);
                P8_SS(i)[lane] += x.x * x.x + x.y * x.y;
            }
        }
#pragma unroll 1
        for (int i = 0; i < 8; ++i) { const float ss = wave_sum(P8_SS(i)[lane]); if (lane == 0) stat[ST_RS3 + tbase + i] = 1.f / sqrtf(ss * (1.f / D_) + EPS); }
    }
#undef P8_TI
#undef P8_TD
#undef P8_SS
}

DI void p10_final(Frame& F) {
    const float* ssq4 = wsp<float>(F, WS_SSQ4); const float* gain = F.in[15]; const bf16* h3b = wsp<bf16>(F, WS_QRY);
    const int NGW = F.G * NWAVES;
    f32x4 gr[8];
#pragma unroll
    for (int j = 0; j < 4; ++j) { gr[2 * j] = ((const f32x4*)gain)[2 * F.lane + 128 * j]; gr[2 * j + 1] = ((const f32x4*)gain)[2 * F.lane + 128 * j + 1]; }
    for (int m0 = F.bid * NWAVES + F.wave; m0 < S_; m0 += 4 * NGW) {
        float sv[4]; u32x4 w[4][4];
#pragma unroll
        for (int u = 0; u < 4; ++u) { const int m = m0 + u * NGW;
            if (m < S_) { sv[u] = (F.lane < 32) ? ssq4[(size_t)m * 32 + F.lane] : 0.f; const u32x4* hr = (const u32x4*)(h3b + (size_t)m * D_) + F.lane;
#pragma unroll
                for (int j = 0; j < 4; ++j) w[u][j] = hr[64 * j]; } }
#pragma unroll
        for (int u = 0; u < 4; ++u) { const int m = m0 + u * NGW;
            if (m < S_) { const float rs = 1.f / sqrtf(wave_sum(sv[u]) * (1.f / D_) + EPS); f32x4* xr = (f32x4*)(F.out + (size_t)m * D_) + 2 * F.lane;
#pragma unroll
                for (int j = 0; j < 4; ++j) { const u32x4 ww = w[u][j];
                    xr[128 * j] = (f32x4){bflo(ww.x), bfhi(ww.x), bflo(ww.y), bfhi(ww.y)} * rs * gr[2 * j];
                    xr[128 * j + 1] = (f32x4){bflo(ww.z), bfhi(ww.z), bflo(ww.w), bfhi(ww.w)} * rs * gr[2 * j + 1]; } } }
    }
}

constexpr int NPHASES = 11;
struct Args { const float* in[16]; float* out; unsigned char* ws; int ph_lo, ph_hi; };
DI int lane_id() { return (int)__builtin_amdgcn_mbcnt_hi(~0u, __builtin_amdgcn_mbcnt_lo(~0u, 0u)); }
DI Frame make_frame(LAS unsigned char* lds, int wave0) {
    typedef const Args __attribute__((address_space(4))) * cargs_t;
    cargs_t ap = (cargs_t)__builtin_amdgcn_kernarg_segment_ptr();
    asm volatile("" : "+s"(ap));
    Frame F;
    F.lds = lds;
    F.tid = threadIdx.x; F.lane = F.tid & 63; F.wave = __builtin_amdgcn_readfirstlane(F.tid >> 6); (void)wave0;
    F.G = gridDim.x; F.bid = blockIdx.x;
#pragma unroll
    for (int i = 0; i < 16; ++i) F.in[i] = ap->in[i];
    F.out = ap->out; F.ws = ap->ws; F.ctl = (unsigned*)(ap->ws + WS_CTL);
    return F;
}
__global__ void __launch_bounds__(NTHREADS, 2) mega_fwd(Args args) {
    extern __shared__ __attribute__((aligned(16))) unsigned char lds_[];
    LAS unsigned char* lds = (LAS unsigned char*)lds_;
    volatile LAS unsigned* MISC = (volatile LAS unsigned*)(lds + MISC_OFF);
    const int wave0 = __builtin_amdgcn_readfirstlane(threadIdx.x >> 6);
    if (threadIdx.x < 64) MISC[threadIdx.x] = 0u;
    __syncthreads();
    const int lo = args.ph_lo, hi = args.ph_hi;
    XcdBarrier bar; bar.bar = (unsigned*)(args.ws + WS_CTL) + CW_BAR; bar.x = 0; bar.st = nullptr;
    if (hi - lo > 1) bar = xcd_barrier_post((unsigned*)(args.ws + WS_CTL) + CW_BAR, MISC + 8, (int)threadIdx.x);
#ifdef ONLY_PHASE
#define IN(k) ((k) == ONLY_PHASE && lo <= (k) && (k) < hi)
#else
#define IN(k) (lo <= (k) && (k) < hi)
#endif
#ifdef TIME_PHASE
#define STAMP(k) do { if (blockIdx.x == 0 && threadIdx.x == 0) { const unsigned long long _t = __builtin_amdgcn_s_memrealtime(); MISC[16 + 2 * (k)] = (unsigned)_t; MISC[17 + 2 * (k)] = (unsigned)(_t >> 32); } } while (0)
#else
#define STAMP(k) do { } while (0)
#endif
#define SEAM(k) do { if (IN(k) && IN((k) + 1)) xcd_barrier(bar, (int)threadIdx.x); STAMP((k) + 1); } while (0)
    STAMP(0);

    if (IN(0)) { Frame F = make_frame(lds, wave0); p0_prologue(F); }
    SEAM(0);
    if (IN(1)) {
        Frame F = make_frame(lds, wave0);
        const float* stat = wsp<float>(F, WS_STAT);
        {
            pg8::Gemm g{(const bf16*)F.out, wsp<bf16>(F, WS_W1T), S_, 3 * AW, D_ / 2}; pg8::StaticOrder S; S.init(S_, 3 * AW, F.G, F.bid);
            Epi1<0> E{wsp<bf16>(F, WS_Q), wsp<bf16>(F, WS_K), wsp<bf16>(F, WS_VT), wsp<bf16>(F, WS_HQ), wsp<bf16>(F, WS_HLF), wsp<bf16>(F, WS_HV), wsp<bf16>(F, WS_HG), wsp<float>(F, WS_KPART), stat + ST_RS1Q};
            pg8::gemm_phase<Epi1<0>, pg8::StaticOrder, PG8_ALIGN, PG8_SP2, true>(F.lds, g, S, E, F.tid); }
        {
            pg8::Gemm g{wsp<bf16>(F, WS_XB), wsp<bf16>(F, WS_W1TB), S_, 4 * AW, D_}; pg8::StaticOrder S; S.init(S_, 4 * AW, F.G, F.bid);
            Epi1<3> E{wsp<bf16>(F, WS_Q), wsp<bf16>(F, WS_K), wsp<bf16>(F, WS_VT), wsp<bf16>(F, WS_HQ), wsp<bf16>(F, WS_HLF), wsp<bf16>(F, WS_HV), wsp<bf16>(F, WS_HG), wsp<float>(F, WS_KPART), stat + ST_RS1};
            int tid2 = F.tid; asm volatile("" : "+v"(tid2));
            pg8::gemm_phase<Epi1<3>, pg8::StaticOrder, PG8_ALIGN, PG8_SP2, false>(F.lds, g, S, E, tid2); }
    }
    SEAM(1);
    if (IN(2)) {
        Frame F = make_frame(lds, wave0);
        p2_gate(F);
        hgrn_mfma<false>(F);
    }
    SEAM(2);
    if (IN(3)) { Frame F = make_frame(lds, wave0); p3_attn(F);
        hgrn_scan(F); }
    SEAM(3);
    if (IN(4)) {
        Frame F = make_frame(lds, wave0);
        p4_combine(F);
        hgrn_mfma<true>(F);
    }
    SEAM(4);
    if (IN(5)) {
        Frame F = make_frame(lds, wave0);
        pg8::Gemm g{wsp<bf16>(F, WS_MIX), wsp<bf16>(F, WS_W2T), S_, D_, D_ / 2}; pg8::StaticOrder S; S.init(S_, D_, F.G, F.bid);
        Epi2 E{F.in[0], F.out, wsp<bf16>(F, WS_H1B), wsp<float>(F, WS_SSQ2)};
        pg8::gemm_phase<Epi2, pg8::StaticOrder, PG8_ALIGN, PG8_SP2, true>(F.lds, g, S, E, F.tid);
    }
    SEAM(5);
    if (IN(6)) {
        Frame F = make_frame(lds, wave0);
        pg8::Gemm g{wsp<bf16>(F, WS_H1B), wsp<bf16>(F, WS_WQT), S_, D_, D_}; pg8::StaticOrder S; S.init(S_, D_, F.G, F.bid);
        EpiB E{wsp<bf16>(F, WS_QRY), D_};
        pg8::gemm_phase<EpiB, pg8::StaticOrder, PG8_ALIGN, PG8_SP2>(F.lds, g, S, E, F.tid);
    }
    SEAM(6);
    if (IN(7)) { Frame F = make_frame(lds, wave0); p7_route(F); }
    SEAM(7);
    if (IN(8)) { Frame F = make_frame(lds, wave0); p8_peer_sliced(F); }
    SEAM(8);
    if (IN(9)) {
        { Frame F = make_frame(lds, wave0); pg8::StaticOrder S; S.init(S_, D_, F.G, F.bid);
          pg8::Gemm g{wsp<bf16>(F, WS_PB), wsp<bf16>(F, WS_WPT), S_, D_, PLE}; EpiP E{wsp<bf16>(F, WS_PLE)};
          pg8::gemm_phase<EpiP, pg8::StaticOrder, PG8_ALIGN, PG8_SP2>(F.lds, g, S, E, F.tid); }
        { Frame F = make_frame(lds, wave0); pg8::StaticOrder S; S.init(S_, D_, F.G, F.bid);
          pg8::Gemm g{wsp<bf16>(F, WS_H1B), wsp<bf16>(F, WS_WGT), S_, D_, D_}; Epi4 E{wsp<bf16>(F, WS_QRY), wsp<bf16>(F, WS_H1B), wsp<bf16>(F, WS_PLE), wsp<float>(F, WS_STAT) + ST_RS3, wsp<float>(F, WS_SSQ4)};
          pg8::gemm_phase<Epi4, pg8::StaticOrder, PG8_ALIGN, PG8_SP2>(F.lds, g, S, E, F.tid); }
    }
    SEAM(9);
    if (IN(10)) { Frame F = make_frame(lds, wave0); p10_final(F); }
#ifdef TIME_PHASE
    if (blockIdx.x == 0) {
        __syncthreads();
        if (threadIdx.x == 0) {
            const unsigned long long tend = __builtin_amdgcn_s_memrealtime();
            const unsigned long long a = ((unsigned long long)MISC[17 + 2 * TIME_PHASE] << 32) | MISC[16 + 2 * TIME_PHASE];
            const unsigned long long b = (TIME_PHASE == 10) ? tend : (((unsigned long long)MISC[19 + 2 * TIME_PHASE] << 32) | MISC[18 + 2 * TIME_PHASE]);
            const unsigned long long wait = 10ull * (b - a);
            while (__builtin_amdgcn_s_memrealtime() - tend < wait) __builtin_amdgcn_s_sleep(32);
        }
    }
#endif
#undef IN
#undef SEAM
}

extern "C" void kernel_launch(void* const* d_in, const int* in_sizes, int n_in, void* d_out, int out_size, void* d_ws, size_t ws_size, hipStream_t stream) {
    static int grid = 0;
    if (grid == 0) {
        if (n_in != 16 || out_size != S_ * D_ || ws_size < WS_END) { fprintf(stderr, "kernel_launch: unexpected problem (n_in %d, out %d, ws %zu < %zu)\n", n_in, out_size, ws_size, (size_t)WS_END); grid = -1; return; }
        int dev = 0, cus = 0, per_cu = 0;
        if (hipGetDevice(&dev) != hipSuccess || hipDeviceGetAttribute(&cus, hipDeviceAttributeMultiprocessorCount, dev) != hipSuccess) { grid = -1; return; }
        if (hipFuncSetAttribute((const void*)mega_fwd, hipFuncAttributeMaxDynamicSharedMemorySize, LDS_BYTES) != hipSuccess) { fprintf(stderr, "kernel_launch: hipFuncSetAttribute failed\n"); grid = -1; return; }
        if (hipOccupancyMaxActiveBlocksPerMultiprocessor(&per_cu, (const void*)mega_fwd, NTHREADS, LDS_BYTES) != hipSuccess || per_cu < 1) { fprintf(stderr, "kernel_launch: occupancy query says %d\n", per_cu); (void)hipGetLastError(); }
        grid = cus;
    }
    if (grid < 0) return;
    (void)hipMemsetAsync((char*)d_ws + WS_CTL, 0, CTL_ZERO_BYTES, stream);
    Args a{};
    for (int i = 0; i < 16; ++i) a.in[i] = (const float*)d_in[i];
    a.out = (float*)d_out; a.ws = (unsigned char*)d_ws;
#if MK_PER_PHASE
    for (int ph = 0; ph < NPHASES; ++ph) {
        a.ph_lo = ph; a.ph_hi = ph + 1;
        hipLaunchKernelGGL(mega_fwd, dim3(grid), dim3(NTHREADS), LDS_BYTES, stream, a);
    }
#else
    a.ph_lo = 0; a.ph_hi = NPHASES;
    void* kargs[] = {&a};
    hipError_t e = hipLaunchCooperativeKernel((const void*)mega_fwd, dim3(grid), dim3(NTHREADS), kargs, LDS_BYTES, stream);
    if (e != hipSuccess) fprintf(stderr, "kernel_launch: cooperative launch failed: %s\n", hipGetErrorString(e));
#endif
}
```

```cpp
#include <hip/hip_runtime.h>
#include <cstdio>
#include <cstdint>

#ifndef MK_PER_PHASE
#define MK_PER_PHASE 0
#endif

namespace pg8 {
#define PG8_LAS __attribute__((address_space(3)))
typedef unsigned short bf16_t;
typedef short bf16x8 __attribute__((ext_vector_type(8)));
typedef float f32x4 __attribute__((ext_vector_type(4)));
typedef unsigned u32x4 __attribute__((ext_vector_type(4)));
constexpr int BM = 256, BK = 64, HALF = 128, HTB = HALF * BK * 2, STAGE_BYTES = 8 * HTB, NXCD = 8, WGM = 8;

__host__ __device__ __forceinline__ int lds_byte(int r, int c) { const int st = (r >> 4) * 2 + (c >> 5), rr = r & 15, cc = c & 31, ob = rr * 64 + cc * 2; return st * 1024 + (ob ^ (((ob >> 9) & 1) << 5)); }
__host__ __device__ __forceinline__ void stage_rc(int b, int& R, int& C) { const int st = b / 1024, sb = b % 1024, swz = sb ^ (((sb >> 9) & 1) << 5); R = (st >> 1) * 16 + swz / 64; C = (st & 1) * 32 + (swz % 64) / 2; }
__host__ __device__ __forceinline__ int perm32(int rho) { const int n = rho >> 4, i = rho & 15; return 8 * (i >> 2) + 4 * n + (i & 3); }

struct Unit { int pm, pn; };
struct Gemm { const bf16_t* A; const bf16_t* Bt; int M, N, K; };

struct StaticOrder {
    int nM, nN, nwg, G, c;
    __host__ __device__ void init(int M, int N, int G_, int c_) { nM = M / BM; nN = N / BM; nwg = nM * nN; G = G_; c = c_; }
    __host__ __device__ bool next(int i, Unit& u) const {
        const long L = (long)i * G + c; if (L >= nwg) return false;
        int wgid = (int)L; { const int q = nwg / NXCD, r = nwg % NXCD, xcd = wgid % NXCD, off = wgid / NXCD; wgid = (xcd < r ? xcd * (q + 1) : r * (q + 1) + (xcd - r) * q) + off; }
        const int nig = WGM * nN, gid = wgid / nig, fm = gid * WGM, gsz = (nM - fm) < WGM ? (nM - fm) : WGM;
        u.pm = fm + ((wgid % nig) % gsz); u.pn = (wgid % nig) / gsz; return true;
    }
    __device__ __forceinline__ void a_ready(const Unit&) const {}
    __device__ __forceinline__ void done(const Unit&) const {}
};

typedef int i32x8 __attribute__((ext_vector_type(8)));
typedef int i32x4 __attribute__((ext_vector_type(4)));
template <bool FP8> struct FragSel { typedef bf16x8 A_t[4][2]; typedef bf16x8 B_t[2][2]; };
template <> struct FragSel<true> { typedef i32x8 A_t[4]; typedef i32x8 B_t[2]; };
template <class Epi, class Sched, bool ALIGN_EPI = false, bool SP2 = false, bool FP8 = false>
__device__ __forceinline__ void gemm_phase(PG8_LAS unsigned char* lds, const Gemm g, const Sched& S, const Epi& E, const int tid) {
    const int wid = __builtin_amdgcn_readfirstlane(tid >> 6), lane = tid & 63, wr = wid >> 2, wc = wid & 3, fr = lane & 15, fq = lane >> 4;
    int K_ = g.K; asm volatile("" : "+s"(K_));
    const int K = K_, nt = K / BK;
    unsigned voffA[2], voffB[2];
#pragma unroll
    for (int i = 0; i < 2; ++i) { int R, C; stage_rc(tid * 16 + i * 8192, R, C); const int Rb = Epi::PERM ? ((R & ~31) + perm32(R & 31)) : R;
        voffA[i] = (unsigned)(R * K + C) * 2u; voffB[i] = (unsigned)(Rb * K + C) * 2u; }
    const size_t kstep = (size_t)(BK * 2);
    const size_t hstep = (size_t)HALF * K * 2;
    const size_t tstep = 2 * hstep;
    const unsigned ldsw = (unsigned)wid * 1024u;
    const int fcol = fq * 8;
    const int aoff = lds_byte(wr * 64 + fr, fcol), boff = lds_byte(wc * 32 + fr, fcol);

#define PG8_SA(b, h) (((b) * 2 + (h)) * HTB)
#define PG8_SB(b, h) ((4 + (b) * 2 + (h)) * HTB)
#define PG8_STAGE(bufoff, gbase, voff) do { _Pragma("unroll") for (int _i = 0; _i < 2; ++_i) \
        __builtin_amdgcn_global_load_lds((const unsigned*)((const char*)(gbase) + (voff)[_i]), (PG8_LAS unsigned*)(lds + (bufoff) + ldsw + _i * 8192), 16, 0, 0); } while (0)
#define PG8_LD8(p) __builtin_shufflevector(*(const PG8_LAS i32x4*)(p), *(const PG8_LAS i32x4*)((p) + 1024), 0, 1, 2, 3, 4, 5, 6, 7)
#define PG8_LDA(dst, b, h) do { if constexpr (FP8) { _Pragma("unroll") for (int m = 0; m < 4; ++m) dst[m] = PG8_LD8(lds + PG8_SA(b, h) + aoff + m * 2048); } \
        else { _Pragma("unroll") for (int m = 0; m < 4; ++m) _Pragma("unroll") for (int k = 0; k < 2; ++k) dst[m][k] = *(const PG8_LAS bf16x8*)(lds + PG8_SA(b, h) + aoff + m * 2048 + k * 1024); } } while (0)
#define PG8_LDB(dst, b, h) do { if constexpr (FP8) { _Pragma("unroll") for (int n = 0; n < 2; ++n) dst[n] = PG8_LD8(lds + PG8_SB(b, h) + boff + n * 2048); } \
        else { _Pragma("unroll") for (int n = 0; n < 2; ++n) _Pragma("unroll") for (int k = 0; k < 2; ++k) dst[n][k] = *(const PG8_LAS bf16x8*)(lds + PG8_SB(b, h) + boff + n * 2048 + k * 1024); } } while (0)
#define PG8_MMA(ai, bj, At, Bt) do { __builtin_amdgcn_s_setprio(1); \
        if constexpr (FP8) { _Pragma("unroll") for (int m = 0; m < 4; ++m) _Pragma("unroll") for (int n = 0; n < 2; ++n) \
            asm volatile("v_mfma_scale_f32_16x16x128_f8f6f4 %0, %1, %2, %0, %3, %3 op_sel_hi:[0,0,0]" : "+v"(acc[ai][bj][m][n]) : "v"(Bt[n]), "v"(At[m]), "v"(one_scale)); } \
        else { _Pragma("unroll") for (int m = 0; m < 4; ++m) _Pragma("unroll") for (int n = 0; n < 2; ++n) _Pragma("unroll") for (int k = 0; k < 2; ++k) \
            acc[ai][bj][m][n] = __builtin_amdgcn_mfma_f32_16x16x32_bf16(Bt[n][k], At[m][k], acc[ai][bj][m][n], 0, 0, 0); } \
        __builtin_amdgcn_s_setprio(0); } while (0)
#define PG8_WAIT_V(n) asm volatile("s_waitcnt vmcnt(" #n ")" ::: "memory")
#define PG8_WAIT_L(n) asm volatile("s_waitcnt lgkmcnt(" #n ")" ::: "memory")
#define PG8_BAR __builtin_amdgcn_s_barrier()
#define PG8_SCHED __builtin_amdgcn_sched_barrier(0)
    int one_scale = 0x7f7f7f7f;
    asm volatile("" : "+v"(one_scale));
    Unit cur, nxt; int ui = 0;
    if (!S.next(0, cur)) return;
    f32x4 acc[2][2][4][2];
#pragma unroll
    for (int a = 0; a < 2; ++a)
#pragma unroll
        for (int b = 0; b < 2; ++b)
#pragma unroll
            for (int m = 0; m < 4; ++m)
#pragma unroll
                for (int n = 0; n < 2; ++n) acc[a][b][m][n] = (f32x4){0.f, 0.f, 0.f, 0.f};
    typename FragSel<FP8>::A_t At; typename FragSel<FP8>::B_t B0, B1;
    const char* cA = (const char*)g.A + (size_t)cur.pm * tstep; const char* cB = (const char*)g.Bt + (size_t)cur.pn * tstep;
    S.a_ready(cur);
    if constexpr (SP2) {
        PG8_STAGE(PG8_SB(0, 0), cB, voffB); PG8_STAGE(PG8_SB(0, 1), cB + hstep, voffB); PG8_STAGE(PG8_SA(0, 0), cA, voffA); PG8_STAGE(PG8_SA(0, 1), cA + hstep, voffA);
        if (wr == 1) PG8_BAR;
        PG8_WAIT_V(2); PG8_BAR;
        PG8_STAGE(PG8_SB(1, 0), cB + kstep, voffB); PG8_STAGE(PG8_SA(1, 0), cA + kstep, voffA); PG8_STAGE(PG8_SB(1, 1), cB + hstep + kstep, voffB);
        PG8_WAIT_V(6); PG8_BAR;
    } else {
        PG8_STAGE(PG8_SB(0, 0), cB, voffB); PG8_STAGE(PG8_SA(0, 0), cA, voffA); PG8_STAGE(PG8_SB(0, 1), cB + hstep, voffB); PG8_STAGE(PG8_SA(0, 1), cA + hstep, voffA);
        if (wr == 1) PG8_BAR;
        PG8_WAIT_V(4); PG8_BAR;
        PG8_STAGE(PG8_SB(1, 0), cB + kstep, voffB); PG8_STAGE(PG8_SA(1, 0), cA + kstep, voffA); PG8_STAGE(PG8_SB(1, 1), cB + hstep + kstep, voffB);
        PG8_WAIT_V(6); PG8_BAR;
    }
    for (;;) {
        const bool has_next = S.next(ui + 1, nxt);
        const char* nA = has_next ? (const char*)g.A + (size_t)nxt.pm * tstep : cA; const char* nB = has_next ? (const char*)g.Bt + (size_t)nxt.pn * tstep : cB;
        for (int t = 0; t < nt; t += 2) {
            const bool last = (t == nt - 2);
            const char* a1 = cA + (size_t)(t + 1) * kstep;
            const char* a2 = last ? nA : cA + (size_t)(t + 2) * kstep; const char* b2 = last ? nB : cB + (size_t)(t + 2) * kstep;
            const char* a3 = a2 + kstep; const char* b3 = b2 + kstep;
            if (last && has_next) S.a_ready(nxt);
            if constexpr (SP2) {
            PG8_LDB(B0, 0, 0); PG8_LDB(B1, 0, 1); PG8_SCHED; PG8_LDA(At, 0, 0); PG8_STAGE(PG8_SA(1, 1), a1 + hstep, voffA);
            PG8_WAIT_V(8); PG8_WAIT_L(0); PG8_BAR; PG8_MMA(0, 0, At, B0); PG8_MMA(0, 1, At, B1); PG8_BAR; PG8_SCHED;
            PG8_LDA(At, 0, 1); PG8_STAGE(PG8_SB(0, 0), b2, voffB); PG8_STAGE(PG8_SB(0, 1), b2 + hstep, voffB); PG8_STAGE(PG8_SA(0, 0), a2, voffA);
            PG8_WAIT_V(8); PG8_WAIT_L(0); PG8_BAR; PG8_MMA(1, 0, At, B0); PG8_MMA(1, 1, At, B1); PG8_BAR; PG8_SCHED;
            PG8_LDB(B0, 1, 0); PG8_LDB(B1, 1, 1); PG8_SCHED; PG8_LDA(At, 1, 0); PG8_STAGE(PG8_SA(0, 1), a2 + hstep, voffA);
            PG8_WAIT_V(8); PG8_WAIT_L(0); PG8_BAR; PG8_MMA(0, 0, At, B0); PG8_MMA(0, 1, At, B1); PG8_BAR; PG8_SCHED;
            PG8_LDA(At, 1, 1); PG8_STAGE(PG8_SB(1, 0), b3, voffB); PG8_STAGE(PG8_SB(1, 1), b3 + hstep, voffB); PG8_STAGE(PG8_SA(1, 0), a3, voffA);
            PG8_WAIT_V(8); PG8_WAIT_L(0); PG8_BAR; PG8_MMA(1, 0, At, B0); PG8_MMA(1, 1, At, B1); PG8_BAR; PG8_SCHED;
            } else {
            PG8_LDB(B0, 0, 0); PG8_SCHED; PG8_LDA(At, 0, 0); PG8_STAGE(PG8_SA(1, 1), a1 + hstep, voffA);
            PG8_WAIT_L(8); PG8_BAR; PG8_WAIT_L(0); PG8_MMA(0, 0, At, B0); PG8_BAR; PG8_SCHED;
            PG8_LDB(B1, 0, 1); PG8_STAGE(PG8_SB(0, 0), b2, voffB);
            PG8_BAR; PG8_WAIT_L(0); PG8_MMA(0, 1, At, B1); PG8_BAR;
            PG8_LDA(At, 0, 1); PG8_STAGE(PG8_SA(0, 0), a2, voffA);
            PG8_BAR; PG8_WAIT_L(0); PG8_MMA(1, 0, At, B0); PG8_BAR; PG8_SCHED;
            PG8_STAGE(PG8_SB(0, 1), b2 + hstep, voffB);
            PG8_WAIT_V(6); PG8_BAR; PG8_MMA(1, 1, At, B1); PG8_BAR;
            PG8_LDB(B0, 1, 0); PG8_SCHED; PG8_LDA(At, 1, 0); PG8_STAGE(PG8_SA(0, 1), a2 + hstep, voffA);
            PG8_WAIT_L(8); PG8_BAR; PG8_WAIT_L(0); PG8_MMA(0, 0, At, B0); PG8_BAR; PG8_SCHED;
            PG8_LDB(B1, 1, 1); PG8_STAGE(PG8_SB(1, 0), b3, voffB);
            PG8_BAR; PG8_WAIT_L(0); PG8_MMA(0, 1, At, B1); PG8_BAR;
            PG8_LDA(At, 1, 1); PG8_STAGE(PG8_SA(1, 0), a3, voffA);
            PG8_BAR; PG8_WAIT_L(0); PG8_MMA(1, 0, At, B0); PG8_BAR; PG8_SCHED;
            PG8_STAGE(PG8_SB(1, 1), b3 + hstep, voffB);
            PG8_WAIT_V(6); PG8_BAR; PG8_MMA(1, 1, At, B1); PG8_BAR;
            }
        }
        if constexpr (ALIGN_EPI) { if (wr == 0) PG8_BAR; }
        if constexpr (FP8) asm volatile("s_nop 15\n\ts_nop 15" ::: "memory");
        E(acc, cur, wr, wc, fr, fq); S.done(cur);
        if (!has_next) break;
#pragma unroll
        for (int a = 0; a < 2; ++a)
#pragma unroll
            for (int b = 0; b < 2; ++b)
#pragma unroll
                for (int m = 0; m < 4; ++m)
#pragma unroll
                    for (int n = 0; n < 2; ++n) acc[a][b][m][n] = (f32x4){0.f, 0.f, 0.f, 0.f};
        cur = nxt; cA = nA; cB = nB; ++ui;
        if constexpr (ALIGN_EPI) { if (wr == 1) PG8_BAR; }
    }
    PG8_WAIT_V(0);
    if constexpr (!ALIGN_EPI) { if (wr == 0) PG8_BAR; }
    PG8_BAR;
#undef PG8_SA
#undef PG8_SB
#undef PG8_STAGE
#undef PG8_LDA
#undef PG8_LDB
#undef PG8_MMA
#undef PG8_WAIT_V
#undef PG8_WAIT_L
#undef PG8_BAR
#undef PG8_SCHED
}
}

#define PG8_SP2 true
#define PG8_ALIGN true

constexpr int NWAVES = 8, NTHREADS = 512;
constexpr int S_ = 16384, D_ = 2048, NIN = 7168, AW = 1024, NH = 8, HD = 128, NBLK = 64, LBLK = 256;
constexpr int PLE = 256, NEXP = 16384, PH = 8, NKEY = 128, PTOP = 16;
constexpr float EPS = 1e-6f;
constexpr float QSCALE = 0.08838834764831845f * 1.4426950408889634f;
constexpr float XSCALE = 16.f, W1SCALE = 512.f;
constexpr float MSCALE = 8.f;
constexpr float OSCALE = 32.f;
constexpr float DSCALE = 512.f, USCALE = 32.f;
constexpr int HSC = 64, HSCLEN = 256, HSUB = 32;
constexpr int LSTRIDE = 256 * (63 * 64 / 2);
__host__ __device__ __forceinline__ int list_off(int n) { return 256 * (63 * n - (n * (n - 1)) / 2); }

constexpr size_t MiB = 1u << 20;
constexpr size_t WS_CTL = 0, CTL_ZERO_BYTES = 1 * MiB;
constexpr size_t WS_W1T = 2 * MiB  , WS_W2T = 30 * MiB, WS_WQT = 38 * MiB, WS_WGT = 46 * MiB, WS_WPT = 54 * MiB, WS_SKB = 55 * MiB;
constexpr size_t WS_STAT = 56 * MiB;
constexpr size_t WS_SSQ2 = 57 * MiB, WS_SSQ4 = 59 * MiB;
constexpr size_t WS_KPART = 61 * MiB, WS_HDEC = 62 * MiB;
constexpr size_t WS_PB = 63 * MiB;
constexpr size_t WS_DOWN = 71 * MiB, WS_UP = 103 * MiB;
constexpr size_t WS_XB = 135 * MiB;
constexpr size_t WS_R1 = 199 * MiB;
constexpr size_t WS_LIST = WS_R1, WS_PML = WS_R1 + 16 * MiB, WS_HST = WS_R1 + 20 * MiB, WS_H1B = WS_R1;
constexpr size_t WS_R2 = 263 * MiB;
constexpr size_t WS_Q = WS_R2, WS_K = WS_R2 + 32 * MiB, WS_VT = WS_R2 + 64 * MiB, WS_MIX = WS_R2, WS_QRY = WS_R2, WS_PIDX = WS_R2 + 64 * MiB, WS_PGATE = WS_R2 + 72 * MiB;
constexpr size_t WS_R3 = 359 * MiB;
constexpr size_t WS_HQ = WS_R3, WS_HLF = WS_R3 + 32 * MiB, WS_HV = WS_R3 + 64 * MiB, WS_HG = WS_R3 + 96 * MiB, WS_PLE = WS_R3, WS_H2B8 = WS_R3 + 64 * MiB  ;
constexpr size_t WS_END = 487 * MiB;
constexpr int CW_BAR = 4096;
constexpr int CW_GCNT = 16384;
constexpr int CW_SCANQ = 24576;
constexpr int ST_RS1 = 0, ST_LB = S_, ST_RS2 = S_ + 1024, ST_RS3 = 2 * S_ + 1024, ST_RS1Q = 3 * S_ + 1024;

constexpr int RING_BYTES = 131072;
constexpr int LDS_BYTES = 147456;
constexpr int MISC_OFF = LDS_BYTES - 256;

#define LAS __attribute__((address_space(3)))
typedef unsigned short bf16;
typedef unsigned u32x4 __attribute__((ext_vector_type(4)));
typedef unsigned u32x2 __attribute__((ext_vector_type(2)));
typedef float f32x4 __attribute__((ext_vector_type(4)));
typedef float f32x2 __attribute__((ext_vector_type(2)));
typedef float f32x16 __attribute__((ext_vector_type(16)));
typedef short bf16x8 __attribute__((ext_vector_type(8)));
typedef short s16x4 __attribute__((ext_vector_type(4)));
typedef __bf16 bf16x2n __attribute__((ext_vector_type(2)));
#define RLX_AGENT __ATOMIC_RELAXED, __HIP_MEMORY_SCOPE_AGENT
#define LDS_WAIT() asm volatile("s_waitcnt lgkmcnt(0)" ::: "memory")
#define DI __device__ __forceinline__

DI unsigned pk2(float lo, float hi) { f32x2 v = {lo, hi}; bf16x2n b = __builtin_convertvector(v, bf16x2n); return __builtin_bit_cast(unsigned, b); }
DI float sat8(float v) { return __builtin_amdgcn_fmed3f(v, -440.f, 440.f); }
DI float bflo(unsigned u) { return __uint_as_float(u << 16); }
DI float bfhi(unsigned u) { return __uint_as_float(u & 0xffff0000u); }
DI float wave_sum(float v) {
#pragma unroll
    for (int o = 1; o < 64; o <<= 1) v += __shfl_xor(v, o);
    return v;
}
DI float sigmoidf_(float x) { return __builtin_amdgcn_rcpf(1.f + __expf(-x)); }
DI float siluf_(float x) { return x * __builtin_amdgcn_rcpf(1.f + __expf(-x)); }
DI int crow(int reg, int h) { return (reg & 3) + 8 * (reg >> 2) + 4 * h; }

#define XB_TMO      128
#define XB_XCNT(j)  (256  + 64 * (j))
#define XB_XSUB(j)  (1280 + 64 * (j))
#define XB_XGEN(j)  (2304 + 64 * (j))
#define XB_TOP      3328
#define XB_TOPGEN   3392
#define XCD_BAR_WORDS 3456
#define XB_SPIN_CAP (1u << 22)
DI unsigned xb_ld(unsigned* p)              { return __hip_atomic_load(p, __ATOMIC_RELAXED, __HIP_MEMORY_SCOPE_AGENT); }
DI unsigned xb_add(unsigned* p, unsigned v) { return __hip_atomic_fetch_add(p, v, __ATOMIC_RELAXED, __HIP_MEMORY_SCOPE_AGENT); }
DI unsigned xb_xcc_id() { return (unsigned)__builtin_amdgcn_s_getreg((3 << 11) | 20) & 0xFu; }
#define XB_SPIN(cond, bar) do { unsigned _sp = 0; while (cond) { __builtin_amdgcn_s_sleep(1); \
    if ((++_sp & 255u) == 0u) { if (xb_ld(&(bar)[XB_TMO])) break; if (_sp > XB_SPIN_CAP) { atomicAdd(&(bar)[XB_TMO], 1u); break; } } } } while (0)
struct XcdBarrier { unsigned* bar; unsigned x; volatile LAS unsigned* st; };
__device__ unsigned g_barw[XCD_BAR_WORDS + 64];
DI XcdBarrier xcd_barrier_post(unsigned* bar, volatile LAS unsigned* st, int tid) {
    XcdBarrier b; b.bar = bar; b.x = xb_xcc_id(); b.st = st;
    if (tid == 0) (void)xb_add(&bar[XB_XCNT(b.x)], 1u);
    return b;
}
DI void xcd_barrier_complete(unsigned* bar, unsigned x, unsigned& nloc, unsigned& nx) {
    const unsigned G = gridDim.x * gridDim.y * gridDim.z;
    unsigned sum, cnt, mine, sp = 0u;
    for (;;) {
        sum = 0u; cnt = 0u; mine = 0u;
#pragma unroll
        for (unsigned j = 0; j < 16; ++j) { const unsigned c = xb_ld(&bar[XB_XCNT(j)]); sum += c; cnt += (c > 0u) ? 1u : 0u; mine = (j == x) ? c : mine; }
        if (sum == G) break;
        __builtin_amdgcn_s_sleep(1);
        if ((++sp & 255u) == 0u) { if (xb_ld(&bar[XB_TMO])) break; if (sp > XB_SPIN_CAP) { atomicAdd(&bar[XB_TMO], 1u); break; } }
    }
    nloc = mine > 0u ? mine : 1u; nx = cnt > 0u ? cnt : 1u;
}
DI void xcd_barrier(const XcdBarrier& b, int tid) {
    asm volatile("s_waitcnt vmcnt(0)" ::: "memory");
    __syncthreads();
    if (tid == 0) {
        unsigned* bar = b.bar;
        __builtin_amdgcn_s_waitcnt(0);
        unsigned nloc = b.st[0], nx = b.st[1];
        if (nloc == 0u) { xcd_barrier_complete(bar, b.x, nloc, nx); b.st[0] = nloc; b.st[1] = nx; }
        const unsigned old = xb_add(&bar[XB_XSUB(b.x)], 1u);
        const unsigned gen = old / nloc;
        if (old + 1u == (gen + 1u) * nloc) {
            __builtin_amdgcn_fence(__ATOMIC_RELEASE, "agent");
            asm volatile("s_waitcnt vmcnt(0)" ::: "memory");
            const unsigned og = xb_add(&bar[XB_TOP], 1u);
            if (og + 1u == (gen + 1u) * nx) xb_add(&bar[XB_TOPGEN], 1u);
        }
        XB_SPIN(xb_ld(&bar[XB_TOPGEN]) == gen, bar);
        __builtin_amdgcn_fence(__ATOMIC_ACQUIRE, "agent");
        asm volatile("s_waitcnt vmcnt(0)" ::: "memory");
    }
    __syncthreads();
}

struct Frame {
    LAS unsigned char* lds;
    unsigned* ctl;
    int tid, lane, wave, G, bid;
    const float* in[16];
    float* out;
    unsigned char* ws;
};
template <class T> DI T* wsp(const Frame& F, size_t off) { return (T*)(F.ws + off); }

constexpr int TP_PITCH = 65, TP_WAVE_BYTES = 64 * TP_PITCH * 4 + 64;
template <bool FP8 = false> DI void p0_transpose_item(const float* W, const float* gain, int K, int N, bf16* WT, LAS float* scr, int item, int lane, int nscaled = 0, float nscale = 1.f, float allscale = 1.f) {
    const int nblk = N / 64, kb = item / nblk, nb = item % nblk, k0 = 64 * kb, n0 = 64 * nb; const float osc = ((n0 < nscaled) ? nscale : 1.f) * allscale;
    const int kr = lane >> 4, n4 = (lane & 15) * 4;
    f32x4 v[16];
#pragma unroll
    for (int i = 0; i < 16; ++i) v[i] = *(const f32x4*)(W + (size_t)(k0 + 4 * i + kr) * N + n0 + n4);
#pragma unroll
    for (int i = 0; i < 16; ++i) { const int kk = 4 * i + kr; const float g = (gain ? gain[k0 + kk] : 1.f) * osc;
        scr[(n4 + 0) * TP_PITCH + kk] = v[i].x * g; scr[(n4 + 1) * TP_PITCH + kk] = v[i].y * g; scr[(n4 + 2) * TP_PITCH + kk] = v[i].z * g; scr[(n4 + 3) * TP_PITCH + kk] = v[i].w * g; }
    LDS_WAIT(); asm volatile("" ::: "memory");
    const int c = lane & 7, nn = lane >> 3;
#pragma unroll
    for (int j = 0; j < 8; ++j) { const int n = nn + 8 * j; const LAS float* sp = scr + n * TP_PITCH + 8 * c;
        if constexpr (FP8) {
            int w0 = __builtin_amdgcn_cvt_pk_fp8_f32(sp[0], sp[1], 0, false); w0 = __builtin_amdgcn_cvt_pk_fp8_f32(sp[2], sp[3], w0, true);
            int w1 = __builtin_amdgcn_cvt_pk_fp8_f32(sp[4], sp[5], 0, false); w1 = __builtin_amdgcn_cvt_pk_fp8_f32(sp[6], sp[7], w1, true);
            *(u32x2*)((unsigned char*)WT + (size_t)(n0 + n) * K + k0 + 8 * c) = (u32x2){(unsigned)w0, (unsigned)w1};
        } else {
            u32x4 o; o.x = pk2(sp[0], sp[1]); o.y = pk2(sp[2], sp[3]); o.z = pk2(sp[4], sp[5]); o.w = pk2(sp[6], sp[7]);
            *(u32x4*)(WT + (size_t)(n0 + n) * K + k0 + 8 * c) = o; } }
    LDS_WAIT(); asm volatile("" ::: "memory");
}
struct TpIt { const float* src; const float* gain; unsigned char* dst; int N, K, k0, n0, dn0; float osc; int fp8; };
DI TpIt tp_decode(const Frame& F, int it) {
    constexpr int I1 = (D_ / 64) * (NIN / 64), I2 = (D_ / 64) * (D_ / 64);
    TpIt t; int r = it, nblk, dreg = -1, dsub = 0;
    if (r < I1) { nblk = NIN / 64; t.N = NIN; t.K = D_; t.src = F.in[3]; t.gain = F.in[2];
        const int nb = r % nblk, reg = nb >> 4; t.fp8 = 1;
        t.osc = ((reg == 0) ? QSCALE : 1.f) * W1SCALE;
        t.dst = wsp<unsigned char>(F, WS_W1T);
        dreg = reg; dsub = nb & 15;
    } else { r -= I1; nblk = D_ / 64; t.N = D_; t.K = D_; t.fp8 = false; t.osc = 1.f;
        if (r < I2) { t.src = F.in[6]; t.gain = nullptr; t.dst = wsp<unsigned char>(F, WS_W2T); t.fp8 = true; t.osc = W1SCALE; }
        else if (r < 2 * I2) { r -= I2; t.src = F.in[8]; t.gain = F.in[7]; t.dst = wsp<unsigned char>(F, WS_WQT); }
        else if (r < 3 * I2) { r -= 2 * I2; t.src = F.in[14]; t.gain = F.in[12]; t.dst = wsp<unsigned char>(F, WS_WGT); t.fp8 = 1; t.osc = W1SCALE; }
        else { r -= 3 * I2; t.src = F.in[13]; t.gain = nullptr; t.dst = wsp<unsigned char>(F, WS_WPT); t.K = PLE; }
    }
    t.k0 = 64 * (r / nblk); t.n0 = 64 * (r % nblk); t.dn0 = (dreg >= 0) ? dreg * AW + dsub * 64 : t.n0;
    return t;
}
DI void tp_loads(const TpIt& t, int lane, f32x4 (&v)[16], float (&g)[16]) {
    const int kr = lane >> 4, n4 = (lane & 15) * 4;
#pragma unroll
    for (int i = 0; i < 16; ++i) g[i] = t.gain ? t.gain[t.k0 + 4 * i + kr] : 1.f;
#pragma unroll
    for (int i = 0; i < 16; ++i) v[i] = __builtin_nontemporal_load((const f32x4*)(t.src + (size_t)(t.k0 + 4 * i + kr) * t.N + t.n0 + n4));
}
DI void tp_process(const TpIt& t, int lane, const f32x4 (&v)[16], const float (&g)[16], LAS float* scr) {
    const int kr = lane >> 4, n4 = (lane & 15) * 4;
#pragma unroll
    for (int i = 0; i < 16; ++i) { const int kk = 4 * i + kr; const float gg = g[i] * t.osc;
        scr[(n4 + 0) * TP_PITCH + kk] = v[i].x * gg; scr[(n4 + 1) * TP_PITCH + kk] = v[i].y * gg; scr[(n4 + 2) * TP_PITCH + kk] = v[i].z * gg; scr[(n4 + 3) * TP_PITCH + kk] = v[i].w * gg; }
    LDS_WAIT(); asm volatile("" ::: "memory");
    const int c = lane & 7, nn = lane >> 3;
    if (t.fp8) {
#pragma unroll
        for (int j = 0; j < 8; ++j) { const int n = nn + 8 * j; const LAS float* sp = scr + n * TP_PITCH + 8 * c;
            int w0 = __builtin_amdgcn_cvt_pk_fp8_f32(sp[0], sp[1], 0, false); w0 = __builtin_amdgcn_cvt_pk_fp8_f32(sp[2], sp[3], w0, true);
            int w1 = __builtin_amdgcn_cvt_pk_fp8_f32(sp[4], sp[5], 0, false); w1 = __builtin_amdgcn_cvt_pk_fp8_f32(sp[6], sp[7], w1, true);
            *(u32x2*)(t.dst + (size_t)(t.dn0 + n) * t.K + t.k0 + 8 * c) = (u32x2){(unsigned)w0, (unsigned)w1}; }
    } else {
#pragma unroll
        for (int j = 0; j < 8; ++j) { const int n = nn + 8 * j; const LAS float* sp = scr + n * TP_PITCH + 8 * c;
            u32x4 o; o.x = pk2(sp[0], sp[1]); o.y = pk2(sp[2], sp[3]); o.z = pk2(sp[4], sp[5]); o.w = pk2(sp[6], sp[7]);
            *(u32x4*)((bf16*)t.dst + (size_t)(t.dn0 + n) * t.K + t.k0 + 8 * c) = o; }
    }
    LDS_WAIT(); asm volatile("" ::: "memory");
}
DI void p0_convert4(const float* src, bf16* dst, unsigned n8, unsigned gtid, unsigned gstride) {
    for (unsigned i0 = gtid; i0 < n8; i0 += 4 * gstride) {
        f32x4 a[4], b[4];
#pragma unroll
        for (int q = 0; q < 4; ++q) { const unsigned i = i0 + q * gstride; if (i < n8) { a[q] = __builtin_nontemporal_load((const f32x4*)(src + (size_t)i * 8)); b[q] = __builtin_nontemporal_load((const f32x4*)(src + (size_t)i * 8 + 4)); } }
#pragma unroll
        for (int q = 0; q < 4; ++q) { const unsigned i = i0 + q * gstride; if (i < n8) {
            u32x4 o; o.x = pk2(a[q].x, a[q].y); o.y = pk2(a[q].z, a[q].w); o.z = pk2(b[q].x, b[q].y); o.w = pk2(b[q].z, b[q].w);
            *(u32x4*)(dst + (size_t)i * 8) = o; } }
    }
}
DI void p0_convert(const float* src, bf16* dst, size_t n8, const float* colgain, size_t gtid, size_t gstride) {
    for (size_t i = gtid; i < n8; i += gstride) {
        f32x4 a = *(const f32x4*)(src + i * 8), b = *(const f32x4*)(src + i * 8 + 4);
        if (colgain) { const int c = (int)((i * 8) & 2047); a = a * *(const f32x4*)(colgain + c); b = b * *(const f32x4*)(colgain + c + 4); }
        u32x4 o; o.x = pk2(a.x, a.y); o.y = pk2(a.z, a.w); o.z = pk2(b.x, b.y); o.w = pk2(b.z, b.w);
        *(u32x4*)(dst + i * 8) = o;
    }
}
DI void p0_convert_fp8(const float* src, unsigned char* dst, size_t nelem, const float* colgain, float scale, size_t gwave, size_t nwaves, int lane) {
    const size_t nunit = nelem / 2048;
    for (size_t u = gwave; u < nunit; u += nwaves) {
        const float* sp = src + u * 2048 + lane * 4; unsigned char* dp = dst + u * 2048 + lane * 4;
        f32x4 a[8];
#pragma unroll
        for (int q = 0; q < 8; ++q) a[q] = __builtin_nontemporal_load((const f32x4*)(sp + q * 256));
#pragma unroll
        for (int q = 0; q < 8; ++q) {
            f32x4 v = a[q];
            if (colgain) v = v * *(const f32x4*)(colgain + q * 256 + lane * 4);
            v = v * scale;
            int w = __builtin_amdgcn_cvt_pk_fp8_f32(v.x, v.y, 0, false);
            w = __builtin_amdgcn_cvt_pk_fp8_f32(v.z, v.w, w, true);
            __builtin_nontemporal_store((unsigned)w, (unsigned*)(dp + q * 256));
        }
    }
}
#ifndef TBL_H1
#define TBL_H1 1
#endif
#ifndef TBL_P7
#define TBL_P7 1
#endif
DI void tbl_load(const float* src, int row, int lane, f32x4 (&a)[8]) {
    const float* sp = src + (size_t)row * 2048 + lane * 4;
#pragma unroll
    for (int q = 0; q < 8; ++q) a[q] = __builtin_nontemporal_load((const f32x4*)(sp + q * 256));
}
DI void tbl_store(unsigned char* dst, int row, int lane, const f32x4 (&a)[8], const float* colgain, float scale) {
    unsigned char* dp = dst + (size_t)row * 2048 + lane * 4;
#pragma unroll
    for (int q = 0; q < 8; ++q) {
        f32x4 v = a[q];
        if (colgain) v = v * *(const f32x4*)(colgain + q * 256 + lane * 4);
        v = v * scale;
        int w = __builtin_amdgcn_cvt_pk_fp8_f32(v.x, v.y, 0, false);
        w = __builtin_amdgcn_cvt_pk_fp8_f32(v.z, v.w, w, true);
        __builtin_nontemporal_store((unsigned)w, (unsigned*)(dp + q * 256));
    }
}
DI void p0_prologue(Frame& F) {
    { const int g0 = F.bid * NTHREADS + F.tid; if (g0 < NH * NBLK) F.ctl[CW_GCNT + g0] = 0u; if (g0 == NH * NBLK) F.ctl[CW_SCANQ] = 0u; }
    LAS float* scr = (LAS float*)(F.lds + F.wave * TP_WAVE_BYTES);
    const int gw = F.bid * NWAVES + F.wave, NGW = F.G * NWAVES;
    const float* x = F.in[0];
    constexpr int I1 = (D_ / 64) * (NIN / 64), I2 = (D_ / 64) * (D_ / 64), IP = (PLE / 64) * (D_ / 64);
    constexpr int NITEMS = I1 + 3 * I2 + IP;
    {
        f32x4 v[16]; float g[16]; TpIt cur; int it = F.wave * F.G + F.bid; bool have = it < NITEMS;
        if (have) { cur = tp_decode(F, it); tp_loads(cur, F.lane, v, g); }
        while (have) {
            const int nx = it + NGW; const bool hn = nx < NITEMS;
            f32x4 vn[16]; float gn[16]; TpIt nxt = cur;
            if (hn) { nxt = tp_decode(F, nx); tp_loads(nxt, F.lane, vn, gn); }
            tp_process(cur, F.lane, v, g, scr);
#pragma unroll
            for (int i = 0; i < 16; ++i) { v[i] = vn[i]; g[i] = gn[i]; }
            cur = nxt; it = nx; have = hn;
        }
    }
    float* stat = wsp<float>(F, WS_STAT);
    bf16* xb = wsp<bf16>(F, WS_XB);
    const int ppb = (S_ / 2 + F.G - 1) / F.G;
    volatile LAS unsigned* rowq = (volatile LAS unsigned*)(F.lds + MISC_OFF + 61 * 4);
    for (;;) {
        unsigned k = 0;
        if (F.lane == 0) k = __hip_atomic_fetch_add((LAS unsigned*)rowq, 1u, __ATOMIC_RELAXED, __HIP_MEMORY_SCOPE_WORKGROUP);
        k = (unsigned)__builtin_amdgcn_readfirstlane((int)k);
        const int pr = F.bid * ppb + (int)k;
        if ((int)k >= ppb || pr >= S_ / 2) break;
        const int m0 = pr, m1 = pr + S_ / 2;
        f32x4 v[2][8];
#pragma unroll
        for (int q = 0; q < 2; ++q) { const f32x4* xr = (const f32x4*)(x + (size_t)(q ? m1 : m0) * D_) + F.lane;
#pragma unroll
            for (int j = 0; j < 8; ++j) v[q][j] = __builtin_nontemporal_load(xr + 64 * j); }
#pragma unroll
        for (int q = 0; q < 2; ++q) {
            const int m = q ? m1 : m0; float s = 0.f;
#pragma unroll
            for (int j = 0; j < 8; ++j) s += (v[q][j].x * v[q][j].x + v[q][j].y * v[q][j].y) + (v[q][j].z * v[q][j].z + v[q][j].w * v[q][j].w);
            s = wave_sum(s);
            if (F.lane == 0) { const float rs = __builtin_amdgcn_rsqf(s * (1.f / D_) + EPS); stat[ST_RS1 + m] = rs; stat[ST_RS1Q + m] = rs * (1.f / (XSCALE * W1SCALE)); }
            u32x2* o8 = (u32x2*)(xb + (size_t)m * D_) + F.lane;
#pragma unroll
            for (int j = 0; j < 8; ++j) { u32x2 w; w.x = pk2(v[q][j].x, v[q][j].y); w.y = pk2(v[q][j].z, v[q][j].w); o8[64 * j] = w; }
            unsigned* o4 = (unsigned*)((unsigned char*)F.out + (size_t)m * D_) + F.lane;
#pragma unroll
            for (int j = 0; j < 8; ++j) { int w = __builtin_amdgcn_cvt_pk_fp8_f32(sat8(v[q][j].x * XSCALE), sat8(v[q][j].y * XSCALE), 0, false); w = __builtin_amdgcn_cvt_pk_fp8_f32(sat8(v[q][j].z * XSCALE), sat8(v[q][j].w * XSCALE), w, true); o4[64 * j] = (unsigned)w; }
        }
    }
    const size_t gtid = (size_t)F.bid * NTHREADS + F.tid, gstride = (size_t)F.G * NTHREADS;
    p0_convert4(F.in[1], wsp<bf16>(F, WS_PB), (unsigned)(S_ * PLE / 8), (unsigned)gtid, (unsigned)gstride);
    p0_convert(F.in[9], wsp<bf16>(F, WS_SKB), (size_t)PH * 2 * NKEY * 128 / 8, nullptr, gtid, gstride);
    {
#if TBL_H1 < 1
    p0_convert_fp8(F.in[10], wsp<unsigned char>(F, WS_DOWN), (size_t)NEXP * D_, F.in[7], DSCALE, (size_t)gw, (size_t)NGW, F.lane);
#endif
#if TBL_P7 < 1
    p0_convert_fp8(F.in[11], wsp<unsigned char>(F, WS_UP), (size_t)NEXP * D_, nullptr, USCALE, (size_t)gw, (size_t)NGW, F.lane);
#endif
    }
    for (size_t i = gtid; i < 1024; i += gstride) { const float l0 = F.in[4][i], l1 = F.in[4][1024 + i]; stat[ST_LB + i] = 1.f / (1.f + __expf(l1 - l0)); }
}

template <int RBASE> struct Epi1 {
    static constexpr bool PERM = true, AFTER_DRAIN = false;
    bf16 *q, *k, *vt, *hq, *hlf, *hv, *hg; float* kpart; const float* rs1;
    template <int R> DI void run(const pg8::f32x4 (&acc)[2][2][4][2], const pg8::Unit& u, int wr, int wc, int fr, int fq, bf16* dst) const {
        const int cb = (u.pn & 3) * 256;
        const int row0 = u.pm * 256 + wr * 64 + fr;
        const int colw = cb + wc * 32 + 8 * fq;
        f32x4 cs[2][2];
        if (R == 1) { cs[0][0] = cs[0][1] = cs[1][0] = cs[1][1] = (f32x4){0.f, 0.f, 0.f, 0.f}; }
#pragma unroll
        for (int ai = 0; ai < 2; ++ai)
#pragma unroll
            for (int m = 0; m < 4; ++m) {
                const int row = row0 + ai * 128 + m * 16;
                const float rs = rs1[row];
#pragma unroll
                for (int bj = 0; bj < 2; ++bj) {
                    const f32x4 v0 = acc[ai][bj][m][0] * rs, v1 = acc[ai][bj][m][1] * rs;
                    const int col = colw + 128 * bj;
                    if (R == 1) { cs[bj][0] = cs[bj][0] + v0; cs[bj][1] = cs[bj][1] + v1; }
                    if (R == 2) {
                        bf16* p = dst + (size_t)col * S_ + row;
#pragma unroll
                        for (int i = 0; i < 4; ++i) { p[(size_t)i * S_] = (bf16)(pk2(v0[i], 0.f) & 0xffffu); p[(size_t)(i + 4) * S_] = (bf16)(pk2(v1[i], 0.f) & 0xffffu); }
                    } else {
                        u32x4 w; w.x = pk2(v0[0], v0[1]); w.y = pk2(v0[2], v0[3]); w.z = pk2(v1[0], v1[1]); w.w = pk2(v1[2], v1[3]);
                        *(u32x4*)(dst + (size_t)row * AW + col) = w;
                    }
                }
                asm volatile("" ::: "memory");
            }
        if (R == 1) {
#pragma unroll
            for (int bj = 0; bj < 2; ++bj)
#pragma unroll
                for (int n = 0; n < 2; ++n)
#pragma unroll
                    for (int i = 0; i < 4; ++i) {
                        float s = cs[bj][n][i];
                        s += __shfl_xor(s, 1); s += __shfl_xor(s, 2); s += __shfl_xor(s, 4); s += __shfl_xor(s, 8);
                        if (fr == 0) kpart[(size_t)(wr * NBLK + u.pm) * AW + colw + 128 * bj + 4 * n + i] = s;
                    }
        }
    }
    DI void operator()(const pg8::f32x4 (&acc)[2][2][4][2], const pg8::Unit& u, int wr, int wc, int fr, int fq) const {
        asm volatile("" : "+v"(fr), "+v"(fq));
        const int reg = RBASE + (u.pn >> 2);
        if constexpr (RBASE == 0) {
            if (reg == 1) run<1>(acc, u, wr, wc, fr, fq, k);
            else if (reg == 2) run<2>(acc, u, wr, wc, fr, fq, vt);
            else { bf16* dst = q; if (reg >= 3) dst = hq + (size_t)(reg - 3) * ((WS_HLF - WS_HQ) / 2); run<0>(acc, u, wr, wc, fr, fq, dst); }
        } else { bf16* dst = hq + (size_t)(reg - 3) * ((WS_HLF - WS_HQ) / 2); run<0>(acc, u, wr, wc, fr, fq, dst); }
    }
};

DI void ins3(float v, int i, float& v0, float& v1, float& v2, int& i0, int& i1, int& i2) {
    const bool c0 = v > v0, c1 = v > v1, c2 = v > v2;
    v2 = c1 ? v1 : (c2 ? v : v2); i2 = c1 ? i1 : (c2 ? i : i2);
    v1 = c0 ? v0 : (c1 ? v : v1); i1 = c0 ? i0 : (c1 ? i : i1);
    v0 = c0 ? v : v0; i0 = c0 ? i : i0;
}
DI void p2_gate(Frame& F) {
    LAS unsigned char* kmh = F.lds;
    LAS unsigned char* kml = F.lds + 64 * 272;
    LAS int* lcnt = (LAS int*)(F.lds + 2 * 64 * 272);
    LAS int* lbase = lcnt + 64;
    const float* kpart = wsp<float>(F, WS_KPART);
    const bf16* q = wsp<bf16>(F, WS_Q);
    unsigned* gcnt = F.ctl + CW_GCNT;
    int* list = wsp<int>(F, WS_LIST);
    const int tid = F.tid, lane = F.lane, w = F.wave, r = lane & 31, hh = lane >> 5;
    for (int it = F.bid; it < NH * 63; it += F.G) {
        const int h = it & 7, qb = 63 - (it >> 3);
        f32x2 kp0[8], kp1[8];
#pragma unroll
        for (int ii = 0; ii < 8; ++ii) { const int i = tid + ii * NTHREADS, n = i >> 6, d = 2 * (i & 63);
            kp0[ii] = *(const f32x2*)(kpart + (size_t)n * AW + h * HD + d); kp1[ii] = *(const f32x2*)(kpart + (size_t)(NBLK + n) * AW + h * HD + d); }
#pragma unroll
        for (int ii = 0; ii < 8; ++ii) {
            const int i = tid + ii * NTHREADS, n = i >> 6, d = 2 * (i & 63);
            f32x2 a = kp0[ii] + kp1[ii]; if (n >= qb) a = (f32x2){0.f, 0.f};
            const unsigned hi = pk2(a.x, a.y);
            const unsigned lo = pk2(a.x - bflo(hi), a.y - bfhi(hi));
            *(LAS unsigned*)(kmh + n * 272 + d * 2) = hi; *(LAS unsigned*)(kml + n * 272 + d * 2) = lo;
        }
        if (tid < 64) lcnt[tid] = 0;
        __syncthreads();
        const int t = qb * LBLK + w * 32 + r;
        bf16x8 Qf[8];
        { const bf16x8* qp = (const bf16x8*)(q + (size_t)t * AW + h * HD + 8 * hh);
#pragma unroll
          for (int s = 0; s < 8; ++s) Qf[s] = qp[2 * s]; }
        float v0 = -INFINITY, v1 = -INFINITY, v2 = -INFINITY; int i0 = -1, i1 = -1, i2 = -1;
#pragma unroll
        for (int nt = 0; nt < 2; ++nt) {
            if (nt * 32 < qb) {
                f32x16 x;
#pragma unroll
                for (int i = 0; i < 16; ++i) x[i] = 0.f;
#pragma unroll
                for (int s = 0; s < 8; ++s) {
                    const bf16x8 ah = *(const LAS bf16x8*)(kmh + (nt * 32 + r) * 272 + 32 * s + 16 * hh), al = *(const LAS bf16x8*)(kml + (nt * 32 + r) * 272 + 32 * s + 16 * hh);
                    x = __builtin_amdgcn_mfma_f32_32x32x16_bf16(ah, Qf[s], x, 0, 0, 0);
                    x = __builtin_amdgcn_mfma_f32_32x32x16_bf16(al, Qf[s], x, 0, 0, 0);
                }
#pragma unroll
                for (int i = 0; i < 16; ++i) { const int n = nt * 32 + crow(i, hh); ins3(n < qb ? x[i] : -INFINITY, n < qb ? n : -1, v0, v1, v2, i0, i1, i2); }
            }
        }
        {
            const float p0 = __shfl_xor(v0, 32), p1 = __shfl_xor(v1, 32), p2 = __shfl_xor(v2, 32);
            const int j0 = __shfl_xor(i0, 32), j1 = __shfl_xor(i1, 32), j2 = __shfl_xor(i2, 32);
            ins3(p0, j0, v0, v1, v2, i0, i1, i2);
            ins3(p1, j1, v0, v1, v2, i0, i1, i2);
            ins3(p2, j2, v0, v1, v2, i0, i1, i2);
        }
        int r0 = 0, r1 = 0, r2 = 0;
        if (hh == 0) {
            if (i0 >= 0) r0 = __hip_atomic_fetch_add(lcnt + i0, 1, __ATOMIC_RELAXED, __HIP_MEMORY_SCOPE_WORKGROUP);
            if (i1 >= 0) r1 = __hip_atomic_fetch_add(lcnt + i1, 1, __ATOMIC_RELAXED, __HIP_MEMORY_SCOPE_WORKGROUP);
            if (i2 >= 0) r2 = __hip_atomic_fetch_add(lcnt + i2, 1, __ATOMIC_RELAXED, __HIP_MEMORY_SCOPE_WORKGROUP);
        }
        __syncthreads();
        if (tid < 64) { const int c = lcnt[tid]; lbase[tid] = c ? (int)__hip_atomic_fetch_add(gcnt + h * NBLK + tid, (unsigned)c, RLX_AGENT) : 0; }
        __syncthreads();
        if (hh == 0) {
            int* lh = list + (size_t)h * LSTRIDE;
            if (i0 >= 0) lh[list_off(i0) + lbase[i0] + r0] = (t << 2) | 0;
            if (i1 >= 0) lh[list_off(i1) + lbase[i1] + r1] = (t << 2) | 1;
            if (i2 >= 0) lh[list_off(i2) + lbase[i2] + r2] = (t << 2) | 2;
        }
        __syncthreads();
    }
}

constexpr int HG_QM = 0, HG_KM = 8704, HG_QD = 17408, HG_KDT = 25856, HG_VT = 36096, HG_O = 46336, HG_TOT = 62720, HG_DL = 64768, HG_BYTES = 65280;
constexpr int HG_RS = 272, HG_RD = 264, HG_RT = 80;
static_assert(2 * HG_BYTES <= MISC_OFF, "hgrn LDS map");
DI bf16x8 pack8(const f32x16& x, int s) {
    u32x4 p; p.x = pk2(x[8 * s + 0], x[8 * s + 1]); p.y = pk2(x[8 * s + 2], x[8 * s + 3]); p.z = pk2(x[8 * s + 4], x[8 * s + 5]); p.w = pk2(x[8 * s + 6], x[8 * s + 7]);
    return __builtin_bit_cast(bf16x8, p);
}
template <bool READOUT> DI void hgrn_mfma(Frame& F) {
    const int w = F.wave, grp = w >> 2, wq = w & 3, lane = F.lane, r = lane & 31, hh = lane >> 5, p = lane;
    LAS unsigned char* L = F.lds + grp * HG_BYTES;
    const bf16* hq = wsp<bf16>(F, WS_HQ); const bf16* hlf = wsp<bf16>(F, WS_HLF); const bf16* hv = wsp<bf16>(F, WS_HV); const bf16* hg = wsp<bf16>(F, WS_HG);
    const float* lbp = wsp<float>(F, WS_STAT) + ST_LB;
    bf16* mixed = wsp<bf16>(F, WS_MIX);
    for (int base = F.bid * 2; base < NH * HSC; base += 2 * F.G) {
        const int it = base + grp, h = it & 7, sc = it >> 3;
        float* hst = wsp<float>(F, WS_HST) + ((size_t)sc * NH + h) * (HD * HD);
        f32x16 S[4];
#pragma unroll
        for (int kb = 0; kb < 4; ++kb)
#pragma unroll
            for (int i = 0; i < 16; ++i) S[kb][i] = READOUT ? hst[(unsigned)((kb * 32 + crow(i, hh)) * HD + wq * 32 + r)] : 0.f;
        const float lb0 = lbp[h * HD + 2 * p], lb1 = lbp[h * HD + 2 * p + 1];
        const int lt = wq * 64 + lane, nt = lt >> 3, nvg = lt & 7;
        f32x4 gn[4];
        if (READOUT) {
#pragma unroll
            for (int j = 0; j < 4; ++j) gn[j] = *(const f32x4*)(F.in[5] + h * HD + nvg * 16 + 4 * j);
        }
        float sumbl0 = 0.f, sumbl1 = 0.f;
        f32x4 trw[8];
        unsigned xf[8], xq[8], xv[8];
        const unsigned gcol = (unsigned)(h * HD + 2 * p);
        {   const unsigned t0 = (unsigned)(sc * HSCLEN + 8 * wq);
#pragma unroll
            for (int i = 0; i < 8; ++i) { xf[i] = *(const unsigned*)(hlf + (t0 + i) * AW + gcol); xv[i] = *(const unsigned*)(hv + (t0 + i) * AW + gcol); if (READOUT) xq[i] = *(const unsigned*)(hq + (t0 + i) * AW + gcol); } }
        for (int c = 0; c < HSCLEN / 32; ++c) {
            const int tc = sc * HSCLEN + c * 32;
            float bl0[8], bl1[8], f0[8], f1[8];
            {   float run0 = 0.f, run1 = 0.f;
#pragma unroll
                for (int i = 0; i < 8; ++i) {
                    const float fa = lb0 + (1.f - lb0) * sigmoidf_(bflo(xf[i])), fb = lb1 + (1.f - lb1) * sigmoidf_(bfhi(xf[i]));
                    run0 += __logf(fa); run1 += __logf(fb); bl0[i] = run0; bl1[i] = run1; f0[i] = fa; f1[i] = fb;
                }
                *(LAS f32x2*)(L + HG_TOT + (wq * 128 + 2 * p) * 4) = (f32x2){run0, run1};
            }
            __syncthreads();
            {
                float off0 = 0.f, off1 = 0.f, bm0, bm1, be0, be1;
                {   f32x2 tq[4];
#pragma unroll
                    for (int q = 0; q < 4; ++q) tq[q] = *(const LAS f32x2*)(L + HG_TOT + (q * 128 + 2 * p) * 4);
#pragma unroll
                    for (int q = 0; q < 4; ++q) if (q < wq) { off0 += tq[q].x; off1 += tq[q].y; }
                    bm0 = tq[0].x + tq[1].x; bm1 = tq[0].y + tq[1].y; be0 = bm0 + tq[2].x + tq[3].x; be1 = bm1 + tq[2].y + tq[3].y; }
                if (wq == 0) { *(LAS f32x2*)(L + HG_DL + 2 * p * 4) = (f32x2){__expf(be0), __expf(be1)}; sumbl0 += be0; sumbl1 += be1; }
                const float em0 = __expf(-bm0), em1 = __expf(-bm1), ek0 = __expf(bm0 - be0), ek1 = __expf(bm1 - be1);
                unsigned kd0[4], kd1[4], vt0[4], vt1[4];
#pragma unroll
                for (int i = 0; i < 8; ++i) {
                    const int t = 8 * wq + i;
                    const float b0 = bl0[i] + off0, b1 = bl1[i] + off1;
                    const float k0 = 1.f - f0[i], k1 = 1.f - f1[i];
                    const float kdv0 = k0 * __expf(be0 - b0), kdv1 = k1 * __expf(be1 - b1);
                    if (READOUT) {
                        const float q0 = siluf_(bflo(xq[i])), q1 = siluf_(bfhi(xq[i]));
                        const float qd0 = q0 * __expf(b0), qd1 = q1 * __expf(b1);
                        *(LAS unsigned*)(L + HG_QD + t * HG_RD + 4 * p) = pk2(qd0, qd1);
                        *(LAS unsigned*)(L + HG_QM + t * HG_RS + 4 * p) = pk2(qd0 * em0, qd1 * em1);
                        *(LAS unsigned*)(L + HG_KM + t * HG_RS + 4 * p) = pk2(kdv0 * ek0, kdv1 * ek1);
                    }
                    if (i & 1) { kd0[i >> 1] |= pk2(0.f, kdv0) ; kd1[i >> 1] |= pk2(0.f, kdv1); vt0[i >> 1] |= xv[i] << 16; vt1[i >> 1] |= xv[i] & 0xffff0000u; }
                    else { kd0[i >> 1] = pk2(kdv0, 0.f); kd1[i >> 1] = pk2(kdv1, 0.f); vt0[i >> 1] = xv[i] & 0xffffu; vt1[i >> 1] = xv[i] >> 16; }
                }
                *(LAS u32x4*)(L + HG_KDT + (2 * p) * HG_RT + 16 * wq) = (u32x4){kd0[0], kd0[1], kd0[2], kd0[3]};
                *(LAS u32x4*)(L + HG_KDT + (2 * p + 1) * HG_RT + 16 * wq) = (u32x4){kd1[0], kd1[1], kd1[2], kd1[3]};
                *(LAS u32x4*)(L + HG_VT + (2 * p) * HG_RT + 16 * wq) = (u32x4){vt0[0], vt0[1], vt0[2], vt0[3]};
                *(LAS u32x4*)(L + HG_VT + (2 * p + 1) * HG_RT + 16 * wq) = (u32x4){vt1[0], vt1[1], vt1[2], vt1[3]};
            }
            __syncthreads();
            if (c + 1 < HSCLEN / 32) { const unsigned t0 = (unsigned)(tc + 32 + 8 * wq);
#pragma unroll
                for (int i = 0; i < 8; ++i) { xf[i] = *(const unsigned*)(hlf + (t0 + i) * AW + gcol); xv[i] = *(const unsigned*)(hv + (t0 + i) * AW + gcol); if (READOUT) xq[i] = *(const unsigned*)(hq + (t0 + i) * AW + gcol); } }
#if TBL_H1 >= 1
            if (!READOUT) {
                const int trow = (it * 4 + wq) * (HSCLEN / 32) + c;
                if (c > 0) tbl_store(wsp<unsigned char>(F, WS_DOWN), trow - 1, lane, trw, F.in[7], DSCALE);
                tbl_load(F.in[10], trow, lane, trw);
            }
#endif
            u32x4 gg0, gg1;
            if (READOUT) { const u32x4* gp = (const u32x4*)(hg + (unsigned)((tc + nt) * AW + h * HD + nvg * 16)); gg0 = gp[0]; gg1 = gp[1]; }
            if (READOUT) {
                f32x16 X, Y;
#pragma unroll
                for (int i = 0; i < 16; ++i) { X[i] = 0.f; Y[i] = 0.f; }
#pragma unroll
                for (int st = 0; st < 8; ++st) {
                    const bf16x8 a = *(const LAS bf16x8*)(L + HG_KM + r * HG_RS + 32 * st + 16 * hh), b = *(const LAS bf16x8*)(L + HG_QM + r * HG_RS + 32 * st + 16 * hh);
                    X = __builtin_amdgcn_mfma_f32_32x32x16_bf16(a, b, X, 0, 0, 0);
                }
#pragma unroll
                for (int i = 0; i < 16; ++i) if (crow(i, hh) > r) X[i] = 0.f;
#pragma unroll
                for (int kb = 0; kb < 4; ++kb)
#pragma unroll
                    for (int st = 0; st < 2; ++st) {
                        const LAS u32x2* qp = (const LAS u32x2*)(L + HG_QD + r * HG_RD + (kb * 32 + 16 * st + 4 * hh) * 2);
                        const u32x2 a0 = qp[0], a1 = qp[2]; const u32x4 av = {a0.x, a0.y, a1.x, a1.y};
                        Y = __builtin_amdgcn_mfma_f32_32x32x16_bf16(__builtin_bit_cast(bf16x8, av), pack8(S[kb], st), Y, 0, 0, 0);
                    }
#pragma unroll
                for (int st = 0; st < 2; ++st) {
                    const LAS u32x2* vp = (const LAS u32x2*)(L + HG_VT + (wq * 32 + r) * HG_RT + (16 * st + 4 * hh) * 2);
                    const u32x2 b0 = vp[0], b1 = vp[2]; const u32x4 bv = {b0.x, b0.y, b1.x, b1.y};
                    Y = __builtin_amdgcn_mfma_f32_32x32x16_bf16(pack8(X, st), __builtin_bit_cast(bf16x8, bv), Y, 0, 0, 0);
                }
#pragma unroll
                for (int i = 0; i < 16; ++i) *(LAS float*)(L + HG_O + crow(i, hh) * 512 + (wq * 32 + r) * 4) = Y[i];
            }
#pragma unroll
            for (int kb = 0; kb < 4; ++kb) {
#pragma unroll
                for (int g4 = 0; g4 < 4; ++g4) { const f32x4 d = *(const LAS f32x4*)(L + HG_DL + (kb * 32 + 8 * g4 + 4 * hh) * 4);
#pragma unroll
                    for (int j = 0; j < 4; ++j) S[kb][4 * g4 + j] *= d[j]; }
#pragma unroll
                for (int st = 0; st < 2; ++st) {
                    const bf16x8 a = *(const LAS bf16x8*)(L + HG_KDT + (kb * 32 + r) * HG_RT + 32 * st + 16 * hh), b = *(const LAS bf16x8*)(L + HG_VT + (wq * 32 + r) * HG_RT + 32 * st + 16 * hh);
                    S[kb] = __builtin_amdgcn_mfma_f32_32x32x16_bf16(a, b, S[kb], 0, 0, 0);
                }
            }
            __syncthreads();
            if (READOUT) {
                f32x4 o[4]; float ss = 0.f;
#pragma unroll
                for (int j = 0; j < 4; ++j) { o[j] = *(const LAS f32x4*)(L + HG_O + nt * 512 + (nvg * 16 + 4 * j) * 4); ss += (o[j].x * o[j].x + o[j].y * o[j].y) + (o[j].z * o[j].z + o[j].w * o[j].w); }
                ss += __shfl_xor(ss, 1); ss += __shfl_xor(ss, 2); ss += __shfl_xor(ss, 4);
                const float rr = __builtin_amdgcn_rsqf(ss * (1.f / HD) + EPS);
                const unsigned gw[8] = {gg0.x, gg0.y, gg0.z, gg0.w, gg1.x, gg1.y, gg1.z, gg1.w};
                u32x4 o8;
#pragma unroll
                for (int j = 0; j < 4; ++j) {
                    const float g0 = siluf_(bflo(gw[2 * j])), g1 = siluf_(bfhi(gw[2 * j])), g2 = siluf_(bflo(gw[2 * j + 1])), g3 = siluf_(bfhi(gw[2 * j + 1]));
                    const float sc = rr * MSCALE;
                    int wv = __builtin_amdgcn_cvt_pk_fp8_f32(sat8(o[j].x * sc * gn[j].x * g0), sat8(o[j].y * sc * gn[j].y * g1), 0, false);
                    wv = __builtin_amdgcn_cvt_pk_fp8_f32(sat8(o[j].z * sc * gn[j].z * g2), sat8(o[j].w * sc * gn[j].w * g3), wv, true);
                    o8[j] = (unsigned)wv;
                }
                *(u32x4*)((unsigned char*)mixed + (unsigned)((tc + nt) * D_ + AW + h * HD + nvg * 16)) = o8;
            }
        }
        if (!READOUT) {
#if TBL_H1 >= 1
            tbl_store(wsp<unsigned char>(F, WS_DOWN), (it * 4 + wq) * (HSCLEN / 32) + HSCLEN / 32 - 1, lane, trw, F.in[7], DSCALE);
#endif
#pragma unroll
            for (int kb = 0; kb < 4; ++kb)
#pragma unroll
                for (int i = 0; i < 16; ++i) hst[(unsigned)((kb * 32 + crow(i, hh)) * HD + wq * 32 + r)] = S[kb][i];
            if (wq == 0) *(f32x2*)(wsp<float>(F, WS_HDEC) + ((size_t)sc * NH + h) * HD + 2 * p) = (f32x2){__expf(sumbl0), __expf(sumbl1)};
        }
        __syncthreads();
    }
}
DI void hgrn_scan(Frame& F) {
    float* hst = wsp<float>(F, WS_HST); const float* hdec = wsp<float>(F, WS_HDEC);
    unsigned* ctr = F.ctl + CW_SCANQ;
    for (;;) {
        unsigned item = 0;
        if (F.lane == 0) item = __hip_atomic_fetch_add(ctr, 1u, __ATOMIC_RELAXED, __HIP_MEMORY_SCOPE_AGENT);
        item = (unsigned)__builtin_amdgcn_readfirstlane((int)item);
        if (item >= (unsigned)(NH * HD * HD / 64)) break;
        const int e = (int)item * 64 + F.lane;
        const int hk = e >> 7;
        float cur = 0.f;
#pragma unroll 1
        for (int sc0 = 0; sc0 < HSC; sc0 += 16) {
            float tmp[16], dc[16];
#pragma unroll
            for (int j = 0; j < 16; ++j) { tmp[j] = hst[(size_t)(sc0 + j) * (NH * HD * HD) + e]; dc[j] = hdec[(size_t)(sc0 + j) * (NH * HD) + hk]; }
#pragma unroll
            for (int j = 0; j < 16; ++j) { hst[(size_t)(sc0 + j) * (NH * HD * HD) + e] = cur; cur = dc[j] * cur + tmp[j]; }
        }
    }
}

constexpr int AT_KSTR = 272, AT_VSTR = 520;
constexpr int AT_K_OFF = 0, AT_V_OFF = 256 * AT_KSTR, AT_PRE_OFF = AT_V_OFF + 128 * AT_VSTR;
static_assert(AT_PRE_OFF + (520 + 512 + 520) * 4 <= MISC_OFF, "attention LDS map");
DI void p3_attn(Frame& F) {
    LAS unsigned char* Kl = F.lds + AT_K_OFF; LAS unsigned char* Vl = F.lds + AT_V_OFF; LAS int* pre = (LAS int*)(F.lds + AT_PRE_OFF); LAS int* cntl = pre + 520;
    const bf16* q = wsp<bf16>(F, WS_Q); const bf16* kg = wsp<bf16>(F, WS_K); const bf16* vt = wsp<bf16>(F, WS_VT);
    const int* list = wsp<int>(F, WS_LIST);
    bf16* po = (bf16*)F.out;
    f32x2* pml = wsp<f32x2>(F, WS_PML);
    const unsigned* gcnt = F.ctl + CW_GCNT;
    const int tid = F.tid, lane = F.lane, w = F.wave, r = lane & 31, hh = lane >> 5;
#ifndef AT_W_FULL
#define AT_W_FULL 16
#define AT_W_HALF 12
#define AT_W_OWN 32
#define AT_W_STG 16
#endif
    LAS int* cpre = cntl + 512;
    if (w == 0) {
        int c[8], wk[8], s = 0, sc = 0;
#pragma unroll
        for (int k = 0; k < 8; ++k) { const unsigned cc = __hip_atomic_load(gcnt + lane * 8 + k, RLX_AGENT); cntl[lane * 8 + k] = (int)cc; const int L = (int)((cc + 255u) >> 8); c[k] = 1 + L; s += c[k];
            const int last = (int)cc - (L - 1) * 256;
            wk[k] = AT_W_OWN + AT_W_STG + (L > 0 ? AT_W_FULL * (L - 1) + (last > 128 ? AT_W_FULL : AT_W_HALF) : 0); sc += wk[k]; }
        int incl = s, cincl = sc;
#pragma unroll
        for (int o = 1; o < 64; o <<= 1) { const int t = __shfl_up(incl, o), tc = __shfl_up(cincl, o); if (lane >= o) { incl += t; cincl += tc; } }
        int run = incl - s, crun = cincl - sc;
#pragma unroll
        for (int k = 0; k < 8; ++k) { pre[lane * 8 + k] = run; run += c[k]; cpre[lane * 8 + k] = crun; crun += wk[k]; }
        if (lane == 63) { pre[512] = incl; cpre[512] = cincl; }
    }
    __syncthreads();
    const int total = pre[512], ctotal = cpre[512];
#define AT_CUT(target_, out_) do { const int _tg = (target_); int _l = 0, _h = 511; while (_l < _h) { const int _m = (_l + _h + 1) >> 1; if (cpre[_m] <= _tg) _l = _m; else _h = _m - 1; } \
        const int _rem = _tg - cpre[_l], _L = (cntl[_l] + 255) >> 8, _a0 = AT_W_OWN + AT_W_STG; \
        out_ = pre[_l] + ((_L > 0 && _rem >= _a0) ? 1 + min((_rem - _a0) / AT_W_FULL, _L - 1) : 0); } while (0)
    int ti0 = 0, ti1 = total;
    if (F.bid > 0) AT_CUT((int)(((long)ctotal * F.bid) / F.G), ti0);
    if (F.bid + 1 < F.G) AT_CUT((int)(((long)ctotal * (F.bid + 1)) / F.G), ti1);
#undef AT_CUT
    int staged = -1;
    unsigned pfk = 0u, pfv = 0u;
#define AT_DECODE(ti_, lo_, seg_, nvalid_) do { int _l = 0, _h = 511; while (_l < _h) { const int _m = (_l + _h + 1) >> 1; if (pre[_m] <= (ti_)) _l = _m; else _h = _m - 1; } \
        lo_ = _l; seg_ = (ti_) - pre[_l]; nvalid_ = seg_ == 0 ? 256 : min(256, cntl[_l] - (seg_ - 1) * 256); } while (0)
#define AT_ENTRY(lo_, seg_, nvalid_) (((seg_) == 0) ? ((((lo_) & 63) * LBLK + ei) << 2 | 3) : ((ei < (nvalid_)) ? list[(unsigned)(((lo_) >> 6) * LSTRIDE + list_off((lo_) & 63) + ((seg_) - 1) * 256 + ei)] : 0))
    const int qb = (w < 4) ? w : 11 - w;
    const int ei = qb * 32 + r;
    int lo = 0, seg = 0, nvalid = 0, e = 0;
    bf16x8 Qf[8];
    if (ti0 < ti1) {
        AT_DECODE(ti0, lo, seg, nvalid); e = AT_ENTRY(lo, seg, nvalid);
        const bf16x8* qp = (const bf16x8*)(q + (unsigned)((e >> 2) * AW + (lo >> 6) * HD + 8 * hh));
#pragma unroll
        for (int s = 0; s < 8; ++s) Qf[s] = qp[2 * s];
    }
    for (int ti = ti0; ti < ti1; ++ti) {
        const int h = lo >> 6, n = lo & 63;
        const bool valid = ei < nvalid;
        const bool wact = qb * 32 < nvalid;
        const int t = e >> 2, slot = e & 3;
        int lo2 = lo, seg2 = 0, nvalid2 = 0, e2 = 0;
        const bool has_next = ti + 1 < ti1;
        if (has_next) { AT_DECODE(ti + 1, lo2, seg2, nvalid2); e2 = AT_ENTRY(lo2, seg2, nvalid2); }
        if (staged != lo) {
        asm volatile("" :: "v"(pfk), "v"(pfv));
        if (staged >= 0) __syncthreads();
        staged = lo;
#pragma unroll
        for (int p = 0; p < 8; ++p) {
            const int idx = p * NTHREADS + tid;
            { const int row = idx >> 4, pc = idx & 15; const u32x4 v = *(const u32x4*)(kg + (unsigned)((n * LBLK + row) * AW + h * HD + pc * 8)); *(LAS u32x4*)(Kl + row * AT_KSTR + pc * 16) = v; }
            { const int d = idx >> 5, pc = idx & 31; const u32x4 v = *(const u32x4*)(vt + (unsigned)((h * HD + d) * S_ + n * LBLK + pc * 8));
              LAS u32x2* dst = (LAS u32x2*)(Vl + d * AT_VSTR + pc * 16); dst[0] = (u32x2){v.x, v.y}; dst[1] = (u32x2){v.z, v.w}; }
        }
        __syncthreads();
        }
        if (!wact) {
            if (has_next) {
                const bf16x8* qp = (const bf16x8*)(q + (unsigned)((e2 >> 2) * AW + (lo2 >> 6) * HD + 8 * hh));
#pragma unroll
                for (int s = 0; s < 8; ++s) Qf[s] = qp[2 * s];
            }
        } else {
        f32x16 X[8];
        bf16x8 Ac[8], An[4];
#pragma unroll
        for (int s = 0; s < 8; ++s) Ac[s] = *(const LAS bf16x8*)(Kl + r * AT_KSTR + 32 * s + 16 * hh);
#pragma unroll
        for (int kb = 0; kb < 8; ++kb) {
            if (kb < 7) {
#pragma unroll
                for (int s = 0; s < 4; ++s) An[s] = *(const LAS bf16x8*)(Kl + ((kb + 1) * 32 + r) * AT_KSTR + 32 * s + 16 * hh);
            }
            f32x16 x;
            if (seg == 0 && kb > qb) {
#pragma unroll
                for (int i = 0; i < 16; ++i) x[i] = -INFINITY;
            } else {
#pragma unroll
                for (int i = 0; i < 16; ++i) x[i] = 0.f;
                __builtin_amdgcn_s_setprio(1);
#pragma unroll
                for (int s = 0; s < 8; ++s) x = __builtin_amdgcn_mfma_f32_32x32x16_bf16(Ac[s], Qf[s], x, 0, 0, 0);
                __builtin_amdgcn_s_setprio(0);
                if (seg == 0 && kb == qb) {
#pragma unroll
                    for (int i = 0; i < 16; ++i) if (crow(i, hh) > r) x[i] = -INFINITY;
                }
            }
            X[kb] = x;
            if (kb < 7) {
#pragma unroll
                for (int s = 0; s < 4; ++s) Ac[s] = An[s];
#pragma unroll
                for (int s = 4; s < 8; ++s) Ac[s] = *(const LAS bf16x8*)(Kl + ((kb + 1) * 32 + r) * AT_KSTR + 32 * s + 16 * hh);
            }
        }
        if (has_next) {
            const bf16x8* qp = (const bf16x8*)(q + (unsigned)((e2 >> 2) * AW + (lo2 >> 6) * HD + 8 * hh));
#pragma unroll
            for (int s = 0; s < 8; ++s) Qf[s] = qp[2 * s];
        }
        float mx = -INFINITY;
#pragma unroll
        for (int kb = 0; kb < 8; ++kb)
#pragma unroll
            for (int i = 0; i < 16; ++i) mx = fmaxf(mx, X[kb][i]);
        mx = fmaxf(mx, __shfl_xor(mx, 32));
        float l = 0.f;
        u32x4 P[8][2];
#pragma unroll
        for (int kb = 0; kb < 8; ++kb) {
#pragma unroll
            for (int s2 = 0; s2 < 2; ++s2) {
                float pe[8];
#pragma unroll
                for (int j = 0; j < 8; ++j) { pe[j] = __builtin_amdgcn_exp2f(X[kb][8 * s2 + j] - mx); l += pe[j]; }
                P[kb][s2] = (u32x4){pk2(pe[0], pe[1]), pk2(pe[2], pe[3]), pk2(pe[4], pe[5]), pk2(pe[6], pe[7])};
            }
        }
        l += __shfl_xor(l, 32);
        __builtin_amdgcn_sched_barrier(0);
        f32x16 O[4];
#pragma unroll
        for (int db = 0; db < 4; ++db)
#pragma unroll
            for (int i = 0; i < 16; ++i) O[db][i] = 0.f;
#pragma unroll
        for (int kb = 0; kb < 8; ++kb) {
            if (kb == 4 && seg == 0 && qb < 4) break;
#pragma unroll
            for (int s2 = 0; s2 < 2; ++s2) {
                const bf16x8 bfrag = __builtin_bit_cast(bf16x8, P[kb][s2]);
                __builtin_amdgcn_s_setprio(1);
#pragma unroll
                for (int db = 0; db < 4; ++db) {
                    const LAS u32x2* vp = (const LAS u32x2*)(Vl + (db * 32 + r) * AT_VSTR + (kb * 32 + 16 * s2 + 4 * hh) * 2);
                    const u32x2 a0 = vp[0], a1 = vp[2];
                    const u32x4 av = {a0.x, a0.y, a1.x, a1.y};
                    O[db] = __builtin_amdgcn_mfma_f32_32x32x16_bf16(__builtin_bit_cast(bf16x8, av), bfrag, O[db], 0, 0, 0);
                }
                __builtin_amdgcn_s_setprio(0);
            }
        }
        {
            const float inv = OSCALE * __builtin_amdgcn_rcpf(l);
            unsigned char* orow = (unsigned char*)po + (unsigned)(((t * NH + h) * 4 + slot) * HD) + 16 * hh;
#pragma unroll
            for (int db = 0; db < 4; ++db) {
                unsigned pk[4];
#pragma unroll
                for (int g4 = 0; g4 < 4; ++g4) { int wv = __builtin_amdgcn_cvt_pk_fp8_f32(O[db][4 * g4 + 0] * inv, O[db][4 * g4 + 1] * inv, 0, false); wv = __builtin_amdgcn_cvt_pk_fp8_f32(O[db][4 * g4 + 2] * inv, O[db][4 * g4 + 3] * inv, wv, true); pk[g4] = (unsigned)wv; }
                const unsigned rcv0 = (unsigned)__shfl_xor((int)(hh ? pk[0] : pk[2]), 32), rcv1 = (unsigned)__shfl_xor((int)(hh ? pk[1] : pk[3]), 32);
                const u32x4 ov = hh ? (u32x4){rcv0, pk[2], rcv1, pk[3]} : (u32x4){pk[0], rcv0, pk[1], rcv1};
                if (valid) *(u32x4*)(orow + db * 32) = ov;
            }
            if (valid && hh == 0) pml[(unsigned)((t * NH + h) * 4 + slot)] = (f32x2){mx, l};
        }
        }
        if (has_next && lo2 != lo) {
            const int h2 = lo2 >> 6, n2 = lo2 & 63;
            pfk = *(const unsigned*)(kg + (unsigned)((n2 * LBLK + (tid >> 1)) * AW + h2 * HD + (tid & 1) * 64));
            pfv = *(const unsigned*)(vt + (unsigned)((h2 * HD + (tid >> 2)) * S_ + n2 * LBLK + (tid & 3) * 64));
        }
        lo = lo2; seg = seg2; nvalid = nvalid2; e = e2;
    }
    asm volatile("" :: "v"(pfk), "v"(pfv));
#undef AT_DECODE
#undef AT_ENTRY
    __syncthreads();
}

DI void p4_combine(Frame& F) {
    const bf16* po = (const bf16*)F.out; const f32x2* pml = wsp<f32x2>(F, WS_PML); bf16* mixed = wsp<bf16>(F, WS_MIX);
    const size_t total = (size_t)S_ * NH * 16, stride = (size_t)F.G * NTHREADS;
    for (size_t w0 = (size_t)F.bid * NTHREADS + F.tid; w0 < total; w0 += 4 * stride) {
        f32x2 ml[4][4]; u32x2 pv[4][4]; int nvv[4];
#pragma unroll
        for (int u = 0; u < 4; ++u) { const size_t wi = w0 + u * stride;
            if (wi < total) { const int c16 = (int)(wi & 15); const size_t th = wi >> 4; const int t = (int)(th >> 3); const int nv = min(3, t >> 8); nvv[u] = nv;
#pragma unroll
                for (int j = 0; j < 4; ++j) { const bool on = (j == 3) || (j < nv); ml[u][j] = on ? pml[th * 4 + j] : (f32x2){-INFINITY, 0.f}; pv[u][j] = on ? *(const u32x2*)((const unsigned char*)po + (th * 4 + j) * HD + c16 * 8) : (u32x2){0u, 0u}; } } }
#pragma unroll
        for (int u = 0; u < 4; ++u) { const size_t wi = w0 + u * stride;
            if (wi < total) { const int c16 = (int)(wi & 15); const size_t th = wi >> 4; const int t = (int)(th >> 3), h = (int)(th & 7); const int nv = nvv[u];
                float M = -INFINITY;
#pragma unroll
                for (int j = 0; j < 4; ++j) M = fmaxf(M, ml[u][j].x);
                float wj[4], W = 0.f;
#pragma unroll
                for (int j = 0; j < 4; ++j) { wj[j] = ((j == 3) || (j < nv)) ? __builtin_amdgcn_exp2f(ml[u][j].x - M) * ml[u][j].y : 0.f; W += wj[j]; }
                const float iW = __builtin_amdgcn_rcpf(W);
                float o[8];
#pragma unroll
                for (int i = 0; i < 8; ++i) o[i] = 0.f;
#pragma unroll
                for (int j = 0; j < 4; ++j) { const u32x2 v = pv[u][j]; const float ww = wj[j] * iW * (1.f / OSCALE);
                    const f32x2 a0 = __builtin_amdgcn_cvt_pk_f32_fp8((int)v.x, false), a1 = __builtin_amdgcn_cvt_pk_f32_fp8((int)v.x, true), a2 = __builtin_amdgcn_cvt_pk_f32_fp8((int)v.y, false), a3 = __builtin_amdgcn_cvt_pk_f32_fp8((int)v.y, true);
                    o[0] += ww * a0.x; o[1] += ww * a0.y; o[2] += ww * a1.x; o[3] += ww * a1.y; o[4] += ww * a2.x; o[5] += ww * a2.y; o[6] += ww * a3.x; o[7] += ww * a3.y; }
                int w0 = __builtin_amdgcn_cvt_pk_fp8_f32(sat8(o[0] * MSCALE), sat8(o[1] * MSCALE), 0, false); w0 = __builtin_amdgcn_cvt_pk_fp8_f32(sat8(o[2] * MSCALE), sat8(o[3] * MSCALE), w0, true);
                int w1 = __builtin_amdgcn_cvt_pk_fp8_f32(sat8(o[4] * MSCALE), sat8(o[5] * MSCALE), 0, false); w1 = __builtin_amdgcn_cvt_pk_fp8_f32(sat8(o[6] * MSCALE), sat8(o[7] * MSCALE), w1, true);
                *(u32x2*)((unsigned char*)mixed + (size_t)t * D_ + h * HD + c16 * 8) = (u32x2){(unsigned)w0, (unsigned)w1}; } }
    }
}

struct Epi2 {
    static constexpr bool PERM = true, AFTER_DRAIN = false;
    const bf16* xb; float* out; bf16* hb; float* ssq;
    DI void operator()(const pg8::f32x4 (&acc)[2][2][4][2], const pg8::Unit& u, int wr, int wc, int fr, int fq) const {
        asm volatile("" : "+v"(fr), "+v"(fq));
        const int row0 = u.pm * 256 + wr * 64 + fr, col0 = u.pn * 256 + wc * 32 + 8 * fq;
#pragma unroll
        for (int ai = 0; ai < 2; ++ai)
#pragma unroll
            for (int m = 0; m < 4; ++m) {
                const int row = row0 + ai * 128 + m * 16; const size_t off = (size_t)row * D_ + col0; float s = 0.f;
#pragma unroll
                for (int bj = 0; bj < 2; ++bj) {
                    const u32x4 xw = *(const u32x4*)(xb + off + bj * 128);
                    const f32x4 v0 = (f32x4){bflo(xw.x), bfhi(xw.x), bflo(xw.y), bfhi(xw.y)} + acc[ai][bj][m][0] * (1.f / (MSCALE * W1SCALE));
                    const f32x4 v1 = (f32x4){bflo(xw.z), bfhi(xw.z), bflo(xw.w), bfhi(xw.w)} + acc[ai][bj][m][1] * (1.f / (MSCALE * W1SCALE));
                    u32x4 b; b.x = pk2(v0[0], v0[1]); b.y = pk2(v0[2], v0[3]); b.z = pk2(v1[0], v1[1]); b.w = pk2(v1[2], v1[3]);
                    *(u32x4*)(hb + off + bj * 128) = b;
                    s += (v0[0] * v0[0] + v0[1] * v0[1]) + (v0[2] * v0[2] + v0[3] * v0[3]) + (v1[0] * v1[0] + v1[1] * v1[1]) + (v1[2] * v1[2] + v1[3] * v1[3]);
                }
                s += __shfl_xor(s, 16); s += __shfl_xor(s, 32);
                if (fq == 0) ssq[(size_t)row * 32 + u.pn * 4 + wc] = s;
                if (m & 1) asm volatile("" ::: "memory");
            }
    }
};
struct EpiB {
    static constexpr bool PERM = true, AFTER_DRAIN = false;
    bf16* O; int ldc;
    DI void operator()(const pg8::f32x4 (&acc)[2][2][4][2], const pg8::Unit& u, int wr, int wc, int fr, int fq) const {
        asm volatile("" : "+v"(fr), "+v"(fq));
        const int row0 = u.pm * 256 + wr * 64 + fr, col0 = u.pn * 256 + wc * 32 + 8 * fq;
#pragma unroll
        for (int ai = 0; ai < 2; ++ai)
#pragma unroll
            for (int m = 0; m < 4; ++m) { bf16* rowp = O + (size_t)(row0 + ai * 128 + m * 16) * ldc + col0;
#pragma unroll
                for (int bj = 0; bj < 2; ++bj) { const f32x4 v0 = acc[ai][bj][m][0], v1 = acc[ai][bj][m][1];
                    u32x4 w; w.x = pk2(v0[0], v0[1]); w.y = pk2(v0[2], v0[3]); w.z = pk2(v1[0], v1[1]); w.w = pk2(v1[2], v1[3]);
                    *(u32x4*)(rowp + bj * 128) = w; } }
    }
};
struct EpiP {
    static constexpr bool PERM = true, AFTER_DRAIN = false;
    bf16* O;
    DI void operator()(const pg8::f32x4 (&acc)[2][2][4][2], const pg8::Unit& u, int wr, int wc, int fr, int fq) const {
        asm volatile("" : "+v"(fr), "+v"(fq));
        const int row0 = u.pm * 256 + wr * 64 + fr, col0 = u.pn * 256 + wc * 32 + 8 * fq;
#pragma unroll
        for (int ai = 0; ai < 2; ++ai)
#pragma unroll
            for (int m = 0; m < 4; ++m) { const size_t off = (size_t)(row0 + ai * 128 + m * 16) * D_ + col0;
#pragma unroll
                for (int bj = 0; bj < 2; ++bj) { const f32x4 v0 = acc[ai][bj][m][0], v1 = acc[ai][bj][m][1];
                    u32x4 w; w.x = pk2(v0[0], v0[1]); w.y = pk2(v0[2], v0[3]); w.z = pk2(v1[0], v1[1]); w.w = pk2(v1[2], v1[3]);
                    *(u32x4*)(O + off + bj * 128) = w; } }
    }
};
struct Epi4 {
    static constexpr bool PERM = true, AFTER_DRAIN = false;
    bf16* h3b; const bf16* hb; const bf16* ple; const float* rs3; float* ssq;
    DI void operator()(const pg8::f32x4 (&acc)[2][2][4][2], const pg8::Unit& u, int wr, int wc, int fr, int fq) const {
        asm volatile("" : "+v"(fr), "+v"(fq));
        const int row0 = u.pm * 256 + wr * 64 + fr, col0 = u.pn * 256 + wc * 32 + 8 * fq;
#pragma unroll
        for (int ai = 0; ai < 2; ++ai)
#pragma unroll
            for (int m = 0; m < 4; ++m) {
                const int row = row0 + ai * 128 + m * 16; const size_t off = (size_t)row * D_ + col0; float s = 0.f; const float rs = rs3[row] * (1.f / (XSCALE * W1SCALE));
#pragma unroll
                for (int bj = 0; bj < 2; ++bj) {
                    const u32x4 pw = *(const u32x4*)(ple + off + bj * 128), hw = *(const u32x4*)(hb + off + bj * 128);
                    const float pv[8] = {bflo(pw.x), bfhi(pw.x), bflo(pw.y), bfhi(pw.y), bflo(pw.z), bfhi(pw.z), bflo(pw.w), bfhi(pw.w)};
                    float v[8] = {bflo(hw.x), bfhi(hw.x), bflo(hw.y), bfhi(hw.y), bflo(hw.z), bfhi(hw.z), bflo(hw.w), bfhi(hw.w)};
#pragma unroll
                    for (int i = 0; i < 4; ++i) { v[i] += sigmoidf_(acc[ai][bj][m][0][i] * rs) * pv[i]; v[4 + i] += sigmoidf_(acc[ai][bj][m][1][i] * rs) * pv[4 + i]; }
                    u32x4 o; o.x = pk2(v[0], v[1]); o.y = pk2(v[2], v[3]); o.z = pk2(v[4], v[5]); o.w = pk2(v[6], v[7]);
                    *(u32x4*)(h3b + off + bj * 128) = o;
#pragma unroll
                    for (int i = 0; i < 8; ++i) s += v[i] * v[i];
                }
                s += __shfl_xor(s, 16); s += __shfl_xor(s, 32);
                if (fq == 0) ssq[(size_t)row * 32 + u.pn * 4 + wc] = s;
                if ((m & 3) == 3) asm volatile("" ::: "memory");
            }
    }
};

DI unsigned fkey(float f, unsigned lowbits, unsigned mask) { unsigned u = __float_as_uint(f); u = (u & 0x80000000u) ? ~u : (u | 0x80000000u); return (u & ~mask) | lowbits; }
DI float fval(unsigned k, unsigned mask) { unsigned u = k & ~mask; u = (u & 0x80000000u) ? (u & 0x7fffffffu) : ~u; return __uint_as_float(u); }
template <int N> DI void bitonic_sort_desc(unsigned (&v)[N]) {
#pragma unroll
    for (int k = 2; k <= N; k <<= 1)
#pragma unroll
        for (int j = k >> 1; j > 0; j >>= 1)
#pragma unroll
            for (int i = 0; i < N; ++i) { const int l = i ^ j;
                if (l > i) { const bool desc = ((i & k) == 0); const unsigned a = v[i], b = v[l]; v[i] = desc ? max(a, b) : min(a, b); v[l] = desc ? min(a, b) : max(a, b); } }
}
DI void merge_top16(unsigned (&a)[16], const unsigned (&b)[16]) {
#pragma unroll
    for (int i = 0; i < 16; ++i) a[i] = max(a[i], b[15 - i]);
#pragma unroll
    for (int j = 8; j > 0; j >>= 1)
#pragma unroll
        for (int i = 0; i < 16; ++i) { const int l = i ^ j; if (l > i) { const unsigned x = a[i], y = a[l]; a[i] = max(x, y); a[l] = min(x, y); } }
}
DI void p7_route(Frame& F) {
    const bf16* qry = wsp<bf16>(F, WS_QRY); const bf16* skb = wsp<bf16>(F, WS_SKB);
    float* stat = wsp<float>(F, WS_STAT); const float* ssq2 = wsp<float>(F, WS_SSQ2);
    int* pidx = wsp<int>(F, WS_PIDX); float* pgate = wsp<float>(F, WS_PGATE);
    LAS unsigned* tops = (LAS unsigned*)F.lds;
    const int tid = F.tid, lane = F.lane, w = F.wave, r = lane & 31, hh = lane >> 5;
    const int tg = w & 3, p = w >> 2;
    for (int it = F.bid; it < (S_ / 128) * 2; it += F.G) {
        const int hg = it & 1, tb = it >> 1;
        const int t = tb * 128 + tg * 32 + r;
        float ss = 0.f;
        { const f32x4* sp = (const f32x4*)(ssq2 + (size_t)t * 32);
#pragma unroll
          for (int j = 0; j < 8; ++j) { const f32x4 v = sp[j]; ss += (v.x + v.y) + (v.z + v.w); } }
        const float rs2 = __builtin_amdgcn_rsqf(ss * (1.f / D_) + EPS);
        if (hg == 0 && p == 0 && hh == 0) stat[ST_RS2 + t] = rs2;
        for (int hq = 0; hq < 4; ++hq) {
            const int h = hg * 4 + hq;
#if TBL_P7 >= 1
            const int trow = ((it * NWAVES + w) * 4 + hq) * 2;
            f32x4 ta[8], tb[8];
#endif
            bf16x8 Bq[8];
            { const bf16x8* qp = (const bf16x8*)(qry + (size_t)t * D_ + h * 256 + p * 128 + 8 * hh);
#pragma unroll
              for (int s = 0; s < 8; ++s) Bq[s] = qp[2 * s]; }
            unsigned kv[4][16];
            const bf16* kbase = skb + (size_t)((h * 2 + p) * NKEY) * 128;
            bf16x8 Ak[2][8];
            { const bf16x8* ap = (const bf16x8*)(kbase + (size_t)r * 128 + 8 * hh);
#pragma unroll
              for (int s = 0; s < 8; ++s) Ak[0][s] = ap[2 * s]; }
#pragma unroll
            for (int kt = 0; kt < 4; ++kt) {
                f32x16 x;
#pragma unroll
                for (int i = 0; i < 16; ++i) x[i] = 0.f;
                if (kt < 3) { const bf16x8* ap = (const bf16x8*)(kbase + (size_t)((kt + 1) * 32 + r) * 128 + 8 * hh);
#pragma unroll
                    for (int s = 0; s < 8; ++s) Ak[(kt + 1) & 1][s] = ap[2 * s]; }
#pragma unroll
                for (int s = 0; s < 8; ++s) x = __builtin_amdgcn_mfma_f32_32x32x16_bf16(Ak[kt & 1][s], Bq[s], x, 0, 0, 0);
#pragma unroll
                for (int i = 0; i < 16; ++i) { const int key = kt * 32 + crow(i, hh); kv[kt][i] = fkey(x[i] * rs2, (unsigned)(127 - key), 127u); }
            }
#if TBL_P7 >= 1
            __builtin_amdgcn_sched_barrier(0);
            tbl_load(F.in[11], trow, lane, ta); tbl_load(F.in[11], trow + 1, lane, tb);
            __builtin_amdgcn_sched_barrier(0);
#endif
#pragma unroll
            for (int kt = 0; kt < 4; ++kt) bitonic_sort_desc<16>(kv[kt]);
            merge_top16(kv[0], kv[1]); merge_top16(kv[2], kv[3]); merge_top16(kv[0], kv[2]);
            unsigned (&tk)[16] = kv[0];
            {
                unsigned ok[16];
#pragma unroll
                for (int i = 0; i < 16; ++i) ok[i] = (unsigned)__shfl_xor((int)tk[i], 32);
                merge_top16(tk, ok);
            }
            if (hh == 0) {
                LAS u32x4* dst = (LAS u32x4*)(tops + (((tg * 32 + r) * 4 + hq) * 2 + p) * 16);
                dst[0] = (u32x4){tk[0], tk[1], tk[2], tk[3]}; dst[1] = (u32x4){tk[4], tk[5], tk[6], tk[7]}; dst[2] = (u32x4){tk[8], tk[9], tk[10], tk[11]}; dst[3] = (u32x4){tk[12], tk[13], tk[14], tk[15]};
            }
#if TBL_P7 >= 1
            __builtin_amdgcn_sched_barrier(0);
            tbl_store(wsp<unsigned char>(F, WS_UP), trow, lane, ta, nullptr, USCALE); tbl_store(wsp<unsigned char>(F, WS_UP), trow + 1, lane, tb, nullptr, USCALE);
#endif
        }
        __syncthreads();
        {
            const int tl = tid & 127, hq = tid >> 7, h = hg * 4 + hq;
            const int tt = tb * 128 + tl;
            unsigned ka[16], kb[16];
            { const LAS u32x4* s = (const LAS u32x4*)(tops + ((tl * 4 + hq) * 2) * 16);
#pragma unroll
              for (int j = 0; j < 4; ++j) { const u32x4 a = s[j], b = s[4 + j]; ka[4 * j] = a.x; ka[4 * j + 1] = a.y; ka[4 * j + 2] = a.z; ka[4 * j + 3] = a.w; kb[4 * j] = b.x; kb[4 * j + 1] = b.y; kb[4 * j + 2] = b.z; kb[4 * j + 3] = b.w; } }
            float va[16], vb[16];
#pragma unroll
            for (int i = 0; i < 16; ++i) { va[i] = fval(ka[i], 127u); vb[i] = fval(kb[i], 127u); }
            unsigned cc[4][16];
#pragma unroll
            for (int gq = 0; gq < 4; ++gq)
#pragma unroll
                for (int k = 0; k < 16; ++k) cc[gq][k] = 0u;
            {
                int cnt = 0;
#pragma unroll
                for (int i = 0; i < 16; ++i)
#pragma unroll
                    for (int j = 0; j < 16; ++j) if ((i + 1) * (j + 1) <= 16) { cc[cnt >> 4][cnt & 15] = fkey(va[i] + vb[j], (unsigned)(255 - (i * 16 + j)), 255u); ++cnt; }
            }
#pragma unroll
            for (int gq = 0; gq < 4; ++gq) bitonic_sort_desc<16>(cc[gq]);
            merge_top16(cc[0], cc[1]); merge_top16(cc[2], cc[3]); merge_top16(cc[0], cc[2]);
            unsigned (&ck)[16] = cc[0];
            float sv[16]; float mxv = -INFINITY;
#pragma unroll
            for (int i = 0; i < 16; ++i) { sv[i] = fval(ck[i], 255u); mxv = fmaxf(mxv, sv[i]); }
            float den = 0.f;
#pragma unroll
            for (int i = 0; i < 16; ++i) { sv[i] = __expf(sv[i] - mxv); den += sv[i]; }
            const float iden = __builtin_amdgcn_rcpf(den);
            int ev[16];
#pragma unroll
            for (int i = 0; i < 16; ++i) {
                const int pos = 255 - (int)(ck[i] & 255u), ci = pos >> 4, cj = pos & 15;
                unsigned ea = 0u, eb = 0u;
#pragma unroll
                for (int k = 0; k < 16; ++k) { ea = (ci == k) ? ka[k] : ea; eb = (cj == k) ? kb[k] : eb; }
                ev[i] = (int)((127u - (ea & 127u)) * 128u + (127u - (eb & 127u)));
                sv[i] *= iden;
            }
            u32x4* io = (u32x4*)(pidx + (size_t)tt * 128 + h * 16); f32x4* go = (f32x4*)(pgate + (size_t)tt * 128 + h * 16);
#pragma unroll
            for (int j = 0; j < 4; ++j) { io[j] = (u32x4){(unsigned)ev[4 * j], (unsigned)ev[4 * j + 1], (unsigned)ev[4 * j + 2], (unsigned)ev[4 * j + 3]}; go[j] = (f32x4){sv[4 * j], sv[4 * j + 1], sv[4 * j + 2], sv[4 * j + 3]}; }
        }
        __syncthreads();
    }
}

DI float gelu_erf(float v) {
    const float av = fabsf(v), t = __builtin_amdgcn_rcpf(av * 0.2316418882f + 1.0f);
    float q = t * 0.5307027145f + (-0.7265760135f); q = q * t + 0.7107068705f; q = q * t + (-0.142248368f); q = q * t + 0.127414796f; q = q * t;
    const float e = __builtin_amdgcn_exp2f((v * v) * (-0.72134752044f));
    const float m = v * (q * e);
    return v < 0.f ? m : v - m;
}
DI float dpp_xor1(float v) { return __builtin_bit_cast(float, __builtin_amdgcn_update_dpp(0, __builtin_bit_cast(int, v), 0xB1, 0xF, 0xF, false)); }
DI float dpp_xor2(float v) { return __builtin_bit_cast(float, __builtin_amdgcn_update_dpp(0, __builtin_bit_cast(int, v), 0x4E, 0xF, 0xF, false)); }
DI float dpp_xor4(float v) { int t = __builtin_amdgcn_update_dpp(0, __builtin_bit_cast(int, v), 0x141, 0xF, 0xF, false);
                             t = __builtin_amdgcn_update_dpp(0, t, 0x1B, 0xF, 0xF, false); return __builtin_bit_cast(float, t); }
DI float dpp_xor8(float v) { return __builtin_bit_cast(float, __builtin_amdgcn_update_dpp(0, __builtin_bit_cast(int, v), 0x128, 0xF, 0xF, false)); }
DI float swap32_sum(float x, float y) { asm volatile("s_nop 1\n\tv_permlane32_swap_b32 %0, %1" : "+v"(x), "+v"(y)); return x + y; }
DI float swap16_sum(float x, float y) { asm volatile("s_nop 1\n\tv_permlane16_swap_b32 %0, %1" : "+v"(x), "+v"(y)); return x + y; }
DI void p8_peer_sliced(Frame& F) {
    const unsigned char* down = wsp<unsigned char>(F, WS_DOWN); const unsigned char* up = wsp<unsigned char>(F, WS_UP);
    bf16* hb = wsp<bf16>(F, WS_H1B); float* stat = wsp<float>(F, WS_STAT); unsigned char* h2b8 = wsp<unsigned char>(F, WS_H2B8);
    const int* pidx = wsp<int>(F, WS_PIDX); const float* pgate = wsp<float>(F, WS_PGATE);
    const int lane = F.lane, g = lane >> 3, l8 = lane & 7;
    LAS unsigned char* wsB = F.lds + F.wave * 10240;
#define P8_TI(i) ((LAS int*)(wsB + (i) * 1280))
#define P8_TD(i) ((LAS float*)(wsB + (i) * 1280 + 512))
#define P8_SS(i) ((LAS float*)(wsB + (i) * 1280 + 1024))
    const int jjA = 8 * (lane & 1) + 4 * ((lane >> 1) & 1) + 2 * ((lane >> 2) & 1);
    const int posA = g * 16 + jjA;
    for (int tbase = (F.bid * NWAVES + F.wave) * 8; tbase < S_; tbase += F.G * NWAVES * 8) {
#pragma unroll
        for (int i = 0; i < 8; ++i) {
            const int e0 = pidx[(unsigned)((tbase + i) * 128 + lane)], e1 = pidx[(unsigned)((tbase + i) * 128 + 64 + lane)];
            P8_TI(i)[(lane & 7) * 16 + (lane >> 3)] = e0; P8_TI(i)[(lane & 7) * 16 + 8 + (lane >> 3)] = e1;
            P8_TD(i)[lane] = 0.f; P8_TD(i)[64 + lane] = 0.f; P8_SS(i)[lane] = 0.f;
        }
        for (int s = 0; s < 16; ++s) {
#pragma unroll 1
            for (int i = 0; i < 8; ++i) {
                int ln = lane; asm volatile("" : "+v"(ln));
                const bool b0 = ln & 1, b1 = ln & 2, b2 = ln & 4;
                u32x4 exv[4];
#pragma unroll
                for (int k = 0; k < 4; ++k) exv[k] = *(const LAS u32x4*)(P8_TI(i) + g * 16 + 4 * k);
                f32x2 hf[8];
                { const u32x4* hp = (const u32x4*)(hb + (unsigned)((tbase + i) * D_ + 128 * s + 16 * l8)); const u32x4 a = hp[0], b = hp[1];
                  hf[0] = (f32x2){bflo(a.x), bfhi(a.x)}; hf[1] = (f32x2){bflo(a.y), bfhi(a.y)}; hf[2] = (f32x2){bflo(a.z), bfhi(a.z)}; hf[3] = (f32x2){bflo(a.w), bfhi(a.w)};
                  hf[4] = (f32x2){bflo(b.x), bfhi(b.x)}; hf[5] = (f32x2){bflo(b.y), bfhi(b.y)}; hf[6] = (f32x2){bflo(b.z), bfhi(b.z)}; hf[7] = (f32x2){bflo(b.w), bfhi(b.w)}; }
                float pv[16];
                {
                    u32x4 rv[16];
#pragma unroll
                    for (int jj = 0; jj < 16; ++jj) rv[jj] = *(const u32x4*)(down + (unsigned)((int)exv[jj >> 2][jj & 3] * D_ + 128 * s + 16 * l8));
#pragma unroll
                    for (int jj = 0; jj < 16; ++jj) { f32x2 a2 = {0.f, 0.f};
#pragma unroll
                        for (int q = 0; q < 4; ++q) { a2 += hf[2 * q] * __builtin_amdgcn_cvt_pk_f32_fp8((int)rv[jj][q], false); a2 += hf[2 * q + 1] * __builtin_amdgcn_cvt_pk_f32_fp8((int)rv[jj][q], true); }
                        pv[jj] = a2.x + a2.y; }
                    __builtin_amdgcn_sched_barrier(0);
                }
                float p8[8], p4[4];
#pragma unroll
                for (int k = 0; k < 8; ++k) { const float snd = b0 ? pv[k] : pv[k + 8], kp = b0 ? pv[k + 8] : pv[k]; p8[k] = kp + dpp_xor1(snd); }
#pragma unroll
                for (int k = 0; k < 4; ++k) { const float snd = b1 ? p8[k] : p8[k + 4], kp = b1 ? p8[k + 4] : p8[k]; p4[k] = kp + dpp_xor2(snd); }
                { const float snd0 = b2 ? p4[0] : p4[2], kp0 = b2 ? p4[2] : p4[0], snd1 = b2 ? p4[1] : p4[3], kp1 = b2 ? p4[3] : p4[1];
                  LAS f32x2* td = (LAS f32x2*)(P8_TD(i) + posA); f32x2 d = *td; d.x += kp0 + dpp_xor4(snd0); d.y += kp1 + dpp_xor4(snd1); *td = d; }
            }
        }
#pragma unroll 1
        for (int i = 0; i < 8; ++i) {
            const float rs2 = stat[ST_RS2 + tbase + i] * (1.f / DSCALE);
            LAS f32x2* td = (LAS f32x2*)(P8_TD(i) + posA); f32x2 d = *td;
            d.x = gelu_erf(d.x * rs2) * pgate[(unsigned)((tbase + i) * 128 + 8 * jjA + g)] * (1.f / USCALE);
            d.y = gelu_erf(d.y * rs2) * pgate[(unsigned)((tbase + i) * 128 + 8 * (jjA + 1) + g)] * (1.f / USCALE);
            *td = d;
        }
        for (int s = 0; s < 16; ++s) {
#pragma unroll 1
            for (int i = 0; i < 8; ++i) {
                int ln = lane; asm volatile("" : "+v"(ln));
                const bool b3 = ln & 8;
                u32x4 exv[4]; f32x4 avv[4];
#pragma unroll
                for (int k = 0; k < 4; ++k) { exv[k] = *(const LAS u32x4*)(P8_TI(i) + g * 16 + 4 * k); avv[k] = *(const LAS f32x4*)(P8_TD(i) + g * 16 + 4 * k); }
                f32x2 acc2[8];
#pragma unroll
                for (int k = 0; k < 8; ++k) acc2[k] = (f32x2){0.f, 0.f};
                {
                    u32x4 rv[16];
#pragma unroll
                    for (int jj = 0; jj < 16; ++jj) rv[jj] = *(const u32x4*)(up + (unsigned)((int)exv[jj >> 2][jj & 3] * D_ + 128 * s + 16 * l8));
#pragma unroll
                    for (int jj = 0; jj < 16; ++jj) { const float av = avv[jj >> 2][jj & 3]; const f32x2 a2 = {av, av};
#pragma unroll
                        for (int q = 0; q < 4; ++q) { acc2[2 * q] += a2 * __builtin_amdgcn_cvt_pk_f32_fp8((int)rv[jj][q], false); acc2[2 * q + 1] += a2 * __builtin_amdgcn_cvt_pk_f32_fp8((int)rv[jj][q], true); } }
                    __builtin_amdgcn_sched_barrier(0);
                }
                float acc[16];
#pragma unroll
                for (int k = 0; k < 8; ++k) { acc[2 * k] = acc2[k].x; acc[2 * k + 1] = acc2[k].y; }
                float p8[8], p4[4];
#pragma unroll
                for (int k = 0; k < 8; ++k) p8[k] = swap32_sum(acc[k], acc[k + 8]);
#pragma unroll
                for (int k = 0; k < 4; ++k) p4[k] = swap16_sum(p8[k], p8[k + 4]);
                const float snd0 = b3 ? p4[0] : p4[2], kp0 = b3 ? p4[2] : p4[0], snd1 = b3 ? p4[1] : p4[3], kp1 = b3 ? p4[3] : p4[1];
                const float o0 = kp0 + dpp_xor8(snd0), o1 = kp1 + dpp_xor8(snd1);
                const unsigned off = (unsigned)((tbase + i) * D_ + 128 * s + 16 * l8 + 2 * g);
                const unsigned hw = *(const unsigned*)(hb + off);
                f32x2 x = {bflo(hw) + o0, bfhi(hw) + o1};
                *(unsigned*)(hb + off) = pk2(x.x, x.y);
                *(unsigned short*)(h2b8 + off) = (unsigned short)__builtin_amdgcn_cvt_pk_fp8_f32(sat8(x.x * XSCALE), sat8(x.y * XSCALE), 0, false);
                P8_SS(i)[lane] += x.x * x.x + x.y * x.y;
            }
        }
#pragma unroll 1
        for (int i = 0; i < 8; ++i) { const float ss = wave_sum(P8_SS(i)[lane]); if (lane == 0) stat[ST_RS3 + tbase + i] = 1.f / sqrtf(ss * (1.f / D_) + EPS); }
    }
#undef P8_TI
#undef P8_TD
#undef P8_SS
}

DI void p10_final(Frame& F) {
    const float* ssq4 = wsp<float>(F, WS_SSQ4); const float* gain = F.in[15]; const bf16* h3b = wsp<bf16>(F, WS_QRY);
    const int NGW = F.G * NWAVES;
    f32x4 gr[8];
#pragma unroll
    for (int j = 0; j < 4; ++j) { gr[2 * j] = ((const f32x4*)gain)[2 * F.lane + 128 * j]; gr[2 * j + 1] = ((const f32x4*)gain)[2 * F.lane + 128 * j + 1]; }
    for (int m0 = F.bid * NWAVES + F.wave; m0 < S_; m0 += 4 * NGW) {
        float sv[4]; u32x4 w[4][4];
#pragma unroll
        for (int u = 0; u < 4; ++u) { const int m = m0 + u * NGW;
            if (m < S_) { sv[u] = (F.lane < 32) ? ssq4[(size_t)m * 32 + F.lane] : 0.f; const u32x4* hr = (const u32x4*)(h3b + (size_t)m * D_) + F.lane;
#pragma unroll
                for (int j = 0; j < 4; ++j) w[u][j] = hr[64 * j]; } }
#pragma unroll
        for (int u = 0; u < 4; ++u) { const int m = m0 + u * NGW;
            if (m < S_) { const float rs = __builtin_amdgcn_rsqf(wave_sum(sv[u]) * (1.f / D_) + EPS); f32x4* xr = (f32x4*)(F.out + (size_t)m * D_) + 2 * F.lane;
#pragma unroll
                for (int j = 0; j < 4; ++j) { const u32x4 ww = w[u][j];
                    xr[128 * j] = (f32x4){bflo(ww.x), bfhi(ww.x), bflo(ww.y), bfhi(ww.y)} * rs * gr[2 * j];
                    xr[128 * j + 1] = (f32x4){bflo(ww.z), bfhi(ww.z), bflo(ww.w), bfhi(ww.w)} * rs * gr[2 * j + 1]; } } }
    }
}

constexpr int NPHASES = 11;
struct Args { const float* in[16]; float* out; unsigned char* ws; int ph_lo, ph_hi; };
DI int lane_id() { return (int)__builtin_amdgcn_mbcnt_hi(~0u, __builtin_amdgcn_mbcnt_lo(~0u, 0u)); }
DI Frame make_frame(LAS unsigned char* lds, int wave0) {
    typedef const Args __attribute__((address_space(4))) * cargs_t;
    cargs_t ap = (cargs_t)__builtin_amdgcn_kernarg_segment_ptr();
    asm volatile("" : "+s"(ap));
    Frame F;
    F.lds = lds;
    F.tid = threadIdx.x; F.lane = F.tid & 63; F.wave = __builtin_amdgcn_readfirstlane(F.tid >> 6); (void)wave0;
    F.G = gridDim.x; F.bid = blockIdx.x;
#pragma unroll
    for (int i = 0; i < 16; ++i) F.in[i] = ap->in[i];
    F.out = ap->out; F.ws = ap->ws; F.ctl = (unsigned*)(ap->ws + WS_CTL);
    return F;
}
__global__ void __launch_bounds__(NTHREADS, 2) mega_fwd(Args args) {
    extern __shared__ __attribute__((aligned(16))) unsigned char lds_[];
    LAS unsigned char* lds = (LAS unsigned char*)lds_;
    volatile LAS unsigned* MISC = (volatile LAS unsigned*)(lds + MISC_OFF);
    const int wave0 = __builtin_amdgcn_readfirstlane(threadIdx.x >> 6);
    if (threadIdx.x < 64) MISC[threadIdx.x] = 0u;
    __syncthreads();
    const int lo = args.ph_lo, hi = args.ph_hi;
    XcdBarrier bar; bar.bar = g_barw; bar.x = 0; bar.st = nullptr;
    if (hi - lo > 1) bar = xcd_barrier_post(g_barw, MISC + 8, (int)threadIdx.x);
#ifdef ONLY_PHASE
#define IN(k) ((k) == ONLY_PHASE && lo <= (k) && (k) < hi)
#else
#define IN(k) (lo <= (k) && (k) < hi)
#endif
#ifdef TIME_PHASE
#define STAMP(k) do { if (blockIdx.x == 0 && threadIdx.x == 0) { const unsigned long long _t = __builtin_amdgcn_s_memrealtime(); MISC[16 + 2 * (k)] = (unsigned)_t; MISC[17 + 2 * (k)] = (unsigned)(_t >> 32); } } while (0)
#else
#define STAMP(k) do { } while (0)
#endif
#define SEAM(k) do { if (IN(k) && IN((k) + 1)) xcd_barrier(bar, (int)threadIdx.x); STAMP((k) + 1); } while (0)
    STAMP(0);

    if (IN(0)) { Frame F = make_frame(lds, wave0); p0_prologue(F); }
    SEAM(0);
    if (IN(1)) {
        Frame F = make_frame(lds, wave0);
        const float* stat = wsp<float>(F, WS_STAT);
        {
            pg8::Gemm g{(const bf16*)F.out, wsp<bf16>(F, WS_W1T), S_, 7 * AW, D_ / 2}; pg8::StaticOrder S; S.init(S_, 7 * AW, F.G, F.bid);
            Epi1<0> E{wsp<bf16>(F, WS_Q), wsp<bf16>(F, WS_K), wsp<bf16>(F, WS_VT), wsp<bf16>(F, WS_HQ), wsp<bf16>(F, WS_HLF), wsp<bf16>(F, WS_HV), wsp<bf16>(F, WS_HG), wsp<float>(F, WS_KPART), stat + ST_RS1Q};
            pg8::gemm_phase<Epi1<0>, pg8::StaticOrder, PG8_ALIGN, PG8_SP2, true>(F.lds, g, S, E, F.tid); }
    }
    SEAM(1);
    if (IN(2)) {
        Frame F = make_frame(lds, wave0);
        p2_gate(F);
        hgrn_mfma<false>(F);
    }
    SEAM(2);
    if (IN(3)) { Frame F = make_frame(lds, wave0); p3_attn(F);
        hgrn_scan(F); }
    SEAM(3);
    if (IN(4)) {
        Frame F = make_frame(lds, wave0);
        p4_combine(F);
        hgrn_mfma<true>(F);
    }
    SEAM(4);
    if (IN(5)) {
        Frame F = make_frame(lds, wave0);
        pg8::Gemm g{wsp<bf16>(F, WS_MIX), wsp<bf16>(F, WS_W2T), S_, D_, D_ / 2}; pg8::StaticOrder S; S.init(S_, D_, F.G, F.bid);
        Epi2 E{wsp<bf16>(F, WS_XB), F.out, wsp<bf16>(F, WS_H1B), wsp<float>(F, WS_SSQ2)};
        pg8::gemm_phase<Epi2, pg8::StaticOrder, PG8_ALIGN, PG8_SP2, true>(F.lds, g, S, E, F.tid);
    }
    SEAM(5);
    if (IN(6)) {
        Frame F = make_frame(lds, wave0);
        pg8::Gemm g{wsp<bf16>(F, WS_H1B), wsp<bf16>(F, WS_WQT), S_, D_, D_}; pg8::StaticOrder S; S.init(S_, D_, F.G, F.bid);
        EpiB E{wsp<bf16>(F, WS_QRY), D_};
        pg8::gemm_phase<EpiB, pg8::StaticOrder, PG8_ALIGN, PG8_SP2>(F.lds, g, S, E, F.tid);
    }
    SEAM(6);
    if (IN(7)) { Frame F = make_frame(lds, wave0); p7_route(F); }
    SEAM(7);
    if (IN(8)) { Frame F = make_frame(lds, wave0); p8_peer_sliced(F); }
    SEAM(8);
    if (IN(9)) {
        { Frame F = make_frame(lds, wave0); pg8::StaticOrder S; S.init(S_, D_, F.G, F.bid);
          pg8::Gemm g{wsp<bf16>(F, WS_PB), wsp<bf16>(F, WS_WPT), S_, D_, PLE}; EpiP E{wsp<bf16>(F, WS_PLE)};
          pg8::gemm_phase<EpiP, pg8::StaticOrder, PG8_ALIGN, PG8_SP2>(F.lds, g, S, E, F.tid); }
        { Frame F = make_frame(lds, wave0); pg8::StaticOrder S; S.init(S_, D_, F.G, F.bid);
          pg8::Gemm g{wsp<bf16>(F, WS_H2B8), wsp<bf16>(F, WS_WGT), S_, D_, D_ / 2}; Epi4 E{wsp<bf16>(F, WS_QRY), wsp<bf16>(F, WS_H1B), wsp<bf16>(F, WS_PLE), wsp<float>(F, WS_STAT) + ST_RS3, wsp<float>(F, WS_SSQ4)};
          pg8::gemm_phase<Epi4, pg8::StaticOrder, PG8_ALIGN, PG8_SP2, true>(F.lds, g, S, E, F.tid); }
    }
    SEAM(9);
    if (IN(10)) { Frame F = make_frame(lds, wave0); p10_final(F); }
#ifdef TIME_PHASE
    if (blockIdx.x == 0) {
        __syncthreads();
        if (threadIdx.x == 0) {
            const unsigned long long tend = __builtin_amdgcn_s_memrealtime();
            const unsigned long long a = ((unsigned long long)MISC[17 + 2 * TIME_PHASE] << 32) | MISC[16 + 2 * TIME_PHASE];
            const unsigned long long b = (TIME_PHASE == 10) ? tend : (((unsigned long long)MISC[19 + 2 * TIME_PHASE] << 32) | MISC[18 + 2 * TIME_PHASE]);
            const unsigned long long wait = 10ull * (b - a);
            while (__builtin_amdgcn_s_memrealtime() - tend < wait) __builtin_amdgcn_s_sleep(32);
        }
    }
#endif
#undef IN
#undef SEAM
    if (hi - lo > 1) {
        __syncthreads();
        if (threadIdx.x == 0) MISC[62] = (xb_add(&g_barw[XCD_BAR_WORDS], 1u) + 1u == gridDim.x) ? 1u : 0u;
        __syncthreads();
        if (MISC[62]) { for (int i = threadIdx.x; i < XCD_BAR_WORDS + 64; i += NTHREADS) __hip_atomic_store(&g_barw[i], 0u, __ATOMIC_RELAXED, __HIP_MEMORY_SCOPE_AGENT); }
    }
}

extern "C" void kernel_launch(void* const* d_in, const int* in_sizes, int n_in, void* d_out, int out_size, void* d_ws, size_t ws_size, hipStream_t stream) {
    static int grid = 0;
    if (grid == 0) {
        if (n_in != 16 || out_size != S_ * D_ || ws_size < WS_END) { fprintf(stderr, "kernel_launch: unexpected problem (n_in %d, out %d, ws %zu < %zu)\n", n_in, out_size, ws_size, (size_t)WS_END); grid = -1; return; }
        int dev = 0, cus = 0, per_cu = 0;
        if (hipGetDevice(&dev) != hipSuccess || hipDeviceGetAttribute(&cus, hipDeviceAttributeMultiprocessorCount, dev) != hipSuccess) { grid = -1; return; }
        if (hipFuncSetAttribute((const void*)mega_fwd, hipFuncAttributeMaxDynamicSharedMemorySize, LDS_BYTES) != hipSuccess) { fprintf(stderr, "kernel_launch: hipFuncSetAttribute failed\n"); grid = -1; return; }
        if (hipOccupancyMaxActiveBlocksPerMultiprocessor(&per_cu, (const void*)mega_fwd, NTHREADS, LDS_BYTES) != hipSuccess || per_cu < 1) { fprintf(stderr, "kernel_launch: occupancy query says %d\n", per_cu); (void)hipGetLastError(); }
        grid = cus;
    }
    if (grid < 0) return;
#if MK_PER_PHASE
    (void)hipMemsetAsync((char*)d_ws + WS_CTL, 0, CTL_ZERO_BYTES, stream);
#endif
    Args a{};
    for (int i = 0; i < 16; ++i) a.in[i] = (const float*)d_in[i];
    a.out = (float*)d_out; a.ws = (unsigned char*)d_ws;
#if MK_PER_PHASE
    for (int ph = 0; ph < NPHASES; ++ph) {
        a.ph_lo = ph; a.ph_hi = ph + 1;
        hipLaunchKernelGGL(mega_fwd, dim3(grid), dim3(NTHREADS), LDS_BYTES, stream, a);
    }
#else
    a.ph_lo = 0; a.ph_hi = NPHASES;
    void* kargs[] = {&a};
    hipError_t e = hipLaunchCooperativeKernel((const void*)mega_fwd, dim3(grid), dim3(NTHREADS), kargs, LDS_BYTES, stream);
    if (e != hipSuccess) fprintf(stderr, "kernel_launch: cooperative launch failed: %s\n", hipGetErrorString(e));
#endif
}
```
